# Optimizing an MI355X kernel written in HIP

```python
import math
import jax
import jax.numpy as jnp
from jax import lax
import numpy as np

D_MODEL = 2048
BATCH = 8
SEQ = 4096
DEPTH = 4

CHUNK = 64
Q_BLOCK = 128
NORM_EPS = 1e-6
ROPE_THETA = 10000.0

FOX_HEADS = 6
FOX_DH = 128
FOX_W = FOX_HEADS * FOX_DH
FORGET_BIAS_CENTER = 3.0

MLA_HEADS = 6
MLA_NOPE = 128
MLA_ROPE = 64
MLA_V = 128
MLA_Q_LORA = 512
MLA_KV_LORA = 256
MLA_W = MLA_HEADS * MLA_V

RET_HEADS = 4
RET_DK = 128
RET_DV = 256
RET_QK_W = RET_HEADS * RET_DK
RET_V_W = RET_HEADS * RET_DV

N_BRANCH = 3

D_FF = 5632
CONV_W = 3

IN_SPLITS = (FOX_W, FOX_W, FOX_W, FOX_HEADS,
             MLA_Q_LORA, MLA_KV_LORA, MLA_ROPE,
             RET_QK_W, RET_QK_W, RET_V_W, RET_V_W,
             N_BRANCH * D_MODEL)
IN_WIDTH = sum(IN_SPLITS)

kernel_name = 'hybrid_fox_mla_retention_convffn'


def rms_norm(x, g):
    xf = x.astype(jnp.float32)
    y = xf * lax.rsqrt(jnp.mean(xf * xf, axis=-1, keepdims=True) + NORM_EPS)
    return (y * g.astype(jnp.float32)).astype(x.dtype)


def apply_rope(x):
    s, d = x.shape[1], x.shape[-1]
    pos = jnp.arange(s, dtype=jnp.float32)
    inv_freq = ROPE_THETA ** (-jnp.arange(0, d, 2, dtype=jnp.float32) / d)
    ang = pos[:, None] * inv_freq[None, :]
    cos = jnp.cos(ang)[None, :, None, :]
    sin = jnp.sin(ang)[None, :, None, :]
    xf = x.astype(jnp.float32)
    x1, x2 = xf[..., : d // 2], xf[..., d // 2:]
    return jnp.concatenate([x1 * cos - x2 * sin, x2 * cos + x1 * sin], axis=-1).astype(x.dtype)


def block_attention(q, k, v, scale, frame_causal, log_decay_cum):
    s_len = q.shape[2]
    outs = []
    for s0 in range(0, s_len, Q_BLOCK):
        s1 = s0 + Q_BLOCK
        logits = jnp.einsum('bhqd,bhkd->bhqk', q[:, :, s0:s1], k[:, :, :s1]).astype(jnp.float32) * scale
        if log_decay_cum is not None:
            logits = logits + log_decay_cum[:, :, s0:s1, None] - log_decay_cum[:, :, None, :s1]
        q_pos = jnp.arange(s0, s1)
        k_pos = jnp.arange(s1)
        if frame_causal:
            mask = k_pos[None, :] <= q_pos[:, None]
        else:
            mask = (k_pos // CHUNK)[None, :] <= (q_pos // CHUNK)[:, None]
        p = jax.nn.softmax(jnp.where(mask, logits, -jnp.inf), axis=-1).astype(v.dtype)
        outs.append(jnp.einsum('bhqk,bhkd->bhqd', p, v[:, :, :s1]))
    return jnp.concatenate(outs, axis=2)


def fox_mixer(q, k, v, f_logit, b_f):
    b, s = q.shape[:2]
    def heads(t):
        return t.reshape(b, s, FOX_HEADS, FOX_DH).transpose(0, 2, 1, 3)
    log_f = jax.nn.log_sigmoid(f_logit.astype(jnp.float32) + b_f.astype(jnp.float32))
    c = jnp.cumsum(log_f, axis=1).transpose(0, 2, 1)
    o = block_attention(heads(q), heads(k), heads(v), FOX_DH ** -0.5, True, c)
    return o.transpose(0, 2, 1, 3).reshape(b, s, FOX_W)


def mla_mixer(c_q, c_kv, k_rope, q_norm_g, kv_norm_g, w_uq, w_ukv):
    b, s = c_q.shape[:2]
    q = (rms_norm(c_q, q_norm_g) @ w_uq).reshape(b, s, MLA_HEADS, MLA_NOPE + MLA_ROPE)
    q = jnp.concatenate([q[..., :MLA_NOPE], apply_rope(q[..., MLA_NOPE:])], axis=-1)
    kv = (rms_norm(c_kv, kv_norm_g) @ w_ukv).reshape(b, s, MLA_HEADS, MLA_NOPE + MLA_V)
    k_nope, v = kv[..., :MLA_NOPE], kv[..., MLA_NOPE:]
    k_r = apply_rope(k_rope[:, :, None, :])
    k = jnp.concatenate([k_nope, jnp.broadcast_to(k_r, (b, s, MLA_HEADS, MLA_ROPE))], axis=-1)
    o = block_attention(q.transpose(0, 2, 1, 3), k.transpose(0, 2, 1, 3), v.transpose(0, 2, 1, 3),
                        (MLA_NOPE + MLA_ROPE) ** -0.5, False, None)
    return o.transpose(0, 2, 1, 3).reshape(b, s, MLA_W)


def retention_mixer(q, k, v, g):
    b, s = q.shape[:2]
    n = s // CHUNK
    dt = v.dtype
    q = apply_rope(q.reshape(b, s, RET_HEADS, RET_DK))
    k = apply_rope(k.reshape(b, s, RET_HEADS, RET_DK)) * (RET_DK ** -0.5)
    qc = q.reshape(b, n, CHUNK, RET_HEADS, RET_DK)
    kc = k.reshape(b, n, CHUNK, RET_HEADS, RET_DK)
    vc = v.reshape(b, n, CHUNK, RET_HEADS, RET_DV)
    log_gamma = jnp.log(1.0 - 2.0 ** (-5.0 - jnp.arange(RET_HEADS, dtype=jnp.float32)))
    idx = jnp.arange(CHUNK, dtype=jnp.float32)
    intra_decay = jnp.exp(log_gamma[:, None, None] * jnp.abs(idx[:, None] - idx[None, :]))
    state_in = jnp.exp(log_gamma[:, None] * (CHUNK - 1 - idx)[None, :])
    cross_decay = jnp.exp(log_gamma[:, None] * (idx + 1.0)[None, :])
    chunk_decay = jnp.exp(log_gamma * CHUNK)
    scores = jnp.einsum('bnjhd,bnlhd->bnhjl', qc, kc) * intra_decay.astype(dt)
    intra = jnp.einsum('bnhjl,bnlhe->bnjhe', scores, vc)
    kv_chunk = jnp.einsum('bnlhd,hl,bnlhe->nbhde', kc, state_in.astype(dt), vc).astype(jnp.float32)
    def step(state, kv_n):
        return chunk_decay[None, :, None, None] * state + kv_n, state
    _, prev = lax.scan(step, jnp.zeros((b, RET_HEADS, RET_DK, RET_DV), jnp.float32), kv_chunk)
    cross = jnp.einsum('bnjhd,nbhde->bnjhe', qc, prev.astype(dt)) * cross_decay.T[None, None, :, :, None].astype(dt)
    o = (intra + cross).reshape(b, s, RET_HEADS, RET_DV).astype(jnp.float32)
    o = o * lax.rsqrt(jnp.mean(o * o, axis=-1, keepdims=True) + NORM_EPS)
    return o.reshape(b, s, RET_V_W).astype(dt) * jax.nn.silu(g)


def conv_ffn(h, w_up, w_gate, conv_w, conv_b, w_down):
    s = h.shape[1]
    u = h @ w_up
    u_pad = jnp.pad(u, ((0, 0), (CONV_W - 1, 0), (0, 0)))
    u_conv = conv_b + sum(conv_w[i] * u_pad[:, i:i + s] for i in range(CONV_W))
    return (jax.nn.gelu(u_conv) * (h @ w_gate)) @ w_down


def _normal(key, shape, fan_in):
    return jax.random.normal(key, shape, jnp.float32) * (fan_in ** -0.5)


def _gain(key, shape):
    return 1.0 + 0.02 * jax.random.normal(key, shape, jnp.float32)


def setup_inputs(seed: int = 0) -> dict:
    key = jax.random.key(seed)
    ks = jax.random.split(key, 20)
    L, D = DEPTH, D_MODEL
    return {
        'x': jax.random.normal(ks[0], (BATCH, SEQ, D), jnp.float32),
        'norm1_g': _gain(ks[1], (L, D)),
        'w_in': _normal(ks[2], (L, D, IN_WIDTH), D),
        'mla_q_norm_g': _gain(ks[3], (L, MLA_Q_LORA)),
        'mla_kv_norm_g': _gain(ks[4], (L, MLA_KV_LORA)),
        'mla_w_uq': _normal(ks[5], (L, MLA_Q_LORA, MLA_HEADS * (MLA_NOPE + MLA_ROPE)), MLA_Q_LORA),
        'mla_w_ukv': _normal(ks[6], (L, MLA_KV_LORA, MLA_HEADS * (MLA_NOPE + MLA_V)), MLA_KV_LORA),
        'fox_b_f': FORGET_BIAS_CENTER + 0.1 * jax.random.normal(ks[7], (L, FOX_HEADS), jnp.float32),
        'w_br_fox': _normal(ks[8], (L, FOX_W, D), FOX_W),
        'w_br_mla': _normal(ks[9], (L, MLA_W, D), MLA_W),
        'w_br_ret': _normal(ks[10], (L, RET_V_W, D), RET_V_W),
        'w_out': _normal(ks[11], (L, D, D), D),
        'norm2_g': _gain(ks[12], (L, D)),
        'ffn_w_up': _normal(ks[13], (L, D, D_FF), D),
        'ffn_w_gate': _normal(ks[14], (L, D, D_FF), D),
        'ffn_conv_w': _normal(ks[15], (L, CONV_W, D_FF), CONV_W),
        'ffn_conv_b': 0.02 * jax.random.normal(ks[16], (L, D_FF), jnp.float32),
        'ffn_w_down': _normal(ks[17], (L, D_FF, D), D_FF),
        'final_norm_g': _gain(ks[18], (D,)),
    }


def reference(x, norm1_g, w_in, mla_q_norm_g, mla_kv_norm_g, mla_w_uq, mla_w_ukv, fox_b_f,
              w_br_fox, w_br_mla, w_br_ret, w_out, norm2_g, ffn_w_up, ffn_w_gate,
              ffn_conv_w, ffn_conv_b, ffn_w_down, final_norm_g):
    b, s, d = x.shape
    split_points = [int(p) for p in np.cumsum(IN_SPLITS)[:-1]]
    for i in range(DEPTH):
        h = rms_norm(x, norm1_g[i])
        (fq, fk, fv, ff, mq, mkv, mkr, rq, rk, rv, rg, gates) = jnp.split(h @ w_in[i], split_points, axis=-1)
        a = fox_mixer(fq, fk, fv, ff, fox_b_f[i])
        bm = mla_mixer(mq, mkv, mkr, mla_q_norm_g[i], mla_kv_norm_g[i], mla_w_uq[i], mla_w_ukv[i])
        c = retention_mixer(rq, rk, rv, rg)
        g = jax.nn.sigmoid(gates.astype(jnp.float32)).astype(x.dtype).reshape(b, s, N_BRANCH, d)
        merged = (g[:, :, 0] * (a @ w_br_fox[i])
                  + g[:, :, 1] * (bm @ w_br_mla[i])
                  + g[:, :, 2] * (c @ w_br_ret[i]))
        x = x + merged @ w_out[i]
        x = x + conv_ffn(rms_norm(x, norm2_g[i]), ffn_w_up[i], ffn_w_gate[i],
                         ffn_conv_w[i], ffn_conv_b[i], ffn_w_down[i])
    return rms_norm(x, final_norm_g)
```

```cpp
#include <hip/hip_runtime.h>
#include <cstdio>
#include <cstdint>
#include <cmath>
#ifndef MK_PER_PHASE
#define MK_PER_PHASE 0
#endif
#include <cstring>
namespace pg8 {
#define PG8_LAS __attribute__((address_space(3)))
typedef unsigned short bf16_t;
typedef short bf16x8 __attribute__((ext_vector_type(8)));
typedef float f32x4 __attribute__((ext_vector_type(4)));
typedef unsigned u32x4 __attribute__((ext_vector_type(4)));
constexpr int BM = 256, BK = 64, HALF = 128, HTB = HALF * BK * 2  , STAGE_BYTES = 8 * HTB, NXCD = 8, WGM = 8;

__host__ __device__ __forceinline__ int lds_byte(int r, int c) { const int st = (r >> 4) * 2 + (c >> 5), rr = r & 15, cc = c & 31, ob = rr * 64 + cc * 2; return st * 1024 + (ob ^ (((ob >> 9) & 1) << 5)); }
__host__ __device__ __forceinline__ void stage_rc(int b, int& R, int& C) { const int st = b / 1024, sb = b % 1024, swz = sb ^ (((sb >> 9) & 1) << 5); R = (st >> 1) * 16 + swz / 64; C = (st & 1) * 32 + (swz % 64) / 2; }
__host__ __device__ __forceinline__ int perm32(int rho) { const int n = rho >> 4, i = rho & 15; return 8 * (i >> 2) + 4 * n + (i & 3); }

struct Unit { int pm, pn; };
struct Gemm { const bf16_t* A; const bf16_t* Bt; int M, N, K; };

struct StaticOrder {
    int nM, nN, nwg, G, c;
    __host__ __device__ void init(int M, int N, int G_, int c_) { nM = M / BM; nN = N / BM; nwg = nM * nN; G = G_; c = c_; }
    __host__ __device__ bool next(int i, Unit& u) const {
        const long L = (long)i * G + c; if (L >= nwg) return false;
        int wgid = (int)L; { const int q = nwg / NXCD, r = nwg % NXCD, xcd = wgid % NXCD, off = wgid / NXCD; wgid = (xcd < r ? xcd * (q + 1) : r * (q + 1) + (xcd - r) * q) + off; }
        const int nig = WGM * nN, gid = wgid / nig, fm = gid * WGM, gsz = (nM - fm) < WGM ? (nM - fm) : WGM;
        u.pm = fm + ((wgid % nig) % gsz); u.pn = (wgid % nig) / gsz; return true;
    }
    __device__ __forceinline__ void a_ready(const Unit&) const {}
    __device__ __forceinline__ void done(const Unit&) const {}
};

template <class Epi, class Sched, bool ALIGN_EPI = false, bool SP2 = false>
__device__ __forceinline__ void gemm_phase(PG8_LAS unsigned char* lds, const Gemm g, const Sched& S, const Epi& E) {
    int tid_ = threadIdx.x; asm volatile("" : "+v"(tid_));
    const int tid = tid_, wid = __builtin_amdgcn_readfirstlane(tid >> 6), lane = tid & 63, wr = wid >> 2, wc = wid & 3, fr = lane & 15, fq = lane >> 4;
    int K_ = g.K; asm volatile("" : "+s"(K_)); const int K = K_, nt = K / BK;
    unsigned voffA[2], voffB[2];
#pragma unroll
    for (int i = 0; i < 2; ++i) { int R, C; stage_rc(tid * 16 + i * 8192, R, C); const int Rb = Epi::PERM ? ((R & ~31) + perm32(R & 31)) : R;
        voffA[i] = (unsigned)(R * K + C) * 2u; voffB[i] = (unsigned)(Rb * K + C) * 2u; }
    const size_t kstep = (size_t)(BK * 2);
    const size_t hstep = (size_t)HALF * K * 2;
    const size_t tstep = 2 * hstep;
    const unsigned ldsw = (unsigned)wid * 1024u;
    const int aoff = lds_byte(wr * 64 + fr, fq * 8), boff = lds_byte(wc * 32 + fr, fq * 8);
#define PG8_SA(b, h) (((b) * 2 + (h)) * HTB)
#define PG8_SB(b, h) ((4 + (b) * 2 + (h)) * HTB)
#define PG8_STAGE(bufoff, gbase, voff) do { _Pragma("unroll") for (int _i = 0; _i < 2; ++_i) \
        __builtin_amdgcn_global_load_lds((const unsigned*)((const char*)(gbase) + (voff)[_i]), (PG8_LAS unsigned*)(lds + (bufoff) + ldsw + _i * 8192), 16, 0, 0); } while (0)
#define PG8_LDA(dst, b, h) do { _Pragma("unroll") for (int m = 0; m < 4; ++m) _Pragma("unroll") for (int k = 0; k < 2; ++k) dst[m][k] = *(const PG8_LAS bf16x8*)(lds + PG8_SA(b, h) + aoff + m * 2048 + k * 1024); } while (0)
#define PG8_LDB(dst, b, h) do { _Pragma("unroll") for (int n = 0; n < 2; ++n) _Pragma("unroll") for (int k = 0; k < 2; ++k) dst[n][k] = *(const PG8_LAS bf16x8*)(lds + PG8_SB(b, h) + boff + n * 2048 + k * 1024); } while (0)
#define PG8_MMA(ai, bj, At, Bt) do { __builtin_amdgcn_s_setprio(1); _Pragma("unroll") for (int m = 0; m < 4; ++m) _Pragma("unroll") for (int n = 0; n < 2; ++n) _Pragma("unroll") for (int k = 0; k < 2; ++k) \
        acc[ai][bj][m][n] = __builtin_amdgcn_mfma_f32_16x16x32_bf16(Bt[n][k], At[m][k], acc[ai][bj][m][n], 0, 0, 0); __builtin_amdgcn_s_setprio(0); } while (0)
#define PG8_WAIT_V(n) asm volatile("s_waitcnt vmcnt(" #n ")" ::: "memory")
#define PG8_WAIT_L(n) asm volatile("s_waitcnt lgkmcnt(" #n ")" ::: "memory")
#define PG8_BAR __builtin_amdgcn_s_barrier()
#define PG8_SCHED __builtin_amdgcn_sched_barrier(0)
    Unit cur, nxt; int ui = 0;
    if (!S.next(0, cur)) return;
    f32x4 acc[2][2][4][2];
#pragma unroll
    for (int a = 0; a < 2; ++a)
#pragma unroll
        for (int b = 0; b < 2; ++b)
#pragma unroll
            for (int m = 0; m < 4; ++m)
#pragma unroll
                for (int n = 0; n < 2; ++n) acc[a][b][m][n] = (f32x4){0.f, 0.f, 0.f, 0.f};
    bf16x8 At[4][2], B0[2][2], B1[2][2];
    const char* cA = (const char*)g.A + (size_t)cur.pm * tstep; const char* cB = (const char*)g.Bt + (size_t)cur.pn * tstep;
    S.a_ready(cur);
    if constexpr (SP2) {
        PG8_STAGE(PG8_SB(0, 0), cB, voffB); PG8_STAGE(PG8_SB(0, 1), cB + hstep, voffB); PG8_STAGE(PG8_SA(0, 0), cA, voffA); PG8_STAGE(PG8_SA(0, 1), cA + hstep, voffA);
        if (wr == 1) PG8_BAR;
        PG8_WAIT_V(2); PG8_BAR;
        PG8_STAGE(PG8_SB(1, 0), cB + kstep, voffB); PG8_STAGE(PG8_SA(1, 0), cA + kstep, voffA); PG8_STAGE(PG8_SB(1, 1), cB + hstep + kstep, voffB);
        PG8_WAIT_V(6); PG8_BAR;
    } else {
        PG8_STAGE(PG8_SB(0, 0), cB, voffB); PG8_STAGE(PG8_SA(0, 0), cA, voffA); PG8_STAGE(PG8_SB(0, 1), cB + hstep, voffB); PG8_STAGE(PG8_SA(0, 1), cA + hstep, voffA);
        if (wr == 1) PG8_BAR;
        PG8_WAIT_V(4); PG8_BAR;
        PG8_STAGE(PG8_SB(1, 0), cB + kstep, voffB); PG8_STAGE(PG8_SA(1, 0), cA + kstep, voffA); PG8_STAGE(PG8_SB(1, 1), cB + hstep + kstep, voffB);
        PG8_WAIT_V(6); PG8_BAR;
    }
    for (;;) {
        const bool has_next = S.next(ui + 1, nxt);
        const char* nA = has_next ? (const char*)g.A + (size_t)nxt.pm * tstep : cA; const char* nB = has_next ? (const char*)g.Bt + (size_t)nxt.pn * tstep : cB;
        for (int t = 0; t < nt; t += 2) {
            const bool last = (t == nt - 2);
            const char* a1 = cA + (size_t)(t + 1) * kstep;
            const char* a2 = last ? nA : cA + (size_t)(t + 2) * kstep; const char* b2 = last ? nB : cB + (size_t)(t + 2) * kstep;
            const char* a3 = a2 + kstep; const char* b3 = b2 + kstep;
            if (last && has_next) S.a_ready(nxt);
            if constexpr (SP2) {
            PG8_LDB(B0, 0, 0); PG8_LDB(B1, 0, 1); PG8_SCHED; PG8_LDA(At, 0, 0); PG8_STAGE(PG8_SA(1, 1), a1 + hstep, voffA);
            PG8_WAIT_V(8); PG8_WAIT_L(0); PG8_BAR; PG8_MMA(0, 0, At, B0); PG8_MMA(0, 1, At, B1); PG8_BAR; PG8_SCHED;
            PG8_LDA(At, 0, 1); PG8_STAGE(PG8_SB(0, 0), b2, voffB); PG8_STAGE(PG8_SB(0, 1), b2 + hstep, voffB); PG8_STAGE(PG8_SA(0, 0), a2, voffA);
            PG8_WAIT_V(8); PG8_WAIT_L(0); PG8_BAR; PG8_MMA(1, 0, At, B0); PG8_MMA(1, 1, At, B1); PG8_BAR; PG8_SCHED;
            PG8_LDB(B0, 1, 0); PG8_LDB(B1, 1, 1); PG8_SCHED; PG8_LDA(At, 1, 0); PG8_STAGE(PG8_SA(0, 1), a2 + hstep, voffA);
            PG8_WAIT_V(8); PG8_WAIT_L(0); PG8_BAR; PG8_MMA(0, 0, At, B0); PG8_MMA(0, 1, At, B1); PG8_BAR; PG8_SCHED;
            PG8_LDA(At, 1, 1); PG8_STAGE(PG8_SB(1, 0), b3, voffB); PG8_STAGE(PG8_SB(1, 1), b3 + hstep, voffB); PG8_STAGE(PG8_SA(1, 0), a3, voffA);
            PG8_WAIT_V(8); PG8_WAIT_L(0); PG8_BAR; PG8_MMA(1, 0, At, B0); PG8_MMA(1, 1, At, B1); PG8_BAR; PG8_SCHED;
            } else {
            PG8_LDB(B0, 0, 0); PG8_SCHED; PG8_LDA(At, 0, 0); PG8_STAGE(PG8_SA(1, 1), a1 + hstep, voffA);
            PG8_WAIT_L(8); PG8_BAR; PG8_WAIT_L(0); PG8_MMA(0, 0, At, B0); PG8_BAR; PG8_SCHED;
            PG8_LDB(B1, 0, 1); PG8_STAGE(PG8_SB(0, 0), b2, voffB);
            PG8_BAR; PG8_WAIT_L(0); PG8_MMA(0, 1, At, B1); PG8_BAR;
            PG8_LDA(At, 0, 1); PG8_STAGE(PG8_SA(0, 0), a2, voffA);
            PG8_BAR; PG8_WAIT_L(0); PG8_MMA(1, 0, At, B0); PG8_BAR; PG8_SCHED;
            PG8_STAGE(PG8_SB(0, 1), b2 + hstep, voffB);
            PG8_WAIT_V(6); PG8_BAR; PG8_MMA(1, 1, At, B1); PG8_BAR;
            PG8_LDB(B0, 1, 0); PG8_SCHED; PG8_LDA(At, 1, 0); PG8_STAGE(PG8_SA(0, 1), a2 + hstep, voffA);
            PG8_WAIT_L(8); PG8_BAR; PG8_WAIT_L(0); PG8_MMA(0, 0, At, B0); PG8_BAR; PG8_SCHED;
            PG8_LDB(B1, 1, 1); PG8_STAGE(PG8_SB(1, 0), b3, voffB);
            PG8_BAR; PG8_WAIT_L(0); PG8_MMA(0, 1, At, B1); PG8_BAR;
            PG8_LDA(At, 1, 1); PG8_STAGE(PG8_SA(1, 0), a3, voffA);
            PG8_BAR; PG8_WAIT_L(0); PG8_MMA(1, 0, At, B0); PG8_BAR; PG8_SCHED;
            PG8_STAGE(PG8_SB(1, 1), b3 + hstep, voffB);
            PG8_WAIT_V(6); PG8_BAR; PG8_MMA(1, 1, At, B1); PG8_BAR;
            }
        }
        if constexpr (ALIGN_EPI) { if (wr == 0) PG8_BAR; }
        if constexpr (!Epi::AFTER_DRAIN) { E(acc, cur, wr, wc, fr, fq); S.done(cur); }
        if (!has_next) break;
#pragma unroll
        for (int a = 0; a < 2; ++a)
#pragma unroll
            for (int b = 0; b < 2; ++b)
#pragma unroll
                for (int m = 0; m < 4; ++m)
#pragma unroll
                    for (int n = 0; n < 2; ++n) acc[a][b][m][n] = (f32x4){0.f, 0.f, 0.f, 0.f};
        cur = nxt; cA = nA; cB = nB; ++ui;
        if constexpr (ALIGN_EPI) { if (wr == 1) PG8_BAR; }
    }
    PG8_WAIT_V(0);
    if constexpr (!ALIGN_EPI) { if (wr == 0) PG8_BAR; }
    PG8_BAR;
    if constexpr (Epi::AFTER_DRAIN) { E.fused(acc, cur, wr, wc, fr, fq, lds, wid, lane); S.done(cur); }
#undef PG8_SA
#undef PG8_SB
#undef PG8_STAGE
#undef PG8_LDA
#undef PG8_LDB
#undef PG8_MMA
#undef PG8_WAIT_V
#undef PG8_WAIT_L
#undef PG8_BAR
#undef PG8_SCHED
}

struct UnitM { int pm, pn, sub; };
struct GemmM { const bf16_t* A0; const bf16_t* B0; size_t strideA, strideB; int nt0, dnt2; int lda, ldb;
    __device__ __forceinline__ const bf16_t* a(int s) const { return A0 + (size_t)s * strideA; }
    __device__ __forceinline__ const bf16_t* b(int s) const { return B0 + (size_t)s * strideB; }
    __device__ __forceinline__ int nt(int s) const { return nt0 + (s >> 1) * dnt2; } };
struct StaticOrder3 {
    StaticOrder S;
    __device__ void init(int M, int N, int G_, int c_) { S.init(M, N, G_, c_); }
    __device__ bool next(int i, UnitM& u) const { Unit t; if (!S.next(i / 3, t)) return false; u.pm = t.pm; u.pn = t.pn; u.sub = i - 3 * (i / 3); return true; }
    __device__ __forceinline__ void a_ready(const UnitM&) const {}
    __device__ __forceinline__ void done(const UnitM&) const {}
};
template <class Epi, class Sched, bool ALIGN_EPI = false, bool SP2 = false>
__device__ __forceinline__ void gemm_phase_m(PG8_LAS unsigned char* lds, const GemmM g, const Sched& S, const Epi& E) {
    int tid_ = threadIdx.x; asm volatile("" : "+v"(tid_));
    const int tid = tid_, wid = __builtin_amdgcn_readfirstlane(tid >> 6), lane = tid & 63, wr = wid >> 2, wc = wid & 3, fr = lane & 15, fq = lane >> 4;
    int lda_ = g.lda, ldb_ = g.ldb; asm volatile("" : "+s"(lda_), "+s"(ldb_)); const int lda = lda_, ldb = ldb_; int nt;
    unsigned voffA[2], voffB[2];
#pragma unroll
    for (int i = 0; i < 2; ++i) { int R, C; stage_rc(tid * 16 + i * 8192, R, C); const int Rb = Epi::PERM ? ((R & ~31) + perm32(R & 31)) : R;
        voffA[i] = (unsigned)(R * lda + C) * 2u; voffB[i] = (unsigned)(Rb * ldb + C) * 2u; }
    const size_t kstep = (size_t)(BK * 2);
    const size_t hstepA = (size_t)HALF * lda * 2, hstepB = (size_t)HALF * ldb * 2;
    const size_t tstepA = 2 * hstepA, tstepB = 2 * hstepB;
    const unsigned ldsw = (unsigned)wid * 1024u;
    const int aoff = lds_byte(wr * 64 + fr, fq * 8), boff = lds_byte(wc * 32 + fr, fq * 8);
#define PG8_SA(b, h) (((b) * 2 + (h)) * HTB)
#define PG8_SB(b, h) ((4 + (b) * 2 + (h)) * HTB)
#define PG8_STAGE(bufoff, gbase, voff) do { _Pragma("unroll") for (int _i = 0; _i < 2; ++_i) \
        __builtin_amdgcn_global_load_lds((const unsigned*)((const char*)(gbase) + (voff)[_i]), (PG8_LAS unsigned*)(lds + (bufoff) + ldsw + _i * 8192), 16, 0, 0); } while (0)
#define PG8_LDA(dst, b, h) do { _Pragma("unroll") for (int m = 0; m < 4; ++m) _Pragma("unroll") for (int k = 0; k < 2; ++k) dst[m][k] = *(const PG8_LAS bf16x8*)(lds + PG8_SA(b, h) + aoff + m * 2048 + k * 1024); } while (0)
#define PG8_LDB(dst, b, h) do { _Pragma("unroll") for (int n = 0; n < 2; ++n) _Pragma("unroll") for (int k = 0; k < 2; ++k) dst[n][k] = *(const PG8_LAS bf16x8*)(lds + PG8_SB(b, h) + boff + n * 2048 + k * 1024); } while (0)
#define PG8_MMA(ai, bj, At, Bt) do { __builtin_amdgcn_s_setprio(1); _Pragma("unroll") for (int m = 0; m < 4; ++m) _Pragma("unroll") for (int n = 0; n < 2; ++n) _Pragma("unroll") for (int k = 0; k < 2; ++k) \
        acc[ai][bj][m][n] = __builtin_amdgcn_mfma_f32_16x16x32_bf16(Bt[n][k], At[m][k], acc[ai][bj][m][n], 0, 0, 0); __builtin_amdgcn_s_setprio(0); } while (0)
#define PG8_WAIT_V(n) asm volatile("s_waitcnt vmcnt(" #n ")" ::: "memory")
#define PG8_WAIT_L(n) asm volatile("s_waitcnt lgkmcnt(" #n ")" ::: "memory")
#define PG8_BAR __builtin_amdgcn_s_barrier()
#define PG8_SCHED __builtin_amdgcn_sched_barrier(0)
    UnitM cur, nxt; int ui = 0;
    if (!S.next(0, cur)) return;
    f32x4 acc[2][2][4][2];
#pragma unroll
    for (int a = 0; a < 2; ++a)
#pragma unroll
        for (int b = 0; b < 2; ++b)
#pragma unroll
            for (int m = 0; m < 4; ++m)
#pragma unroll
                for (int n = 0; n < 2; ++n) acc[a][b][m][n] = (f32x4){0.f, 0.f, 0.f, 0.f};
    bf16x8 At[4][2], B0[2][2], B1[2][2];
    const char* cA = (const char*)g.a(cur.sub) + (size_t)cur.pm * tstepA; const char* cB = (const char*)g.b(cur.sub) + (size_t)cur.pn * tstepB; nt = g.nt(cur.sub);
    S.a_ready(cur);
    if constexpr (SP2) {
        PG8_STAGE(PG8_SB(0, 0), cB, voffB); PG8_STAGE(PG8_SB(0, 1), cB + hstepB, voffB); PG8_STAGE(PG8_SA(0, 0), cA, voffA); PG8_STAGE(PG8_SA(0, 1), cA + hstepA, voffA);
        if (wr == 1) PG8_BAR;
        PG8_WAIT_V(2); PG8_BAR;
        PG8_STAGE(PG8_SB(1, 0), cB + kstep, voffB); PG8_STAGE(PG8_SA(1, 0), cA + kstep, voffA); PG8_STAGE(PG8_SB(1, 1), cB + hstepB + kstep, voffB);
        PG8_WAIT_V(6); PG8_BAR;
    } else {
        PG8_STAGE(PG8_SB(0, 0), cB, voffB); PG8_STAGE(PG8_SA(0, 0), cA, voffA); PG8_STAGE(PG8_SB(0, 1), cB + hstepB, voffB); PG8_STAGE(PG8_SA(0, 1), cA + hstepA, voffA);
        if (wr == 1) PG8_BAR;
        PG8_WAIT_V(4); PG8_BAR;
        PG8_STAGE(PG8_SB(1, 0), cB + kstep, voffB); PG8_STAGE(PG8_SA(1, 0), cA + kstep, voffA); PG8_STAGE(PG8_SB(1, 1), cB + hstepB + kstep, voffB);
        PG8_WAIT_V(6); PG8_BAR;
    }
    for (;;) {
        const bool has_next = S.next(ui + 1, nxt);
        const char* nA = has_next ? (const char*)g.a(nxt.sub) + (size_t)nxt.pm * tstepA : cA; const char* nB = has_next ? (const char*)g.b(nxt.sub) + (size_t)nxt.pn * tstepB : cB;
        for (int t = 0; t < nt; t += 2) {
            const bool last = (t == nt - 2);
            const char* a1 = cA + (size_t)(t + 1) * kstep;
            const char* a2 = last ? nA : cA + (size_t)(t + 2) * kstep; const char* b2 = last ? nB : cB + (size_t)(t + 2) * kstep;
            const char* a3 = a2 + kstep; const char* b3 = b2 + kstep;
            if (last && has_next) S.a_ready(nxt);
            if constexpr (SP2) {
            PG8_LDB(B0, 0, 0); PG8_LDB(B1, 0, 1); PG8_SCHED; PG8_LDA(At, 0, 0); PG8_STAGE(PG8_SA(1, 1), a1 + hstepA, voffA);
            PG8_WAIT_V(8); PG8_WAIT_L(0); PG8_BAR; PG8_MMA(0, 0, At, B0); PG8_MMA(0, 1, At, B1); PG8_BAR; PG8_SCHED;
            PG8_LDA(At, 0, 1); PG8_STAGE(PG8_SB(0, 0), b2, voffB); PG8_STAGE(PG8_SB(0, 1), b2 + hstepB, voffB); PG8_STAGE(PG8_SA(0, 0), a2, voffA);
            PG8_WAIT_V(8); PG8_WAIT_L(0); PG8_BAR; PG8_MMA(1, 0, At, B0); PG8_MMA(1, 1, At, B1); PG8_BAR; PG8_SCHED;
            PG8_LDB(B0, 1, 0); PG8_LDB(B1, 1, 1); PG8_SCHED; PG8_LDA(At, 1, 0); PG8_STAGE(PG8_SA(0, 1), a2 + hstepA, voffA);
            PG8_WAIT_V(8); PG8_WAIT_L(0); PG8_BAR; PG8_MMA(0, 0, At, B0); PG8_MMA(0, 1, At, B1); PG8_BAR; PG8_SCHED;
            PG8_LDA(At, 1, 1); PG8_STAGE(PG8_SB(1, 0), b3, voffB); PG8_STAGE(PG8_SB(1, 1), b3 + hstepB, voffB); PG8_STAGE(PG8_SA(1, 0), a3, voffA);
            PG8_WAIT_V(8); PG8_WAIT_L(0); PG8_BAR; PG8_MMA(1, 0, At, B0); PG8_MMA(1, 1, At, B1); PG8_BAR; PG8_SCHED;
            } else {
            PG8_LDB(B0, 0, 0); PG8_SCHED; PG8_LDA(At, 0, 0); PG8_STAGE(PG8_SA(1, 1), a1 + hstepA, voffA);
            PG8_WAIT_L(8); PG8_BAR; PG8_WAIT_L(0); PG8_MMA(0, 0, At, B0); PG8_BAR; PG8_SCHED;
            PG8_LDB(B1, 0, 1); PG8_STAGE(PG8_SB(0, 0), b2, voffB);
            PG8_BAR; PG8_WAIT_L(0); PG8_MMA(0, 1, At, B1); PG8_BAR;
            PG8_LDA(At, 0, 1); PG8_STAGE(PG8_SA(0, 0), a2, voffA);
            PG8_BAR; PG8_WAIT_L(0); PG8_MMA(1, 0, At, B0); PG8_BAR; PG8_SCHED;
            PG8_STAGE(PG8_SB(0, 1), b2 + hstepB, voffB);
            PG8_WAIT_V(6); PG8_BAR; PG8_MMA(1, 1, At, B1); PG8_BAR;
            PG8_LDB(B0, 1, 0); PG8_SCHED; PG8_LDA(At, 1, 0); PG8_STAGE(PG8_SA(0, 1), a2 + hstepA, voffA);
            PG8_WAIT_L(8); PG8_BAR; PG8_WAIT_L(0); PG8_MMA(0, 0, At, B0); PG8_BAR; PG8_SCHED;
            PG8_LDB(B1, 1, 1); PG8_STAGE(PG8_SB(1, 0), b3, voffB);
            PG8_BAR; PG8_WAIT_L(0); PG8_MMA(0, 1, At, B1); PG8_BAR;
            PG8_LDA(At, 1, 1); PG8_STAGE(PG8_SA(1, 0), a3, voffA);
            PG8_BAR; PG8_WAIT_L(0); PG8_MMA(1, 0, At, B0); PG8_BAR; PG8_SCHED;
            PG8_STAGE(PG8_SB(1, 1), b3 + hstepB, voffB);
            PG8_WAIT_V(6); PG8_BAR; PG8_MMA(1, 1, At, B1); PG8_BAR;
            }
        }
        if constexpr (ALIGN_EPI) { if (wr == 0) PG8_BAR; }
        if constexpr (!Epi::AFTER_DRAIN) { E(acc, cur, wr, wc, fr, fq); S.done(cur); }
        if (!has_next) break;
        if (nxt.sub == 0) {
#pragma unroll
        for (int a = 0; a < 2; ++a)
#pragma unroll
            for (int b = 0; b < 2; ++b)
#pragma unroll
                for (int m = 0; m < 4; ++m)
#pragma unroll
                    for (int n = 0; n < 2; ++n) acc[a][b][m][n] = (f32x4){0.f, 0.f, 0.f, 0.f}; }
        cur = nxt; cA = nA; cB = nB; ++ui; nt = g.nt(cur.sub);
        if constexpr (ALIGN_EPI) { if (wr == 1) PG8_BAR; }
    }
    PG8_WAIT_V(0);
    if constexpr (!ALIGN_EPI) { if (wr == 0) PG8_BAR; }
    PG8_BAR;
    if constexpr (Epi::AFTER_DRAIN) { E.fused(acc, cur, wr, wc, fr, fq, lds, wid, lane); S.done(cur); }
#undef PG8_SA
#undef PG8_SB
#undef PG8_STAGE
#undef PG8_LDA
#undef PG8_LDB
#undef PG8_MMA
#undef PG8_WAIT_V
#undef PG8_WAIT_L
#undef PG8_BAR
#undef PG8_SCHED
}
}

namespace pg8 {
typedef float f32x2 __attribute__((ext_vector_type(2)));
__device__ __forceinline__ unsigned cvt_pk_bf16(float lo, float hi) { unsigned r; asm volatile("v_cvt_pk_bf16_f32 %0, %1, %2" : "=v"(r) : "v"(lo), "v"(hi)); return r; }
__device__ __forceinline__ void store8(bf16_t* p, const f32x4 v0, const f32x4 v1) {
    u32x4 w; w.x = cvt_pk_bf16(v0[0], v0[1]); w.y = cvt_pk_bf16(v0[2], v0[3]); w.z = cvt_pk_bf16(v1[0], v1[1]); w.w = cvt_pk_bf16(v1[2], v1[3]); *(u32x4*)p = w; }
__device__ __forceinline__ float fsigmoid(float x) { return __builtin_amdgcn_rcpf(1.0f + __builtin_amdgcn_exp2f(-1.4426950408889634f * x)); }
__device__ __forceinline__ f32x4 act4(const f32x4 v, const int ACT) {
    if (ACT == 0) return v;
    f32x4 o;
#pragma unroll
    for (int j = 0; j < 4; ++j) { const float s = fsigmoid(v[j]); o[j] = (ACT == 1) ? v[j] * s : s; }
    return o; }
__device__ __forceinline__ void bf8_to_f32(const u32x4 w, f32x4& a, f32x4& b) {
    a[0] = __uint_as_float(w.x << 16); a[1] = __uint_as_float(w.x & 0xffff0000u); a[2] = __uint_as_float(w.y << 16); a[3] = __uint_as_float(w.y & 0xffff0000u);
    b[0] = __uint_as_float(w.z << 16); b[1] = __uint_as_float(w.z & 0xffff0000u); b[2] = __uint_as_float(w.w << 16); b[3] = __uint_as_float(w.w & 0xffff0000u); }

constexpr int SEQ_MASK = 4095;
__device__ __forceinline__ void rope4(const float* tab, const f32x4 a, const f32x4 b, float sc, bf16_t* p1, bf16_t* p2) {
    typedef unsigned u32x2 __attribute__((ext_vector_type(2)));
    const f32x4 t0 = *(const f32x4*)(tab), t1 = *(const f32x4*)(tab + 4);
    const float o10 = (a[0] * t0[0] - b[0] * t0[1]) * sc, o20 = (b[0] * t0[0] + a[0] * t0[1]) * sc;
    const float o11 = (a[1] * t0[2] - b[1] * t0[3]) * sc, o21 = (b[1] * t0[2] + a[1] * t0[3]) * sc;
    const float o12 = (a[2] * t1[0] - b[2] * t1[1]) * sc, o22 = (b[2] * t1[0] + a[2] * t1[1]) * sc;
    const float o13 = (a[3] * t1[2] - b[3] * t1[3]) * sc, o23 = (b[3] * t1[2] + a[3] * t1[3]) * sc;
    u32x2 w1, w2; w1.x = cvt_pk_bf16(o10, o11); w1.y = cvt_pk_bf16(o12, o13); w2.x = cvt_pk_bf16(o20, o21); w2.y = cvt_pk_bf16(o22, o23);
    *(u32x2*)p1 = w1; *(u32x2*)p2 = w2;
}
#define EPI_FENCE() asm volatile("" ::: "memory")

struct EpiInProj {
    static constexpr bool PERM = true, AFTER_DRAIN = false;
    unsigned char* ws; size_t o_fqkv, o_cq, o_ckv, o_kr, o_rq, o_rk, o_rv, o_rg, o_gates, o_ff, o_t128, o_t64; int skip;
    __device__ __forceinline__ void plain(const f32x4 (&acc)[2][2][4][2], bf16_t* dst, int ld, int colbase, int act, int row0, int wc, int fq) const {
        const int col0 = colbase + wc * 32 + 8 * fq;
#pragma unroll
        for (int ai = 0; ai < 2; ++ai)
#pragma unroll
            for (int m = 0; m < 4; ++m) { bf16_t* rowp = dst + (size_t)(row0 + ai * HALF + m * 16) * ld + col0;
#pragma unroll
                for (int bj = 0; bj < 2; ++bj) { f32x4 v0 = acc[ai][bj][m][0], v1 = acc[ai][bj][m][1];
                    if (act) {
#pragma unroll
                        for (int j = 0; j < 4; ++j) { const float s0 = fsigmoid(v0[j]), s1 = fsigmoid(v1[j]); v0[j] = (act == 1) ? v0[j] * s0 : s0; v1[j] = (act == 1) ? v1[j] * s1 : s1; } }
                    if (skip == 2) { u32x4 w; w.x = cvt_pk_bf16(v0[0], v0[1]); w.y = cvt_pk_bf16(v0[2], v0[3]); w.z = cvt_pk_bf16(v1[0], v1[1]); w.w = cvt_pk_bf16(v1[2], v1[3]); asm volatile("" :: "v"(w)); }
                    else store8(rowp + bj * HALF, v0, v1); }
                EPI_FENCE(); }
    }
    __device__ __forceinline__ void rope128(const f32x4 (&acc)[2][2][4][2], bf16_t* dst, int t, float sc, int row0, int wc, int fq) const {
        const int x = 32 * wc + 8 * fq, hh = x >> 6, i0 = x & 63, head = 2 * t + hh; const float* T128 = (const float*)(ws + o_t128);
#pragma unroll
        for (int ai = 0; ai < 2; ++ai)
#pragma unroll
            for (int m = 0; m < 4; ++m) { const int row = row0 + ai * HALF + m * 16, pos = row & SEQ_MASK;
                const float* tp = T128 + ((size_t)pos * 64 + i0) * 2; bf16_t* p = dst + (size_t)row * 512 + 128 * head + i0;
                rope4(tp, acc[ai][0][m][0], acc[ai][1][m][0], sc, p, p + 64); rope4(tp + 8, acc[ai][0][m][1], acc[ai][1][m][1], sc, p + 4, p + 68);
                EPI_FENCE(); }
    }
    __device__ __forceinline__ void misc(const f32x4 (&acc)[2][2][4][2], int row0, int wc, int fq) const {
        if (wc == 0) { const int i0 = 8 * fq; const float* T64 = (const float*)(ws + o_t64); bf16_t* kr = (bf16_t*)(ws + o_kr);
#pragma unroll
            for (int ai = 0; ai < 2; ++ai)
#pragma unroll
                for (int m = 0; m < 4; ++m) { const int row = row0 + ai * HALF + m * 16, pos = row & SEQ_MASK;
                    const float* tp = T64 + ((size_t)pos * 32 + i0) * 2; bf16_t* p = kr + (size_t)row * 64 + i0;
                    rope4(tp, acc[ai][0][m][0], acc[ai][1][m][0], 1.0f, p, p + 32); rope4(tp + 8, acc[ai][0][m][1], acc[ai][1][m][1], 1.0f, p + 4, p + 36);
                    EPI_FENCE(); }
        } else if (wc == 1) { if (fq == 0) { float* ff = (float*)(ws + o_ff);
#pragma unroll
            for (int ai = 0; ai < 2; ++ai)
#pragma unroll
                for (int m = 0; m < 4; ++m) { const int row = row0 + ai * HALF + m * 16; float* p = ff + (size_t)row * 8; *(f32x4*)p = acc[ai][0][m][0]; *(f32x4*)(p + 4) = acc[ai][0][m][1]; } } }
    }
    __device__ __forceinline__ void operator()(const f32x4 (&acc)[2][2][4][2], const Unit& u, int wr, int wc, int fr, int fq) const {
        const int pn = u.pn, row0 = u.pm * BM + wr * 64 + fr;
        if (skip == 1) {
#pragma unroll
            for (int ai = 0; ai < 2; ++ai)
#pragma unroll
                for (int bj = 0; bj < 2; ++bj)
#pragma unroll
                    for (int m = 0; m < 4; ++m) asm volatile("" :: "v"(acc[ai][bj][m][0]), "v"(acc[ai][bj][m][1]));
            return; }
        if (pn == 12) misc(acc, row0, wc, fq);
        else if (pn >= 13 && pn < 17) { const bool isk = pn >= 15; rope128(acc, (bf16_t*)(ws + (isk ? o_rk : o_rq)), isk ? pn - 15 : pn - 13, isk ? 0.08838834764831845f : 1.0f, row0, wc, fq); }
        else { size_t off; int ld, cb, act = 0;
            if (pn < 9) { off = o_fqkv; ld = 2304; cb = 256 * pn; }
            else if (pn < 11) { off = o_cq; ld = 512; cb = 256 * (pn - 9); }
            else if (pn == 11) { off = o_ckv; ld = 256; cb = 0; }
            else if (pn < 21) { off = o_rv; ld = 1024; cb = 256 * (pn - 17); }
            else if (pn < 25) { off = o_rg; ld = 1024; cb = 256 * (pn - 21); act = 1; }
            else { off = o_gates; ld = 6144; cb = 256 * (pn - 25); act = 2; }
            plain(acc, (bf16_t*)(ws + off), ld, cb, act, row0, wc, fq); }
    }
};

struct EpiUq {
    static constexpr bool PERM = true, AFTER_DRAIN = false;
    bf16_t* qm; const float* rstd; const float* T64;
    __device__ __forceinline__ void operator()(const f32x4 (&acc)[2][2][4][2], const Unit& u, int wr, int wc, int fr, int fq) const {
        const int pn = u.pn, row0 = u.pm * BM + wr * 64 + fr;
        float rsv[2][4];
#pragma unroll
        for (int ai = 0; ai < 2; ++ai)
#pragma unroll
            for (int m = 0; m < 4; ++m) rsv[ai][m] = rstd[row0 + ai * HALF + m * 16];
        if (pn < 3) {
#pragma unroll
            for (int ai = 0; ai < 2; ++ai)
#pragma unroll
                for (int m = 0; m < 4; ++m) { const int row = row0 + ai * HALF + m * 16; const float rs = rsv[ai][m];
#pragma unroll
                    for (int bj = 0; bj < 2; ++bj) store8(qm + (size_t)row * 1152 + 192 * (2 * pn + bj) + 32 * wc + 8 * fq, acc[ai][bj][m][0] * rs, acc[ai][bj][m][1] * rs);
                    EPI_FENCE(); }
        } else { const int head = (pn == 3) ? wc : 4 + wc; if (head < 6) { const int i0 = 8 * fq;
#pragma unroll
            for (int ai = 0; ai < 2; ++ai)
#pragma unroll
                for (int m = 0; m < 4; ++m) { const int row = row0 + ai * HALF + m * 16, pos = row & SEQ_MASK; const float rs = rsv[ai][m];
                    const float* tp = T64 + ((size_t)pos * 32 + i0) * 2; bf16_t* p = qm + (size_t)row * 1152 + 192 * head + 128 + i0;
                    rope4(tp, acc[ai][0][m][0], acc[ai][1][m][0], rs, p, p + 32); rope4(tp + 8, acc[ai][0][m][1], acc[ai][1][m][1], rs, p + 4, p + 36);
                    EPI_FENCE(); } } }
    }
};
struct EpiUkv {
    static constexpr bool PERM = true, AFTER_DRAIN = false;
    bf16_t* kvm; const float* rstd;
    __device__ __forceinline__ void operator()(const f32x4 (&acc)[2][2][4][2], const Unit& u, int wr, int wc, int fr, int fq) const {
        const int row0 = u.pm * BM + wr * 64 + fr, col0 = u.pn * BM + wc * 32 + 8 * fq;
        float rsv[2][4];
#pragma unroll
        for (int ai = 0; ai < 2; ++ai)
#pragma unroll
            for (int m = 0; m < 4; ++m) rsv[ai][m] = rstd[row0 + ai * HALF + m * 16];
#pragma unroll
        for (int ai = 0; ai < 2; ++ai)
#pragma unroll
            for (int m = 0; m < 4; ++m) { const int row = row0 + ai * HALF + m * 16; const float rs = rsv[ai][m];
#pragma unroll
                for (int bj = 0; bj < 2; ++bj) store8(kvm + (size_t)row * 1536 + col0 + bj * HALF, acc[ai][bj][m][0] * rs, acc[ai][bj][m][1] * rs);
                EPI_FENCE(); }
    }
};
template <int PASS> struct EpiMerge {
    static constexpr bool PERM = true, AFTER_DRAIN = false;
    const bf16_t* gates; float* tmp; bf16_t* out;
    __device__ __forceinline__ void operator()(const f32x4 (&acc)[2][2][4][2], const Unit& u, int wr, int wc, int fr, int fq) const {
        const int row0 = u.pm * BM + wr * 64 + fr, col0 = u.pn * BM + wc * 32 + 8 * fq;
#pragma unroll
        for (int ai = 0; ai < 2; ++ai)
#pragma unroll
            for (int m = 0; m < 4; ++m) { const int row = row0 + ai * HALF + m * 16;
#pragma unroll
                for (int bj = 0; bj < 2; ++bj) { const int col = col0 + bj * HALF;
                    f32x4 g0, g1; bf8_to_f32(*(const u32x4*)(gates + (size_t)row * 6144 + 2048 * PASS + col), g0, g1);
                    f32x4 v0 = g0 * acc[ai][bj][m][0], v1 = g1 * acc[ai][bj][m][1];
                    float* tp = tmp + (size_t)row * 2048 + col;
                    if (PASS > 0) { v0 += *(const f32x4*)tp; v1 += *(const f32x4*)(tp + 4); }
                    if (PASS < 2) { *(f32x4*)tp = v0; *(f32x4*)(tp + 4) = v1; }
                    else store8(out + (size_t)row * 2048 + col, v0, v1);
                    EPI_FENCE(); } }
    }
};
struct EpiMergeM {
    static constexpr bool PERM = true, AFTER_DRAIN = false;
    const bf16_t* gates; bf16_t* out;
    __device__ __forceinline__ void operator()(f32x4 (&acc)[2][2][4][2], const UnitM& u, int wr, int wc, int fr, int fq) const {
        int t_ = threadIdx.x; asm volatile("" : "+v"(t_)); (void)fr; (void)fq; const int lrow0 = wr * 64 + (t_ & 15), lcol0 = wc * 32 + 8 * ((t_ >> 4) & 3);
        const int sub = u.sub;
#pragma unroll
        for (int ai = 0; ai < 2; ++ai) {
            u32x4 ga[4][2], gb[4][2];
#pragma unroll
            for (int m = 0; m < 4; ++m)
#pragma unroll
                for (int bj = 0; bj < 2; ++bj) { const bf16_t* gp = gates + ((size_t)u.pm * BM + lrow0 + ai * HALF + m * 16) * 6144 + 2048 * sub + u.pn * BM + lcol0 + bj * HALF;
                    ga[m][bj] = *(const u32x4*)gp; if (sub < 2) gb[m][bj] = *(const u32x4*)(gp + 2048); }
#pragma unroll
            for (int m = 0; m < 4; ++m)
#pragma unroll
                for (int bj = 0; bj < 2; ++bj) { f32x4 a0, a1; bf8_to_f32(ga[m][bj], a0, a1);
#pragma unroll
                    for (int j = 0; j < 4; ++j) { a0[j] = fmaxf(a0[j], 1e-30f); a1[j] = fmaxf(a1[j], 1e-30f); }
                    if (sub < 2) { f32x4 b0, b1; bf8_to_f32(gb[m][bj], b0, b1);
#pragma unroll
                        for (int j = 0; j < 4; ++j) { a0[j] *= __builtin_amdgcn_rcpf(fmaxf(b0[j], 1e-30f)); a1[j] *= __builtin_amdgcn_rcpf(fmaxf(b1[j], 1e-30f)); }
                        acc[ai][bj][m][0] *= a0; acc[ai][bj][m][1] *= a1; }
                    else store8(out + ((size_t)u.pm * BM + lrow0 + ai * HALF + m * 16) * 2048 + u.pn * BM + lcol0 + bj * HALF, acc[ai][bj][m][0] * a0, acc[ai][bj][m][1] * a1); }
            EPI_FENCE(); }
    }
};
struct EpiResid {
    static constexpr bool PERM = true, AFTER_DRAIN = false;
    bf16_t* xb;
    __device__ __forceinline__ void operator()(const f32x4 (&acc)[2][2][4][2], const Unit& u, int wr, int wc, int fr, int fq) const {
        int t_ = threadIdx.x; asm volatile("" : "+v"(t_)); (void)fr; (void)fq;
        const int row0 = u.pm * BM + wr * 64 + (t_ & 15), col0 = u.pn * BM + wc * 32 + 8 * ((t_ >> 4) & 3);
#pragma unroll
        for (int ai = 0; ai < 2; ++ai) {
            u32x4 b[4][2];
#pragma unroll
            for (int m = 0; m < 4; ++m)
#pragma unroll
                for (int bj = 0; bj < 2; ++bj) b[m][bj] = *(const u32x4*)(xb + (size_t)(row0 + ai * HALF + m * 16) * 4096 + col0 + bj * HALF);
#pragma unroll
            for (int m = 0; m < 4; ++m)
#pragma unroll
                for (int bj = 0; bj < 2; ++bj) { f32x4 x0, x1; bf8_to_f32(b[m][bj], x0, x1);
                    store8(xb + (size_t)(row0 + ai * HALF + m * 16) * 4096 + col0 + bj * HALF, x0 + acc[ai][bj][m][0], x1 + acc[ai][bj][m][1]); }
            EPI_FENCE(); }
    }
};
__device__ __forceinline__ float gelu_gate(float xc, float g) {
    const float z = xc * (1.0f + 0.044715f * xc * xc);
    return xc * __builtin_amdgcn_rcpf(1.0f + __builtin_amdgcn_exp2f(-2.3022081985378545f * z)) * g;
}
template <int CTRL> __device__ __forceinline__ float dpp_f(float old, float src) {
    return __builtin_bit_cast(float, __builtin_amdgcn_update_dpp(__builtin_bit_cast(int, old), __builtin_bit_cast(int, src), CTRL, 0xf, 0xf, false)); }
struct EpiConvAct {
    static constexpr bool PERM = true, AFTER_DRAIN = false;
    bf16_t* act; float* utail; float* uhead; float* ghead; const float* cw; const float* cb; PG8_LAS float* xbuf;
    __device__ __forceinline__ void operator()(const f32x4 (&acc)[2][2][4][2], const Unit& u, int wr_, int wc_, int fr_, int fq_) const {
        int t_ = threadIdx.x; asm volatile("" : "+v"(t_)); const int fr = t_ & 15, fq = (t_ >> 4) & 3, wr = wr_, wc = wc_; (void)fr_; (void)fq_;
        const int lc = 32 * wc + 8 * fq, f0 = u.pn * HALF + lc;
        if (fr >= 14) {
#pragma unroll
            for (int ai = 0; ai < 2; ++ai) { PG8_LAS float* xp = xbuf + ((2 * ai + wr) * 2 + (fr - 14)) * 128 + lc; *(PG8_LAS f32x4*)xp = acc[ai][0][3][0]; *(PG8_LAS f32x4*)(xp + 4) = acc[ai][0][3][1]; }
            if (wr == 1) { float* tp = utail + ((size_t)u.pm * 2 + (fr - 14)) * 5632 + f0; *(f32x4*)tp = acc[1][0][3][0]; *(f32x4*)(tp + 4) = acc[1][0][3][1]; } }
        if (fr < 2 && wr == 0) { const size_t o = ((size_t)u.pm * 2 + fr) * 5632 + f0;
            *(f32x4*)(uhead + o) = acc[0][0][0][0]; *(f32x4*)(uhead + o + 4) = acc[0][0][0][1]; *(f32x4*)(ghead + o) = acc[0][1][0][0]; *(f32x4*)(ghead + o + 4) = acc[0][1][0][1]; }
        asm volatile("s_waitcnt lgkmcnt(0)" ::: "memory"); __builtin_amdgcn_s_barrier(); asm volatile("" ::: "memory");
        float w0[8], w1[8], w2[8], bb[8];
#pragma unroll
        for (int h = 0; h < 2; ++h) { const f32x4 a = *(const f32x4*)(cw + f0 + 4 * h), b = *(const f32x4*)(cw + 5632 + f0 + 4 * h), c = *(const f32x4*)(cw + 2 * 5632 + f0 + 4 * h), d = *(const f32x4*)(cb + f0 + 4 * h);
#pragma unroll
            for (int j = 0; j < 4; ++j) { w0[4 * h + j] = a[j]; w1[4 * h + j] = b[j]; w2[4 * h + j] = c[j]; bb[4 * h + j] = d[j]; } }
        const int row0 = u.pm * BM + wr * 64 + fr;
#pragma unroll
        for (int ai = 0; ai < 2; ++ai) {
            f32x4 t0a = {0.f, 0.f, 0.f, 0.f}, t0b = t0a, t1a = t0a, t1b = t0a;
            if (2 * ai + wr > 0) { const PG8_LAS float* xp = xbuf + ((2 * ai + wr - 1) * 2) * 128 + lc; t0a = *(const PG8_LAS f32x4*)xp; t0b = *(const PG8_LAS f32x4*)(xp + 4); t1a = *(const PG8_LAS f32x4*)(xp + 128); t1b = *(const PG8_LAS f32x4*)(xp + 132); }
#pragma unroll
            for (int m = 0; m < 4; ++m) { f32x4 o0, o1;
#pragma unroll
                for (int n = 0; n < 2; ++n)
#pragma unroll
                    for (int j = 0; j < 4; ++j) { const int k = 4 * n + j; const float cur = acc[ai][0][m][n][j];
                        float a1, a2;
                        if (m == 0) { const float T0 = n ? t0b[j] : t0a[j], T1 = n ? t1b[j] : t1a[j]; a1 = T1; a2 = (fr == 0) ? T0 : T1; }
                        else { const float pv = acc[ai][0][m - 1][n][j]; a1 = dpp_f<0x10F>(pv, pv); a2 = dpp_f<0x10E>(pv, pv); }
                        const float s1 = dpp_f<0x111>(a1, cur), s2 = dpp_f<0x112>(a2, cur);
                        const float xc = bb[k] + w0[k] * s2 + w1[k] * s1 + w2[k] * cur;
                        const float r = gelu_gate(xc, acc[ai][1][m][n][j]);
                        if (n == 0) o0[j] = r; else o1[j] = r; }
                store8(act + (size_t)(row0 + ai * HALF + m * 16) * 5632 + f0, o0, o1);
                EPI_FENCE(); } }
    }
};
}

namespace att {
#define ATT_LAS __attribute__((address_space(3)))
typedef unsigned short bf16_t;
typedef short bf16x8 __attribute__((ext_vector_type(8)));
typedef short s16x4 __attribute__((ext_vector_type(4)));
typedef float f32x16 __attribute__((ext_vector_type(16)));
typedef float f32x4 __attribute__((ext_vector_type(4)));
typedef unsigned u32x4 __attribute__((ext_vector_type(4)));
typedef unsigned u32x2 __attribute__((ext_vector_type(2)));
constexpr int SHM_T = 16384;
#define KSWZ(row, colB) ((row) * 256 + ((colB) ^ (((row) & 15) << 4)))
#define KSWZ64(row, colB) ((row) * 128 + ((colB) ^ ((((row) >> 1) & 7) << 4)))
#define SBAR() __builtin_amdgcn_sched_barrier(0)
__device__ __forceinline__ int v_st(int k, int c) { const int kk = (k & ~0xC) | ((k & 4) << 1) | ((k & 8) >> 1); return ((kk >> 3) * 4 + (c >> 5)) * 512 + ((kk & 7) * 32 + (c & 31)) * 2; }
__device__ __forceinline__ int v_rd_base(int lane) { return ((lane & 3) << 3) | (((lane >> 2) & 3) << 6) | (((lane >> 4) & 1) << 5) | (((lane >> 5) & 1) << 8); }
constexpr int v_rd_off(int d0, int ks, int half) { return d0 * 512 + ks * 4096 + half * 2048; }
__device__ __forceinline__ unsigned cvtpk(float lo, float hi) { unsigned r; asm volatile("v_cvt_pk_bf16_f32 %0, %1, %2" : "=v"(r) : "v"(lo), "v"(hi)); return r; }

template <bool ROPE>
__device__ __forceinline__ void qkt(f32x16& p0, f32x16& p1, const ATT_LAS char* Kt, const ATT_LAS char* Kr, int r32, int hi, const bf16x8* qr) {
    p0 = f32x16{}; p1 = f32x16{};
#pragma unroll
    for (int d0 = 0; d0 < 8; ++d0) { const ATT_LAS char* a = Kt + KSWZ(r32, (d0 * 16 + hi * 8) * 2);
        const bf16x8 b0 = *(const ATT_LAS bf16x8*)a, b1 = *(const ATT_LAS bf16x8*)(a + 32 * 256);
        p0 = __builtin_amdgcn_mfma_f32_32x32x16_bf16(b0, qr[d0], p0, 0, 0, 0);
        p1 = __builtin_amdgcn_mfma_f32_32x32x16_bf16(b1, qr[d0], p1, 0, 0, 0); }
    if (ROPE) {
#pragma unroll
        for (int d0 = 0; d0 < 4; ++d0) { const ATT_LAS char* a = Kr + KSWZ64(r32, (d0 * 16 + hi * 8) * 2);
            const bf16x8 b0 = *(const ATT_LAS bf16x8*)a, b1 = *(const ATT_LAS bf16x8*)(a + 32 * 128);
            p0 = __builtin_amdgcn_mfma_f32_32x32x16_bf16(b0, qr[8 + d0], p0, 0, 0, 0);
            p1 = __builtin_amdgcn_mfma_f32_32x32x16_bf16(b1, qr[8 + d0], p1, 0, 0, 0); } }
}
__device__ __forceinline__ void pv_tile_T(f32x16* o, int vb, bf16x8 pa0, bf16x8 pa1, bf16x8 pa2, bf16x8 pa3) {
#define TRRD(dst, off) asm volatile("ds_read_b64_tr_b16 %0, %1 offset:%2" : "=&v"(dst) : "v"(vb), "i"(off) : "memory")
#define PV_D0(d0) do { s16x4 l0, l1, l2, l3, h0, h1, h2, h3; constexpr int b_ = v_rd_off(d0, 0, 0); \
        TRRD(l0, b_); TRRD(h0, b_ + 2048); TRRD(l1, b_ + 4096); TRRD(h1, b_ + 6144); TRRD(l2, b_ + 8192); TRRD(h2, b_ + 10240); TRRD(l3, b_ + 12288); TRRD(h3, b_ + 14336); \
        asm volatile("s_waitcnt lgkmcnt(0)" ::: "memory"); SBAR(); \
        o[d0] = __builtin_amdgcn_mfma_f32_32x32x16_bf16((bf16x8){l0[0], l0[1], l0[2], l0[3], h0[0], h0[1], h0[2], h0[3]}, pa0, o[d0], 0, 0, 0); \
        o[d0] = __builtin_amdgcn_mfma_f32_32x32x16_bf16((bf16x8){l1[0], l1[1], l1[2], l1[3], h1[0], h1[1], h1[2], h1[3]}, pa1, o[d0], 0, 0, 0); \
        o[d0] = __builtin_amdgcn_mfma_f32_32x32x16_bf16((bf16x8){l2[0], l2[1], l2[2], l2[3], h2[0], h2[1], h2[2], h2[3]}, pa2, o[d0], 0, 0, 0); \
        o[d0] = __builtin_amdgcn_mfma_f32_32x32x16_bf16((bf16x8){l3[0], l3[1], l3[2], l3[3], h3[0], h3[1], h3[2], h3[3]}, pa3, o[d0], 0, 0, 0); } while (0)
    PV_D0(0); PV_D0(1); PV_D0(2); PV_D0(3);
#undef PV_D0
#undef TRRD
}
__device__ __forceinline__ void pack_p(const f32x16& p0, const f32x16& p1, bf16x8& pa0, bf16x8& pa1, bf16x8& pa2, bf16x8& pa3) {
#define PK4(P, B_, OUT) do { unsigned a0 = cvtpk(P[B_+0], P[B_+1]), a1 = cvtpk(P[B_+2], P[B_+3]); \
        unsigned b0 = cvtpk(P[B_+4], P[B_+5]), b1 = cvtpk(P[B_+6], P[B_+7]); \
        auto r0 = __builtin_amdgcn_permlane32_swap(a0, b0, false, false); auto r1 = __builtin_amdgcn_permlane32_swap(a1, b1, false, false); \
        u32x4 w = {r0[0], r1[0], r0[1], r1[1]}; OUT = *reinterpret_cast<bf16x8*>(&w); } while (0)
    PK4(p0, 0, pa0); PK4(p0, 8, pa1); PK4(p1, 0, pa2); PK4(p1, 8, pa3);
#undef PK4
}
__device__ __forceinline__ float swap_max(float v) { auto rr = __builtin_amdgcn_permlane32_swap(__float_as_uint(v), __float_as_uint(v), false, false); return fmaxf(__uint_as_float(rr[0]), __uint_as_float(rr[1])); }
__device__ __forceinline__ float swap_sum(float v) { auto rr = __builtin_amdgcn_permlane32_swap(__float_as_uint(v), __float_as_uint(v), false, false); return __uint_as_float(rr[0]) + __uint_as_float(rr[1]); }

struct UnitPtrs {
    const bf16_t* Q; int ldq;
    const bf16_t* K; int ldk;
    const bf16_t* V; int ldv;
    const bf16_t* KR;
    const float* bias;
    const bf16_t* G;
    bf16_t* O; int ldo;
    int P0;
    float c2;
    const bf16_t* ST;
    int T0;
};
template <int MODE>
__device__ __forceinline__ void mixer_unit(const UnitPtrs& U, ATT_LAS char* lds) {
    constexpr bool ROPE = (MODE == 1);
    constexpr int NQ = ROPE ? 12 : 8;
    constexpr int K_OFF = 0, KR_OFF = 32768, V_OFF = (MODE == 1) ? 49152 : 32768, V_SZ = (MODE == 2) ? 32768 : 16384, BIAS_OFF = 65536, SCR_OFF = 98304;
    int tid_ = threadIdx.x; asm volatile("" : "+v"(tid_));
    const int tid = tid_, wid = __builtin_amdgcn_readfirstlane(tid >> 6), lane = tid & 63, r32 = lane & 31, hi = lane >> 5;
    const int rg = (MODE == 2) ? (wid >> 1) : wid;
    const int vhalf = (MODE == 2) ? (wid & 1) : 0;
    const int qlo = U.P0 + 32 * rg;
    const int tbase = (MODE == 2) ? (U.T0 >> 6) : 0;
    const int NT = (U.P0 + ((MODE == 2) ? 128 : 256)) / 64 - tbase;
    const int tlast = (qlo >> 6) - tbase;
    bf16x8 qr[NQ];
    { const bf16_t* qp = U.Q + (size_t)(32 * rg + r32) * U.ldq + hi * 8;
#pragma unroll
      for (int d0 = 0; d0 < NQ; ++d0) qr[d0] = *(const bf16x8*)(qp + d0 * 16); }
    const int sr = tid >> 4, sc = (tid & 15) * 8;
    const int kws = KSWZ(sr, sc * 2), vst0 = v_st(sr, sc), vst1 = v_st(32 + sr, sc);
    const int rr = tid >> 3, rc = (tid & 7) * 8, krs = KSWZ64(rr, rc * 2);
    const int vbase = (int)(unsigned)(uintptr_t)(lds + V_OFF) + v_rd_base(lane) + vhalf * SHM_T;
    bf16x8 st_k0, st_k1, st_v0, st_v1, st_v2, st_v3, st_r;
#define ST_LOAD(kb_) do { const bf16_t* kp_ = U.K + (size_t)((kb_) + sr) * U.ldk + sc; st_k0 = *(const bf16x8*)kp_; st_k1 = *(const bf16x8*)(kp_ + (size_t)32 * U.ldk); \
        const bf16_t* vp_ = U.V + (size_t)((kb_) + sr) * U.ldv + sc; st_v0 = *(const bf16x8*)vp_; st_v1 = *(const bf16x8*)(vp_ + (size_t)32 * U.ldv); \
        if (MODE == 2) { st_v2 = *(const bf16x8*)(vp_ + 128); st_v3 = *(const bf16x8*)(vp_ + (size_t)32 * U.ldv + 128); } \
        if (MODE == 1) { st_r = *(const bf16x8*)(U.KR + (size_t)((kb_) + rr) * 64 + rc); } } while (0)
#define ST_WRITE(bf) do { ATT_LAS char* kd_ = lds + K_OFF + (bf) * SHM_T; *(ATT_LAS bf16x8*)(kd_ + kws) = st_k0; *(ATT_LAS bf16x8*)(kd_ + kws + 32 * 256) = st_k1; \
        ATT_LAS char* vd_ = lds + V_OFF + (bf) * V_SZ; *(ATT_LAS bf16x8*)(vd_ + vst0) = st_v0; *(ATT_LAS bf16x8*)(vd_ + vst1) = st_v1; \
        if (MODE == 2) { *(ATT_LAS bf16x8*)(vd_ + SHM_T + vst0) = st_v2; *(ATT_LAS bf16x8*)(vd_ + SHM_T + vst1) = st_v3; } \
        if (MODE == 1) { *(ATT_LAS bf16x8*)(lds + KR_OFF + (bf) * 8192 + krs) = st_r; } } while (0)
    float m_reg = -1e30f, l_reg = 0.f; f32x16 o[4] = {};
    float colf[(MODE == 2) ? 32 : 1];
    if (MODE == 2) {
#pragma unroll
        for (int r = 0; r < 16; ++r) { const int c = (r & 3) + 8 * (r >> 2); colf[r] = __builtin_amdgcn_exp2f(-U.c2 * (float)c); colf[16 + r] = __builtin_amdgcn_exp2f(-U.c2 * (float)(c + 32)); } }
    const int qpos = qlo + r32;
    ST_LOAD(tbase * 64);
    if (MODE == 0) { const int nk = U.P0 + 256; ATT_LAS float* bl = (ATT_LAS float*)(lds + BIAS_OFF); for (int i = tid; i < nk; i += 512) bl[i] = -U.bias[i]; }
    ST_WRITE(0);
    __syncthreads();
    if (MODE == 2) { if (U.ST) {
        const bf16_t* sp = U.ST + (size_t)(vhalf * 128 + r32) * 128 + hi * 8;
        bf16x8 sa[4][8];
#pragma unroll
        for (int d0 = 0; d0 < 4; ++d0)
#pragma unroll
            for (int ks = 0; ks < 8; ++ks) sa[d0][ks] = *(const bf16x8*)(sp + (size_t)d0 * 32 * 128 + ks * 16);
#pragma unroll
        for (int d0 = 0; d0 < 4; ++d0)
#pragma unroll
            for (int ks = 0; ks < 8; ++ks) o[d0] = __builtin_amdgcn_mfma_f32_32x32x16_bf16(sa[d0][ks], qr[ks], o[d0], 0, 0, 0);
        const float rf = __builtin_amdgcn_exp2f(U.c2 * (float)(qpos - U.T0 + 1));
#pragma unroll
        for (int d0 = 0; d0 < 4; ++d0)
#pragma unroll
            for (int r = 0; r < 16; ++r) o[d0][r] *= rf; } }
#define STEP(t, B) do { const int t_ = (t); const bool more_ = (t_ + 1 < NT); \
        if (more_) ST_LOAD((tbase + t_ + 1) * 64); \
        if (t_ <= tlast) { f32x16 p0, p1; bf16x8 pa0, pa1, pa2, pa3; \
            qkt<ROPE>(p0, p1, lds + K_OFF + (B) * SHM_T, lds + KR_OFF + (B) * 8192, r32, hi, qr); \
            const int dq = qpos - (tbase + t_) * 64 - 4 * hi; \
            if (MODE == 2) { \
                if (t_ < tlast) { const float rowf = __builtin_amdgcn_exp2f(U.c2 * (float)dq);     \
                    _Pragma("unroll") for (int r = 0; r < 16; ++r) { p0[r] *= rowf * colf[r]; p1[r] *= rowf * colf[16 + r]; } \
                } else { \
                    _Pragma("unroll") for (int r = 0; r < 16; ++r) { const int c = (r & 3) + 8 * (r >> 2); \
                        p0[r] *= __builtin_amdgcn_exp2f(U.c2 * fabsf((float)(dq - c))); p1[r] *= __builtin_amdgcn_exp2f(U.c2 * fabsf((float)(dq - c - 32))); } } \
            } else { \
                if (MODE == 0) { const ATT_LAS float* bl = (const ATT_LAS float*)(lds + BIAS_OFF) + t_ * 64 + 4 * hi; \
                    _Pragma("unroll") for (int g = 0; g < 4; ++g) { const f32x4 b0 = *(const ATT_LAS f32x4*)(bl + 8 * g), b1 = *(const ATT_LAS f32x4*)(bl + 32 + 8 * g); \
                        _Pragma("unroll") for (int j = 0; j < 4; ++j) { p0[4 * g + j] = fmaf(p0[4 * g + j], U.c2, b0[j]); p1[4 * g + j] = fmaf(p1[4 * g + j], U.c2, b1[j]); } } \
                    if (t_ == tlast) { const float NEG = -__builtin_inff(); \
                        _Pragma("unroll") for (int r = 0; r < 16; ++r) { const int c = (r & 3) + 8 * (r >> 2); if (dq - c < 0) p0[r] = NEG; if (dq - c - 32 < 0) p1[r] = NEG; } } \
                } else { _Pragma("unroll") for (int r = 0; r < 16; ++r) { p0[r] *= U.c2; p1[r] *= U.c2; } } \
                float pmax = p0[0]; \
                _Pragma("unroll") for (int r = 1; r < 16; ++r) pmax = fmaxf(pmax, p0[r]); \
                _Pragma("unroll") for (int r = 0; r < 16; ++r) pmax = fmaxf(pmax, p1[r]); \
                pmax = swap_max(pmax); \
                const float mn = fmaxf(m_reg, pmax), alpha = __builtin_amdgcn_exp2f(m_reg - mn); m_reg = mn; \
                if (!__all(alpha == 1.0f)) { _Pragma("unroll") for (int d_ = 0; d_ < 4; ++d_) _Pragma("unroll") for (int r = 0; r < 16; ++r) o[d_][r] *= alpha; } \
                float ps = 0.f; \
                _Pragma("unroll") for (int r = 0; r < 16; ++r) { p0[r] = __builtin_amdgcn_exp2f(p0[r] - mn); p1[r] = __builtin_amdgcn_exp2f(p1[r] - mn); ps += p0[r] + p1[r]; } \
                ps = swap_sum(ps); l_reg = l_reg * alpha + ps; \
            } \
            pack_p(p0, p1, pa0, pa1, pa2, pa3); \
            pv_tile_T(o, vbase + (B) * V_SZ, pa0, pa1, pa2, pa3); } \
        if (more_) ST_WRITE((B) ^ 1); \
        __syncthreads(); } while (0)
    for (int t = 0; t < NT; t += 2) { STEP(t, 0); STEP(t + 1, 1); }
#undef STEP
#undef ST_LOAD
#undef ST_WRITE
    bf16_t* orow = U.O + (size_t)(32 * rg + r32) * U.ldo + vhalf * 128 + 4 * hi;
    if (MODE == 2) {
        float ss = 0.f;
#pragma unroll
        for (int d0 = 0; d0 < 4; ++d0)
#pragma unroll
            for (int r = 0; r < 16; ++r) ss += o[d0][r] * o[d0][r];
        ss = swap_sum(ss);
        ATT_LAS float* scr = (ATT_LAS float*)(lds + SCR_OFF);
        if (hi == 0) scr[wid * 32 + r32] = ss;
        __syncthreads();
        const float tot = ss + scr[(wid ^ 1) * 32 + r32];
        const float rstd = __builtin_amdgcn_rsqf(tot * (1.0f / 256.0f) + 1e-6f);
        const bf16_t* grow = U.G + (size_t)(32 * rg + r32) * 1024 + vhalf * 128 + 4 * hi;
#pragma unroll
        for (int d0 = 0; d0 < 4; ++d0)
#pragma unroll
            for (int g = 0; g < 4; ++g) { const u32x2 gw = *(const u32x2*)(grow + 32 * d0 + 8 * g);
                const float g0 = __uint_as_float(gw.x << 16), g1 = __uint_as_float(gw.x & 0xffff0000u), g2 = __uint_as_float(gw.y << 16), g3 = __uint_as_float(gw.y & 0xffff0000u);
                u32x2 w; w.x = cvtpk(o[d0][4 * g] * rstd * g0, o[d0][4 * g + 1] * rstd * g1); w.y = cvtpk(o[d0][4 * g + 2] * rstd * g2, o[d0][4 * g + 3] * rstd * g3);
                *(u32x2*)(orow + 32 * d0 + 8 * g) = w; }
        __syncthreads();
    } else {
        const float inv = 1.0f / l_reg;
#pragma unroll
        for (int d0 = 0; d0 < 4; ++d0)
#pragma unroll
            for (int g = 0; g < 4; ++g) { u32x2 w; w.x = cvtpk(o[d0][4 * g] * inv, o[d0][4 * g + 1] * inv); w.y = cvtpk(o[d0][4 * g + 2] * inv, o[d0][4 * g + 3] * inv);
                *(u32x2*)(orow + 32 * d0 + 8 * g) = w; }
    }
}

__device__ __forceinline__ void ret_state_unit(const bf16_t* K, int ldk, const bf16_t* V, int ldv, float c2, float* SL, ATT_LAS char* lds) {
    int tid_ = threadIdx.x; asm volatile("" : "+v"(tid_));
    const int tid = tid_, wid = __builtin_amdgcn_readfirstlane(tid >> 6), lane = tid & 63, r32 = lane & 31, hi = lane >> 5;
    const int sr = tid >> 4, sc = (tid & 15) * 8, vst0 = v_st(sr, sc), vst1 = v_st(32 + sr, sc);
    constexpr int KI = 0, VI = 16384;
    const int kb = (int)(unsigned)(uintptr_t)(lds + KI) + v_rd_base(lane), vb = (int)(unsigned)(uintptr_t)(lds + VI) + v_rd_base(lane) + (wid >> 2) * SHM_T;
    f32x16 acc[4] = {};
    for (int t = 0; t < 4; ++t) {
        const bf16_t* kp = K + (size_t)(t * 64 + sr) * ldk + sc; const bf16_t* vp = V + (size_t)(t * 64 + sr) * ldv + sc;
        const u32x4 k0 = *(const u32x4*)kp, k1 = *(const u32x4*)(kp + (size_t)32 * ldk);
        const bf16x8 v0 = *(const bf16x8*)vp, v1 = *(const bf16x8*)(vp + (size_t)32 * ldv), v2 = *(const bf16x8*)(vp + 128), v3 = *(const bf16x8*)(vp + (size_t)32 * ldv + 128);
        const float w0 = __builtin_amdgcn_exp2f(c2 * (float)(255 - (t * 64 + sr))), w1 = __builtin_amdgcn_exp2f(c2 * (float)(255 - (t * 64 + 32 + sr)));
        u32x4 q0, q1;
#define WSC(w, s) cvtpk(__uint_as_float((w) << 16) * (s), __uint_as_float((w) & 0xffff0000u) * (s))
        q0.x = WSC(k0.x, w0); q0.y = WSC(k0.y, w0); q0.z = WSC(k0.z, w0); q0.w = WSC(k0.w, w0); q1.x = WSC(k1.x, w1); q1.y = WSC(k1.y, w1); q1.z = WSC(k1.z, w1); q1.w = WSC(k1.w, w1);
#undef WSC
        __syncthreads();
        *(ATT_LAS u32x4*)(lds + KI + vst0) = q0; *(ATT_LAS u32x4*)(lds + KI + vst1) = q1;
        *(ATT_LAS bf16x8*)(lds + VI + vst0) = v0; *(ATT_LAS bf16x8*)(lds + VI + vst1) = v1; *(ATT_LAS bf16x8*)(lds + VI + SHM_T + vst0) = v2; *(ATT_LAS bf16x8*)(lds + VI + SHM_T + vst1) = v3;
        __syncthreads();
#define TRR(dst, base, off) asm volatile("ds_read_b64_tr_b16 %0, %1 offset:%2" : "=&v"(dst) : "v"(base), "i"(off) : "memory")
#define KS_STEP(ks) do { s16x4 vl, vh, kl0, kh0, kl1, kh1, kl2, kh2, kl3, kh3; \
        TRR(vl, vbw, (ks) * 4096); TRR(vh, vbw, (ks) * 4096 + 2048); \
        TRR(kl0, kb, 0 * 512 + (ks) * 4096); TRR(kh0, kb, 0 * 512 + (ks) * 4096 + 2048); TRR(kl1, kb, 1 * 512 + (ks) * 4096); TRR(kh1, kb, 1 * 512 + (ks) * 4096 + 2048); \
        TRR(kl2, kb, 2 * 512 + (ks) * 4096); TRR(kh2, kb, 2 * 512 + (ks) * 4096 + 2048); TRR(kl3, kb, 3 * 512 + (ks) * 4096); TRR(kh3, kb, 3 * 512 + (ks) * 4096 + 2048); \
        asm volatile("s_waitcnt lgkmcnt(0)" ::: "memory"); SBAR(); \
        const bf16x8 vf = (bf16x8){vl[0], vl[1], vl[2], vl[3], vh[0], vh[1], vh[2], vh[3]}; \
        acc[0] = __builtin_amdgcn_mfma_f32_32x32x16_bf16(vf, (bf16x8){kl0[0], kl0[1], kl0[2], kl0[3], kh0[0], kh0[1], kh0[2], kh0[3]}, acc[0], 0, 0, 0); \
        acc[1] = __builtin_amdgcn_mfma_f32_32x32x16_bf16(vf, (bf16x8){kl1[0], kl1[1], kl1[2], kl1[3], kh1[0], kh1[1], kh1[2], kh1[3]}, acc[1], 0, 0, 0); \
        acc[2] = __builtin_amdgcn_mfma_f32_32x32x16_bf16(vf, (bf16x8){kl2[0], kl2[1], kl2[2], kl2[3], kh2[0], kh2[1], kh2[2], kh2[3]}, acc[2], 0, 0, 0); \
        acc[3] = __builtin_amdgcn_mfma_f32_32x32x16_bf16(vf, (bf16x8){kl3[0], kl3[1], kl3[2], kl3[3], kh3[0], kh3[1], kh3[2], kh3[3]}, acc[3], 0, 0, 0); } while (0)
        const int vbw = vb + (wid & 3) * 512;
        KS_STEP(0); KS_STEP(1); KS_STEP(2); KS_STEP(3);
#undef KS_STEP
#undef TRR
    }
#pragma unroll
    for (int e0 = 0; e0 < 4; ++e0)
#pragma unroll
        for (int r = 0; r < 16; ++r) SL[(size_t)(32 * wid + (r & 3) + 8 * (r >> 2) + 4 * hi) * 128 + 32 * e0 + r32] = acc[e0][r];
    __syncthreads();
}
}

constexpr int DM = 2048, NBATCH = 8, SEQ = 4096, DEPTH = 4, M = NBATCH * SEQ;
constexpr int IN_W = 12358, NIN = 12544, DFF = 5632, NUG = 2 * DFF, NUQ = 1280, NUKV = 1536;
constexpr float NORM_EPS = 1e-6f;
constexpr int NWAVES = 8;
constexpr int PH = 11, NPHASE = DEPTH * PH + 1;

constexpr size_t MiB = 1u << 20;
constexpr size_t WS_CTL = 0, CTL_ZERO_BYTES = 1 * MiB;
constexpr size_t WS_T128 = 1 * MiB, WS_T64 = 3 * MiB, WS_CL = 4 * MiB, WS_RSQ = 5 * MiB, WS_RSKV = 5 * MiB + 512 * 1024, WS_FF = 6 * MiB;
constexpr size_t WS_W = 8 * MiB;
constexpr size_t WO_IN = 0, WO_UQ = WO_IN + (size_t)NIN * DM * 2, WO_UKV = WO_UQ + (size_t)NUQ * 512 * 2, WO_BF = WO_UKV + (size_t)NUKV * 256 * 2, WO_BM = WO_BF + (size_t)DM * 1024 * 2,
                 WO_BR = WO_BM + (size_t)DM * 1024 * 2, WO_OUT = WO_BR + (size_t)DM * 1024 * 2, WO_UG = WO_OUT + (size_t)DM * DM * 2, WO_DN = WO_UG + (size_t)NUG * DM * 2, WO_END = WO_DN + (size_t)DM * DFF * 2;
static_assert(WO_END == 137 * MiB, "weight region");
constexpr size_t WS_H = 146 * MiB;
constexpr size_t WS_BIG = 274 * MiB;
constexpr size_t WS_GATES = WS_BIG, WS_FQKV = WS_GATES + 384 * MiB, WS_CQ = WS_FQKV + 144 * MiB, WS_CKV = WS_CQ + 32 * MiB, WS_RQ = WS_CKV + 16 * MiB, WS_RK = WS_RQ + 32 * MiB,
                 WS_RV = WS_RK + 32 * MiB, WS_RG = WS_RV + 64 * MiB, WS_KR = WS_RG + 64 * MiB, WS_QM = WS_KR + 4 * MiB, WS_KVM = WS_QM + 72 * MiB, WS_A = WS_KVM + 96 * MiB,
                 WS_BM = WS_A + 64 * MiB, WS_C = WS_BM + 64 * MiB, WS_SLOC = WS_C + 64 * MiB, WS_SST = WS_SLOC + 64 * MiB, WS_MIX_END = WS_SST + 32 * MiB;
constexpr size_t WS_TMP = WS_FQKV;
static_assert(WS_RV - WS_FQKV == 256 * MiB, "tmp overlay");
constexpr size_t WS_U = WS_BIG, WS_GT = WS_U + 352 * MiB, WS_ACT = WS_GT + 352 * MiB, WS_FFN_END = WS_ACT + 352 * MiB;
constexpr size_t WS_UTAIL = WS_U, WS_UHEAD = WS_U + 8 * MiB, WS_GHEAD = WS_U + 16 * MiB;
constexpr size_t WS_END = WS_MIX_END > WS_FFN_END ? WS_MIX_END : WS_FFN_END;
constexpr int CW_BAR = 4096;
constexpr int CW_QUEUE = 16384;

constexpr int RING_OFF = 0, RING_BYTES = 131072;
constexpr int LDSCTL_OFF = RING_BYTES, MISC_OFF = LDSCTL_OFF + 320;
constexpr int LDS_BYTES = 147456;
static_assert(MISC_OFF + 128 <= LDS_BYTES, "LDS map");

#define LAS __attribute__((address_space(3)))
typedef unsigned short bf16;
typedef unsigned v4u __attribute__((ext_vector_type(4)));
typedef float f32x4 __attribute__((ext_vector_type(4)));
#define LDS_WAIT() asm volatile("s_waitcnt lgkmcnt(0)" ::: "memory")
__device__ __forceinline__ unsigned f2bf(float f) { unsigned u = __builtin_bit_cast(unsigned, f); return (u + 0x7fffu + ((u >> 16) & 1u)) >> 16; }
__device__ __forceinline__ unsigned pk2(float lo, float hi) { return f2bf(lo) | (f2bf(hi) << 16); }

#define XB_TMO      128
#define XB_XCNT(j)  (256  + 64 * (j))
#define XB_XSUB(j)  (1280 + 64 * (j))
#define XB_XGEN(j)  (2304 + 64 * (j))
#define XB_TOP      3328
#define XB_TOPGEN   3392
#define XCD_BAR_WORDS 3456
#define XB_SPIN_CAP (1u << 18)
__device__ __forceinline__ unsigned xb_ld(unsigned* p)              { return __hip_atomic_load(p, __ATOMIC_RELAXED, __HIP_MEMORY_SCOPE_AGENT); }
__device__ __forceinline__ unsigned xb_add(unsigned* p, unsigned v) { return __hip_atomic_fetch_add(p, v, __ATOMIC_RELAXED, __HIP_MEMORY_SCOPE_AGENT); }
__device__ __forceinline__ unsigned xb_xcc_id() { return (unsigned)__builtin_amdgcn_s_getreg((3 << 11) | 20) & 0xFu; }
#define XB_SPIN(cond, bar) do { unsigned _sp = 0; while (cond) { __builtin_amdgcn_s_sleep(1); \
    if ((++_sp & 255u) == 0u) { if (xb_ld(&(bar)[XB_TMO])) break; if (_sp > XB_SPIN_CAP) { atomicAdd(&(bar)[XB_TMO], 1u); break; } } } } while (0)
struct XcdBarrier { unsigned* bar; unsigned x; volatile LAS unsigned* st; };
__device__ __forceinline__ XcdBarrier xcd_barrier_post(unsigned* bar, volatile LAS unsigned* st) {
    XcdBarrier b; b.bar = bar; b.x = xb_xcc_id(); b.st = st;
    if (threadIdx.x == 0) (void)xb_add(&bar[XB_XCNT(b.x)], 1u);
    return b;
}
__device__ __forceinline__ void xcd_barrier_complete(unsigned* bar, unsigned x, unsigned& nloc, unsigned& nx) {
    const unsigned G = gridDim.x * gridDim.y * gridDim.z;
    unsigned sum, cnt, mine, sp = 0u;
    for (;;) {
        sum = 0u; cnt = 0u; mine = 0u;
#pragma unroll
        for (unsigned j = 0; j < 16; ++j) { const unsigned c = xb_ld(&bar[XB_XCNT(j)]); sum += c; cnt += (c > 0u) ? 1u : 0u; mine = (j == x) ? c : mine; }
        if (sum == G) break;
        __builtin_amdgcn_s_sleep(1);
        if ((++sp & 255u) == 0u) { if (xb_ld(&bar[XB_TMO])) break; if (sp > XB_SPIN_CAP) { atomicAdd(&bar[XB_TMO], 1u); break; } }
    }
    nloc = mine > 0u ? mine : 1u; nx = cnt > 0u ? cnt : 1u;
}
__device__ __forceinline__ void xcd_barrier(const XcdBarrier& b) {
    asm volatile("s_waitcnt vmcnt(0)" ::: "memory");
    __syncthreads();
    if (threadIdx.x == 0) {
        unsigned bx = b.x; size_t bz_ = 0; asm volatile("" : "+s"(bz_), "+s"(bx)); unsigned* bar = b.bar + bz_;
        __builtin_amdgcn_s_waitcnt(0);
        unsigned nloc = b.st[0], nx = b.st[1];
        if (nloc == 0u) { xcd_barrier_complete(bar, bx, nloc, nx); b.st[0] = nloc; b.st[1] = nx; }
        const unsigned old = xb_add(&bar[XB_XSUB(bx)], 1u);
        const unsigned gen = old / nloc;
        if (old + 1u == (gen + 1u) * nloc) {
            __builtin_amdgcn_fence(__ATOMIC_RELEASE, "agent");
            asm volatile("s_waitcnt vmcnt(0)" ::: "memory");
            const unsigned og = xb_add(&bar[XB_TOP], 1u);
            const unsigned tg = og / nx;
            if (og + 1u == (tg + 1u) * nx) xb_add(&bar[XB_TOPGEN], 1u);
            else XB_SPIN(xb_ld(&bar[XB_TOPGEN]) == tg, bar);
            __builtin_amdgcn_fence(__ATOMIC_ACQUIRE, "agent");
            xb_add(&bar[XB_XGEN(bx)], 1u);
            asm volatile("s_waitcnt vmcnt(0)" ::: "memory");
        } else {
            XB_SPIN(xb_ld(&bar[XB_XGEN(bx)]) == gen, bar);
            __builtin_amdgcn_fence(__ATOMIC_ACQUIRE, "agent");
            asm volatile("s_waitcnt vmcnt(0)" ::: "memory");
        }
    }
    __syncthreads();
}

__device__ __forceinline__ float wave_sum(float v, int lane) {
#pragma unroll
    for (int o = 1; o < 64; o <<= 1) v += __builtin_bit_cast(float, __builtin_amdgcn_ds_bpermute((lane ^ o) << 2, __builtin_bit_cast(int, v)));
    return v;
}
__device__ __forceinline__ double lane_up_d(double v, int lane, int o) {
    const int src = (lane >= o ? lane - o : lane) << 2; const unsigned long long u = __builtin_bit_cast(unsigned long long, v);
    const unsigned lo = (unsigned)__builtin_amdgcn_ds_bpermute(src, (int)(unsigned)u), hi = (unsigned)__builtin_amdgcn_ds_bpermute(src, (int)(unsigned)(u >> 32));
    return __builtin_bit_cast(double, ((unsigned long long)hi << 32) | lo);
}
__device__ __forceinline__ void wconv_item(const float* W, int ldw, int src, int valid, const float* kscale, bf16* dst, int K, int k0, LAS float* scr, int lane) {
    const int j = lane & 31; const bool ok = j < valid;
    float wv[32];
#pragma unroll
    for (int i = 0; i < 32; ++i) { const int kk = 2 * i + (lane >> 5); wv[i] = ok ? W[(size_t)(k0 + kk) * ldw + src + j] : 0.f; }
    if (kscale) {
#pragma unroll
        for (int i = 0; i < 32; ++i) wv[i] *= kscale[k0 + 2 * i + (lane >> 5)]; }
#pragma unroll
    for (int i = 0; i < 32; ++i) scr[(2 * i + (lane >> 5)) * 33 + j] = wv[i];
    LDS_WAIT(); asm volatile("" ::: "memory");
    const int c = lane & 7;
#pragma unroll
    for (int jj = 0; jj < 4; ++jj) { const int n = (lane >> 3) + 8 * jj; const LAS float* s = scr + (8 * c) * 33 + n;
        v4u o; o.x = pk2(s[0 * 33], s[1 * 33]); o.y = pk2(s[2 * 33], s[3 * 33]); o.z = pk2(s[4 * 33], s[5 * 33]); o.w = pk2(s[6 * 33], s[7 * 33]);
        *(v4u*)(dst + (size_t)n * K + k0 + 8 * c) = o; }
    LDS_WAIT(); asm volatile("" ::: "memory");
}
__device__ __forceinline__ void inproj_src(int g, int& src, int& valid) {
    const int n = g * 32; valid = 32;
    if (n < 2304) src = n;
    else if (n < 2816) src = 2310 + (n - 2304);
    else if (n < 3072) src = 2822 + (n - 2816);
    else if (n < 3328) { const int p = n - 3072; if (p == 0) src = 3078; else if (p == 32) { src = 2304; valid = 6; } else if (p == 128) src = 3110; else { src = 0; valid = 0; } }
    else if (n < 4352) { const int base = (n < 3840) ? 3142 : 3654; const int p = (n < 3840) ? n - 3328 : n - 3840; const int t = p >> 8, q = p & 255, bj = q >> 7, x = q & 127, hh = x >> 6, i = x & 63;
        src = base + 128 * (2 * t + hh) + 64 * bj + i; }
    else if (n < 5376) src = 4166 + (n - 4352);
    else if (n < 6400) src = 5190 + (n - 5376);
    else src = 6214 + (n - 6400);
}
__device__ __forceinline__ void uq_src(int g, int& src, int& valid) {
    const int n = g * 32; valid = 32;
    if (n < 768) { const int t = n >> 8, q = n & 255, bj = q >> 7, x = q & 127; src = 192 * (2 * t + bj) + x; }
    else { const int t4 = (n >= 1024) ? 1 : 0; const int q = n - 768 - 256 * t4, bj = q >> 7, x = q & 127, hh = (x >> 5) + 4 * t4; if (hh < 6) src = 192 * hh + 128 + 32 * bj; else { src = 0; valid = 0; } }
}

struct Args {
    const float* in[19]; float* out; unsigned char* ws;
    float invf128[64]; float invf64[32];
    int ph_lo, ph_hi;
};

static_assert(sizeof(Args) == 560, "Args layout");

#define KAS __attribute__((address_space(4)))
#define GAS1 __attribute__((address_space(1)))
__device__ __forceinline__ const KAS char* karg_base() { size_t z = 0; asm volatile("" : "+s"(z)); return (const KAS char*)__builtin_amdgcn_kernarg_segment_ptr() + z; }
__device__ __forceinline__ const float* arg_in(int i) { typedef const GAS1 float* gp; return (const float*)(*(const KAS gp*)(karg_base() + 8 * i)); }
__device__ __forceinline__ float* arg_out() { typedef GAS1 float* gp; return (float*)(*(const KAS gp*)(karg_base() + 152)); }
__device__ __forceinline__ unsigned char* arg_ws() { typedef GAS1 unsigned char* gp; return (unsigned char*)(*(const KAS gp*)(karg_base() + 160)); }
__device__ __forceinline__ float arg_invf128(int i) { return *(const KAS float*)(karg_base() + 168 + 4 * i); }
__device__ __forceinline__ float arg_invf64(int i) { return *(const KAS float*)(karg_base() + 424 + 4 * i); }
struct Ctx { int tid, lane, wave, G, vcu, gw, NGW; LAS unsigned char* lds; unsigned char* ws; };
__device__ __forceinline__ Ctx ctx_local(const Ctx& C0) { Ctx C = C0; int t_ = threadIdx.x; asm volatile("" : "+v"(t_)); C.tid = t_; C.lane = t_ & 63; size_t z_ = 0; asm volatile("" : "+s"(C.wave), "+s"(C.gw), "+s"(C.vcu), "+s"(z_)); C.ws = arg_ws() + z_; return C; }

constexpr int XPITCH = 4096;
__device__ __forceinline__ void cvt8(const v4u w, float (&v)[8]) {
    v[0] = __uint_as_float(w.x << 16); v[1] = __uint_as_float(w.x & 0xffff0000u); v[2] = __uint_as_float(w.y << 16); v[3] = __uint_as_float(w.y & 0xffff0000u);
    v[4] = __uint_as_float(w.z << 16); v[5] = __uint_as_float(w.z & 0xffff0000u); v[6] = __uint_as_float(w.w << 16); v[7] = __uint_as_float(w.w & 0xffff0000u); }
__device__ __forceinline__ void rows_rmsnorm_first(const Ctx& C0, const float* x, const float* gain, bf16* xb, bf16* out) { const Ctx C = ctx_local(C0);
    f32x4 g[8];
#pragma unroll
    for (int j = 0; j < 8; ++j) g[j] = ((const f32x4*)gain + C.lane)[64 * j];
    for (int m = C.gw; m < M; m += 2 * C.NGW) {
        const int m2 = m + C.NGW; const bool has2 = m2 < M;
        const f32x4* xa = (const f32x4*)(x + (size_t)m * DM) + C.lane; const f32x4* xq = (const f32x4*)(x + (size_t)(has2 ? m2 : m) * DM) + C.lane;
        f32x4 va[8], vb[8]; float sa = 0.f, sb = 0.f;
#pragma unroll
        for (int j = 0; j < 8; ++j) va[j] = xa[64 * j];
#pragma unroll
        for (int j = 0; j < 8; ++j) vb[j] = xq[64 * j];
#pragma unroll
        for (int j = 0; j < 8; ++j) { sa += (va[j].x * va[j].x + va[j].y * va[j].y) + (va[j].z * va[j].z + va[j].w * va[j].w); sb += (vb[j].x * vb[j].x + vb[j].y * vb[j].y) + (vb[j].z * vb[j].z + vb[j].w * vb[j].w); }
        const float ra = __builtin_amdgcn_rsqf(wave_sum(sa, C.lane) * (1.0f / DM) + NORM_EPS), rb = __builtin_amdgcn_rsqf(wave_sum(sb, C.lane) * (1.0f / DM) + NORM_EPS);
        unsigned long long* oa = (unsigned long long*)(out + (size_t)m * DM) + C.lane; unsigned long long* ya = (unsigned long long*)(xb + (size_t)m * XPITCH) + C.lane;
#pragma unroll
        for (int j = 0; j < 8; ++j) { oa[64 * j] = (unsigned long long)pk2(va[j].x * ra * g[j].x, va[j].y * ra * g[j].y) | ((unsigned long long)pk2(va[j].z * ra * g[j].z, va[j].w * ra * g[j].w) << 32);
            ya[64 * j] = (unsigned long long)pk2(va[j].x, va[j].y) | ((unsigned long long)pk2(va[j].z, va[j].w) << 32); }
        if (has2) { unsigned long long* ob = (unsigned long long*)(out + (size_t)m2 * DM) + C.lane; unsigned long long* yb = (unsigned long long*)(xb + (size_t)m2 * XPITCH) + C.lane;
#pragma unroll
            for (int j = 0; j < 8; ++j) { ob[64 * j] = (unsigned long long)pk2(vb[j].x * rb * g[j].x, vb[j].y * rb * g[j].y) | ((unsigned long long)pk2(vb[j].z * rb * g[j].z, vb[j].w * rb * g[j].w) << 32);
                yb[64 * j] = (unsigned long long)pk2(vb[j].x, vb[j].y) | ((unsigned long long)pk2(vb[j].z, vb[j].w) << 32); } }
    }
}
__device__ __forceinline__ void rows_rmsnorm_bf16(const Ctx& C0, const bf16* xb, const float* gain, bf16* out) { const Ctx C = ctx_local(C0);
    f32x4 g[4][2];
#pragma unroll
    for (int j = 0; j < 4; ++j) { g[j][0] = *(const f32x4*)(gain + 8 * (C.lane + 64 * j)); g[j][1] = *(const f32x4*)(gain + 8 * (C.lane + 64 * j) + 4); }
    for (int m0 = C.gw; m0 < M; m0 += 4 * C.NGW) {
        v4u w[4][4];
#pragma unroll
        for (int q = 0; q < 4; ++q) { const int m = m0 + q * C.NGW; const v4u* xr = (const v4u*)(xb + (size_t)(m < M ? m : m0) * XPITCH) + C.lane;
#pragma unroll
            for (int j = 0; j < 4; ++j) w[q][j] = xr[64 * j]; }
#pragma unroll
        for (int q = 0; q < 4; ++q) { const int m = m0 + q * C.NGW; float s = 0.f;
#pragma unroll
            for (int j = 0; j < 4; ++j) { float v[8]; cvt8(w[q][j], v);
#pragma unroll
                for (int e = 0; e < 8; ++e) s += v[e] * v[e]; }
            const float r = __builtin_amdgcn_rsqf(wave_sum(s, C.lane) * (1.0f / DM) + NORM_EPS);
            if (m < M) { v4u* orow = (v4u*)(out + (size_t)m * DM) + C.lane;
#pragma unroll
                for (int j = 0; j < 4; ++j) { float v[8]; cvt8(w[q][j], v);
                    v4u o; o.x = pk2(v[0] * r * g[j][0][0], v[1] * r * g[j][0][1]); o.y = pk2(v[2] * r * g[j][0][2], v[3] * r * g[j][0][3]); o.z = pk2(v[4] * r * g[j][1][0], v[5] * r * g[j][1][1]); o.w = pk2(v[6] * r * g[j][1][2], v[7] * r * g[j][1][3]);
                    orow[64 * j] = o; } } }
    }
}
__device__ __forceinline__ void rows_rmsnorm_final(const Ctx& C0, float* outp, const float* gain) { const Ctx C = ctx_local(C0);
    f32x4 g[4][2];
#pragma unroll
    for (int j = 0; j < 4; ++j) { g[j][0] = *(const f32x4*)(gain + 8 * (C.lane + 64 * j)); g[j][1] = *(const f32x4*)(gain + 8 * (C.lane + 64 * j) + 4); }
    for (int m0 = C.gw; m0 < M; m0 += 4 * C.NGW) {
        v4u w[4][4];
#pragma unroll
        for (int q = 0; q < 4; ++q) { const int m = m0 + q * C.NGW; const v4u* xr = (const v4u*)((const bf16*)outp + (size_t)(m < M ? m : m0) * XPITCH) + C.lane;
#pragma unroll
            for (int j = 0; j < 4; ++j) w[q][j] = xr[64 * j]; }
        asm volatile("s_waitcnt vmcnt(0)" ::: "memory");
#pragma unroll
        for (int q = 0; q < 4; ++q) { const int m = m0 + q * C.NGW; float s = 0.f;
#pragma unroll
            for (int j = 0; j < 4; ++j) { float v[8]; cvt8(w[q][j], v);
#pragma unroll
                for (int e = 0; e < 8; ++e) s += v[e] * v[e]; }
            const float r = __builtin_amdgcn_rsqf(wave_sum(s, C.lane) * (1.0f / DM) + NORM_EPS);
            if (m < M) { float* orow = outp + (size_t)m * DM + 8 * C.lane;
#pragma unroll
                for (int j = 0; j < 4; ++j) { float v[8]; cvt8(w[q][j], v);
                    *(f32x4*)(orow + 512 * j) = (f32x4){v[0] * r * g[j][0][0], v[1] * r * g[j][0][1], v[2] * r * g[j][0][2], v[3] * r * g[j][0][3]};
                    *(f32x4*)(orow + 512 * j + 4) = (f32x4){v[4] * r * g[j][1][0], v[5] * r * g[j][1][1], v[6] * r * g[j][1][2], v[7] * r * g[j][1][3]}; } } }
    }
}
__device__ __forceinline__ void sincos_d(float angf, float& co, float& si) {
    const double a = (double)angf; const double k = __builtin_rint(a * 0.15915494309189535); double r = a - k * 6.283185307179586477;
    const double q = __builtin_rint(r * 0.63661977236758134308); const double y = r - q * 1.57079632679489661923; const double y2 = y * y;
    const double sy = y * (1.0 + y2 * (-1.0 / 6 + y2 * (1.0 / 120 + y2 * (-1.0 / 5040 + y2 * (1.0 / 362880 + y2 * (-1.0 / 39916800 + y2 * (1.0 / 6227020800.0)))))));
    const double cy = 1.0 + y2 * (-0.5 + y2 * (1.0 / 24 + y2 * (-1.0 / 720 + y2 * (1.0 / 40320 + y2 * (-1.0 / 3628800 + y2 * (1.0 / 479001600 + y2 * (-1.0 / 87178291200.0)))))));
    const int qi = ((int)q) & 3;
    const double s = (qi == 0) ? sy : (qi == 1) ? cy : (qi == 2) ? -sy : -cy;
    const double c = (qi == 0) ? cy : (qi == 1) ? -sy : (qi == 2) ? -cy : sy;
    co = (float)c; si = (float)s;
}
__device__ __forceinline__ void rope_tables(const Ctx& C0, const Args& A) { const Ctx C = ctx_local(C0);
    float* T128 = (float*)(C.ws + WS_T128); float* T64 = (float*)(C.ws + WS_T64);
    const int gt = (C.vcu * NWAVES + C.wave) * 64 + C.lane, NGT = C.NGW * 64;
    for (int e = gt; e < SEQ * 64; e += NGT) { const int pos = e >> 6, i = e & 63; float c, s; sincos_d((float)pos * arg_invf128(i), c, s); T128[2 * e] = c; T128[2 * e + 1] = s; }
    for (int e = gt; e < SEQ * 32; e += NGT) { const int pos = e >> 5, i = e & 31; float c, s; sincos_d((float)pos * arg_invf64(i), c, s); T64[2 * e] = c; T64[2 * e + 1] = s; }
}
__device__ __forceinline__ void p0_phase(const Ctx& C0, const Args& A, int layer) { const Ctx C = ctx_local(C0);
    LAS float* scr = (LAS float*)(C.lds + RING_OFF + C.wave * 16384);
    const float* w_in = arg_in(2) + (size_t)layer * DM * IN_W;
    const float* w_uq = arg_in(5) + (size_t)layer * 512 * 1152; const float* w_ukv = arg_in(6) + (size_t)layer * 256 * 1536;
    const float* qg = arg_in(3) + (size_t)layer * 512; const float* kvg = arg_in(4) + (size_t)layer * 256;
    const float* w_bf = arg_in(8) + (size_t)layer * 768 * DM; const float* w_bm = arg_in(9) + (size_t)layer * 768 * DM; const float* w_br = arg_in(10) + (size_t)layer * 1024 * DM;
    const float* w_out = arg_in(11) + (size_t)layer * DM * DM;
    const float* w_up = arg_in(13) + (size_t)layer * DM * DFF; const float* w_gate = arg_in(14) + (size_t)layer * DM * DFF; const float* w_dn = arg_in(17) + (size_t)layer * DFF * DM;
    bf16* Wb = (bf16*)(C.ws + WS_W);
    constexpr int I_IN = (NIN / 32) * (DM / 64), I_UQ = (NUQ / 32) * (512 / 64), I_UKV = (NUKV / 32) * (256 / 64), I_BF = (DM / 32) * (768 / 64), I_BR = (DM / 32) * (1024 / 64),
                  I_OUT = (DM / 32) * (DM / 64), I_UG = (NUG / 32) * (DM / 64), I_DN = (DM / 32) * (DFF / 64);
    constexpr int NITEMS = I_IN + I_UQ + I_UKV + 2 * I_BF + I_BR + I_OUT + I_UG + I_DN;
    for (int it = C.gw; it < NITEMS; it += C.NGW) {
        int r = it, src, valid;
        if (r < I_IN) { const int g = r / (DM / 64), kb = r % (DM / 64); inproj_src(g, src, valid); wconv_item(w_in, IN_W, src, valid, nullptr, (bf16*)((char*)Wb + WO_IN) + (size_t)g * 32 * DM, DM, kb * 64, scr, C.lane); continue; } r -= I_IN;
        if (r < I_UQ) { const int g = r / 8, kb = r % 8; uq_src(g, src, valid); wconv_item(w_uq, 1152, src, valid, qg, (bf16*)((char*)Wb + WO_UQ) + (size_t)g * 32 * 512, 512, kb * 64, scr, C.lane); continue; } r -= I_UQ;
        if (r < I_UKV) { const int g = r / 4, kb = r % 4; wconv_item(w_ukv, 1536, g * 32, 32, kvg, (bf16*)((char*)Wb + WO_UKV) + (size_t)g * 32 * 256, 256, kb * 64, scr, C.lane); continue; } r -= I_UKV;
        if (r < I_BF) { const int g = r / 12, kb = r % 12; wconv_item(w_bf, DM, g * 32, 32, nullptr, (bf16*)((char*)Wb + WO_BF) + (size_t)g * 32 * 1024, 1024, kb * 64, scr, C.lane); continue; } r -= I_BF;
        if (r < I_BF) { const int g = r / 12, kb = r % 12; wconv_item(w_bm, DM, g * 32, 32, nullptr, (bf16*)((char*)Wb + WO_BM) + (size_t)g * 32 * 1024, 1024, kb * 64, scr, C.lane); continue; } r -= I_BF;
        if (r < I_BR) { const int g = r / 16, kb = r % 16; wconv_item(w_br, DM, g * 32, 32, nullptr, (bf16*)((char*)Wb + WO_BR) + (size_t)g * 32 * 1024, 1024, kb * 64, scr, C.lane); continue; } r -= I_BR;
        if (r < I_OUT) { const int g = r / 32, kb = r % 32; wconv_item(w_out, DM, g * 32, 32, nullptr, (bf16*)((char*)Wb + WO_OUT) + (size_t)g * 32 * DM, DM, kb * 64, scr, C.lane); continue; } r -= I_OUT;
        if (r < I_UG) { const int g = r / 32, kb = r % 32; const int n = g * 32, t = n >> 8, bj = (n >> 7) & 1, x = n & 127;
            wconv_item(bj ? w_gate : w_up, DFF, 128 * t + x, 32, nullptr, (bf16*)((char*)Wb + WO_UG) + (size_t)g * 32 * DM, DM, kb * 64, scr, C.lane); continue; } r -= I_UG;
        { const int g = r / 88, kb = r % 88; wconv_item(w_dn, DM, g * 32, 32, nullptr, (bf16*)((char*)Wb + WO_DN) + (size_t)g * 32 * DFF, DFF, kb * 64, scr, C.lane); }
    }
    if (layer == 0) rows_rmsnorm_first(C, arg_in(0), arg_in(1), (bf16*)arg_out(), (bf16*)(C.ws + WS_H));
    else rows_rmsnorm_bf16(C, (const bf16*)arg_out(), arg_in(1) + (size_t)layer * DM, (bf16*)(C.ws + WS_H));
}
__device__ __forceinline__ void p2_phase(const Ctx& C0, const Args& A, int layer) { const Ctx C = ctx_local(C0);
    const float* ff = (const float*)(C.ws + WS_FF); float* cL = (float*)(C.ws + WS_CL);
    LAS double* red = (LAS double*)(C.lds + RING_OFF);
    for (int sq = C.vcu; sq < NBATCH * 6; sq += C.G) {
        const int b = sq / 6, h = sq % 6; const float bias = arg_in(7)[layer * 6 + h];
        double v[8]; double run = 0.0;
#pragma unroll
        for (int j = 0; j < 8; ++j) { const float xf = ff[((size_t)b * SEQ + C.tid * 8 + j) * 8 + h] + bias;
            const float ls = fminf(xf, 0.f) - 0.6931471805599453f * __builtin_amdgcn_logf(1.0f + __builtin_amdgcn_exp2f(-1.4426950408889634f * fabsf(xf)));
            run += (double)ls; v[j] = run; }
        double incl = run;
#pragma unroll
        for (int o = 1; o < 64; o <<= 1) { const double t = lane_up_d(incl, C.lane, o); if (C.lane >= o) incl += t; }
        __syncthreads();
        if (C.lane == 63) red[C.wave] = incl;
        __syncthreads();
        double base = incl - run;
        for (int w = 0; w < C.wave; ++w) base += red[w];
        float* dst = cL + (size_t)sq * SEQ + C.tid * 8;
#pragma unroll
        for (int j = 0; j < 8; ++j) dst[j] = (float)((base + v[j]) * 1.4426950408889634);
    }
    const bf16* cq = (const bf16*)(C.ws + WS_CQ); const bf16* ckv = (const bf16*)(C.ws + WS_CKV); float* rq = (float*)(C.ws + WS_RSQ); float* rkv = (float*)(C.ws + WS_RSKV);
    for (int m0 = C.gw; m0 < M; m0 += 4 * C.NGW) {
        v4u a[4], c[4];
#pragma unroll
        for (int q = 0; q < 4; ++q) { const int m = m0 + q * C.NGW; const int mm = m < M ? m : m0; a[q] = *((const v4u*)(cq + (size_t)mm * 512) + C.lane); c[q] = *((const v4u*)(ckv + (size_t)mm * 256) + (C.lane & 31)); }
#pragma unroll
        for (int q = 0; q < 4; ++q) { const int m = m0 + q * C.NGW;
            float s = 0.f, s2 = 0.f; const unsigned w[4] = {a[q].x, a[q].y, a[q].z, a[q].w}, w2[4] = {c[q].x, c[q].y, c[q].z, c[q].w};
#pragma unroll
            for (int j = 0; j < 4; ++j) { const float lo = __uint_as_float(w[j] << 16), hi = __uint_as_float(w[j] & 0xffff0000u); s += lo * lo + hi * hi;
                const float lo2 = __uint_as_float(w2[j] << 16), hi2 = __uint_as_float(w2[j] & 0xffff0000u); if (C.lane < 32) s2 += lo2 * lo2 + hi2 * hi2; }
            s = wave_sum(s, C.lane); s2 = wave_sum(s2, C.lane);
            if (C.lane == 0 && m < M) { rq[m] = __builtin_amdgcn_rsqf(s * (1.0f / 512.0f) + NORM_EPS); rkv[m] = __builtin_amdgcn_rsqf(s2 * (1.0f / 256.0f) + NORM_EPS); } }
    }
    { const bf16* rk = (const bf16*)(C.ws + WS_RK); const bf16* rv = (const bf16*)(C.ws + WS_RV); float* sloc = (float*)(C.ws + WS_SLOC);
      for (int u = C.vcu; u < NBATCH * 4 * 16; u += C.G) { const int k = u & 15, h = (u >> 4) & 3, b = u >> 6; const size_t row0 = (size_t)b * SEQ + 256 * k;
          att::ret_state_unit(rk + row0 * 512 + 128 * h, 512, rv + row0 * 1024 + 256 * h, 1024, __builtin_amdgcn_logf(1.0f - __builtin_amdgcn_exp2f(-5.0f - (float)h)), sloc + (size_t)u * 32768, (LAS char*)(C.lds + RING_OFF)); } }
}
__device__ __forceinline__ void ret_scan(const Ctx& C0) { const Ctx C = ctx_local(C0);
    const float* sloc = (const float*)(C.ws + WS_SLOC); bf16* sst = (bf16*)(C.ws + WS_SST);
    for (int it = C.gw * 64 + C.lane; it < NBATCH * 4 * 8192; it += C.NGW * 64) {
        const int bh = it >> 13, e4 = (it & 8191) * 4, h = bh & 3;
        const float g256 = __builtin_amdgcn_exp2f(256.0f * __builtin_amdgcn_logf(1.0f - __builtin_amdgcn_exp2f(-5.0f - (float)h)));
        f32x4 s = {0.f, 0.f, 0.f, 0.f};
        f32x4 l[16];
#pragma unroll
        for (int k = 0; k < 15; ++k) l[k] = *(const f32x4*)(sloc + ((size_t)bh * 16 + k) * 32768 + e4);
#pragma unroll
        for (int k = 0; k < 16; ++k) { const size_t o = ((size_t)bh * 16 + k) * 32768 + e4;
            *(unsigned long long*)(sst + o) = (unsigned long long)pk2(s[0], s[1]) | ((unsigned long long)pk2(s[2], s[3]) << 32);
            if (k < 15) s = s * g256 + l[k]; }
    }
}
__device__ __forceinline__ void p9_phase(const Ctx& C0, const Args& A, int layer) { const Ctx C = ctx_local(C0);
    const float* utail = (const float*)(C.ws + WS_UTAIL); const float* uhead = (const float*)(C.ws + WS_UHEAD); const float* ghead = (const float*)(C.ws + WS_GHEAD); bf16* act = (bf16*)(C.ws + WS_ACT);
    const float* cw = arg_in(15) + (size_t)layer * 3 * DFF; const float* cb = arg_in(16) + (size_t)layer * DFF;
    constexpr int NCH = DFF / 8, NITEM = (M / 256) * 2 * NCH;
    for (int it = C.gw * 64 + C.lane; it < NITEM; it += C.NGW * 64) {
        const int ch = it % NCH, rr = (it / NCH) & 1, pm = it / (2 * NCH), f0 = ch * 8;
        if ((pm & 15) == 0) continue;
        const float* p2 = rr ? utail + ((size_t)(pm - 1) * 2 + 1) * DFF : utail + ((size_t)(pm - 1) * 2) * DFF;
        const float* p1 = rr ? uhead + ((size_t)pm * 2) * DFF : utail + ((size_t)(pm - 1) * 2 + 1) * DFF;
        const float* p0 = uhead + ((size_t)pm * 2 + rr) * DFF; const float* pg = ghead + ((size_t)pm * 2 + rr) * DFF;
        unsigned o[4];
#pragma unroll
        for (int h = 0; h < 2; ++h) { const f32x4 x2 = *(const f32x4*)(p2 + f0 + 4 * h), x1 = *(const f32x4*)(p1 + f0 + 4 * h), x0 = *(const f32x4*)(p0 + f0 + 4 * h), g = *(const f32x4*)(pg + f0 + 4 * h);
            const f32x4 a = *(const f32x4*)(cw + f0 + 4 * h), b = *(const f32x4*)(cw + DFF + f0 + 4 * h), c = *(const f32x4*)(cw + 2 * DFF + f0 + 4 * h), d = *(const f32x4*)(cb + f0 + 4 * h);
            float r[4];
#pragma unroll
            for (int j = 0; j < 4; ++j) r[j] = pg8::gelu_gate(d[j] + a[j] * x2[j] + b[j] * x1[j] + c[j] * x0[j], g[j]);
            o[2 * h] = pg8::cvt_pk_bf16(r[0], r[1]); o[2 * h + 1] = pg8::cvt_pk_bf16(r[2], r[3]); }
        *(v4u*)(act + (size_t)(pm * 256 + rr) * DFF + f0) = (v4u){o[0], o[1], o[2], o[3]};
    }
}
#ifndef PROBE_SKIP_EPI
#define PROBE_SKIP_EPI 0
#endif
#ifndef KIND_MASK
#define KIND_MASK 7
#endif

__device__ __forceinline__ int queue_next(unsigned* head, volatile LAS unsigned* slot) {
    __syncthreads();
    if (threadIdx.x == 0) *slot = __hip_atomic_fetch_add(head, 1u, __ATOMIC_RELAXED, __HIP_MEMORY_SCOPE_AGENT);
    __syncthreads();
    return (int)*slot;
}
__device__ __forceinline__ void p4_phase(const Ctx& C0, const Args& A, int layer, volatile LAS unsigned* slot, int rep) { const Ctx C = ctx_local(C0);
    unsigned* qh = (unsigned*)(C.ws + WS_CTL) + CW_QUEUE + 64 * 3 * layer + 64 * 12 * rep;
    const bool k0 = rep == 0 || (KIND_MASK & 1), k1 = rep == 0 || (KIND_MASK & 2), k2 = rep == 0 || (KIND_MASK & 4);
    LAS char* lds = (LAS char*)(C.lds + RING_OFF);
    const bf16* fqkv = (const bf16*)(C.ws + WS_FQKV); const float* cL = (const float*)(C.ws + WS_CL);
    const bf16* qm = (const bf16*)(C.ws + WS_QM); const bf16* kvm = (const bf16*)(C.ws + WS_KVM); const bf16* kr = (const bf16*)(C.ws + WS_KR);
    const bf16* rq = (const bf16*)(C.ws + WS_RQ); const bf16* rk = (const bf16*)(C.ws + WS_RK); const bf16* rv = (const bf16*)(C.ws + WS_RV); const bf16* rg = (const bf16*)(C.ws + WS_RG);
    bf16* oa = (bf16*)(C.ws + WS_A); bf16* ob = (bf16*)(C.ws + WS_BM); bf16* oc = (bf16*)(C.ws + WS_C);
    if (k2) for (;;) { const int i = queue_next(qh + 128, slot); if (i >= 1024) break;
        const int qb = 31 - i / 32, bh = i % 32, b = bh >> 2, h = bh & 3; const size_t row0 = (size_t)b * SEQ + 128 * qb, seq0 = (size_t)b * SEQ;
        att::UnitPtrs U; U.Q = rq + row0 * 512 + 128 * h; U.ldq = 512; U.K = rk + seq0 * 512 + 128 * h; U.ldk = 512; U.V = rv + seq0 * 1024 + 256 * h; U.ldv = 1024; U.KR = nullptr; U.bias = nullptr;
        U.G = rg + row0 * 1024 + 256 * h; U.O = oc + row0 * 1024 + 256 * h; U.ldo = 1024; U.P0 = 128 * qb; U.T0 = 256 * (qb >> 1);
        U.ST = (qb >> 1) ? (const bf16*)(C.ws + WS_SST) + ((size_t)bh * 16 + (qb >> 1)) * 32768 : nullptr; U.c2 = __builtin_amdgcn_logf(1.0f - __builtin_amdgcn_exp2f(-5.0f - (float)h));
        att::mixer_unit<2>(U, lds); }
    if (k1) for (;;) { const int i = queue_next(qh + 64, slot); if (i >= 768) break;
        const int qb = 15 - i / 48, bh = i % 48, b = bh / 6, h = bh % 6; const size_t row0 = (size_t)b * SEQ + 256 * qb, seq0 = (size_t)b * SEQ;
        att::UnitPtrs U; U.Q = qm + row0 * 1152 + 192 * h; U.ldq = 1152; U.K = kvm + seq0 * 1536 + 256 * h; U.ldk = 1536; U.V = U.K + 128; U.ldv = 1536; U.KR = kr + seq0 * 64; U.bias = nullptr; U.G = nullptr; U.ST = nullptr; U.T0 = 0;
        U.O = ob + row0 * 1024 + 128 * h; U.ldo = 1024; U.P0 = 256 * qb; U.c2 = 0.07216878364870322f * 1.4426950408889634f;
        att::mixer_unit<1>(U, lds); }
    if (k0) for (;;) { const int i = queue_next(qh, slot); if (i >= 768) break;
        const int qb = 15 - i / 48, bh = i % 48, b = bh / 6, h = bh % 6; const size_t row0 = (size_t)b * SEQ + 256 * qb, seq0 = (size_t)b * SEQ;
        att::UnitPtrs U; U.Q = fqkv + row0 * 2304 + 128 * h; U.ldq = 2304; U.K = fqkv + seq0 * 2304 + 768 + 128 * h; U.ldk = 2304; U.V = U.K + 768; U.ldv = 2304; U.KR = nullptr; U.G = nullptr; U.ST = nullptr; U.T0 = 0;
        U.bias = cL + (size_t)bh * SEQ; U.O = oa + row0 * 1024 + 128 * h; U.ldo = 1024; U.P0 = 256 * qb; U.c2 = 0.08838834764831845f * 1.4426950408889634f;
        att::mixer_unit<0>(U, lds); }
}

__global__ void __launch_bounds__(NWAVES * 64, 2) hyb_fwd(Args args) {
    extern __shared__ __attribute__((aligned(16))) unsigned char lds_raw[];
    Ctx C;
    C.lds = (LAS unsigned char*)lds_raw;
    volatile LAS unsigned* MISC = (volatile LAS unsigned*)(C.lds + MISC_OFF);
    C.tid = 0; C.lane = 0; C.wave = __builtin_amdgcn_readfirstlane((int)threadIdx.x >> 6);
    C.G = gridDim.x; { const int bx = blockIdx.x; C.vcu = (C.G % 8 == 0) ? (bx % 8) * (C.G / 8) + bx / 8 : bx; }
    C.gw = C.vcu * NWAVES + C.wave; C.NGW = C.G * NWAVES; C.ws = arg_ws();
    unsigned* ctl = (unsigned*)(C.ws + WS_CTL);
    for (int u = threadIdx.x; u < (LDS_BYTES - LDSCTL_OFF) / 4; u += NWAVES * 64) ((LAS unsigned*)(C.lds + LDSCTL_OFF))[u] = 0u;
    __syncthreads();
#if MK_PER_PHASE
    XcdBarrier bar; bar.bar = ctl + CW_BAR; bar.x = 0; bar.st = nullptr; (void)bar;
#define GRID_BAR() do { } while (0)
#else
    XcdBarrier bar = xcd_barrier_post(ctl + CW_BAR, MISC + 8);
#define GRID_BAR() xcd_barrier(bar)
#endif
    const int lo = args.ph_lo, hi = args.ph_hi;
#define IN(k) (lo <= (k) && (k) < hi)
#ifndef PHASE_MASK
#define PHASE_MASK 0xFFFF
#endif
#define PHM(k) (((PHASE_MASK) >> (k)) & 1)
#ifndef SUB_MASK
#define SUB_MASK 0xFF
#endif
#define SUBM(k) (((SUB_MASK) >> (k)) & 1)
#ifndef REPEAT_MASK
#define REPEAT_MASK 0
#endif
#define REPS(k) (1 + (((REPEAT_MASK) >> (k)) & 1))

#define SEAM(k) do { if (IN(k) && IN((k) + 1)) GRID_BAR(); } while (0)
    PG8_LAS unsigned char* ring = (PG8_LAS unsigned char*)(C.lds + RING_OFF);
    const int bid = (int)blockIdx.x;
    if (PHM(0) && IN(0)) rope_tables(C, args);
    for (int layer = 0; layer < DEPTH; ++layer) {
        const int p = layer * PH;
        _Pragma("unroll") for (int rep = 0; rep < REPS(0); ++rep) if (PHM(0) && IN(p + 0)) { p0_phase(C, args, layer); if (rep + 1 < REPS(0)) GRID_BAR(); else SEAM(p + 0); }
        _Pragma("unroll") for (int rep = 0; rep < REPS(1); ++rep) if (PHM(1) && IN(p + 1)) { size_t wz_ = 0; asm volatile("" : "+s"(wz_)); unsigned char* wsl = arg_ws() + wz_; pg8::bf16_t* Wb = (pg8::bf16_t*)(wsl + WS_W); pg8::bf16_t* Hb = (pg8::bf16_t*)(wsl + WS_H);
            pg8::Gemm g{Hb, (const pg8::bf16_t*)((char*)Wb + WO_IN), M, NIN, DM}; pg8::StaticOrder S; S.init(M, NIN, C.G, bid);
            pg8::EpiInProj E{wsl, WS_FQKV, WS_CQ, WS_CKV, WS_KR, WS_RQ, WS_RK, WS_RV, WS_RG, WS_GATES, WS_FF, WS_T128, WS_T64, (rep + 1 < REPS(1)) ? PROBE_SKIP_EPI : 0};
            pg8::gemm_phase<pg8::EpiInProj, pg8::StaticOrder, true, true>(ring, g, S, E);
            if (rep + 1 < REPS(1)) GRID_BAR(); else SEAM(p + 1); }
        _Pragma("unroll") for (int rep = 0; rep < REPS(2); ++rep) if (PHM(2) && IN(p + 2)) { p2_phase(C, args, layer); if (rep + 1 < REPS(2)) GRID_BAR(); else SEAM(p + 2); }
        _Pragma("unroll") for (int rep = 0; rep < REPS(3); ++rep) if (PHM(3) && IN(p + 3)) { size_t wz_ = 0; asm volatile("" : "+s"(wz_)); unsigned char* wsl = arg_ws() + wz_; pg8::bf16_t* Wb = (pg8::bf16_t*)(wsl + WS_W); pg8::bf16_t* Hb = (pg8::bf16_t*)(wsl + WS_H);
            if (SUBM(0)) { pg8::Gemm g{(const pg8::bf16_t*)(wsl + WS_CQ), (const pg8::bf16_t*)((char*)Wb + WO_UQ), M, NUQ, 512}; pg8::StaticOrder S; S.init(M, NUQ, C.G, bid);
              pg8::EpiUq E{(pg8::bf16_t*)(wsl + WS_QM), (const float*)(wsl + WS_RSQ), (const float*)(wsl + WS_T64)};
              pg8::gemm_phase<pg8::EpiUq, pg8::StaticOrder, true, true>(ring, g, S, E); }
            if (SUBM(1)) { pg8::Gemm g{(const pg8::bf16_t*)(wsl + WS_CKV), (const pg8::bf16_t*)((char*)Wb + WO_UKV), M, NUKV, 256}; pg8::StaticOrder S; S.init(M, NUKV, C.G, bid);
              pg8::EpiUkv E{(pg8::bf16_t*)(wsl + WS_KVM), (const float*)(wsl + WS_RSKV)};
              pg8::gemm_phase<pg8::EpiUkv, pg8::StaticOrder, true, true>(ring, g, S, E); }
            ret_scan(C);
            if (rep + 1 < REPS(3)) GRID_BAR(); else SEAM(p + 3); }
        _Pragma("unroll") for (int rep = 0; rep < REPS(4); ++rep) if (PHM(4) && IN(p + 4)) { p4_phase(C, args, layer, MISC + 16, rep); if (rep + 1 < REPS(4)) GRID_BAR(); else SEAM(p + 4); }
        _Pragma("unroll") for (int rep = 0; rep < REPS(5); ++rep) if (PHM(5) && IN(p + 5)) { size_t wz_ = 0; asm volatile("" : "+s"(wz_)); unsigned char* wsl = arg_ws() + wz_; pg8::bf16_t* Wb = (pg8::bf16_t*)(wsl + WS_W); pg8::bf16_t* Hb = (pg8::bf16_t*)(wsl + WS_H);
            { static_assert(WS_BM - WS_A == WS_C - WS_BM && WO_BM - WO_BF == WO_BR - WO_BM, "equally spaced sub-GEMM operands");
              pg8::GemmM g{(const pg8::bf16_t*)(wsl + WS_A), (const pg8::bf16_t*)((char*)Wb + WO_BF), (WS_BM - WS_A) / 2, (WO_BM - WO_BF) / 2, 12, 4, 1024, 1024};
              pg8::StaticOrder3 S; S.init(M, DM, C.G, bid);
              pg8::EpiMergeM E{(const pg8::bf16_t*)(wsl + WS_GATES), Hb};
              pg8::gemm_phase_m<pg8::EpiMergeM, pg8::StaticOrder3, true, true>(ring, g, S, E); }
            if (rep + 1 < REPS(5)) GRID_BAR(); else SEAM(p + 5); }
        _Pragma("unroll") for (int rep = 0; rep < REPS(6); ++rep) if (PHM(6) && IN(p + 6)) { size_t wz_ = 0; asm volatile("" : "+s"(wz_)); unsigned char* wsl = arg_ws() + wz_; pg8::bf16_t* Wb = (pg8::bf16_t*)(wsl + WS_W); pg8::bf16_t* Hb = (pg8::bf16_t*)(wsl + WS_H);
            pg8::Gemm g{Hb, (const pg8::bf16_t*)((char*)Wb + WO_OUT), M, DM, DM}; pg8::StaticOrder S; S.init(M, DM, C.G, bid);
            pg8::EpiResid E{(pg8::bf16_t*)arg_out()}; pg8::gemm_phase<pg8::EpiResid, pg8::StaticOrder, true, true>(ring, g, S, E);
            if (rep + 1 < REPS(6)) GRID_BAR(); else SEAM(p + 6); }
        _Pragma("unroll") for (int rep = 0; rep < REPS(7); ++rep) if (PHM(7) && IN(p + 7)) { rows_rmsnorm_bf16(C, (const bf16*)arg_out(), arg_in(12) + (size_t)layer * DM, (bf16*)(C.ws + WS_H)); if (rep + 1 < REPS(7)) GRID_BAR(); else SEAM(p + 7); }
        _Pragma("unroll") for (int rep = 0; rep < REPS(8); ++rep) if (PHM(8) && IN(p + 8)) { size_t wz_ = 0; asm volatile("" : "+s"(wz_)); unsigned char* wsl = arg_ws() + wz_; pg8::bf16_t* Wb = (pg8::bf16_t*)(wsl + WS_W); pg8::bf16_t* Hb = (pg8::bf16_t*)(wsl + WS_H);
            pg8::Gemm g{Hb, (const pg8::bf16_t*)((char*)Wb + WO_UG), M, NUG, DM}; pg8::StaticOrder S; S.init(M, NUG, C.G, bid);
            pg8::EpiConvAct E{(pg8::bf16_t*)(wsl + WS_ACT), (float*)(wsl + WS_UTAIL), (float*)(wsl + WS_UHEAD), (float*)(wsl + WS_GHEAD), arg_in(15) + (size_t)layer * 3 * DFF, arg_in(16) + (size_t)layer * DFF, (PG8_LAS float*)(C.lds + LDSCTL_OFF + 1024)};
            pg8::gemm_phase<pg8::EpiConvAct, pg8::StaticOrder, true, true>(ring, g, S, E);
            if (rep + 1 < REPS(8)) GRID_BAR(); else SEAM(p + 8); }
        _Pragma("unroll") for (int rep = 0; rep < REPS(9); ++rep) if (PHM(9) && IN(p + 9)) { p9_phase(C, args, layer); if (rep + 1 < REPS(9)) GRID_BAR(); else SEAM(p + 9); }
        _Pragma("unroll") for (int rep = 0; rep < REPS(10); ++rep) if (PHM(10) && IN(p + 10)) { size_t wz_ = 0; asm volatile("" : "+s"(wz_)); unsigned char* wsl = arg_ws() + wz_; pg8::bf16_t* Wb = (pg8::bf16_t*)(wsl + WS_W); pg8::bf16_t* Hb = (pg8::bf16_t*)(wsl + WS_H);
            pg8::Gemm g{(const pg8::bf16_t*)(wsl + WS_ACT), (const pg8::bf16_t*)((char*)Wb + WO_DN), M, DM, DFF}; pg8::StaticOrder S; S.init(M, DM, C.G, bid);
            pg8::EpiResid E{(pg8::bf16_t*)arg_out()}; pg8::gemm_phase<pg8::EpiResid, pg8::StaticOrder, true, true>(ring, g, S, E);
            if (rep + 1 < REPS(10)) GRID_BAR(); else SEAM(p + 10); }
    }
    if (IN(DEPTH * PH)) rows_rmsnorm_final(C, arg_out(), arg_in(18));
#if defined(PROBE_EXTRA_BARRIERS) && !MK_PER_PHASE
    for (int i = 0; i < PROBE_EXTRA_BARRIERS; ++i) GRID_BAR();
#endif
#undef IN
#undef SEAM
#undef GRID_BAR
}

extern "C" void kernel_launch(void* const* d_in, const int* in_sizes, int n_in, void* d_out, int out_size, void* d_ws, size_t ws_size, hipStream_t stream) {
    static int grid = 0;
    if (grid == 0) {
        if (n_in != 19 || out_size != M * DM || ws_size < WS_END) { fprintf(stderr, "kernel_launch: unexpected problem (n_in %d, out %d, ws %zu < %zu); nothing launched\n", n_in, out_size, ws_size, (size_t)WS_END); grid = -1; return; }
        int dev = 0, cus = 0, per_cu = 0;
        if (hipGetDevice(&dev) != hipSuccess || hipDeviceGetAttribute(&cus, hipDeviceAttributeMultiprocessorCount, dev) != hipSuccess) { grid = -1; return; }
        if (hipFuncSetAttribute((const void*)hyb_fwd, hipFuncAttributeMaxDynamicSharedMemorySize, LDS_BYTES) != hipSuccess) { fprintf(stderr, "kernel_launch: hipFuncSetAttribute failed\n"); grid = -1; return; }
        if (hipOccupancyMaxActiveBlocksPerMultiprocessor(&per_cu, (const void*)hyb_fwd, NWAVES * 64, LDS_BYTES) != hipSuccess || per_cu < 1) { fprintf(stderr, "kernel_launch: occupancy query says %d\n", per_cu); }
        (void)hipGetLastError();
        grid = cus;
    }
    if (grid < 0) return;
    (void)in_sizes;
    if (hipMemsetAsync((char*)d_ws + WS_CTL, 0, CTL_ZERO_BYTES, stream) != hipSuccess) return;
    Args a; memset(&a, 0, sizeof(a));
    for (int i = 0; i < 19; ++i) a.in[i] = (const float*)d_in[i];
    a.out = (float*)d_out; a.ws = (unsigned char*)d_ws;
    for (int i = 0; i < 64; ++i) a.invf128[i] = (float)pow(10000.0, -(double)(2 * i) / 128.0);
    for (int i = 0; i < 32; ++i) a.invf64[i] = (float)pow(10000.0, -(double)(2 * i) / 64.0);
#if MK_PER_PHASE
    for (int ph = 0; ph < NPHASE; ++ph) { a.ph_lo = ph; a.ph_hi = ph + 1; hipLaunchKernelGGL(hyb_fwd, dim3(grid), dim3(NWAVES * 64), LDS_BYTES, stream, a); }
#else
    a.ph_lo = 0; a.ph_hi = NPHASE; hipLaunchKernelGGL(hyb_fwd, dim3(grid), dim3(NWAVES * 64), LDS_BYTES, stream, a);
#endif
    const hipError_t le = hipPeekAtLastError();
    if (le != hipSuccess) fprintf(stderr, "kernel_launch: launch failed: %s\n", hipGetErrorName(le));
}
```

```cpp
#include <hip/hip_runtime.h>
#include <cstdio>
#include <cstdint>
#include <cmath>
#ifndef MK_PER_PHASE
#define MK_PER_PHASE 0
#endif
#include <cstring>
namespace pg8 {
#define PG8_LAS __attribute__((address_space(3)))
typedef unsigned short bf16_t;
typedef short bf16x8 __attribute__((ext_vector_type(8)));
typedef float f32x4 __attribute__((ext_vector_type(4)));
typedef unsigned u32x4 __attribute__((ext_vector_type(4)));
constexpr int BM = 256, BK = 64, HALF = 128, HTB = HALF * BK * 2  , STAGE_BYTES = 8 * HTB, NXCD = 8, WGM = 8;

__host__ __device__ __forceinline__ int lds_byte(int r, int c) { const int st = (r >> 4) * 2 + (c >> 5), rr = r & 15, cc = c & 31, ob = rr * 64 + cc * 2; return st * 1024 + (ob ^ (((ob >> 9) & 1) << 5)); }
__host__ __device__ __forceinline__ void stage_rc(int b, int& R, int& C) { const int st = b / 1024, sb = b % 1024, swz = sb ^ (((sb >> 9) & 1) << 5); R = (st >> 1) * 16 + swz / 64; C = (st & 1) * 32 + (swz % 64) / 2; }
__host__ __device__ __forceinline__ int perm32(int rho) { const int n = rho >> 4, i = rho & 15; return 8 * (i >> 2) + 4 * n + (i & 3); }

struct Unit { int pm, pn; };
struct Gemm { const bf16_t* A; const bf16_t* Bt; int M, N, K; };

struct StaticOrder {
    int nM, nN, nwg, G, c;
    __host__ __device__ void init(int M, int N, int G_, int c_) { nM = M / BM; nN = N / BM; nwg = nM * nN; G = G_; c = c_; }
    __host__ __device__ bool next(int i, Unit& u) const {
        const long L = (long)i * G + c; if (L >= nwg) return false;
        int wgid = (int)L; { const int q = nwg / NXCD, r = nwg % NXCD, xcd = wgid % NXCD, off = wgid / NXCD; wgid = (xcd < r ? xcd * (q + 1) : r * (q + 1) + (xcd - r) * q) + off; }
        const int nig = WGM * nN, gid = wgid / nig, fm = gid * WGM, gsz = (nM - fm) < WGM ? (nM - fm) : WGM;
        u.pm = fm + ((wgid % nig) % gsz); u.pn = (wgid % nig) / gsz; return true;
    }
    __device__ __forceinline__ void a_ready(const Unit&) const {}
    __device__ __forceinline__ void done(const Unit&) const {}
};

template <class Epi, class Sched, bool ALIGN_EPI = false, bool SP2 = false>
__device__ __forceinline__ void gemm_phase(PG8_LAS unsigned char* lds, const Gemm g, const Sched& S, const Epi& E) {
    int tid_ = threadIdx.x; asm volatile("" : "+v"(tid_));
    const int tid = tid_, wid = __builtin_amdgcn_readfirstlane(tid >> 6), lane = tid & 63, wr = wid >> 2, wc = wid & 3, fr = lane & 15, fq = lane >> 4;
    int K_ = g.K; asm volatile("" : "+s"(K_)); const int K = K_, nt = K / BK;
    unsigned voffA[2], voffB[2];
#pragma unroll
    for (int i = 0; i < 2; ++i) { int R, C; stage_rc(tid * 16 + i * 8192, R, C); const int Rb = Epi::PERM ? ((R & ~31) + perm32(R & 31)) : R;
        voffA[i] = (unsigned)(R * K + C) * 2u; voffB[i] = (unsigned)(Rb * K + C) * 2u; }
    const size_t kstep = (size_t)(BK * 2);
    const size_t hstep = (size_t)HALF * K * 2;
    const size_t tstep = 2 * hstep;
    const unsigned ldsw = (unsigned)wid * 1024u;
    const int aoff = lds_byte(wr * 64 + fr, fq * 8), boff = lds_byte(wc * 32 + fr, fq * 8);
#define PG8_SA(b, h) (((b) * 2 + (h)) * HTB)
#define PG8_SB(b, h) ((4 + (b) * 2 + (h)) * HTB)
#define PG8_STAGE(bufoff, gbase, voff) do { _Pragma("unroll") for (int _i = 0; _i < 2; ++_i) \
        __builtin_amdgcn_global_load_lds((const unsigned*)((const char*)(gbase) + (voff)[_i]), (PG8_LAS unsigned*)(lds + (bufoff) + ldsw + _i * 8192), 16, 0, 0); } while (0)
#define PG8_LDA(dst, b, h) do { _Pragma("unroll") for (int m = 0; m < 4; ++m) _Pragma("unroll") for (int k = 0; k < 2; ++k) dst[m][k] = *(const PG8_LAS bf16x8*)(lds + PG8_SA(b, h) + aoff + m * 2048 + k * 1024); } while (0)
#define PG8_LDB(dst, b, h) do { _Pragma("unroll") for (int n = 0; n < 2; ++n) _Pragma("unroll") for (int k = 0; k < 2; ++k) dst[n][k] = *(const PG8_LAS bf16x8*)(lds + PG8_SB(b, h) + boff + n * 2048 + k * 1024); } while (0)
#define PG8_MMA(ai, bj, At, Bt) do { __builtin_amdgcn_s_setprio(1); _Pragma("unroll") for (int m = 0; m < 4; ++m) _Pragma("unroll") for (int n = 0; n < 2; ++n) _Pragma("unroll") for (int k = 0; k < 2; ++k) \
        acc[ai][bj][m][n] = __builtin_amdgcn_mfma_f32_16x16x32_bf16(Bt[n][k], At[m][k], acc[ai][bj][m][n], 0, 0, 0); __builtin_amdgcn_s_setprio(0); } while (0)
#define PG8_WAIT_V(n) asm volatile("s_waitcnt vmcnt(" #n ")" ::: "memory")
#define PG8_WAIT_L(n) asm volatile("s_waitcnt lgkmcnt(" #n ")" ::: "memory")
#define PG8_BAR __builtin_amdgcn_s_barrier()
#define PG8_SCHED __builtin_amdgcn_sched_barrier(0)
    Unit cur, nxt; int ui = 0;
    if (!S.next(0, cur)) return;
    f32x4 acc[2][2][4][2];
#pragma unroll
    for (int a = 0; a < 2; ++a)
#pragma unroll
        for (int b = 0; b < 2; ++b)
#pragma unroll
            for (int m = 0; m < 4; ++m)
#pragma unroll
                for (int n = 0; n < 2; ++n) acc[a][b][m][n] = (f32x4){0.f, 0.f, 0.f, 0.f};
    bf16x8 At[4][2], B0[2][2], B1[2][2];
    const char* cA = (const char*)g.A + (size_t)cur.pm * tstep; const char* cB = (const char*)g.Bt + (size_t)cur.pn * tstep;
    S.a_ready(cur);
    if constexpr (SP2) {
        PG8_STAGE(PG8_SB(0, 0), cB, voffB); PG8_STAGE(PG8_SB(0, 1), cB + hstep, voffB); PG8_STAGE(PG8_SA(0, 0), cA, voffA); PG8_STAGE(PG8_SA(0, 1), cA + hstep, voffA);
        if (wr == 1) PG8_BAR;
        PG8_WAIT_V(2); PG8_BAR;
        PG8_STAGE(PG8_SB(1, 0), cB + kstep, voffB); PG8_STAGE(PG8_SA(1, 0), cA + kstep, voffA); PG8_STAGE(PG8_SB(1, 1), cB + hstep + kstep, voffB);
        PG8_WAIT_V(6); PG8_BAR;
    } else {
        PG8_STAGE(PG8_SB(0, 0), cB, voffB); PG8_STAGE(PG8_SA(0, 0), cA, voffA); PG8_STAGE(PG8_SB(0, 1), cB + hstep, voffB); PG8_STAGE(PG8_SA(0, 1), cA + hstep, voffA);
        if (wr == 1) PG8_BAR;
        PG8_WAIT_V(4); PG8_BAR;
        PG8_STAGE(PG8_SB(1, 0), cB + kstep, voffB); PG8_STAGE(PG8_SA(1, 0), cA + kstep, voffA); PG8_STAGE(PG8_SB(1, 1), cB + hstep + kstep, voffB);
        PG8_WAIT_V(6); PG8_BAR;
    }
    for (;;) {
        const bool has_next = S.next(ui + 1, nxt);
        const char* nA = has_next ? (const char*)g.A + (size_t)nxt.pm * tstep : cA; const char* nB = has_next ? (const char*)g.Bt + (size_t)nxt.pn * tstep : cB;
        for (int t = 0; t < nt; t += 2) {
            const bool last = (t == nt - 2);
            const char* a1 = cA + (size_t)(t + 1) * kstep;
            const char* a2 = last ? nA : cA + (size_t)(t + 2) * kstep; const char* b2 = last ? nB : cB + (size_t)(t + 2) * kstep;
            const char* a3 = a2 + kstep; const char* b3 = b2 + kstep;
            if (last && has_next) S.a_ready(nxt);
            if constexpr (SP2) {
            PG8_LDB(B0, 0, 0); PG8_LDB(B1, 0, 1); PG8_SCHED; PG8_LDA(At, 0, 0); PG8_STAGE(PG8_SA(1, 1), a1 + hstep, voffA);
            PG8_WAIT_V(8); PG8_WAIT_L(0); PG8_BAR; PG8_MMA(0, 0, At, B0); PG8_MMA(0, 1, At, B1); PG8_BAR; PG8_SCHED;
            PG8_LDA(At, 0, 1); PG8_STAGE(PG8_SB(0, 0), b2, voffB); PG8_STAGE(PG8_SB(0, 1), b2 + hstep, voffB); PG8_STAGE(PG8_SA(0, 0), a2, voffA);
            PG8_WAIT_V(8); PG8_WAIT_L(0); PG8_BAR; PG8_MMA(1, 0, At, B0); PG8_MMA(1, 1, At, B1); PG8_BAR; PG8_SCHED;
            PG8_LDB(B0, 1, 0); PG8_LDB(B1, 1, 1); PG8_SCHED; PG8_LDA(At, 1, 0); PG8_STAGE(PG8_SA(0, 1), a2 + hstep, voffA);
            PG8_WAIT_V(8); PG8_WAIT_L(0); PG8_BAR; PG8_MMA(0, 0, At, B0); PG8_MMA(0, 1, At, B1); PG8_BAR; PG8_SCHED;
            PG8_LDA(At, 1, 1); PG8_STAGE(PG8_SB(1, 0), b3, voffB); PG8_STAGE(PG8_SB(1, 1), b3 + hstep, voffB); PG8_STAGE(PG8_SA(1, 0), a3, voffA);
            PG8_WAIT_V(8); PG8_WAIT_L(0); PG8_BAR; PG8_MMA(1, 0, At, B0); PG8_MMA(1, 1, At, B1); PG8_BAR; PG8_SCHED;
            } else {
            PG8_LDB(B0, 0, 0); PG8_SCHED; PG8_LDA(At, 0, 0); PG8_STAGE(PG8_SA(1, 1), a1 + hstep, voffA);
            PG8_WAIT_L(8); PG8_BAR; PG8_WAIT_L(0); PG8_MMA(0, 0, At, B0); PG8_BAR; PG8_SCHED;
            PG8_LDB(B1, 0, 1); PG8_STAGE(PG8_SB(0, 0), b2, voffB);
            PG8_BAR; PG8_WAIT_L(0); PG8_MMA(0, 1, At, B1); PG8_BAR;
            PG8_LDA(At, 0, 1); PG8_STAGE(PG8_SA(0, 0), a2, voffA);
            PG8_BAR; PG8_WAIT_L(0); PG8_MMA(1, 0, At, B0); PG8_BAR; PG8_SCHED;
            PG8_STAGE(PG8_SB(0, 1), b2 + hstep, voffB);
            PG8_WAIT_V(6); PG8_BAR; PG8_MMA(1, 1, At, B1); PG8_BAR;
            PG8_LDB(B0, 1, 0); PG8_SCHED; PG8_LDA(At, 1, 0); PG8_STAGE(PG8_SA(0, 1), a2 + hstep, voffA);
            PG8_WAIT_L(8); PG8_BAR; PG8_WAIT_L(0); PG8_MMA(0, 0, At, B0); PG8_BAR; PG8_SCHED;
            PG8_LDB(B1, 1, 1); PG8_STAGE(PG8_SB(1, 0), b3, voffB);
            PG8_BAR; PG8_WAIT_L(0); PG8_MMA(0, 1, At, B1); PG8_BAR;
            PG8_LDA(At, 1, 1); PG8_STAGE(PG8_SA(1, 0), a3, voffA);
            PG8_BAR; PG8_WAIT_L(0); PG8_MMA(1, 0, At, B0); PG8_BAR; PG8_SCHED;
            PG8_STAGE(PG8_SB(1, 1), b3 + hstep, voffB);
            PG8_WAIT_V(6); PG8_BAR; PG8_MMA(1, 1, At, B1); PG8_BAR;
            }
        }
        if constexpr (ALIGN_EPI) { if (wr == 0) PG8_BAR; }
        if constexpr (!Epi::AFTER_DRAIN) { E(acc, cur, wr, wc, fr, fq); S.done(cur); }
        if (!has_next) break;
#pragma unroll
        for (int a = 0; a < 2; ++a)
#pragma unroll
            for (int b = 0; b < 2; ++b)
#pragma unroll
                for (int m = 0; m < 4; ++m)
#pragma unroll
                    for (int n = 0; n < 2; ++n) acc[a][b][m][n] = (f32x4){0.f, 0.f, 0.f, 0.f};
        cur = nxt; cA = nA; cB = nB; ++ui;
        if constexpr (ALIGN_EPI) { if (wr == 1) PG8_BAR; }
    }
    PG8_WAIT_V(0);
    if constexpr (!ALIGN_EPI) { if (wr == 0) PG8_BAR; }
    PG8_BAR;
    if constexpr (Epi::AFTER_DRAIN) { E.fused(acc, cur, wr, wc, fr, fq, lds, wid, lane); S.done(cur); }
#undef PG8_SA
#undef PG8_SB
#undef PG8_STAGE
#undef PG8_LDA
#undef PG8_LDB
#undef PG8_MMA
#undef PG8_WAIT_V
#undef PG8_WAIT_L
#undef PG8_BAR
#undef PG8_SCHED
}

struct UnitM { int pm, pn, sub; };
struct GemmM { const bf16_t* A0; const bf16_t* B0; size_t strideA, strideB; int nt0, dnt2; int lda, ldb;
    __device__ __forceinline__ const bf16_t* a(int s) const { return A0 + (size_t)s * strideA; }
    __device__ __forceinline__ const bf16_t* b(int s) const { return B0 + (size_t)s * strideB; }
    __device__ __forceinline__ int nt(int s) const { return nt0 + (s >> 1) * dnt2; } };
struct StaticOrder3 {
    StaticOrder S;
    __device__ void init(int M, int N, int G_, int c_) { S.init(M, N, G_, c_); }
    __device__ bool next(int i, UnitM& u) const { Unit t; if (!S.next(i / 3, t)) return false; u.pm = t.pm; u.pn = t.pn; u.sub = i - 3 * (i / 3); return true; }
    __device__ __forceinline__ void a_ready(const UnitM&) const {}
    __device__ __forceinline__ void done(const UnitM&) const {}
};
template <class Epi, class Sched, bool ALIGN_EPI = false, bool SP2 = false>
__device__ __forceinline__ void gemm_phase_m(PG8_LAS unsigned char* lds, const GemmM g, const Sched& S, const Epi& E) {
    int tid_ = threadIdx.x; asm volatile("" : "+v"(tid_));
    const int tid = tid_, wid = __builtin_amdgcn_readfirstlane(tid >> 6), lane = tid & 63, wr = wid >> 2, wc = wid & 3, fr = lane & 15, fq = lane >> 4;
    int lda_ = g.lda, ldb_ = g.ldb; asm volatile("" : "+s"(lda_), "+s"(ldb_)); const int lda = lda_, ldb = ldb_; int nt;
    unsigned voffA[2], voffB[2];
#pragma unroll
    for (int i = 0; i < 2; ++i) { int R, C; stage_rc(tid * 16 + i * 8192, R, C); const int Rb = Epi::PERM ? ((R & ~31) + perm32(R & 31)) : R;
        voffA[i] = (unsigned)(R * lda + C) * 2u; voffB[i] = (unsigned)(Rb * ldb + C) * 2u; }
    const size_t kstep = (size_t)(BK * 2);
    const size_t hstepA = (size_t)HALF * lda * 2, hstepB = (size_t)HALF * ldb * 2;
    const size_t tstepA = 2 * hstepA, tstepB = 2 * hstepB;
    const unsigned ldsw = (unsigned)wid * 1024u;
    const int aoff = lds_byte(wr * 64 + fr, fq * 8), boff = lds_byte(wc * 32 + fr, fq * 8);
#define PG8_SA(b, h) (((b) * 2 + (h)) * HTB)
#define PG8_SB(b, h) ((4 + (b) * 2 + (h)) * HTB)
#define PG8_STAGE(bufoff, gbase, voff) do { _Pragma("unroll") for (int _i = 0; _i < 2; ++_i) \
        __builtin_amdgcn_global_load_lds((const unsigned*)((const char*)(gbase) + (voff)[_i]), (PG8_LAS unsigned*)(lds + (bufoff) + ldsw + _i * 8192), 16, 0, 0); } while (0)
#define PG8_LDA(dst, b, h) do { _Pragma("unroll") for (int m = 0; m < 4; ++m) _Pragma("unroll") for (int k = 0; k < 2; ++k) dst[m][k] = *(const PG8_LAS bf16x8*)(lds + PG8_SA(b, h) + aoff + m * 2048 + k * 1024); } while (0)
#define PG8_LDB(dst, b, h) do { _Pragma("unroll") for (int n = 0; n < 2; ++n) _Pragma("unroll") for (int k = 0; k < 2; ++k) dst[n][k] = *(const PG8_LAS bf16x8*)(lds + PG8_SB(b, h) + boff + n * 2048 + k * 1024); } while (0)
#define PG8_MMA(ai, bj, At, Bt) do { __builtin_amdgcn_s_setprio(1); _Pragma("unroll") for (int m = 0; m < 4; ++m) _Pragma("unroll") for (int n = 0; n < 2; ++n) _Pragma("unroll") for (int k = 0; k < 2; ++k) \
        acc[ai][bj][m][n] = __builtin_amdgcn_mfma_f32_16x16x32_bf16(Bt[n][k], At[m][k], acc[ai][bj][m][n], 0, 0, 0); __builtin_amdgcn_s_setprio(0); } while (0)
#define PG8_WAIT_V(n) asm volatile("s_waitcnt vmcnt(" #n ")" ::: "memory")
#define PG8_WAIT_L(n) asm volatile("s_waitcnt lgkmcnt(" #n ")" ::: "memory")
#define PG8_BAR __builtin_amdgcn_s_barrier()
#define PG8_SCHED __builtin_amdgcn_sched_barrier(0)
    UnitM cur, nxt; int ui = 0;
    if (!S.next(0, cur)) return;
    f32x4 acc[2][2][4][2];
#pragma unroll
    for (int a = 0; a < 2; ++a)
#pragma unroll
        for (int b = 0; b < 2; ++b)
#pragma unroll
            for (int m = 0; m < 4; ++m)
#pragma unroll
                for (int n = 0; n < 2; ++n) acc[a][b][m][n] = (f32x4){0.f, 0.f, 0.f, 0.f};
    bf16x8 At[4][2], B0[2][2], B1[2][2];
    const char* cA = (const char*)g.a(cur.sub) + (size_t)cur.pm * tstepA; const char* cB = (const char*)g.b(cur.sub) + (size_t)cur.pn * tstepB; nt = g.nt(cur.sub);
    S.a_ready(cur);
    if constexpr (SP2) {
        PG8_STAGE(PG8_SB(0, 0), cB, voffB); PG8_STAGE(PG8_SB(0, 1), cB + hstepB, voffB); PG8_STAGE(PG8_SA(0, 0), cA, voffA); PG8_STAGE(PG8_SA(0, 1), cA + hstepA, voffA);
        if (wr == 1) PG8_BAR;
        PG8_WAIT_V(2); PG8_BAR;
        PG8_STAGE(PG8_SB(1, 0), cB + kstep, voffB); PG8_STAGE(PG8_SA(1, 0), cA + kstep, voffA); PG8_STAGE(PG8_SB(1, 1), cB + hstepB + kstep, voffB);
        PG8_WAIT_V(6); PG8_BAR;
    } else {
        PG8_STAGE(PG8_SB(0, 0), cB, voffB); PG8_STAGE(PG8_SA(0, 0), cA, voffA); PG8_STAGE(PG8_SB(0, 1), cB + hstepB, voffB); PG8_STAGE(PG8_SA(0, 1), cA + hstepA, voffA);
        if (wr == 1) PG8_BAR;
        PG8_WAIT_V(4); PG8_BAR;
        PG8_STAGE(PG8_SB(1, 0), cB + kstep, voffB); PG8_STAGE(PG8_SA(1, 0), cA + kstep, voffA); PG8_STAGE(PG8_SB(1, 1), cB + hstepB + kstep, voffB);
        PG8_WAIT_V(6); PG8_BAR;
    }
    for (;;) {
        const bool has_next = S.next(ui + 1, nxt);
        const char* nA = has_next ? (const char*)g.a(nxt.sub) + (size_t)nxt.pm * tstepA : cA; const char* nB = has_next ? (const char*)g.b(nxt.sub) + (size_t)nxt.pn * tstepB : cB;
        for (int t = 0; t < nt; t += 2) {
            const bool last = (t == nt - 2);
            const char* a1 = cA + (size_t)(t + 1) * kstep;
            const char* a2 = last ? nA : cA + (size_t)(t + 2) * kstep; const char* b2 = last ? nB : cB + (size_t)(t + 2) * kstep;
            const char* a3 = a2 + kstep; const char* b3 = b2 + kstep;
            if (last && has_next) S.a_ready(nxt);
            if constexpr (SP2) {
            PG8_LDB(B0, 0, 0); PG8_LDB(B1, 0, 1); PG8_SCHED; PG8_LDA(At, 0, 0); PG8_STAGE(PG8_SA(1, 1), a1 + hstepA, voffA);
            PG8_WAIT_V(8); PG8_WAIT_L(0); PG8_BAR; PG8_MMA(0, 0, At, B0); PG8_MMA(0, 1, At, B1); PG8_BAR; PG8_SCHED;
            PG8_LDA(At, 0, 1); PG8_STAGE(PG8_SB(0, 0), b2, voffB); PG8_STAGE(PG8_SB(0, 1), b2 + hstepB, voffB); PG8_STAGE(PG8_SA(0, 0), a2, voffA);
            PG8_WAIT_V(8); PG8_WAIT_L(0); PG8_BAR; PG8_MMA(1, 0, At, B0); PG8_MMA(1, 1, At, B1); PG8_BAR; PG8_SCHED;
            PG8_LDB(B0, 1, 0); PG8_LDB(B1, 1, 1); PG8_SCHED; PG8_LDA(At, 1, 0); PG8_STAGE(PG8_SA(0, 1), a2 + hstepA, voffA);
            PG8_WAIT_V(8); PG8_WAIT_L(0); PG8_BAR; PG8_MMA(0, 0, At, B0); PG8_MMA(0, 1, At, B1); PG8_BAR; PG8_SCHED;
            PG8_LDA(At, 1, 1); PG8_STAGE(PG8_SB(1, 0), b3, voffB); PG8_STAGE(PG8_SB(1, 1), b3 + hstepB, voffB); PG8_STAGE(PG8_SA(1, 0), a3, voffA);
            PG8_WAIT_V(8); PG8_WAIT_L(0); PG8_BAR; PG8_MMA(1, 0, At, B0); PG8_MMA(1, 1, At, B1); PG8_BAR; PG8_SCHED;
            } else {
            PG8_LDB(B0, 0, 0); PG8_SCHED; PG8_LDA(At, 0, 0); PG8_STAGE(PG8_SA(1, 1), a1 + hstepA, voffA);
            PG8_WAIT_L(8); PG8_BAR; PG8_WAIT_L(0); PG8_MMA(0, 0, At, B0); PG8_BAR; PG8_SCHED;
            PG8_LDB(B1, 0, 1); PG8_STAGE(PG8_SB(0, 0), b2, voffB);
            PG8_BAR; PG8_WAIT_L(0); PG8_MMA(0, 1, At, B1); PG8_BAR;
            PG8_LDA(At, 0, 1); PG8_STAGE(PG8_SA(0, 0), a2, voffA);
            PG8_BAR; PG8_WAIT_L(0); PG8_MMA(1, 0, At, B0); PG8_BAR; PG8_SCHED;
            PG8_STAGE(PG8_SB(0, 1), b2 + hstepB, voffB);
            PG8_WAIT_V(6); PG8_BAR; PG8_MMA(1, 1, At, B1); PG8_BAR;
            PG8_LDB(B0, 1, 0); PG8_SCHED; PG8_LDA(At, 1, 0); PG8_STAGE(PG8_SA(0, 1), a2 + hstepA, voffA);
            PG8_WAIT_L(8); PG8_BAR; PG8_WAIT_L(0); PG8_MMA(0, 0, At, B0); PG8_BAR; PG8_SCHED;
            PG8_LDB(B1, 1, 1); PG8_STAGE(PG8_SB(1, 0), b3, voffB);
            PG8_BAR; PG8_WAIT_L(0); PG8_MMA(0, 1, At, B1); PG8_BAR;
            PG8_LDA(At, 1, 1); PG8_STAGE(PG8_SA(1, 0), a3, voffA);
            PG8_BAR; PG8_WAIT_L(0); PG8_MMA(1, 0, At, B0); PG8_BAR; PG8_SCHED;
            PG8_STAGE(PG8_SB(1, 1), b3 + hstepB, voffB);
            PG8_WAIT_V(6); PG8_BAR; PG8_MMA(1, 1, At, B1); PG8_BAR;
            }
        }
        if constexpr (ALIGN_EPI) { if (wr == 0) PG8_BAR; }
        if constexpr (!Epi::AFTER_DRAIN) { E(acc, cur, wr, wc, fr, fq); S.done(cur); }
        if (!has_next) break;
        if (nxt.sub == 0) {
#pragma unroll
        for (int a = 0; a < 2; ++a)
#pragma unroll
            for (int b = 0; b < 2; ++b)
#pragma unroll
                for (int m = 0; m < 4; ++m)
#pragma unroll
                    for (int n = 0; n < 2; ++n) acc[a][b][m][n] = (f32x4){0.f, 0.f, 0.f, 0.f}; }
        cur = nxt; cA = nA; cB = nB; ++ui; nt = g.nt(cur.sub);
        if constexpr (ALIGN_EPI) { if (wr == 1) PG8_BAR; }
    }
    PG8_WAIT_V(0);
    if constexpr (!ALIGN_EPI) { if (wr == 0) PG8_BAR; }
    PG8_BAR;
    if constexpr (Epi::AFTER_DRAIN) { E.fused(acc, cur, wr, wc, fr, fq, lds, wid, lane); S.done(cur); }
#undef PG8_SA
#undef PG8_SB
#undef PG8_STAGE
#undef PG8_LDA
#undef PG8_LDB
#undef PG8_MMA
#undef PG8_WAIT_V
#undef PG8_WAIT_L
#undef PG8_BAR
#undef PG8_SCHED
}
}

namespace pg8 {
typedef float f32x2 __attribute__((ext_vector_type(2)));
__device__ __forceinline__ unsigned cvt_pk_bf16(float lo, float hi) { unsigned r; asm volatile("v_cvt_pk_bf16_f32 %0, %1, %2" : "=v"(r) : "v"(lo), "v"(hi)); return r; }
__device__ __forceinline__ void store8(bf16_t* p, const f32x4 v0, const f32x4 v1) {
    u32x4 w; w.x = cvt_pk_bf16(v0[0], v0[1]); w.y = cvt_pk_bf16(v0[2], v0[3]); w.z = cvt_pk_bf16(v1[0], v1[1]); w.w = cvt_pk_bf16(v1[2], v1[3]); *(u32x4*)p = w; }
__device__ __forceinline__ float fsigmoid(float x) { return __builtin_amdgcn_rcpf(1.0f + __builtin_amdgcn_exp2f(-1.4426950408889634f * x)); }
__device__ __forceinline__ f32x4 act4(const f32x4 v, const int ACT) {
    if (ACT == 0) return v;
    f32x4 o;
#pragma unroll
    for (int j = 0; j < 4; ++j) { const float s = fsigmoid(v[j]); o[j] = (ACT == 1) ? v[j] * s : s; }
    return o; }
__device__ __forceinline__ void bf8_to_f32(const u32x4 w, f32x4& a, f32x4& b) {
    a[0] = __uint_as_float(w.x << 16); a[1] = __uint_as_float(w.x & 0xffff0000u); a[2] = __uint_as_float(w.y << 16); a[3] = __uint_as_float(w.y & 0xffff0000u);
    b[0] = __uint_as_float(w.z << 16); b[1] = __uint_as_float(w.z & 0xffff0000u); b[2] = __uint_as_float(w.w << 16); b[3] = __uint_as_float(w.w & 0xffff0000u); }

constexpr int SEQ_MASK = 4095;
__device__ __forceinline__ void rope4(const float* tab, const f32x4 a, const f32x4 b, float sc, bf16_t* p1, bf16_t* p2) {
    typedef unsigned u32x2 __attribute__((ext_vector_type(2)));
    const f32x4 t0 = *(const f32x4*)(tab), t1 = *(const f32x4*)(tab + 4);
    const float o10 = (a[0] * t0[0] - b[0] * t0[1]) * sc, o20 = (b[0] * t0[0] + a[0] * t0[1]) * sc;
    const float o11 = (a[1] * t0[2] - b[1] * t0[3]) * sc, o21 = (b[1] * t0[2] + a[1] * t0[3]) * sc;
    const float o12 = (a[2] * t1[0] - b[2] * t1[1]) * sc, o22 = (b[2] * t1[0] + a[2] * t1[1]) * sc;
    const float o13 = (a[3] * t1[2] - b[3] * t1[3]) * sc, o23 = (b[3] * t1[2] + a[3] * t1[3]) * sc;
    u32x2 w1, w2; w1.x = cvt_pk_bf16(o10, o11); w1.y = cvt_pk_bf16(o12, o13); w2.x = cvt_pk_bf16(o20, o21); w2.y = cvt_pk_bf16(o22, o23);
    *(u32x2*)p1 = w1; *(u32x2*)p2 = w2;
}
#define EPI_FENCE() asm volatile("" ::: "memory")

struct EpiInProj {
    static constexpr bool PERM = true, AFTER_DRAIN = false;
    unsigned char* ws; size_t o_fqkv, o_cq, o_ckv, o_kr, o_rq, o_rk, o_rv, o_rg, o_gates, o_ff, o_t128, o_t64; int skip;
    __device__ __forceinline__ void plain(const f32x4 (&acc)[2][2][4][2], bf16_t* dst, int ld, int colbase, int act, int row0, int wc, int fq) const {
        const int col0 = colbase + wc * 32 + 8 * fq;
#pragma unroll
        for (int ai = 0; ai < 2; ++ai)
#pragma unroll
            for (int m = 0; m < 4; ++m) { bf16_t* rowp = dst + (size_t)(row0 + ai * HALF + m * 16) * ld + col0;
#pragma unroll
                for (int bj = 0; bj < 2; ++bj) { f32x4 v0 = acc[ai][bj][m][0], v1 = acc[ai][bj][m][1];
                    if (act) {
#pragma unroll
                        for (int j = 0; j < 4; ++j) { const float s0 = fsigmoid(v0[j]), s1 = fsigmoid(v1[j]); v0[j] = (act == 1) ? v0[j] * s0 : s0; v1[j] = (act == 1) ? v1[j] * s1 : s1; } }
                    if (skip == 2) { u32x4 w; w.x = cvt_pk_bf16(v0[0], v0[1]); w.y = cvt_pk_bf16(v0[2], v0[3]); w.z = cvt_pk_bf16(v1[0], v1[1]); w.w = cvt_pk_bf16(v1[2], v1[3]); asm volatile("" :: "v"(w)); }
                    else store8(rowp + bj * HALF, v0, v1); }
                EPI_FENCE(); }
    }
    __device__ __forceinline__ void rope128(const f32x4 (&acc)[2][2][4][2], bf16_t* dst, int t, float sc, int row0, int wc, int fq) const {
        const int x = 32 * wc + 8 * fq, hh = x >> 6, i0 = x & 63, head = 2 * t + hh; const float* T128 = (const float*)(ws + o_t128);
#pragma unroll
        for (int ai = 0; ai < 2; ++ai)
#pragma unroll
            for (int m = 0; m < 4; ++m) { const int row = row0 + ai * HALF + m * 16, pos = row & SEQ_MASK;
                const float* tp = T128 + ((size_t)pos * 64 + i0) * 2; bf16_t* p = dst + (size_t)row * 512 + 128 * head + i0;
                rope4(tp, acc[ai][0][m][0], acc[ai][1][m][0], sc, p, p + 64); rope4(tp + 8, acc[ai][0][m][1], acc[ai][1][m][1], sc, p + 4, p + 68);
                EPI_FENCE(); }
    }
    __device__ __forceinline__ void misc(const f32x4 (&acc)[2][2][4][2], int row0, int wc, int fq) const {
        if (wc == 0) { const int i0 = 8 * fq; const float* T64 = (const float*)(ws + o_t64); bf16_t* kr = (bf16_t*)(ws + o_kr);
#pragma unroll
            for (int ai = 0; ai < 2; ++ai)
#pragma unroll
                for (int m = 0; m < 4; ++m) { const int row = row0 + ai * HALF + m * 16, pos = row & SEQ_MASK;
                    const float* tp = T64 + ((size_t)pos * 32 + i0) * 2; bf16_t* p = kr + (size_t)row * 64 + i0;
                    rope4(tp, acc[ai][0][m][0], acc[ai][1][m][0], 1.0f, p, p + 32); rope4(tp + 8, acc[ai][0][m][1], acc[ai][1][m][1], 1.0f, p + 4, p + 36);
                    EPI_FENCE(); }
        } else if (wc == 1) { if (fq == 0) { float* ff = (float*)(ws + o_ff);
#pragma unroll
            for (int ai = 0; ai < 2; ++ai)
#pragma unroll
                for (int m = 0; m < 4; ++m) { const int row = row0 + ai * HALF + m * 16; float* p = ff + (size_t)row * 8; *(f32x4*)p = acc[ai][0][m][0]; *(f32x4*)(p + 4) = acc[ai][0][m][1]; } } }
    }
    __device__ __forceinline__ void operator()(const f32x4 (&acc)[2][2][4][2], const Unit& u, int wr, int wc, int fr, int fq) const {
        const int pn = u.pn, row0 = u.pm * BM + wr * 64 + fr;
        if (skip == 1) {
#pragma unroll
            for (int ai = 0; ai < 2; ++ai)
#pragma unroll
                for (int bj = 0; bj < 2; ++bj)
#pragma unroll
                    for (int m = 0; m < 4; ++m) asm volatile("" :: "v"(acc[ai][bj][m][0]), "v"(acc[ai][bj][m][1]));
            return; }
        if (pn == 12) misc(acc, row0, wc, fq);
        else if (pn >= 13 && pn < 17) { const bool isk = pn >= 15; rope128(acc, (bf16_t*)(ws + (isk ? o_rk : o_rq)), isk ? pn - 15 : pn - 13, isk ? 0.08838834764831845f : 1.0f, row0, wc, fq); }
        else { size_t off; int ld, cb, act = 0;
            if (pn < 9) { off = o_fqkv; ld = 2304; cb = 256 * pn; }
            else if (pn < 11) { off = o_cq; ld = 512; cb = 256 * (pn - 9); }
            else if (pn == 11) { off = o_ckv; ld = 256; cb = 0; }
            else if (pn < 21) { off = o_rv; ld = 1024; cb = 256 * (pn - 17); }
            else if (pn < 25) { off = o_rg; ld = 1024; cb = 256 * (pn - 21); act = 1; }
            else { off = o_gates; ld = 6144; cb = 256 * (pn - 25); act = 2; }
            plain(acc, (bf16_t*)(ws + off), ld, cb, act, row0, wc, fq); }
    }
};

struct EpiUq {
    static constexpr bool PERM = true, AFTER_DRAIN = false;
    bf16_t* qm; const float* rstd; const float* T64;
    __device__ __forceinline__ void operator()(const f32x4 (&acc)[2][2][4][2], const Unit& u, int wr, int wc, int fr, int fq) const {
        const int pn = u.pn, row0 = u.pm * BM + wr * 64 + fr;
        float rsv[2][4];
#pragma unroll
        for (int ai = 0; ai < 2; ++ai)
#pragma unroll
            for (int m = 0; m < 4; ++m) rsv[ai][m] = rstd[row0 + ai * HALF + m * 16];
        if (pn < 3) {
#pragma unroll
            for (int ai = 0; ai < 2; ++ai)
#pragma unroll
                for (int m = 0; m < 4; ++m) { const int row = row0 + ai * HALF + m * 16; const float rs = rsv[ai][m];
#pragma unroll
                    for (int bj = 0; bj < 2; ++bj) store8(qm + (size_t)row * 1152 + 192 * (2 * pn + bj) + 32 * wc + 8 * fq, acc[ai][bj][m][0] * rs, acc[ai][bj][m][1] * rs);
                    EPI_FENCE(); }
        } else { const int head = (pn == 3) ? wc : 4 + wc; if (head < 6) { const int i0 = 8 * fq;
#pragma unroll
            for (int ai = 0; ai < 2; ++ai)
#pragma unroll
                for (int m = 0; m < 4; ++m) { const int row = row0 + ai * HALF + m * 16, pos = row & SEQ_MASK; const float rs = rsv[ai][m];
                    const float* tp = T64 + ((size_t)pos * 32 + i0) * 2; bf16_t* p = qm + (size_t)row * 1152 + 192 * head + 128 + i0;
                    rope4(tp, acc[ai][0][m][0], acc[ai][1][m][0], rs, p, p + 32); rope4(tp + 8, acc[ai][0][m][1], acc[ai][1][m][1], rs, p + 4, p + 36);
                    EPI_FENCE(); } } }
    }
};
struct EpiUkv {
    static constexpr bool PERM = true, AFTER_DRAIN = false;
    bf16_t* kvm; const float* rstd;
    __device__ __forceinline__ void operator()(const f32x4 (&acc)[2][2][4][2], const Unit& u, int wr, int wc, int fr, int fq) const {
        const int row0 = u.pm * BM + wr * 64 + fr, col0 = u.pn * BM + wc * 32 + 8 * fq;
        float rsv[2][4];
#pragma unroll
        for (int ai = 0; ai < 2; ++ai)
#pragma unroll
            for (int m = 0; m < 4; ++m) rsv[ai][m] = rstd[row0 + ai * HALF + m * 16];
#pragma unroll
        for (int ai = 0; ai < 2; ++ai)
#pragma unroll
            for (int m = 0; m < 4; ++m) { const int row = row0 + ai * HALF + m * 16; const float rs = rsv[ai][m];
#pragma unroll
                for (int bj = 0; bj < 2; ++bj) store8(kvm + (size_t)row * 1536 + col0 + bj * HALF, acc[ai][bj][m][0] * rs, acc[ai][bj][m][1] * rs);
                EPI_FENCE(); }
    }
};
template <int PASS> struct EpiMerge {
    static constexpr bool PERM = true, AFTER_DRAIN = false;
    const bf16_t* gates; float* tmp; bf16_t* out;
    __device__ __forceinline__ void operator()(const f32x4 (&acc)[2][2][4][2], const Unit& u, int wr, int wc, int fr, int fq) const {
        const int row0 = u.pm * BM + wr * 64 + fr, col0 = u.pn * BM + wc * 32 + 8 * fq;
#pragma unroll
        for (int ai = 0; ai < 2; ++ai)
#pragma unroll
            for (int m = 0; m < 4; ++m) { const int row = row0 + ai * HALF + m * 16;
#pragma unroll
                for (int bj = 0; bj < 2; ++bj) { const int col = col0 + bj * HALF;
                    f32x4 g0, g1; bf8_to_f32(*(const u32x4*)(gates + (size_t)row * 6144 + 2048 * PASS + col), g0, g1);
                    f32x4 v0 = g0 * acc[ai][bj][m][0], v1 = g1 * acc[ai][bj][m][1];
                    float* tp = tmp + (size_t)row * 2048 + col;
                    if (PASS > 0) { v0 += *(const f32x4*)tp; v1 += *(const f32x4*)(tp + 4); }
                    if (PASS < 2) { *(f32x4*)tp = v0; *(f32x4*)(tp + 4) = v1; }
                    else store8(out + (size_t)row * 2048 + col, v0, v1);
                    EPI_FENCE(); } }
    }
};
struct EpiMergeM {
    static constexpr bool PERM = true, AFTER_DRAIN = false;
    const bf16_t* gates; bf16_t* out;
    __device__ __forceinline__ void operator()(f32x4 (&acc)[2][2][4][2], const UnitM& u, int wr, int wc, int fr, int fq) const {
        int t_ = threadIdx.x; asm volatile("" : "+v"(t_)); (void)fr; (void)fq; const int lrow0 = wr * 64 + (t_ & 15), lcol0 = wc * 32 + 8 * ((t_ >> 4) & 3);
        const int sub = u.sub;
#pragma unroll
        for (int ai = 0; ai < 2; ++ai) {
            u32x4 ga[4][2], gb[4][2];
#pragma unroll
            for (int m = 0; m < 4; ++m)
#pragma unroll
                for (int bj = 0; bj < 2; ++bj) { const bf16_t* gp = gates + ((size_t)u.pm * BM + lrow0 + ai * HALF + m * 16) * 6144 + 2048 * sub + u.pn * BM + lcol0 + bj * HALF;
                    ga[m][bj] = *(const u32x4*)gp; if (sub < 2) gb[m][bj] = *(const u32x4*)(gp + 2048); }
#pragma unroll
            for (int m = 0; m < 4; ++m)
#pragma unroll
                for (int bj = 0; bj < 2; ++bj) { f32x4 a0, a1; bf8_to_f32(ga[m][bj], a0, a1);
#pragma unroll
                    for (int j = 0; j < 4; ++j) { a0[j] = fmaxf(a0[j], 1e-30f); a1[j] = fmaxf(a1[j], 1e-30f); }
                    if (sub < 2) { f32x4 b0, b1; bf8_to_f32(gb[m][bj], b0, b1);
#pragma unroll
                        for (int j = 0; j < 4; ++j) { a0[j] *= __builtin_amdgcn_rcpf(fmaxf(b0[j], 1e-30f)); a1[j] *= __builtin_amdgcn_rcpf(fmaxf(b1[j], 1e-30f)); }
                        acc[ai][bj][m][0] *= a0; acc[ai][bj][m][1] *= a1; }
                    else store8(out + ((size_t)u.pm * BM + lrow0 + ai * HALF + m * 16) * 2048 + u.pn * BM + lcol0 + bj * HALF, acc[ai][bj][m][0] * a0, acc[ai][bj][m][1] * a1); }
            EPI_FENCE(); }
    }
};
struct EpiResid {
    static constexpr bool PERM = true, AFTER_DRAIN = false;
    bf16_t* xb;
    __device__ __forceinline__ void operator()(const f32x4 (&acc)[2][2][4][2], const Unit& u, int wr, int wc, int fr, int fq) const {
        int t_ = threadIdx.x; asm volatile("" : "+v"(t_)); (void)fr; (void)fq;
        const int row0 = u.pm * BM + wr * 64 + (t_ & 15), col0 = u.pn * BM + wc * 32 + 8 * ((t_ >> 4) & 3);
#pragma unroll
        for (int ai = 0; ai < 2; ++ai) {
            u32x4 b[4][2];
#pragma unroll
            for (int m = 0; m < 4; ++m)
#pragma unroll
                for (int bj = 0; bj < 2; ++bj) b[m][bj] = *(const u32x4*)(xb + (size_t)(row0 + ai * HALF + m * 16) * 4096 + col0 + bj * HALF);
#pragma unroll
            for (int m = 0; m < 4; ++m)
#pragma unroll
                for (int bj = 0; bj < 2; ++bj) { f32x4 x0, x1; bf8_to_f32(b[m][bj], x0, x1);
                    store8(xb + (size_t)(row0 + ai * HALF + m * 16) * 4096 + col0 + bj * HALF, x0 + acc[ai][bj][m][0], x1 + acc[ai][bj][m][1]); }
            EPI_FENCE(); }
    }
};
__device__ __forceinline__ float gelu_gate(float xc, float g) {
    const float z = xc * (1.0f + 0.044715f * xc * xc);
    return xc * __builtin_amdgcn_rcpf(1.0f + __builtin_amdgcn_exp2f(-2.3022081985378545f * z)) * g;
}
template <int CTRL> __device__ __forceinline__ float dpp_f(float old, float src) {
    return __builtin_bit_cast(float, __builtin_amdgcn_update_dpp(__builtin_bit_cast(int, old), __builtin_bit_cast(int, src), CTRL, 0xf, 0xf, false)); }
struct EpiConvAct {
    static constexpr bool PERM = true, AFTER_DRAIN = false;
    bf16_t* act; float* utail; float* uhead; float* ghead; const float* cw; const float* cb; PG8_LAS float* xbuf;
    __device__ __forceinline__ void operator()(const f32x4 (&acc)[2][2][4][2], const Unit& u, int wr_, int wc_, int fr_, int fq_) const {
        int t_ = threadIdx.x; asm volatile("" : "+v"(t_)); const int fr = t_ & 15, fq = (t_ >> 4) & 3, wr = wr_, wc = wc_; (void)fr_; (void)fq_;
        const int lc = 32 * wc + 8 * fq, f0 = u.pn * HALF + lc;
        if (fr >= 14) {
#pragma unroll
            for (int ai = 0; ai < 2; ++ai) { PG8_LAS float* xp = xbuf + ((2 * ai + wr) * 2 + (fr - 14)) * 128 + lc; *(PG8_LAS f32x4*)xp = acc[ai][0][3][0]; *(PG8_LAS f32x4*)(xp + 4) = acc[ai][0][3][1]; }
            if (wr == 1) { float* tp = utail + ((size_t)u.pm * 2 + (fr - 14)) * 5632 + f0; *(f32x4*)tp = acc[1][0][3][0]; *(f32x4*)(tp + 4) = acc[1][0][3][1]; } }
        if (fr < 2 && wr == 0) { const size_t o = ((size_t)u.pm * 2 + fr) * 5632 + f0;
            *(f32x4*)(uhead + o) = acc[0][0][0][0]; *(f32x4*)(uhead + o + 4) = acc[0][0][0][1]; *(f32x4*)(ghead + o) = acc[0][1][0][0]; *(f32x4*)(ghead + o + 4) = acc[0][1][0][1]; }
        asm volatile("s_waitcnt lgkmcnt(0)" ::: "memory"); __builtin_amdgcn_s_barrier(); asm volatile("" ::: "memory");
        float w0[8], w1[8], w2[8], bb[8];
#pragma unroll
        for (int h = 0; h < 2; ++h) { const f32x4 a = *(const f32x4*)(cw + f0 + 4 * h), b = *(const f32x4*)(cw + 5632 + f0 + 4 * h), c = *(const f32x4*)(cw + 2 * 5632 + f0 + 4 * h), d = *(const f32x4*)(cb + f0 + 4 * h);
#pragma unroll
            for (int j = 0; j < 4; ++j) { w0[4 * h + j] = a[j]; w1[4 * h + j] = b[j]; w2[4 * h + j] = c[j]; bb[4 * h + j] = d[j]; } }
        const int row0 = u.pm * BM + wr * 64 + fr;
#pragma unroll
        for (int ai = 0; ai < 2; ++ai) {
            f32x4 t0a = {0.f, 0.f, 0.f, 0.f}, t0b = t0a, t1a = t0a, t1b = t0a;
            if (2 * ai + wr > 0) { const PG8_LAS float* xp = xbuf + ((2 * ai + wr - 1) * 2) * 128 + lc; t0a = *(const PG8_LAS f32x4*)xp; t0b = *(const PG8_LAS f32x4*)(xp + 4); t1a = *(const PG8_LAS f32x4*)(xp + 128); t1b = *(const PG8_LAS f32x4*)(xp + 132); }
#pragma unroll
            for (int m = 0; m < 4; ++m) { f32x4 o0, o1;
#pragma unroll
                for (int n = 0; n < 2; ++n)
#pragma unroll
                    for (int j = 0; j < 4; ++j) { const int k = 4 * n + j; const float cur = acc[ai][0][m][n][j];
                        float a1, a2;
                        if (m == 0) { const float T0 = n ? t0b[j] : t0a[j], T1 = n ? t1b[j] : t1a[j]; a1 = T1; a2 = (fr == 0) ? T0 : T1; }
                        else { const float pv = acc[ai][0][m - 1][n][j]; a1 = dpp_f<0x10F>(pv, pv); a2 = dpp_f<0x10E>(pv, pv); }
                        const float s1 = dpp_f<0x111>(a1, cur), s2 = dpp_f<0x112>(a2, cur);
                        const float xc = bb[k] + w0[k] * s2 + w1[k] * s1 + w2[k] * cur;
                        const float r = gelu_gate(xc, acc[ai][1][m][n][j]);
                        if (n == 0) o0[j] = r; else o1[j] = r; }
                store8(act + (size_t)(row0 + ai * HALF + m * 16) * 5632 + f0, o0, o1);
                EPI_FENCE(); } }
    }
};
}

namespace att {
#define ATT_LAS __attribute__((address_space(3)))
typedef unsigned short bf16_t;
typedef short bf16x8 __attribute__((ext_vector_type(8)));
typedef short s16x4 __attribute__((ext_vector_type(4)));
typedef float f32x16 __attribute__((ext_vector_type(16)));
typedef float f32x4 __attribute__((ext_vector_type(4)));
typedef unsigned u32x4 __attribute__((ext_vector_type(4)));
typedef unsigned u32x2 __attribute__((ext_vector_type(2)));
constexpr int SHM_T = 16384;
#define KSWZ(row, colB) ((row) * 256 + ((colB) ^ (((row) & 15) << 4)))
#define KSWZ64(row, colB) ((row) * 128 + ((colB) ^ ((((row) >> 1) & 7) << 4)))
#define SBAR() __builtin_amdgcn_sched_barrier(0)
__device__ __forceinline__ int v_st(int k, int c) { const int kk = (k & ~0xC) | ((k & 4) << 1) | ((k & 8) >> 1); return ((kk >> 3) * 4 + (c >> 5)) * 512 + ((kk & 7) * 32 + (c & 31)) * 2; }
__device__ __forceinline__ int v_rd_base(int lane) { return ((lane & 3) << 3) | (((lane >> 2) & 3) << 6) | (((lane >> 4) & 1) << 5) | (((lane >> 5) & 1) << 8); }
constexpr int v_rd_off(int d0, int ks, int half) { return d0 * 512 + ks * 4096 + half * 2048; }
__device__ __forceinline__ unsigned cvtpk(float lo, float hi) { unsigned r; asm volatile("v_cvt_pk_bf16_f32 %0, %1, %2" : "=v"(r) : "v"(lo), "v"(hi)); return r; }

template <bool ROPE>
__device__ __forceinline__ void qkt(f32x16& p0, f32x16& p1, const ATT_LAS char* Kt, const ATT_LAS char* Kr, int r32, int hi, const bf16x8* qr) {
    p0 = f32x16{}; p1 = f32x16{};
#pragma unroll
    for (int d0 = 0; d0 < 8; ++d0) { const ATT_LAS char* a = Kt + KSWZ(r32, (d0 * 16 + hi * 8) * 2);
        const bf16x8 b0 = *(const ATT_LAS bf16x8*)a, b1 = *(const ATT_LAS bf16x8*)(a + 32 * 256);
        p0 = __builtin_amdgcn_mfma_f32_32x32x16_bf16(b0, qr[d0], p0, 0, 0, 0);
        p1 = __builtin_amdgcn_mfma_f32_32x32x16_bf16(b1, qr[d0], p1, 0, 0, 0); }
    if (ROPE) {
#pragma unroll
        for (int d0 = 0; d0 < 4; ++d0) { const ATT_LAS char* a = Kr + KSWZ64(r32, (d0 * 16 + hi * 8) * 2);
            const bf16x8 b0 = *(const ATT_LAS bf16x8*)a, b1 = *(const ATT_LAS bf16x8*)(a + 32 * 128);
            p0 = __builtin_amdgcn_mfma_f32_32x32x16_bf16(b0, qr[8 + d0], p0, 0, 0, 0);
            p1 = __builtin_amdgcn_mfma_f32_32x32x16_bf16(b1, qr[8 + d0], p1, 0, 0, 0); } }
}
__device__ __forceinline__ void pv_tile_T(f32x16* o, int vb, bf16x8 pa0, bf16x8 pa1, bf16x8 pa2, bf16x8 pa3) {
#define TRRD(dst, off) asm volatile("ds_read_b64_tr_b16 %0, %1 offset:%2" : "=&v"(dst) : "v"(vb), "i"(off) : "memory")
#define PV_D0(d0) do { s16x4 l0, l1, l2, l3, h0, h1, h2, h3; constexpr int b_ = v_rd_off(d0, 0, 0); \
        TRRD(l0, b_); TRRD(h0, b_ + 2048); TRRD(l1, b_ + 4096); TRRD(h1, b_ + 6144); TRRD(l2, b_ + 8192); TRRD(h2, b_ + 10240); TRRD(l3, b_ + 12288); TRRD(h3, b_ + 14336); \
        asm volatile("s_waitcnt lgkmcnt(0)" ::: "memory"); SBAR(); \
        o[d0] = __builtin_amdgcn_mfma_f32_32x32x16_bf16((bf16x8){l0[0], l0[1], l0[2], l0[3], h0[0], h0[1], h0[2], h0[3]}, pa0, o[d0], 0, 0, 0); \
        o[d0] = __builtin_amdgcn_mfma_f32_32x32x16_bf16((bf16x8){l1[0], l1[1], l1[2], l1[3], h1[0], h1[1], h1[2], h1[3]}, pa1, o[d0], 0, 0, 0); \
        o[d0] = __builtin_amdgcn_mfma_f32_32x32x16_bf16((bf16x8){l2[0], l2[1], l2[2], l2[3], h2[0], h2[1], h2[2], h2[3]}, pa2, o[d0], 0, 0, 0); \
        o[d0] = __builtin_amdgcn_mfma_f32_32x32x16_bf16((bf16x8){l3[0], l3[1], l3[2], l3[3], h3[0], h3[1], h3[2], h3[3]}, pa3, o[d0], 0, 0, 0); } while (0)
    PV_D0(0); PV_D0(1); PV_D0(2); PV_D0(3);
#undef PV_D0
#undef TRRD
}
__device__ __forceinline__ void pack_p(const f32x16& p0, const f32x16& p1, bf16x8& pa0, bf16x8& pa1, bf16x8& pa2, bf16x8& pa3) {
#define PK4(P, B_, OUT) do { unsigned a0 = cvtpk(P[B_+0], P[B_+1]), a1 = cvtpk(P[B_+2], P[B_+3]); \
        unsigned b0 = cvtpk(P[B_+4], P[B_+5]), b1 = cvtpk(P[B_+6], P[B_+7]); \
        auto r0 = __builtin_amdgcn_permlane32_swap(a0, b0, false, false); auto r1 = __builtin_amdgcn_permlane32_swap(a1, b1, false, false); \
        u32x4 w = {r0[0], r1[0], r0[1], r1[1]}; OUT = *reinterpret_cast<bf16x8*>(&w); } while (0)
    PK4(p0, 0, pa0); PK4(p0, 8, pa1); PK4(p1, 0, pa2); PK4(p1, 8, pa3);
#undef PK4
}
__device__ __forceinline__ float swap_max(float v) { auto rr = __builtin_amdgcn_permlane32_swap(__float_as_uint(v), __float_as_uint(v), false, false); return fmaxf(__uint_as_float(rr[0]), __uint_as_float(rr[1])); }
__device__ __forceinline__ float swap_sum(float v) { auto rr = __builtin_amdgcn_permlane32_swap(__float_as_uint(v), __float_as_uint(v), false, false); return __uint_as_float(rr[0]) + __uint_as_float(rr[1]); }

struct UnitPtrs {
    const bf16_t* Q; int ldq;
    const bf16_t* K; int ldk;
    const bf16_t* V; int ldv;
    const bf16_t* KR;
    const float* bias;
    const bf16_t* G;
    bf16_t* O; int ldo;
    int P0;
    float c2;
    const bf16_t* ST;
    int T0;
};
template <int MODE>
__device__ __forceinline__ void mixer_unit(const UnitPtrs& U, ATT_LAS char* lds) {
    constexpr bool ROPE = (MODE == 1);
    constexpr int NQ = ROPE ? 12 : 8;
    constexpr int K_OFF = 0, KR_OFF = 32768, V_OFF = (MODE == 1) ? 49152 : 32768, V_SZ = (MODE == 2) ? 32768 : 16384, BIAS_OFF = 65536, SCR_OFF = 98304;
    int tid_ = threadIdx.x; asm volatile("" : "+v"(tid_));
    const int tid = tid_, wid = __builtin_amdgcn_readfirstlane(tid >> 6), lane = tid & 63, r32 = lane & 31, hi = lane >> 5;
    const int rg = (MODE == 2) ? (wid >> 1) : wid;
    const int vhalf = (MODE == 2) ? (wid & 1) : 0;
    const int qlo = U.P0 + 32 * rg;
    const int tbase = (MODE == 2) ? (U.T0 >> 6) : 0;
    const int NT = (U.P0 + ((MODE == 2) ? 128 : 256)) / 64 - tbase;
    const int tlast = (qlo >> 6) - tbase;
    bf16x8 qr[NQ];
    { const bf16_t* qp = U.Q + (size_t)(32 * rg + r32) * U.ldq + hi * 8;
#pragma unroll
      for (int d0 = 0; d0 < NQ; ++d0) qr[d0] = *(const bf16x8*)(qp + d0 * 16); }
    const int sr = tid >> 4, sc = (tid & 15) * 8;
    const int kws = KSWZ(sr, sc * 2), vst0 = v_st(sr, sc), vst1 = v_st(32 + sr, sc);
    const int rr = tid >> 3, rc = (tid & 7) * 8, krs = KSWZ64(rr, rc * 2);
    const int vbase = (int)(unsigned)(uintptr_t)(lds + V_OFF) + v_rd_base(lane) + vhalf * SHM_T;
    bf16x8 st_k0, st_k1, st_v0, st_v1, st_v2, st_v3, st_r;
#define ST_LOAD(kb_) do { const bf16_t* kp_ = U.K + (size_t)((kb_) + sr) * U.ldk + sc; st_k0 = *(const bf16x8*)kp_; st_k1 = *(const bf16x8*)(kp_ + (size_t)32 * U.ldk); \
        const bf16_t* vp_ = U.V + (size_t)((kb_) + sr) * U.ldv + sc; st_v0 = *(const bf16x8*)vp_; st_v1 = *(const bf16x8*)(vp_ + (size_t)32 * U.ldv); \
        if (MODE == 2) { st_v2 = *(const bf16x8*)(vp_ + 128); st_v3 = *(const bf16x8*)(vp_ + (size_t)32 * U.ldv + 128); } \
        if (MODE == 1) { st_r = *(const bf16x8*)(U.KR + (size_t)((kb_) + rr) * 64 + rc); } } while (0)
#define ST_WRITE(bf) do { ATT_LAS char* kd_ = lds + K_OFF + (bf) * SHM_T; *(ATT_LAS bf16x8*)(kd_ + kws) = st_k0; *(ATT_LAS bf16x8*)(kd_ + kws + 32 * 256) = st_k1; \
        ATT_LAS char* vd_ = lds + V_OFF + (bf) * V_SZ; *(ATT_LAS bf16x8*)(vd_ + vst0) = st_v0; *(ATT_LAS bf16x8*)(vd_ + vst1) = st_v1; \
        if (MODE == 2) { *(ATT_LAS bf16x8*)(vd_ + SHM_T + vst0) = st_v2; *(ATT_LAS bf16x8*)(vd_ + SHM_T + vst1) = st_v3; } \
        if (MODE == 1) { *(ATT_LAS bf16x8*)(lds + KR_OFF + (bf) * 8192 + krs) = st_r; } } while (0)
    float m_reg = -1e30f, l_reg = 0.f; f32x16 o[4] = {};
    float colf[(MODE == 2) ? 32 : 1];
    if (MODE == 2) {
#pragma unroll
        for (int r = 0; r < 16; ++r) { const int c = (r & 3) + 8 * (r >> 2); colf[r] = __builtin_amdgcn_exp2f(-U.c2 * (float)c); colf[16 + r] = __builtin_amdgcn_exp2f(-U.c2 * (float)(c + 32)); } }
    const int qpos = qlo + r32;
    ST_LOAD(tbase * 64);
    if (MODE == 0) { const int nk = U.P0 + 256; ATT_LAS float* bl = (ATT_LAS float*)(lds + BIAS_OFF); for (int i = tid; i < nk; i += 512) bl[i] = -U.bias[i]; }
    ST_WRITE(0);
    __syncthreads();
    if (MODE == 2) { if (U.ST) {
        const bf16_t* sp = U.ST + (size_t)(vhalf * 128 + r32) * 128 + hi * 8;
        bf16x8 sa[4][8];
#pragma unroll
        for (int d0 = 0; d0 < 4; ++d0)
#pragma unroll
            for (int ks = 0; ks < 8; ++ks) sa[d0][ks] = *(const bf16x8*)(sp + (size_t)d0 * 32 * 128 + ks * 16);
#pragma unroll
        for (int d0 = 0; d0 < 4; ++d0)
#pragma unroll
            for (int ks = 0; ks < 8; ++ks) o[d0] = __builtin_amdgcn_mfma_f32_32x32x16_bf16(sa[d0][ks], qr[ks], o[d0], 0, 0, 0);
        const float rf = __builtin_amdgcn_exp2f(U.c2 * (float)(qpos - U.T0 + 1));
#pragma unroll
        for (int d0 = 0; d0 < 4; ++d0)
#pragma unroll
            for (int r = 0; r < 16; ++r) o[d0][r] *= rf; } }
#define STEP(t, B) do { const int t_ = (t); const bool more_ = (t_ + 1 < NT); \
        if (more_) ST_LOAD((tbase + t_ + 1) * 64); \
        if (t_ <= tlast) { f32x16 p0, p1; bf16x8 pa0, pa1, pa2, pa3; \
            qkt<ROPE>(p0, p1, lds + K_OFF + (B) * SHM_T, lds + KR_OFF + (B) * 8192, r32, hi, qr); \
            const int dq = qpos - (tbase + t_) * 64 - 4 * hi; \
            if (MODE == 2) { \
                if (t_ < tlast) { const float rowf = __builtin_amdgcn_exp2f(U.c2 * (float)dq);     \
                    _Pragma("unroll") for (int r = 0; r < 16; ++r) { p0[r] *= rowf * colf[r]; p1[r] *= rowf * colf[16 + r]; } \
                } else { \
                    _Pragma("unroll") for (int r = 0; r < 16; ++r) { const int c = (r & 3) + 8 * (r >> 2); \
                        p0[r] *= __builtin_amdgcn_exp2f(U.c2 * fabsf((float)(dq - c))); p1[r] *= __builtin_amdgcn_exp2f(U.c2 * fabsf((float)(dq - c - 32))); } } \
            } else { \
                if (MODE == 0) { const ATT_LAS float* bl = (const ATT_LAS float*)(lds + BIAS_OFF) + t_ * 64 + 4 * hi; \
                    _Pragma("unroll") for (int g = 0; g < 4; ++g) { const f32x4 b0 = *(const ATT_LAS f32x4*)(bl + 8 * g), b1 = *(const ATT_LAS f32x4*)(bl + 32 + 8 * g); \
                        _Pragma("unroll") for (int j = 0; j < 4; ++j) { p0[4 * g + j] = fmaf(p0[4 * g + j], U.c2, b0[j]); p1[4 * g + j] = fmaf(p1[4 * g + j], U.c2, b1[j]); } } \
                    if (t_ == tlast) { const float NEG = -__builtin_inff(); \
                        _Pragma("unroll") for (int r = 0; r < 16; ++r) { const int c = (r & 3) + 8 * (r >> 2); if (dq - c < 0) p0[r] = NEG; if (dq - c - 32 < 0) p1[r] = NEG; } } \
                } else { _Pragma("unroll") for (int r = 0; r < 16; ++r) { p0[r] *= U.c2; p1[r] *= U.c2; } } \
                float pmax = p0[0]; \
                _Pragma("unroll") for (int r = 1; r < 16; ++r) pmax = fmaxf(pmax, p0[r]); \
                _Pragma("unroll") for (int r = 0; r < 16; ++r) pmax = fmaxf(pmax, p1[r]); \
                pmax = swap_max(pmax); \
                const float mn = fmaxf(m_reg, pmax), alpha = __builtin_amdgcn_exp2f(m_reg - mn); m_reg = mn; \
                if (!__all(alpha == 1.0f)) { _Pragma("unroll") for (int d_ = 0; d_ < 4; ++d_) _Pragma("unroll") for (int r = 0; r < 16; ++r) o[d_][r] *= alpha; } \
                float ps = 0.f; \
                _Pragma("unroll") for (int r = 0; r < 16; ++r) { p0[r] = __builtin_amdgcn_exp2f(p0[r] - mn); p1[r] = __builtin_amdgcn_exp2f(p1[r] - mn); ps += p0[r] + p1[r]; } \
                ps = swap_sum(ps); l_reg = l_reg * alpha + ps; \
            } \
            pack_p(p0, p1, pa0, pa1, pa2, pa3); \
            pv_tile_T(o, vbase + (B) * V_SZ, pa0, pa1, pa2, pa3); } \
        if (more_) ST_WRITE((B) ^ 1); \
        __syncthreads(); } while (0)
    for (int t = 0; t < NT; t += 2) { STEP(t, 0); STEP(t + 1, 1); }
#undef STEP
#undef ST_LOAD
#undef ST_WRITE
    bf16_t* orow = U.O + (size_t)(32 * rg + r32) * U.ldo + vhalf * 128 + 4 * hi;
    if (MODE == 2) {
        float ss = 0.f;
#pragma unroll
        for (int d0 = 0; d0 < 4; ++d0)
#pragma unroll
            for (int r = 0; r < 16; ++r) ss += o[d0][r] * o[d0][r];
        ss = swap_sum(ss);
        ATT_LAS float* scr = (ATT_LAS float*)(lds + SCR_OFF);
        if (hi == 0) scr[wid * 32 + r32] = ss;
        __syncthreads();
        const float tot = ss + scr[(wid ^ 1) * 32 + r32];
        const float rstd = __builtin_amdgcn_rsqf(tot * (1.0f / 256.0f) + 1e-6f);
        const bf16_t* grow = U.G + (size_t)(32 * rg + r32) * 1024 + vhalf * 128 + 4 * hi;
#pragma unroll
        for (int d0 = 0; d0 < 4; ++d0)
#pragma unroll
            for (int g = 0; g < 4; ++g) { const u32x2 gw = *(const u32x2*)(grow + 32 * d0 + 8 * g);
                const float g0 = __uint_as_float(gw.x << 16), g1 = __uint_as_float(gw.x & 0xffff0000u), g2 = __uint_as_float(gw.y << 16), g3 = __uint_as_float(gw.y & 0xffff0000u);
                u32x2 w; w.x = cvtpk(o[d0][4 * g] * rstd * g0, o[d0][4 * g + 1] * rstd * g1); w.y = cvtpk(o[d0][4 * g + 2] * rstd * g2, o[d0][4 * g + 3] * rstd * g3);
                *(u32x2*)(orow + 32 * d0 + 8 * g) = w; }
        __syncthreads();
    } else {
        const float inv = 1.0f / l_reg;
#pragma unroll
        for (int d0 = 0; d0 < 4; ++d0)
#pragma unroll
            for (int g = 0; g < 4; ++g) { u32x2 w; w.x = cvtpk(o[d0][4 * g] * inv, o[d0][4 * g + 1] * inv); w.y = cvtpk(o[d0][4 * g + 2] * inv, o[d0][4 * g + 3] * inv);
                *(u32x2*)(orow + 32 * d0 + 8 * g) = w; }
    }
}

__device__ __forceinline__ void ret_state_unit(const bf16_t* K, int ldk, const bf16_t* V, int ldv, float c2, float* SL, ATT_LAS char* lds) {
    int tid_ = threadIdx.x; asm volatile("" : "+v"(tid_));
    const int tid = tid_, wid = __builtin_amdgcn_readfirstlane(tid >> 6), lane = tid & 63, r32 = lane & 31, hi = lane >> 5;
    const int sr = tid >> 4, sc = (tid & 15) * 8, vst0 = v_st(sr, sc), vst1 = v_st(32 + sr, sc);
    constexpr int KI = 0, VI = 16384;
    const int kb = (int)(unsigned)(uintptr_t)(lds + KI) + v_rd_base(lane), vb = (int)(unsigned)(uintptr_t)(lds + VI) + v_rd_base(lane) + (wid >> 2) * SHM_T;
    f32x16 acc[4] = {};
    for (int t = 0; t < 4; ++t) {
        const bf16_t* kp = K + (size_t)(t * 64 + sr) * ldk + sc; const bf16_t* vp = V + (size_t)(t * 64 + sr) * ldv + sc;
        const u32x4 k0 = *(const u32x4*)kp, k1 = *(const u32x4*)(kp + (size_t)32 * ldk);
        const bf16x8 v0 = *(const bf16x8*)vp, v1 = *(const bf16x8*)(vp + (size_t)32 * ldv), v2 = *(const bf16x8*)(vp + 128), v3 = *(const bf16x8*)(vp + (size_t)32 * ldv + 128);
        const float w0 = __builtin_amdgcn_exp2f(c2 * (float)(255 - (t * 64 + sr))), w1 = __builtin_amdgcn_exp2f(c2 * (float)(255 - (t * 64 + 32 + sr)));
        u32x4 q0, q1;
#define WSC(w, s) cvtpk(__uint_as_float((w) << 16) * (s), __uint_as_float((w) & 0xffff0000u) * (s))
        q0.x = WSC(k0.x, w0); q0.y = WSC(k0.y, w0); q0.z = WSC(k0.z, w0); q0.w = WSC(k0.w, w0); q1.x = WSC(k1.x, w1); q1.y = WSC(k1.y, w1); q1.z = WSC(k1.z, w1); q1.w = WSC(k1.w, w1);
#undef WSC
        __syncthreads();
        *(ATT_LAS u32x4*)(lds + KI + vst0) = q0; *(ATT_LAS u32x4*)(lds + KI + vst1) = q1;
        *(ATT_LAS bf16x8*)(lds + VI + vst0) = v0; *(ATT_LAS bf16x8*)(lds + VI + vst1) = v1; *(ATT_LAS bf16x8*)(lds + VI + SHM_T + vst0) = v2; *(ATT_LAS bf16x8*)(lds + VI + SHM_T + vst1) = v3;
        __syncthreads();
#define TRR(dst, base, off) asm volatile("ds_read_b64_tr_b16 %0, %1 offset:%2" : "=&v"(dst) : "v"(base), "i"(off) : "memory")
#define KS_STEP(ks) do { s16x4 vl, vh, kl0, kh0, kl1, kh1, kl2, kh2, kl3, kh3; \
        TRR(vl, vbw, (ks) * 4096); TRR(vh, vbw, (ks) * 4096 + 2048); \
        TRR(kl0, kb, 0 * 512 + (ks) * 4096); TRR(kh0, kb, 0 * 512 + (ks) * 4096 + 2048); TRR(kl1, kb, 1 * 512 + (ks) * 4096); TRR(kh1, kb, 1 * 512 + (ks) * 4096 + 2048); \
        TRR(kl2, kb, 2 * 512 + (ks) * 4096); TRR(kh2, kb, 2 * 512 + (ks) * 4096 + 2048); TRR(kl3, kb, 3 * 512 + (ks) * 4096); TRR(kh3, kb, 3 * 512 + (ks) * 4096 + 2048); \
        asm volatile("s_waitcnt lgkmcnt(0)" ::: "memory"); SBAR(); \
        const bf16x8 vf = (bf16x8){vl[0], vl[1], vl[2], vl[3], vh[0], vh[1], vh[2], vh[3]}; \
        acc[0] = __builtin_amdgcn_mfma_f32_32x32x16_bf16(vf, (bf16x8){kl0[0], kl0[1], kl0[2], kl0[3], kh0[0], kh0[1], kh0[2], kh0[3]}, acc[0], 0, 0, 0); \
        acc[1] = __builtin_amdgcn_mfma_f32_32x32x16_bf16(vf, (bf16x8){kl1[0], kl1[1], kl1[2], kl1[3], kh1[0], kh1[1], kh1[2], kh1[3]}, acc[1], 0, 0, 0); \
        acc[2] = __builtin_amdgcn_mfma_f32_32x32x16_bf16(vf, (bf16x8){kl2[0], kl2[1], kl2[2], kl2[3], kh2[0], kh2[1], kh2[2], kh2[3]}, acc[2], 0, 0, 0); \
        acc[3] = __builtin_amdgcn_mfma_f32_32x32x16_bf16(vf, (bf16x8){kl3[0], kl3[1], kl3[2], kl3[3], kh3[0], kh3[1], kh3[2], kh3[3]}, acc[3], 0, 0, 0); } while (0)
        const int vbw = vb + (wid & 3) * 512;
        KS_STEP(0); KS_STEP(1); KS_STEP(2); KS_STEP(3);
#undef KS_STEP
#undef TRR
    }
#pragma unroll
    for (int e0 = 0; e0 < 4; ++e0)
#pragma unroll
        for (int r = 0; r < 16; ++r) SL[(size_t)(32 * wid + (r & 3) + 8 * (r >> 2) + 4 * hi) * 128 + 32 * e0 + r32] = acc[e0][r];
    __syncthreads();
}
}

constexpr int DM = 2048, NBATCH = 8, SEQ = 4096, DEPTH = 4, M = NBATCH * SEQ;
constexpr int IN_W = 12358, NIN = 12544, DFF = 5632, NUG = 2 * DFF, NUQ = 1280, NUKV = 1536;
constexpr float NORM_EPS = 1e-6f;
constexpr int NWAVES = 8;
constexpr int PH = 11, NPHASE = DEPTH * PH + 1;

constexpr size_t MiB = 1u << 20;
constexpr size_t WS_CTL = 0, CTL_ZERO_BYTES = 1 * MiB;
constexpr size_t WS_T128 = 1 * MiB, WS_T64 = 3 * MiB, WS_CL = 4 * MiB, WS_RSQ = 5 * MiB, WS_RSKV = 5 * MiB + 512 * 1024, WS_FF = 6 * MiB;
constexpr size_t WS_W = 8 * MiB;
constexpr size_t WO_IN = 0, WO_UQ = WO_IN + (size_t)NIN * DM * 2, WO_UKV = WO_UQ + (size_t)NUQ * 512 * 2, WO_BF = WO_UKV + (size_t)NUKV * 256 * 2, WO_BM = WO_BF + (size_t)DM * 1024 * 2,
                 WO_BR = WO_BM + (size_t)DM * 1024 * 2, WO_OUT = WO_BR + (size_t)DM * 1024 * 2, WO_UG = WO_OUT + (size_t)DM * DM * 2, WO_DN = WO_UG + (size_t)NUG * DM * 2, WO_END = WO_DN + (size_t)DM * DFF * 2;
static_assert(WO_END == 137 * MiB, "weight region");
constexpr size_t WS_H = 146 * MiB;
constexpr size_t WS_BIG = 274 * MiB;
constexpr size_t WS_GATES = WS_BIG, WS_FQKV = WS_GATES + 384 * MiB, WS_CQ = WS_FQKV + 144 * MiB, WS_CKV = WS_CQ + 32 * MiB, WS_RQ = WS_CKV + 16 * MiB, WS_RK = WS_RQ + 32 * MiB,
                 WS_RV = WS_RK + 32 * MiB, WS_RG = WS_RV + 64 * MiB, WS_KR = WS_RG + 64 * MiB, WS_QM = WS_KR + 4 * MiB, WS_KVM = WS_QM + 72 * MiB, WS_A = WS_KVM + 96 * MiB,
                 WS_BM = WS_A + 64 * MiB, WS_C = WS_BM + 64 * MiB, WS_SLOC = WS_C + 64 * MiB, WS_SST = WS_SLOC + 64 * MiB, WS_MIX_END = WS_SST + 32 * MiB;
constexpr size_t WS_TMP = WS_FQKV;
static_assert(WS_RV - WS_FQKV == 256 * MiB, "tmp overlay");
constexpr size_t WS_U = WS_BIG, WS_GT = WS_U + 352 * MiB, WS_ACT = WS_GT + 352 * MiB, WS_FFN_END = WS_ACT + 352 * MiB;
constexpr size_t WS_UTAIL = WS_U, WS_UHEAD = WS_U + 8 * MiB, WS_GHEAD = WS_U + 16 * MiB;
constexpr size_t WS_END = WS_MIX_END > WS_FFN_END ? WS_MIX_END : WS_FFN_END;
constexpr int CW_BAR = 4096;
constexpr int CW_QUEUE = 16384;

constexpr int RING_OFF = 0, RING_BYTES = 131072;
constexpr int LDSCTL_OFF = RING_BYTES, MISC_OFF = LDSCTL_OFF + 320;
constexpr int LDS_BYTES = 147456;
static_assert(MISC_OFF + 128 <= LDS_BYTES, "LDS map");

#define LAS __attribute__((address_space(3)))
typedef unsigned short bf16;
typedef unsigned v4u __attribute__((ext_vector_type(4)));
typedef float f32x4 __attribute__((ext_vector_type(4)));
#define LDS_WAIT() asm volatile("s_waitcnt lgkmcnt(0)" ::: "memory")
__device__ __forceinline__ unsigned f2bf(float f) { unsigned u = __builtin_bit_cast(unsigned, f); return (u + 0x7fffu + ((u >> 16) & 1u)) >> 16; }
__device__ __forceinline__ unsigned pk2(float lo, float hi) { return f2bf(lo) | (f2bf(hi) << 16); }

#define XB_TMO      128
#define XB_XCNT(j)  (256  + 64 * (j))
#define XB_XSUB(j)  (1280 + 64 * (j))
#define XB_XGEN(j)  (2304 + 64 * (j))
#define XB_TOP      3328
#define XB_TOPGEN   3392
#define XCD_BAR_WORDS 3456
#define XB_SPIN_CAP (1u << 18)
__device__ __forceinline__ unsigned xb_ld(unsigned* p)              { return __hip_atomic_load(p, __ATOMIC_RELAXED, __HIP_MEMORY_SCOPE_AGENT); }
__device__ __forceinline__ unsigned xb_add(unsigned* p, unsigned v) { return __hip_atomic_fetch_add(p, v, __ATOMIC_RELAXED, __HIP_MEMORY_SCOPE_AGENT); }
__device__ __forceinline__ unsigned xb_xcc_id() { return (unsigned)__builtin_amdgcn_s_getreg((3 << 11) | 20) & 0xFu; }
#define XB_SPIN(cond, bar) do { unsigned _sp = 0; while (cond) { __builtin_amdgcn_s_sleep(1); \
    if ((++_sp & 255u) == 0u) { if (xb_ld(&(bar)[XB_TMO])) break; if (_sp > XB_SPIN_CAP) { atomicAdd(&(bar)[XB_TMO], 1u); break; } } } } while (0)
struct XcdBarrier { unsigned* bar; unsigned x; volatile LAS unsigned* st; };
__device__ __forceinline__ XcdBarrier xcd_barrier_post(unsigned* bar, volatile LAS unsigned* st) {
    XcdBarrier b; b.bar = bar; b.x = xb_xcc_id(); b.st = st;
    if (threadIdx.x == 0) (void)xb_add(&bar[XB_XCNT(b.x)], 1u);
    return b;
}
__device__ __forceinline__ void xcd_barrier_complete(unsigned* bar, unsigned x, unsigned& nloc, unsigned& nx) {
    const unsigned G = gridDim.x * gridDim.y * gridDim.z;
    unsigned sum, cnt, mine, sp = 0u;
    for (;;) {
        sum = 0u; cnt = 0u; mine = 0u;
#pragma unroll
        for (unsigned j = 0; j < 16; ++j) { const unsigned c = xb_ld(&bar[XB_XCNT(j)]); sum += c; cnt += (c > 0u) ? 1u : 0u; mine = (j == x) ? c : mine; }
        if (sum == G) break;
        __builtin_amdgcn_s_sleep(1);
        if ((++sp & 255u) == 0u) { if (xb_ld(&bar[XB_TMO])) break; if (sp > XB_SPIN_CAP) { atomicAdd(&bar[XB_TMO], 1u); break; } }
    }
    nloc = mine > 0u ? mine : 1u; nx = cnt > 0u ? cnt : 1u;
}
__device__ __forceinline__ void xcd_barrier(const XcdBarrier& b) {
    asm volatile("s_waitcnt vmcnt(0)" ::: "memory");
    __syncthreads();
    if (threadIdx.x == 0) {
        unsigned bx = b.x; size_t bz_ = 0; asm volatile("" : "+s"(bz_), "+s"(bx)); unsigned* bar = b.bar + bz_;
        __builtin_amdgcn_s_waitcnt(0);
        unsigned nloc = b.st[0], nx = b.st[1];
        if (nloc == 0u) { xcd_barrier_complete(bar, bx, nloc, nx); b.st[0] = nloc; b.st[1] = nx; }
        const unsigned old = xb_add(&bar[XB_XSUB(bx)], 1u);
        const unsigned gen = old / nloc;
        if (old + 1u == (gen + 1u) * nloc) {
            __builtin_amdgcn_fence(__ATOMIC_RELEASE, "agent");
            asm volatile("s_waitcnt vmcnt(0)" ::: "memory");
            const unsigned og = xb_add(&bar[XB_TOP], 1u);
            const unsigned tg = og / nx;
            if (og + 1u == (tg + 1u) * nx) xb_add(&bar[XB_TOPGEN], 1u);
            else XB_SPIN(xb_ld(&bar[XB_TOPGEN]) == tg, bar);
            __builtin_amdgcn_fence(__ATOMIC_ACQUIRE, "agent");
            xb_add(&bar[XB_XGEN(bx)], 1u);
            asm volatile("s_waitcnt vmcnt(0)" ::: "memory");
        } else {
            XB_SPIN(xb_ld(&bar[XB_XGEN(bx)]) == gen, bar);
            __builtin_amdgcn_fence(__ATOMIC_ACQUIRE, "agent");
            asm volatile("s_waitcnt vmcnt(0)" ::: "memory");
        }
    }
    __syncthreads();
}

__device__ __forceinline__ float wave_sum(float v, int lane) {
#pragma unroll
    for (int o = 1; o < 64; o <<= 1) v += __builtin_bit_cast(float, __builtin_amdgcn_ds_bpermute((lane ^ o) << 2, __builtin_bit_cast(int, v)));
    return v;
}
__device__ __forceinline__ double lane_up_d(double v, int lane, int o) {
    const int src = (lane >= o ? lane - o : lane) << 2; const unsigned long long u = __builtin_bit_cast(unsigned long long, v);
    const unsigned lo = (unsigned)__builtin_amdgcn_ds_bpermute(src, (int)(unsigned)u), hi = (unsigned)__builtin_amdgcn_ds_bpermute(src, (int)(unsigned)(u >> 32));
    return __builtin_bit_cast(double, ((unsigned long long)hi << 32) | lo);
}
__device__ __forceinline__ void wconv_item(const float* W, int ldw, int src, int valid, const float* kscale, bf16* dst, int K, int k0, LAS float* scr, int lane) {
    const int j = lane & 31; const bool ok = j < valid;
    float wv[32];
#pragma unroll
    for (int i = 0; i < 32; ++i) { const int kk = 2 * i + (lane >> 5); wv[i] = ok ? W[(size_t)(k0 + kk) * ldw + src + j] : 0.f; }
    if (kscale) {
#pragma unroll
        for (int i = 0; i < 32; ++i) wv[i] *= kscale[k0 + 2 * i + (lane >> 5)]; }
#pragma unroll
    for (int i = 0; i < 32; ++i) scr[(2 * i + (lane >> 5)) * 33 + j] = wv[i];
    LDS_WAIT(); asm volatile("" ::: "memory");
    const int c = lane & 7;
#pragma unroll
    for (int jj = 0; jj < 4; ++jj) { const int n = (lane >> 3) + 8 * jj; const LAS float* s = scr + (8 * c) * 33 + n;
        v4u o; o.x = pk2(s[0 * 33], s[1 * 33]); o.y = pk2(s[2 * 33], s[3 * 33]); o.z = pk2(s[4 * 33], s[5 * 33]); o.w = pk2(s[6 * 33], s[7 * 33]);
        *(v4u*)(dst + (size_t)n * K + k0 + 8 * c) = o; }
    LDS_WAIT(); asm volatile("" ::: "memory");
}
__device__ __forceinline__ void inproj_src(int g, int& src, int& valid) {
    const int n = g * 32; valid = 32;
    if (n < 2304) src = n;
    else if (n < 2816) src = 2310 + (n - 2304);
    else if (n < 3072) src = 2822 + (n - 2816);
    else if (n < 3328) { const int p = n - 3072; if (p == 0) src = 3078; else if (p == 32) { src = 2304; valid = 6; } else if (p == 128) src = 3110; else { src = 0; valid = 0; } }
    else if (n < 4352) { const int base = (n < 3840) ? 3142 : 3654; const int p = (n < 3840) ? n - 3328 : n - 3840; const int t = p >> 8, q = p & 255, bj = q >> 7, x = q & 127, hh = x >> 6, i = x & 63;
        src = base + 128 * (2 * t + hh) + 64 * bj + i; }
    else if (n < 5376) src = 4166 + (n - 4352);
    else if (n < 6400) src = 5190 + (n - 5376);
    else src = 6214 + (n - 6400);
}
__device__ __forceinline__ void uq_src(int g, int& src, int& valid) {
    const int n = g * 32; valid = 32;
    if (n < 768) { const int t = n >> 8, q = n & 255, bj = q >> 7, x = q & 127; src = 192 * (2 * t + bj) + x; }
    else { const int t4 = (n >= 1024) ? 1 : 0; const int q = n - 768 - 256 * t4, bj = q >> 7, x = q & 127, hh = (x >> 5) + 4 * t4; if (hh < 6) src = 192 * hh + 128 + 32 * bj; else { src = 0; valid = 0; } }
}

struct Args {
    const float* in[19]; float* out; unsigned char* ws;
    float invf128[64]; float invf64[32];
    int ph_lo, ph_hi;
};

static_assert(sizeof(Args) == 560, "Args layout");

#define KAS __attribute__((address_space(4)))
#define GAS1 __attribute__((address_space(1)))
__device__ __forceinline__ const KAS char* karg_base() { size_t z = 0; asm volatile("" : "+s"(z)); return (const KAS char*)__builtin_amdgcn_kernarg_segment_ptr() + z; }
__device__ __forceinline__ const float* arg_in(int i) { typedef const GAS1 float* gp; return (const float*)(*(const KAS gp*)(karg_base() + 8 * i)); }
__device__ __forceinline__ float* arg_out() { typedef GAS1 float* gp; return (float*)(*(const KAS gp*)(karg_base() + 152)); }
__device__ __forceinline__ unsigned char* arg_ws() { typedef GAS1 unsigned char* gp; return (unsigned char*)(*(const KAS gp*)(karg_base() + 160)); }
__device__ __forceinline__ float arg_invf128(int i) { return *(const KAS float*)(karg_base() + 168 + 4 * i); }
__device__ __forceinline__ float arg_invf64(int i) { return *(const KAS float*)(karg_base() + 424 + 4 * i); }
struct Ctx { int tid, lane, wave, G, vcu, gw, NGW; LAS unsigned char* lds; unsigned char* ws; };
__device__ __forceinline__ Ctx ctx_local(const Ctx& C0) { Ctx C = C0; int t_ = threadIdx.x; asm volatile("" : "+v"(t_)); C.tid = t_; C.lane = t_ & 63; size_t z_ = 0; asm volatile("" : "+s"(C.wave), "+s"(C.gw), "+s"(C.vcu), "+s"(z_)); C.ws = arg_ws() + z_; return C; }

constexpr int XPITCH = 4096;
__device__ __forceinline__ void cvt8(const v4u w, float (&v)[8]) {
    v[0] = __uint_as_float(w.x << 16); v[1] = __uint_as_float(w.x & 0xffff0000u); v[2] = __uint_as_float(w.y << 16); v[3] = __uint_as_float(w.y & 0xffff0000u);
    v[4] = __uint_as_float(w.z << 16); v[5] = __uint_as_float(w.z & 0xffff0000u); v[6] = __uint_as_float(w.w << 16); v[7] = __uint_as_float(w.w & 0xffff0000u); }
__device__ __forceinline__ void rows_rmsnorm_first(const Ctx& C0, const float* x, const float* gain, bf16* xb, bf16* out) { const Ctx C = ctx_local(C0);
    f32x4 g[8];
#pragma unroll
    for (int j = 0; j < 8; ++j) g[j] = ((const f32x4*)gain + C.lane)[64 * j];
    for (int m = C.gw; m < M; m += 2 * C.NGW) {
        const int m2 = m + C.NGW; const bool has2 = m2 < M;
        const f32x4* xa = (const f32x4*)(x + (size_t)m * DM) + C.lane; const f32x4* xq = (const f32x4*)(x + (size_t)(has2 ? m2 : m) * DM) + C.lane;
        f32x4 va[8], vb[8]; float sa = 0.f, sb = 0.f;
#pragma unroll
        for (int j = 0; j < 8; ++j) va[j] = xa[64 * j];
#pragma unroll
        for (int j = 0; j < 8; ++j) vb[j] = xq[64 * j];
#pragma unroll
        for (int j = 0; j < 8; ++j) { sa += (va[j].x * va[j].x + va[j].y * va[j].y) + (va[j].z * va[j].z + va[j].w * va[j].w); sb += (vb[j].x * vb[j].x + vb[j].y * vb[j].y) + (vb[j].z * vb[j].z + vb[j].w * vb[j].w); }
        const float ra = __builtin_amdgcn_rsqf(wave_sum(sa, C.lane) * (1.0f / DM) + NORM_EPS), rb = __builtin_amdgcn_rsqf(wave_sum(sb, C.lane) * (1.0f / DM) + NORM_EPS);
        unsigned long long* oa = (unsigned long long*)(out + (size_t)m * DM) + C.lane; unsigned long long* ya = (unsigned long long*)(xb + (size_t)m * XPITCH) + C.lane;
#pragma unroll
        for (int j = 0; j < 8; ++j) { oa[64 * j] = (unsigned long long)pk2(va[j].x * ra * g[j].x, va[j].y * ra * g[j].y) | ((unsigned long long)pk2(va[j].z * ra * g[j].z, va[j].w * ra * g[j].w) << 32);
            ya[64 * j] = (unsigned long long)pk2(va[j].x, va[j].y) | ((unsigned long long)pk2(va[j].z, va[j].w) << 32); }
        if (has2) { unsigned long long* ob = (unsigned long long*)(out + (size_t)m2 * DM) + C.lane; unsigned long long* yb = (unsigned long long*)(xb + (size_t)m2 * XPITCH) + C.lane;
#pragma unroll
            for (int j = 0; j < 8; ++j) { ob[64 * j] = (unsigned long long)pk2(vb[j].x * rb * g[j].x, vb[j].y * rb * g[j].y) | ((unsigned long long)pk2(vb[j].z * rb * g[j].z, vb[j].w * rb * g[j].w) << 32);
                yb[64 * j] = (unsigned long long)pk2(vb[j].x, vb[j].y) | ((unsigned long long)pk2(vb[j].z, vb[j].w) << 32); } }
    }
}
__device__ __forceinline__ void rows_rmsnorm_bf16(const Ctx& C0, const bf16* xb, const float* gain, bf16* out) { const Ctx C = ctx_local(C0);
    f32x4 g[4][2];
#pragma unroll
    for (int j = 0; j < 4; ++j) { g[j][0] = *(const f32x4*)(gain + 8 * (C.lane + 64 * j)); g[j][1] = *(const f32x4*)(gain + 8 * (C.lane + 64 * j) + 4); }
    for (int m0 = C.gw; m0 < M; m0 += 4 * C.NGW) {
        v4u w[4][4];
#pragma unroll
        for (int q = 0; q < 4; ++q) { const int m = m0 + q * C.NGW; const v4u* xr = (const v4u*)(xb + (size_t)(m < M ? m : m0) * XPITCH) + C.lane;
#pragma unroll
            for (int j = 0; j < 4; ++j) w[q][j] = xr[64 * j]; }
#pragma unroll
        for (int q = 0; q < 4; ++q) { const int m = m0 + q * C.NGW; float s = 0.f;
#pragma unroll
            for (int j = 0; j < 4; ++j) { float v[8]; cvt8(w[q][j], v);
#pragma unroll
                for (int e = 0; e < 8; ++e) s += v[e] * v[e]; }
            const float r = __builtin_amdgcn_rsqf(wave_sum(s, C.lane) * (1.0f / DM) + NORM_EPS);
            if (m < M) { v4u* orow = (v4u*)(out + (size_t)m * DM) + C.lane;
#pragma unroll
                for (int j = 0; j < 4; ++j) { float v[8]; cvt8(w[q][j], v);
                    v4u o; o.x = pk2(v[0] * r * g[j][0][0], v[1] * r * g[j][0][1]); o.y = pk2(v[2] * r * g[j][0][2], v[3] * r * g[j][0][3]); o.z = pk2(v[4] * r * g[j][1][0], v[5] * r * g[j][1][1]); o.w = pk2(v[6] * r * g[j][1][2], v[7] * r * g[j][1][3]);
                    orow[64 * j] = o; } } }
    }
}
__device__ __forceinline__ void rows_rmsnorm_final(const Ctx& C0, float* outp, const float* gain) { const Ctx C = ctx_local(C0);
    f32x4 g[4][2];
#pragma unroll
    for (int j = 0; j < 4; ++j) { g[j][0] = *(const f32x4*)(gain + 8 * (C.lane + 64 * j)); g[j][1] = *(const f32x4*)(gain + 8 * (C.lane + 64 * j) + 4); }
    for (int m0 = C.gw; m0 < M; m0 += 4 * C.NGW) {
        v4u w[4][4];
#pragma unroll
        for (int q = 0; q < 4; ++q) { const int m = m0 + q * C.NGW; const v4u* xr = (const v4u*)((const bf16*)outp + (size_t)(m < M ? m : m0) * XPITCH) + C.lane;
#pragma unroll
            for (int j = 0; j < 4; ++j) w[q][j] = xr[64 * j]; }
        asm volatile("s_waitcnt vmcnt(0)" ::: "memory");
#pragma unroll
        for (int q = 0; q < 4; ++q) { const int m = m0 + q * C.NGW; float s = 0.f;
#pragma unroll
            for (int j = 0; j < 4; ++j) { float v[8]; cvt8(w[q][j], v);
#pragma unroll
                for (int e = 0; e < 8; ++e) s += v[e] * v[e]; }
            const float r = __builtin_amdgcn_rsqf(wave_sum(s, C.lane) * (1.0f / DM) + NORM_EPS);
            if (m < M) { float* orow = outp + (size_t)m * DM + 8 * C.lane;
#pragma unroll
                for (int j = 0; j < 4; ++j) { float v[8]; cvt8(w[q][j], v);
                    *(f32x4*)(orow + 512 * j) = (f32x4){v[0] * r * g[j][0][0], v[1] * r * g[j][0][1], v[2] * r * g[j][0][2], v[3] * r * g[j][0][3]};
                    *(f32x4*)(orow + 512 * j + 4) = (f32x4){v[4] * r * g[j][1][0], v[5] * r * g[j][1][1], v[6] * r * g[j][1][2], v[7] * r * g[j][1][3]}; } } }
    }
}
__device__ __forceinline__ void sincos_d(float angf, float& co, float& si) {
    const double a = (double)angf; const double k = __builtin_rint(a * 0.15915494309189535); double r = a - k * 6.283185307179586477;
    const double q = __builtin_rint(r * 0.63661977236758134308); const double y = r - q * 1.57079632679489661923; const double y2 = y * y;
    const double sy = y * (1.0 + y2 * (-1.0 / 6 + y2 * (1.0 / 120 + y2 * (-1.0 / 5040 + y2 * (1.0 / 362880 + y2 * (-1.0 / 39916800 + y2 * (1.0 / 6227020800.0)))))));
    const double cy = 1.0 + y2 * (-0.5 + y2 * (1.0 / 24 + y2 * (-1.0 / 720 + y2 * (1.0 / 40320 + y2 * (-1.0 / 3628800 + y2 * (1.0 / 479001600 + y2 * (-1.0 / 87178291200.0)))))));
    const int qi = ((int)q) & 3;
    const double s = (qi == 0) ? sy : (qi == 1) ? cy : (qi == 2) ? -sy : -cy;
    const double c = (qi == 0) ? cy : (qi == 1) ? -sy : (qi == 2) ? -cy : sy;
    co = (float)c; si = (float)s;
}
__device__ __forceinline__ void rope_tables(const Ctx& C0, const Args& A) { const Ctx C = ctx_local(C0);
    float* T128 = (float*)(C.ws + WS_T128); float* T64 = (float*)(C.ws + WS_T64);
    const int gt = (C.vcu * NWAVES + C.wave) * 64 + C.lane, NGT = C.NGW * 64;
    for (int e = gt; e < SEQ * 64; e += NGT) { const int pos = e >> 6, i = e & 63; float c, s; sincos_d((float)pos * arg_invf128(i), c, s); T128[2 * e] = c; T128[2 * e + 1] = s; }
    for (int e = gt; e < SEQ * 32; e += NGT) { const int pos = e >> 5, i = e & 31; float c, s; sincos_d((float)pos * arg_invf64(i), c, s); T64[2 * e] = c; T64[2 * e + 1] = s; }
}
__device__ __forceinline__ void p0_phase(const Ctx& C0, const Args& A, int layer) { const Ctx C = ctx_local(C0);
    LAS float* scr = (LAS float*)(C.lds + RING_OFF + C.wave * 16384);
    const float* w_in = arg_in(2) + (size_t)layer * DM * IN_W;
    const float* w_uq = arg_in(5) + (size_t)layer * 512 * 1152; const float* w_ukv = arg_in(6) + (size_t)layer * 256 * 1536;
    const float* qg = arg_in(3) + (size_t)layer * 512; const float* kvg = arg_in(4) + (size_t)layer * 256;
    const float* w_bf = arg_in(8) + (size_t)layer * 768 * DM; const float* w_bm = arg_in(9) + (size_t)layer * 768 * DM; const float* w_br = arg_in(10) + (size_t)layer * 1024 * DM;
    const float* w_out = arg_in(11) + (size_t)layer * DM * DM;
    const float* w_up = arg_in(13) + (size_t)layer * DM * DFF; const float* w_gate = arg_in(14) + (size_t)layer * DM * DFF; const float* w_dn = arg_in(17) + (size_t)layer * DFF * DM;
    bf16* Wb = (bf16*)(C.ws + WS_W);
    constexpr int I_IN = (NIN / 32) * (DM / 64), I_UQ = (NUQ / 32) * (512 / 64), I_UKV = (NUKV / 32) * (256 / 64), I_BF = (DM / 32) * (768 / 64), I_BR = (DM / 32) * (1024 / 64),
                  I_OUT = (DM / 32) * (DM / 64), I_UG = (NUG / 32) * (DM / 64), I_DN = (DM / 32) * (DFF / 64);
    constexpr int NITEMS = I_IN + I_UQ + I_UKV + 2 * I_BF + I_BR + I_OUT;
    for (int it = C.gw; it < NITEMS; it += C.NGW) {
        int r = it, src, valid;
        if (r < I_IN) { const int g = r / (DM / 64), kb = r % (DM / 64); inproj_src(g, src, valid); wconv_item(w_in, IN_W, src, valid, nullptr, (bf16*)((char*)Wb + WO_IN) + (size_t)g * 32 * DM, DM, kb * 64, scr, C.lane); continue; } r -= I_IN;
        if (r < I_UQ) { const int g = r / 8, kb = r % 8; uq_src(g, src, valid); wconv_item(w_uq, 1152, src, valid, qg, (bf16*)((char*)Wb + WO_UQ) + (size_t)g * 32 * 512, 512, kb * 64, scr, C.lane); continue; } r -= I_UQ;
        if (r < I_UKV) { const int g = r / 4, kb = r % 4; wconv_item(w_ukv, 1536, g * 32, 32, kvg, (bf16*)((char*)Wb + WO_UKV) + (size_t)g * 32 * 256, 256, kb * 64, scr, C.lane); continue; } r -= I_UKV;
        if (r < I_BF) { const int g = r / 12, kb = r % 12; wconv_item(w_bf, DM, g * 32, 32, nullptr, (bf16*)((char*)Wb + WO_BF) + (size_t)g * 32 * 1024, 1024, kb * 64, scr, C.lane); continue; } r -= I_BF;
        if (r < I_BF) { const int g = r / 12, kb = r % 12; wconv_item(w_bm, DM, g * 32, 32, nullptr, (bf16*)((char*)Wb + WO_BM) + (size_t)g * 32 * 1024, 1024, kb * 64, scr, C.lane); continue; } r -= I_BF;
        if (r < I_BR) { const int g = r / 16, kb = r % 16; wconv_item(w_br, DM, g * 32, 32, nullptr, (bf16*)((char*)Wb + WO_BR) + (size_t)g * 32 * 1024, 1024, kb * 64, scr, C.lane); continue; } r -= I_BR;
        if (r < I_OUT) { const int g = r / 32, kb = r % 32; wconv_item(w_out, DM, g * 32, 32, nullptr, (bf16*)((char*)Wb + WO_OUT) + (size_t)g * 32 * DM, DM, kb * 64, scr, C.lane); }
    }
    if (layer == 0) rows_rmsnorm_first(C, arg_in(0), arg_in(1), (bf16*)arg_out(), (bf16*)(C.ws + WS_H));
    else rows_rmsnorm_bf16(C, (const bf16*)arg_out(), arg_in(1) + (size_t)layer * DM, (bf16*)(C.ws + WS_H));
}
__device__ __forceinline__ void wconv_ffn(const Ctx& C0, int layer, int first, int nblk) { const Ctx C = ctx_local(C0);
    LAS float* scr = (LAS float*)(C.lds + RING_OFF + C.wave * 16384);
    const float* w_up = arg_in(13) + (size_t)layer * DM * DFF; const float* w_gate = arg_in(14) + (size_t)layer * DM * DFF; const float* w_dn = arg_in(17) + (size_t)layer * DFF * DM;
    bf16* Wb = (bf16*)(C.ws + WS_W);
    constexpr int I_UG = (NUG / 32) * (DM / 64), I_DN = (DM / 32) * (DFF / 64);
    for (int it = first * NWAVES + C.wave; it < I_UG + I_DN; it += nblk * NWAVES) {
        int r = it;
        if (r < I_UG) { const int g = r / 32, kb = r % 32; const int n = g * 32, t = n >> 8, bj = (n >> 7) & 1, x = n & 127;
            wconv_item(bj ? w_gate : w_up, DFF, 128 * t + x, 32, nullptr, (bf16*)((char*)Wb + WO_UG) + (size_t)g * 32 * DM, DM, kb * 64, scr, C.lane); continue; } r -= I_UG;
        { const int g = r / 88, kb = r % 88; wconv_item(w_dn, DM, g * 32, 32, nullptr, (bf16*)((char*)Wb + WO_DN) + (size_t)g * 32 * DFF, DFF, kb * 64, scr, C.lane); }
    }
}
__device__ __forceinline__ void p2_phase(const Ctx& C0, const Args& A, int layer) { const Ctx C = ctx_local(C0);
    const float* ff = (const float*)(C.ws + WS_FF); float* cL = (float*)(C.ws + WS_CL);
    LAS double* red = (LAS double*)(C.lds + RING_OFF);
    for (int sq = C.vcu; sq < NBATCH * 6; sq += C.G) {
        const int b = sq / 6, h = sq % 6; const float bias = arg_in(7)[layer * 6 + h];
        double v[8]; double run = 0.0;
#pragma unroll
        for (int j = 0; j < 8; ++j) { const float xf = ff[((size_t)b * SEQ + C.tid * 8 + j) * 8 + h] + bias;
            const float ls = fminf(xf, 0.f) - 0.6931471805599453f * __builtin_amdgcn_logf(1.0f + __builtin_amdgcn_exp2f(-1.4426950408889634f * fabsf(xf)));
            run += (double)ls; v[j] = run; }
        double incl = run;
#pragma unroll
        for (int o = 1; o < 64; o <<= 1) { const double t = lane_up_d(incl, C.lane, o); if (C.lane >= o) incl += t; }
        __syncthreads();
        if (C.lane == 63) red[C.wave] = incl;
        __syncthreads();
        double base = incl - run;
        for (int w = 0; w < C.wave; ++w) base += red[w];
        float* dst = cL + (size_t)sq * SEQ + C.tid * 8;
#pragma unroll
        for (int j = 0; j < 8; ++j) dst[j] = (float)((base + v[j]) * 1.4426950408889634);
    }
    const bf16* cq = (const bf16*)(C.ws + WS_CQ); const bf16* ckv = (const bf16*)(C.ws + WS_CKV); float* rq = (float*)(C.ws + WS_RSQ); float* rkv = (float*)(C.ws + WS_RSKV);
    for (int m0 = C.gw; m0 < M; m0 += 4 * C.NGW) {
        v4u a[4], c[4];
#pragma unroll
        for (int q = 0; q < 4; ++q) { const int m = m0 + q * C.NGW; const int mm = m < M ? m : m0; a[q] = *((const v4u*)(cq + (size_t)mm * 512) + C.lane); c[q] = *((const v4u*)(ckv + (size_t)mm * 256) + (C.lane & 31)); }
#pragma unroll
        for (int q = 0; q < 4; ++q) { const int m = m0 + q * C.NGW;
            float s = 0.f, s2 = 0.f; const unsigned w[4] = {a[q].x, a[q].y, a[q].z, a[q].w}, w2[4] = {c[q].x, c[q].y, c[q].z, c[q].w};
#pragma unroll
            for (int j = 0; j < 4; ++j) { const float lo = __uint_as_float(w[j] << 16), hi = __uint_as_float(w[j] & 0xffff0000u); s += lo * lo + hi * hi;
                const float lo2 = __uint_as_float(w2[j] << 16), hi2 = __uint_as_float(w2[j] & 0xffff0000u); if (C.lane < 32) s2 += lo2 * lo2 + hi2 * hi2; }
            s = wave_sum(s, C.lane); s2 = wave_sum(s2, C.lane);
            if (C.lane == 0 && m < M) { rq[m] = __builtin_amdgcn_rsqf(s * (1.0f / 512.0f) + NORM_EPS); rkv[m] = __builtin_amdgcn_rsqf(s2 * (1.0f / 256.0f) + NORM_EPS); } }
    }
    { const bf16* rk = (const bf16*)(C.ws + WS_RK); const bf16* rv = (const bf16*)(C.ws + WS_RV); float* sloc = (float*)(C.ws + WS_SLOC);
      for (int u = C.vcu; u < NBATCH * 4 * 16; u += C.G) { const int k = u & 15, h = (u >> 4) & 3, b = u >> 6; const size_t row0 = (size_t)b * SEQ + 256 * k;
          att::ret_state_unit(rk + row0 * 512 + 128 * h, 512, rv + row0 * 1024 + 256 * h, 1024, __builtin_amdgcn_logf(1.0f - __builtin_amdgcn_exp2f(-5.0f - (float)h)), sloc + (size_t)u * 32768, (LAS char*)(C.lds + RING_OFF)); } }
}
__device__ __forceinline__ void ret_scan(const Ctx& C0) { const Ctx C = ctx_local(C0);
    const float* sloc = (const float*)(C.ws + WS_SLOC); bf16* sst = (bf16*)(C.ws + WS_SST);
    for (int it = C.gw * 64 + C.lane; it < NBATCH * 4 * 8192; it += C.NGW * 64) {
        const int bh = it >> 13, e4 = (it & 8191) * 4, h = bh & 3;
        const float g256 = __builtin_amdgcn_exp2f(256.0f * __builtin_amdgcn_logf(1.0f - __builtin_amdgcn_exp2f(-5.0f - (float)h)));
        f32x4 s = {0.f, 0.f, 0.f, 0.f};
        f32x4 l[16];
#pragma unroll
        for (int k = 0; k < 15; ++k) l[k] = *(const f32x4*)(sloc + ((size_t)bh * 16 + k) * 32768 + e4);
#pragma unroll
        for (int k = 0; k < 16; ++k) { const size_t o = ((size_t)bh * 16 + k) * 32768 + e4;
            *(unsigned long long*)(sst + o) = (unsigned long long)pk2(s[0], s[1]) | ((unsigned long long)pk2(s[2], s[3]) << 32);
            if (k < 15) s = s * g256 + l[k]; }
    }
}
__device__ __forceinline__ void p9_phase(const Ctx& C0, const Args& A, int layer) { const Ctx C = ctx_local(C0);
    const float* utail = (const float*)(C.ws + WS_UTAIL); const float* uhead = (const float*)(C.ws + WS_UHEAD); const float* ghead = (const float*)(C.ws + WS_GHEAD); bf16* act = (bf16*)(C.ws + WS_ACT);
    const float* cw = arg_in(15) + (size_t)layer * 3 * DFF; const float* cb = arg_in(16) + (size_t)layer * DFF;
    constexpr int NCH = DFF / 8, NITEM = (M / 256) * 2 * NCH;
    for (int it = C.gw * 64 + C.lane; it < NITEM; it += C.NGW * 64) {
        const int ch = it % NCH, rr = (it / NCH) & 1, pm = it / (2 * NCH), f0 = ch * 8;
        if ((pm & 15) == 0) continue;
        const float* p2 = rr ? utail + ((size_t)(pm - 1) * 2 + 1) * DFF : utail + ((size_t)(pm - 1) * 2) * DFF;
        const float* p1 = rr ? uhead + ((size_t)pm * 2) * DFF : utail + ((size_t)(pm - 1) * 2 + 1) * DFF;
        const float* p0 = uhead + ((size_t)pm * 2 + rr) * DFF; const float* pg = ghead + ((size_t)pm * 2 + rr) * DFF;
        unsigned o[4];
#pragma unroll
        for (int h = 0; h < 2; ++h) { const f32x4 x2 = *(const f32x4*)(p2 + f0 + 4 * h), x1 = *(const f32x4*)(p1 + f0 + 4 * h), x0 = *(const f32x4*)(p0 + f0 + 4 * h), g = *(const f32x4*)(pg + f0 + 4 * h);
            const f32x4 a = *(const f32x4*)(cw + f0 + 4 * h), b = *(const f32x4*)(cw + DFF + f0 + 4 * h), c = *(const f32x4*)(cw + 2 * DFF + f0 + 4 * h), d = *(const f32x4*)(cb + f0 + 4 * h);
            float r[4];
#pragma unroll
            for (int j = 0; j < 4; ++j) r[j] = pg8::gelu_gate(d[j] + a[j] * x2[j] + b[j] * x1[j] + c[j] * x0[j], g[j]);
            o[2 * h] = pg8::cvt_pk_bf16(r[0], r[1]); o[2 * h + 1] = pg8::cvt_pk_bf16(r[2], r[3]); }
        *(v4u*)(act + (size_t)(pm * 256 + rr) * DFF + f0) = (v4u){o[0], o[1], o[2], o[3]};
    }
}
#ifndef PROBE_SKIP_EPI
#define PROBE_SKIP_EPI 0
#endif
#ifndef KIND_MASK
#define KIND_MASK 7
#endif

__device__ __forceinline__ int queue_next(unsigned* head, volatile LAS unsigned* slot) {
    __syncthreads();
    if (threadIdx.x == 0) *slot = __hip_atomic_fetch_add(head, 1u, __ATOMIC_RELAXED, __HIP_MEMORY_SCOPE_AGENT);
    __syncthreads();
    return (int)*slot;
}
__device__ __forceinline__ void p4_phase(const Ctx& C0, const Args& A, int layer, volatile LAS unsigned* slot, int rep) { const Ctx C = ctx_local(C0);
    unsigned* qh = (unsigned*)(C.ws + WS_CTL) + CW_QUEUE + 64 * 3 * layer + 64 * 12 * rep;
    const bool k0 = rep == 0 || (KIND_MASK & 1), k1 = rep == 0 || (KIND_MASK & 2), k2 = rep == 0 || (KIND_MASK & 4);
    LAS char* lds = (LAS char*)(C.lds + RING_OFF);
    const bf16* fqkv = (const bf16*)(C.ws + WS_FQKV); const float* cL = (const float*)(C.ws + WS_CL);
    const bf16* qm = (const bf16*)(C.ws + WS_QM); const bf16* kvm = (const bf16*)(C.ws + WS_KVM); const bf16* kr = (const bf16*)(C.ws + WS_KR);
    const bf16* rq = (const bf16*)(C.ws + WS_RQ); const bf16* rk = (const bf16*)(C.ws + WS_RK); const bf16* rv = (const bf16*)(C.ws + WS_RV); const bf16* rg = (const bf16*)(C.ws + WS_RG);
    bf16* oa = (bf16*)(C.ws + WS_A); bf16* ob = (bf16*)(C.ws + WS_BM); bf16* oc = (bf16*)(C.ws + WS_C);
    if (k2) for (;;) { const int i = queue_next(qh + 128, slot); if (i >= 1024) break;
        const int qb = 31 - i / 32, bh = i % 32, b = bh >> 2, h = bh & 3; const size_t row0 = (size_t)b * SEQ + 128 * qb, seq0 = (size_t)b * SEQ;
        att::UnitPtrs U; U.Q = rq + row0 * 512 + 128 * h; U.ldq = 512; U.K = rk + seq0 * 512 + 128 * h; U.ldk = 512; U.V = rv + seq0 * 1024 + 256 * h; U.ldv = 1024; U.KR = nullptr; U.bias = nullptr;
        U.G = rg + row0 * 1024 + 256 * h; U.O = oc + row0 * 1024 + 256 * h; U.ldo = 1024; U.P0 = 128 * qb; U.T0 = 256 * (qb >> 1);
        U.ST = (qb >> 1) ? (const bf16*)(C.ws + WS_SST) + ((size_t)bh * 16 + (qb >> 1)) * 32768 : nullptr; U.c2 = __builtin_amdgcn_logf(1.0f - __builtin_amdgcn_exp2f(-5.0f - (float)h));
        att::mixer_unit<2>(U, lds); }
    if (k1) for (;;) { const int i = queue_next(qh + 64, slot); if (i >= 768) break;
        const int qb = 15 - i / 48, bh = i % 48, b = bh / 6, h = bh % 6; const size_t row0 = (size_t)b * SEQ + 256 * qb, seq0 = (size_t)b * SEQ;
        att::UnitPtrs U; U.Q = qm + row0 * 1152 + 192 * h; U.ldq = 1152; U.K = kvm + seq0 * 1536 + 256 * h; U.ldk = 1536; U.V = U.K + 128; U.ldv = 1536; U.KR = kr + seq0 * 64; U.bias = nullptr; U.G = nullptr; U.ST = nullptr; U.T0 = 0;
        U.O = ob + row0 * 1024 + 128 * h; U.ldo = 1024; U.P0 = 256 * qb; U.c2 = 0.07216878364870322f * 1.4426950408889634f;
        att::mixer_unit<1>(U, lds); }
    if (k0) for (;;) { const int i = queue_next(qh, slot); if (i >= 768) break;
        const int qb = 15 - i / 48, bh = i % 48, b = bh / 6, h = bh % 6; const size_t row0 = (size_t)b * SEQ + 256 * qb, seq0 = (size_t)b * SEQ;
        att::UnitPtrs U; U.Q = fqkv + row0 * 2304 + 128 * h; U.ldq = 2304; U.K = fqkv + seq0 * 2304 + 768 + 128 * h; U.ldk = 2304; U.V = U.K + 768; U.ldv = 2304; U.KR = nullptr; U.G = nullptr; U.ST = nullptr; U.T0 = 0;
        U.bias = cL + (size_t)bh * SEQ; U.O = oa + row0 * 1024 + 128 * h; U.ldo = 1024; U.P0 = 256 * qb; U.c2 = 0.08838834764831845f * 1.4426950408889634f;
        att::mixer_unit<0>(U, lds); }
}

__global__ void __launch_bounds__(NWAVES * 64, 2) hyb_fwd(Args args) {
    extern __shared__ __attribute__((aligned(16))) unsigned char lds_raw[];
    Ctx C;
    C.lds = (LAS unsigned char*)lds_raw;
    volatile LAS unsigned* MISC = (volatile LAS unsigned*)(C.lds + MISC_OFF);
    C.tid = 0; C.lane = 0; C.wave = __builtin_amdgcn_readfirstlane((int)threadIdx.x >> 6);
    C.G = gridDim.x; { const int bx = blockIdx.x; C.vcu = (C.G % 8 == 0) ? (bx % 8) * (C.G / 8) + bx / 8 : bx; }
    C.gw = C.vcu * NWAVES + C.wave; C.NGW = C.G * NWAVES; C.ws = arg_ws();
    unsigned* ctl = (unsigned*)(C.ws + WS_CTL);
    for (int u = threadIdx.x; u < (LDS_BYTES - LDSCTL_OFF) / 4; u += NWAVES * 64) ((LAS unsigned*)(C.lds + LDSCTL_OFF))[u] = 0u;
    __syncthreads();
#if MK_PER_PHASE
    XcdBarrier bar; bar.bar = ctl + CW_BAR; bar.x = 0; bar.st = nullptr; (void)bar;
#define GRID_BAR() do { } while (0)
#else
    XcdBarrier bar = xcd_barrier_post(ctl + CW_BAR, MISC + 8);
#define GRID_BAR() xcd_barrier(bar)
#endif
    const int lo = args.ph_lo, hi = args.ph_hi;
#define IN(k) (lo <= (k) && (k) < hi)
#ifndef PHASE_MASK
#define PHASE_MASK 0xFFFF
#endif
#define PHM(k) (((PHASE_MASK) >> (k)) & 1)
#ifndef SUB_MASK
#define SUB_MASK 0xFF
#endif
#define SUBM(k) (((SUB_MASK) >> (k)) & 1)
#ifndef REPEAT_MASK
#define REPEAT_MASK 0
#endif
#define REPS(k) (1 + (((REPEAT_MASK) >> (k)) & 1))

#define SEAM(k) do { if (IN(k) && IN((k) + 1)) GRID_BAR(); } while (0)
    PG8_LAS unsigned char* ring = (PG8_LAS unsigned char*)(C.lds + RING_OFF);
    const int bid = (int)blockIdx.x;
    if (PHM(0) && IN(0)) rope_tables(C, args);
    for (int layer = 0; layer < DEPTH; ++layer) {
        const int p = layer * PH;
        _Pragma("unroll") for (int rep = 0; rep < REPS(0); ++rep) if (PHM(0) && IN(p + 0)) { p0_phase(C, args, layer); if (rep + 1 < REPS(0)) GRID_BAR(); else SEAM(p + 0); }
        _Pragma("unroll") for (int rep = 0; rep < REPS(1); ++rep) if (PHM(1) && IN(p + 1)) { size_t wz_ = 0; asm volatile("" : "+s"(wz_)); unsigned char* wsl = arg_ws() + wz_; pg8::bf16_t* Wb = (pg8::bf16_t*)(wsl + WS_W); pg8::bf16_t* Hb = (pg8::bf16_t*)(wsl + WS_H);
            pg8::Gemm g{Hb, (const pg8::bf16_t*)((char*)Wb + WO_IN), M, NIN, DM}; pg8::StaticOrder S; S.init(M, NIN, C.G, bid);
            pg8::EpiInProj E{wsl, WS_FQKV, WS_CQ, WS_CKV, WS_KR, WS_RQ, WS_RK, WS_RV, WS_RG, WS_GATES, WS_FF, WS_T128, WS_T64, (rep + 1 < REPS(1)) ? PROBE_SKIP_EPI : 0};
            pg8::gemm_phase<pg8::EpiInProj, pg8::StaticOrder, true, true>(ring, g, S, E);
            { const int nfull = (M / 256) * (NIN / 256) % C.G; if (rep + 1 == REPS(1)) { if (nfull == 0) wconv_ffn(C, layer, bid, C.G); else if (bid >= nfull) wconv_ffn(C, layer, bid - nfull, C.G - nfull); } }
            if (rep + 1 < REPS(1)) GRID_BAR(); else SEAM(p + 1); }
        _Pragma("unroll") for (int rep = 0; rep < REPS(2); ++rep) if (PHM(2) && IN(p + 2)) { p2_phase(C, args, layer); if (rep + 1 < REPS(2)) GRID_BAR(); else SEAM(p + 2); }
        _Pragma("unroll") for (int rep = 0; rep < REPS(3); ++rep) if (PHM(3) && IN(p + 3)) { size_t wz_ = 0; asm volatile("" : "+s"(wz_)); unsigned char* wsl = arg_ws() + wz_; pg8::bf16_t* Wb = (pg8::bf16_t*)(wsl + WS_W); pg8::bf16_t* Hb = (pg8::bf16_t*)(wsl + WS_H);
            if (SUBM(0)) { pg8::Gemm g{(const pg8::bf16_t*)(wsl + WS_CQ), (const pg8::bf16_t*)((char*)Wb + WO_UQ), M, NUQ, 512}; pg8::StaticOrder S; S.init(M, NUQ, C.G, bid);
              pg8::EpiUq E{(pg8::bf16_t*)(wsl + WS_QM), (const float*)(wsl + WS_RSQ), (const float*)(wsl + WS_T64)};
              pg8::gemm_phase<pg8::EpiUq, pg8::StaticOrder, true, true>(ring, g, S, E); }
            if (SUBM(1)) { pg8::Gemm g{(const pg8::bf16_t*)(wsl + WS_CKV), (const pg8::bf16_t*)((char*)Wb + WO_UKV), M, NUKV, 256}; pg8::StaticOrder S; S.init(M, NUKV, C.G, bid);
              pg8::EpiUkv E{(pg8::bf16_t*)(wsl + WS_KVM), (const float*)(wsl + WS_RSKV)};
              pg8::gemm_phase<pg8::EpiUkv, pg8::StaticOrder, true, true>(ring, g, S, E); }
            ret_scan(C);
            if (rep + 1 < REPS(3)) GRID_BAR(); else SEAM(p + 3); }
        _Pragma("unroll") for (int rep = 0; rep < REPS(4); ++rep) if (PHM(4) && IN(p + 4)) { p4_phase(C, args, layer, MISC + 16, rep); if (rep + 1 < REPS(4)) GRID_BAR(); else SEAM(p + 4); }
        _Pragma("unroll") for (int rep = 0; rep < REPS(5); ++rep) if (PHM(5) && IN(p + 5)) { size_t wz_ = 0; asm volatile("" : "+s"(wz_)); unsigned char* wsl = arg_ws() + wz_; pg8::bf16_t* Wb = (pg8::bf16_t*)(wsl + WS_W); pg8::bf16_t* Hb = (pg8::bf16_t*)(wsl + WS_H);
            { static_assert(WS_BM - WS_A == WS_C - WS_BM && WO_BM - WO_BF == WO_BR - WO_BM, "equally spaced sub-GEMM operands");
              pg8::GemmM g{(const pg8::bf16_t*)(wsl + WS_A), (const pg8::bf16_t*)((char*)Wb + WO_BF), (WS_BM - WS_A) / 2, (WO_BM - WO_BF) / 2, 12, 4, 1024, 1024};
              pg8::StaticOrder3 S; S.init(M, DM, C.G, bid);
              pg8::EpiMergeM E{(const pg8::bf16_t*)(wsl + WS_GATES), Hb};
              pg8::gemm_phase_m<pg8::EpiMergeM, pg8::StaticOrder3, true, true>(ring, g, S, E); }
            if (rep + 1 < REPS(5)) GRID_BAR(); else SEAM(p + 5); }
        _Pragma("unroll") for (int rep = 0; rep < REPS(6); ++rep) if (PHM(6) && IN(p + 6)) { size_t wz_ = 0; asm volatile("" : "+s"(wz_)); unsigned char* wsl = arg_ws() + wz_; pg8::bf16_t* Wb = (pg8::bf16_t*)(wsl + WS_W); pg8::bf16_t* Hb = (pg8::bf16_t*)(wsl + WS_H);
            pg8::Gemm g{Hb, (const pg8::bf16_t*)((char*)Wb + WO_OUT), M, DM, DM}; pg8::StaticOrder S; S.init(M, DM, C.G, bid);
            pg8::EpiResid E{(pg8::bf16_t*)arg_out()}; pg8::gemm_phase<pg8::EpiResid, pg8::StaticOrder, true, true>(ring, g, S, E);
            if (rep + 1 < REPS(6)) GRID_BAR(); else SEAM(p + 6); }
        _Pragma("unroll") for (int rep = 0; rep < REPS(7); ++rep) if (PHM(7) && IN(p + 7)) { rows_rmsnorm_bf16(C, (const bf16*)arg_out(), arg_in(12) + (size_t)layer * DM, (bf16*)(C.ws + WS_H)); if (rep + 1 < REPS(7)) GRID_BAR(); else SEAM(p + 7); }
        _Pragma("unroll") for (int rep = 0; rep < REPS(8); ++rep) if (PHM(8) && IN(p + 8)) { size_t wz_ = 0; asm volatile("" : "+s"(wz_)); unsigned char* wsl = arg_ws() + wz_; pg8::bf16_t* Wb = (pg8::bf16_t*)(wsl + WS_W); pg8::bf16_t* Hb = (pg8::bf16_t*)(wsl + WS_H);
            pg8::Gemm g{Hb, (const pg8::bf16_t*)((char*)Wb + WO_UG), M, NUG, DM}; pg8::StaticOrder S; S.init(M, NUG, C.G, bid);
            pg8::EpiConvAct E{(pg8::bf16_t*)(wsl + WS_ACT), (float*)(wsl + WS_UTAIL), (float*)(wsl + WS_UHEAD), (float*)(wsl + WS_GHEAD), arg_in(15) + (size_t)layer * 3 * DFF, arg_in(16) + (size_t)layer * DFF, (PG8_LAS float*)(C.lds + LDSCTL_OFF + 1024)};
            pg8::gemm_phase<pg8::EpiConvAct, pg8::StaticOrder, true, true>(ring, g, S, E);
            if (rep + 1 < REPS(8)) GRID_BAR(); else SEAM(p + 8); }
        _Pragma("unroll") for (int rep = 0; rep < REPS(9); ++rep) if (PHM(9) && IN(p + 9)) { p9_phase(C, args, layer); if (rep + 1 < REPS(9)) GRID_BAR(); else SEAM(p + 9); }
        _Pragma("unroll") for (int rep = 0; rep < REPS(10); ++rep) if (PHM(10) && IN(p + 10)) { size_t wz_ = 0; asm volatile("" : "+s"(wz_)); unsigned char* wsl = arg_ws() + wz_; pg8::bf16_t* Wb = (pg8::bf16_t*)(wsl + WS_W); pg8::bf16_t* Hb = (pg8::bf16_t*)(wsl + WS_H);
            pg8::Gemm g{(const pg8::bf16_t*)(wsl + WS_ACT), (const pg8::bf16_t*)((char*)Wb + WO_DN), M, DM, DFF}; pg8::StaticOrder S; S.init(M, DM, C.G, bid);
            pg8::EpiResid E{(pg8::bf16_t*)arg_out()}; pg8::gemm_phase<pg8::EpiResid, pg8::StaticOrder, true, true>(ring, g, S, E);
            if (rep + 1 < REPS(10)) GRID_BAR(); else SEAM(p + 10); }
    }
    if (IN(DEPTH * PH)) rows_rmsnorm_final(C, arg_out(), arg_in(18));
#if defined(PROBE_EXTRA_BARRIERS) && !MK_PER_PHASE
    for (int i = 0; i < PROBE_EXTRA_BARRIERS; ++i) GRID_BAR();
#endif
#undef IN
#undef SEAM
#undef GRID_BAR
}

extern "C" void kernel_launch(void* const* d_in, const int* in_sizes, int n_in, void* d_out, int out_size, void* d_ws, size_t ws_size, hipStream_t stream) {
    static int grid = 0;
    if (grid == 0) {
        if (n_in != 19 || out_size != M * DM || ws_size < WS_END) { fprintf(stderr, "kernel_launch: unexpected problem (n_in %d, out %d, ws %zu < %zu); nothing launched\n", n_in, out_size, ws_size, (size_t)WS_END); grid = -1; return; }
        int dev = 0, cus = 0, per_cu = 0;
        if (hipGetDevice(&dev) != hipSuccess || hipDeviceGetAttribute(&cus, hipDeviceAttributeMultiprocessorCount, dev) != hipSuccess) { grid = -1; return; }
        if (hipFuncSetAttribute((const void*)hyb_fwd, hipFuncAttributeMaxDynamicSharedMemorySize, LDS_BYTES) != hipSuccess) { fprintf(stderr, "kernel_launch: hipFuncSetAttribute failed\n"); grid = -1; return; }
        if (hipOccupancyMaxActiveBlocksPerMultiprocessor(&per_cu, (const void*)hyb_fwd, NWAVES * 64, LDS_BYTES) != hipSuccess || per_cu < 1) { fprintf(stderr, "kernel_launch: occupancy query says %d\n", per_cu); }
        (void)hipGetLastError();
        grid = cus;
    }
    if (grid < 0) return;
    (void)in_sizes;
    if (hipMemsetAsync((char*)d_ws + WS_CTL, 0, CTL_ZERO_BYTES, stream) != hipSuccess) return;
    Args a; memset(&a, 0, sizeof(a));
    for (int i = 0; i < 19; ++i) a.in[i] = (const float*)d_in[i];
    a.out = (float*)d_out; a.ws = (unsigned char*)d_ws;
    for (int i = 0; i < 64; ++i) a.invf128[i] = (float)pow(10000.0, -(double)(2 * i) / 128.0);
    for (int i = 0; i < 32; ++i) a.invf64[i] = (float)pow(10000.0, -(double)(2 * i) / 64.0);
#if MK_PER_PHASE
    for (int ph = 0; ph < NPHASE; ++ph) { a.ph_lo = ph; a.ph_hi = ph + 1; hipLaunchKernelGGL(hyb_fwd, dim3(grid), dim3(NWAVES * 64), LDS_BYTES, stream, a); }
#else
    a.ph_lo = 0; a.ph_hi = NPHASE; hipLaunchKernelGGL(hyb_fwd, dim3(grid), dim3(NWAVES * 64), LDS_BYTES, stream, a);
#endif
    const hipError_t le = hipPeekAtLastError();
    if (le != hipSuccess) fprintf(stderr, "kernel_launch: launch failed: %s\n", hipGetErrorName(le));
}
```

```cpp
#include <hip/hip_runtime.h>
#include <cstdio>
#include <cstdint>
#include <cmath>
#ifndef MK_PER_PHASE
#define MK_PER_PHASE 0
#endif
#include <cstring>
namespace pg8 {
#define PG8_LAS __attribute__((address_space(3)))
typedef unsigned short bf16_t;
typedef short bf16x8 __attribute__((ext_vector_type(8)));
typedef float f32x4 __attribute__((ext_vector_type(4)));
typedef unsigned u32x4 __attribute__((ext_vector_type(4)));
constexpr int BM = 256, BK = 64, HALF = 128, HTB = HALF * BK * 2  , STAGE_BYTES = 8 * HTB, NXCD = 8, WGM = 8;

__host__ __device__ __forceinline__ int lds_byte(int r, int c) { const int st = (r >> 4) * 2 + (c >> 5), rr = r & 15, cc = c & 31, ob = rr * 64 + cc * 2; return st * 1024 + (ob ^ (((ob >> 9) & 1) << 5)); }
__host__ __device__ __forceinline__ void stage_rc(int b, int& R, int& C) { const int st = b / 1024, sb = b % 1024, swz = sb ^ (((sb >> 9) & 1) << 5); R = (st >> 1) * 16 + swz / 64; C = (st & 1) * 32 + (swz % 64) / 2; }
__host__ __device__ __forceinline__ int perm32(int rho) { const int n = rho >> 4, i = rho & 15; return 8 * (i >> 2) + 4 * n + (i & 3); }

struct Unit { int pm, pn; };
struct Gemm { const bf16_t* A; const bf16_t* Bt; int M, N, K; };

struct StaticOrder {
    int nM, nN, nwg, G, c;
    __host__ __device__ void init(int M, int N, int G_, int c_) { nM = M / BM; nN = N / BM; nwg = nM * nN; G = G_; c = c_; }
    __host__ __device__ bool next(int i, Unit& u) const {
        const long L = (long)i * G + c; if (L >= nwg) return false;
        int wgid = (int)L; { const int q = nwg / NXCD, r = nwg % NXCD, xcd = wgid % NXCD, off = wgid / NXCD; wgid = (xcd < r ? xcd * (q + 1) : r * (q + 1) + (xcd - r) * q) + off; }
        const int nig = WGM * nN, gid = wgid / nig, fm = gid * WGM, gsz = (nM - fm) < WGM ? (nM - fm) : WGM;
        u.pm = fm + ((wgid % nig) % gsz); u.pn = (wgid % nig) / gsz; return true;
    }
    __device__ __forceinline__ void a_ready(const Unit&) const {}
    __device__ __forceinline__ void done(const Unit&) const {}
};

template <class Epi, class Sched, bool ALIGN_EPI = false, bool SP2 = false>
__device__ __forceinline__ void gemm_phase(PG8_LAS unsigned char* lds, const Gemm g, const Sched& S, const Epi& E) {
    int tid_ = threadIdx.x; asm volatile("" : "+v"(tid_));
    const int tid = tid_, wid = __builtin_amdgcn_readfirstlane(tid >> 6), lane = tid & 63, wr = wid >> 2, wc = wid & 3, fr = lane & 15, fq = lane >> 4;
    int K_ = g.K; asm volatile("" : "+s"(K_)); const int K = K_, nt = K / BK;
    unsigned voffA[2], voffB[2];
#pragma unroll
    for (int i = 0; i < 2; ++i) { int R, C; stage_rc(tid * 16 + i * 8192, R, C); const int Rb = Epi::PERM ? ((R & ~31) + perm32(R & 31)) : R;
        voffA[i] = (unsigned)(R * K + C) * 2u; voffB[i] = (unsigned)(Rb * K + C) * 2u; }
    const size_t kstep = (size_t)(BK * 2);
    const size_t hstep = (size_t)HALF * K * 2;
    const size_t tstep = 2 * hstep;
    const unsigned ldsw = (unsigned)wid * 1024u;
    const int aoff = lds_byte(wr * 64 + fr, fq * 8), boff = lds_byte(wc * 32 + fr, fq * 8);
#define PG8_SA(b, h) (((b) * 2 + (h)) * HTB)
#define PG8_SB(b, h) ((4 + (b) * 2 + (h)) * HTB)
#define PG8_STAGE(bufoff, gbase, voff) do { _Pragma("unroll") for (int _i = 0; _i < 2; ++_i) \
        __builtin_amdgcn_global_load_lds((const unsigned*)((const char*)(gbase) + (voff)[_i]), (PG8_LAS unsigned*)(lds + (bufoff) + ldsw + _i * 8192), 16, 0, 0); } while (0)
#define PG8_LDA(dst, b, h) do { _Pragma("unroll") for (int m = 0; m < 4; ++m) _Pragma("unroll") for (int k = 0; k < 2; ++k) dst[m][k] = *(const PG8_LAS bf16x8*)(lds + PG8_SA(b, h) + aoff + m * 2048 + k * 1024); } while (0)
#define PG8_LDB(dst, b, h) do { _Pragma("unroll") for (int n = 0; n < 2; ++n) _Pragma("unroll") for (int k = 0; k < 2; ++k) dst[n][k] = *(const PG8_LAS bf16x8*)(lds + PG8_SB(b, h) + boff + n * 2048 + k * 1024); } while (0)
#define PG8_MMA(ai, bj, At, Bt) do { __builtin_amdgcn_s_setprio(1); _Pragma("unroll") for (int m = 0; m < 4; ++m) _Pragma("unroll") for (int n = 0; n < 2; ++n) _Pragma("unroll") for (int k = 0; k < 2; ++k) \
        acc[ai][bj][m][n] = __builtin_amdgcn_mfma_f32_16x16x32_bf16(Bt[n][k], At[m][k], acc[ai][bj][m][n], 0, 0, 0); __builtin_amdgcn_s_setprio(0); } while (0)
#define PG8_WAIT_V(n) asm volatile("s_waitcnt vmcnt(" #n ")" ::: "memory")
#define PG8_WAIT_L(n) asm volatile("s_waitcnt lgkmcnt(" #n ")" ::: "memory")
#define PG8_BAR __builtin_amdgcn_s_barrier()
#define PG8_SCHED __builtin_amdgcn_sched_barrier(0)
    Unit cur, nxt; int ui = 0;
    if (!S.next(0, cur)) return;
    f32x4 acc[2][2][4][2];
#pragma unroll
    for (int a = 0; a < 2; ++a)
#pragma unroll
        for (int b = 0; b < 2; ++b)
#pragma unroll
            for (int m = 0; m < 4; ++m)
#pragma unroll
                for (int n = 0; n < 2; ++n) acc[a][b][m][n] = (f32x4){0.f, 0.f, 0.f, 0.f};
    bf16x8 At[4][2], B0[2][2], B1[2][2];
    const char* cA = (const char*)g.A + (size_t)cur.pm * tstep; const char* cB = (const char*)g.Bt + (size_t)cur.pn * tstep;
    S.a_ready(cur);
    if constexpr (SP2) {
        PG8_STAGE(PG8_SB(0, 0), cB, voffB); PG8_STAGE(PG8_SB(0, 1), cB + hstep, voffB); PG8_STAGE(PG8_SA(0, 0), cA, voffA); PG8_STAGE(PG8_SA(0, 1), cA + hstep, voffA);
        if (wr == 1) PG8_BAR;
        PG8_WAIT_V(2); PG8_BAR;
        PG8_STAGE(PG8_SB(1, 0), cB + kstep, voffB); PG8_STAGE(PG8_SA(1, 0), cA + kstep, voffA); PG8_STAGE(PG8_SB(1, 1), cB + hstep + kstep, voffB);
        PG8_WAIT_V(6); PG8_BAR;
    } else {
        PG8_STAGE(PG8_SB(0, 0), cB, voffB); PG8_STAGE(PG8_SA(0, 0), cA, voffA); PG8_STAGE(PG8_SB(0, 1), cB + hstep, voffB); PG8_STAGE(PG8_SA(0, 1), cA + hstep, voffA);
        if (wr == 1) PG8_BAR;
        PG8_WAIT_V(4); PG8_BAR;
        PG8_STAGE(PG8_SB(1, 0), cB + kstep, voffB); PG8_STAGE(PG8_SA(1, 0), cA + kstep, voffA); PG8_STAGE(PG8_SB(1, 1), cB + hstep + kstep, voffB);
        PG8_WAIT_V(6); PG8_BAR;
    }
    for (;;) {
        const bool has_next = S.next(ui + 1, nxt);
        const char* nA = has_next ? (const char*)g.A + (size_t)nxt.pm * tstep : cA; const char* nB = has_next ? (const char*)g.Bt + (size_t)nxt.pn * tstep : cB;
        for (int t = 0; t < nt; t += 2) {
            const bool last = (t == nt - 2);
            const char* a1 = cA + (size_t)(t + 1) * kstep;
            const char* a2 = last ? nA : cA + (size_t)(t + 2) * kstep; const char* b2 = last ? nB : cB + (size_t)(t + 2) * kstep;
            const char* a3 = a2 + kstep; const char* b3 = b2 + kstep;
            if (last && has_next) S.a_ready(nxt);
            if constexpr (SP2) {
            PG8_LDB(B0, 0, 0); PG8_LDB(B1, 0, 1); PG8_SCHED; PG8_LDA(At, 0, 0); PG8_STAGE(PG8_SA(1, 1), a1 + hstep, voffA);
            PG8_WAIT_V(8); PG8_WAIT_L(0); PG8_BAR; PG8_MMA(0, 0, At, B0); PG8_MMA(0, 1, At, B1); PG8_BAR; PG8_SCHED;
            PG8_LDA(At, 0, 1); PG8_STAGE(PG8_SB(0, 0), b2, voffB); PG8_STAGE(PG8_SB(0, 1), b2 + hstep, voffB); PG8_STAGE(PG8_SA(0, 0), a2, voffA);
            PG8_WAIT_V(8); PG8_WAIT_L(0); PG8_BAR; PG8_MMA(1, 0, At, B0); PG8_MMA(1, 1, At, B1); PG8_BAR; PG8_SCHED;
            PG8_LDB(B0, 1, 0); PG8_LDB(B1, 1, 1); PG8_SCHED; PG8_LDA(At, 1, 0); PG8_STAGE(PG8_SA(0, 1), a2 + hstep, voffA);
            PG8_WAIT_V(8); PG8_WAIT_L(0); PG8_BAR; PG8_MMA(0, 0, At, B0); PG8_MMA(0, 1, At, B1); PG8_BAR; PG8_SCHED;
            PG8_LDA(At, 1, 1); PG8_STAGE(PG8_SB(1, 0), b3, voffB); PG8_STAGE(PG8_SB(1, 1), b3 + hstep, voffB); PG8_STAGE(PG8_SA(1, 0), a3, voffA);
            PG8_WAIT_V(8); PG8_WAIT_L(0); PG8_BAR; PG8_MMA(1, 0, At, B0); PG8_MMA(1, 1, At, B1); PG8_BAR; PG8_SCHED;
            } else {
            PG8_LDB(B0, 0, 0); PG8_SCHED; PG8_LDA(At, 0, 0); PG8_STAGE(PG8_SA(1, 1), a1 + hstep, voffA);
            PG8_WAIT_L(8); PG8_BAR; PG8_WAIT_L(0); PG8_MMA(0, 0, At, B0); PG8_BAR; PG8_SCHED;
            PG8_LDB(B1, 0, 1); PG8_STAGE(PG8_SB(0, 0), b2, voffB);
            PG8_BAR; PG8_WAIT_L(0); PG8_MMA(0, 1, At, B1); PG8_BAR;
            PG8_LDA(At, 0, 1); PG8_STAGE(PG8_SA(0, 0), a2, voffA);
            PG8_BAR; PG8_WAIT_L(0); PG8_MMA(1, 0, At, B0); PG8_BAR; PG8_SCHED;
            PG8_STAGE(PG8_SB(0, 1), b2 + hstep, voffB);
            PG8_WAIT_V(6); PG8_BAR; PG8_MMA(1, 1, At, B1); PG8_BAR;
            PG8_LDB(B0, 1, 0); PG8_SCHED; PG8_LDA(At, 1, 0); PG8_STAGE(PG8_SA(0, 1), a2 + hstep, voffA);
            PG8_WAIT_L(8); PG8_BAR; PG8_WAIT_L(0); PG8_MMA(0, 0, At, B0); PG8_BAR; PG8_SCHED;
            PG8_LDB(B1, 1, 1); PG8_STAGE(PG8_SB(1, 0), b3, voffB);
            PG8_BAR; PG8_WAIT_L(0); PG8_MMA(0, 1, At, B1); PG8_BAR;
            PG8_LDA(At, 1, 1); PG8_STAGE(PG8_SA(1, 0), a3, voffA);
            PG8_BAR; PG8_WAIT_L(0); PG8_MMA(1, 0, At, B0); PG8_BAR; PG8_SCHED;
            PG8_STAGE(PG8_SB(1, 1), b3 + hstep, voffB);
            PG8_WAIT_V(6); PG8_BAR; PG8_MMA(1, 1, At, B1); PG8_BAR;
            }
        }
        if constexpr (ALIGN_EPI) { if (wr == 0) PG8_BAR; }
        if constexpr (!Epi::AFTER_DRAIN) { E(acc, cur, wr, wc, fr, fq); S.done(cur); }
        if (!has_next) break;
#pragma unroll
        for (int a = 0; a < 2; ++a)
#pragma unroll
            for (int b = 0; b < 2; ++b)
#pragma unroll
                for (int m = 0; m < 4; ++m)
#pragma unroll
                    for (int n = 0; n < 2; ++n) acc[a][b][m][n] = (f32x4){0.f, 0.f, 0.f, 0.f};
        cur = nxt; cA = nA; cB = nB; ++ui;
        if constexpr (ALIGN_EPI) { if (wr == 1) PG8_BAR; }
    }
    PG8_WAIT_V(0);
    if constexpr (!ALIGN_EPI) { if (wr == 0) PG8_BAR; }
    PG8_BAR;
    if constexpr (Epi::AFTER_DRAIN) { E.fused(acc, cur, wr, wc, fr, fq, lds, wid, lane); S.done(cur); }
#undef PG8_SA
#undef PG8_SB
#undef PG8_STAGE
#undef PG8_LDA
#undef PG8_LDB
#undef PG8_MMA
#undef PG8_WAIT_V
#undef PG8_WAIT_L
#undef PG8_BAR
#undef PG8_SCHED
}

struct UnitM { int pm, pn, sub; };
struct GemmM { const bf16_t* A0; const bf16_t* B0; size_t strideA, strideB; int nt0, dnt2; int lda, ldb;
    __device__ __forceinline__ const bf16_t* a(int s) const { return A0 + (size_t)s * strideA; }
    __device__ __forceinline__ const bf16_t* b(int s) const { return B0 + (size_t)s * strideB; }
    __device__ __forceinline__ int nt(int s) const { return nt0 + (s >> 1) * dnt2; } };
struct StaticOrder3 {
    StaticOrder S;
    __device__ void init(int M, int N, int G_, int c_) { S.init(M, N, G_, c_); }
    __device__ bool next(int i, UnitM& u) const { Unit t; if (!S.next(i / 3, t)) return false; u.pm = t.pm; u.pn = t.pn; u.sub = i - 3 * (i / 3); return true; }
    __device__ __forceinline__ void a_ready(const UnitM&) const {}
    __device__ __forceinline__ void done(const UnitM&) const {}
};
template <class Epi, class Sched, bool ALIGN_EPI = false, bool SP2 = false>
__device__ __forceinline__ void gemm_phase_m(PG8_LAS unsigned char* lds, const GemmM g, const Sched& S, const Epi& E) {
    int tid_ = threadIdx.x; asm volatile("" : "+v"(tid_));
    const int tid = tid_, wid = __builtin_amdgcn_readfirstlane(tid >> 6), lane = tid & 63, wr = wid >> 2, wc = wid & 3, fr = lane & 15, fq = lane >> 4;
    int lda_ = g.lda, ldb_ = g.ldb; asm volatile("" : "+s"(lda_), "+s"(ldb_)); const int lda = lda_, ldb = ldb_; int nt;
    unsigned voffA[2], voffB[2];
#pragma unroll
    for (int i = 0; i < 2; ++i) { int R, C; stage_rc(tid * 16 + i * 8192, R, C); const int Rb = Epi::PERM ? ((R & ~31) + perm32(R & 31)) : R;
        voffA[i] = (unsigned)(R * lda + C) * 2u; voffB[i] = (unsigned)(Rb * ldb + C) * 2u; }
    const size_t kstep = (size_t)(BK * 2);
    const size_t hstepA = (size_t)HALF * lda * 2, hstepB = (size_t)HALF * ldb * 2;
    const size_t tstepA = 2 * hstepA, tstepB = 2 * hstepB;
    const unsigned ldsw = (unsigned)wid * 1024u;
    const int aoff = lds_byte(wr * 64 + fr, fq * 8), boff = lds_byte(wc * 32 + fr, fq * 8);
#define PG8_SA(b, h) (((b) * 2 + (h)) * HTB)
#define PG8_SB(b, h) ((4 + (b) * 2 + (h)) * HTB)
#define PG8_STAGE(bufoff, gbase, voff) do { _Pragma("unroll") for (int _i = 0; _i < 2; ++_i) \
        __builtin_amdgcn_global_load_lds((const unsigned*)((const char*)(gbase) + (voff)[_i]), (PG8_LAS unsigned*)(lds + (bufoff) + ldsw + _i * 8192), 16, 0, 0); } while (0)
#define PG8_LDA(dst, b, h) do { _Pragma("unroll") for (int m = 0; m < 4; ++m) _Pragma("unroll") for (int k = 0; k < 2; ++k) dst[m][k] = *(const PG8_LAS bf16x8*)(lds + PG8_SA(b, h) + aoff + m * 2048 + k * 1024); } while (0)
#define PG8_LDB(dst, b, h) do { _Pragma("unroll") for (int n = 0; n < 2; ++n) _Pragma("unroll") for (int k = 0; k < 2; ++k) dst[n][k] = *(const PG8_LAS bf16x8*)(lds + PG8_SB(b, h) + boff + n * 2048 + k * 1024); } while (0)
#define PG8_MMA(ai, bj, At, Bt) do { __builtin_amdgcn_s_setprio(1); _Pragma("unroll") for (int m = 0; m < 4; ++m) _Pragma("unroll") for (int n = 0; n < 2; ++n) _Pragma("unroll") for (int k = 0; k < 2; ++k) \
        acc[ai][bj][m][n] = __builtin_amdgcn_mfma_f32_16x16x32_bf16(Bt[n][k], At[m][k], acc[ai][bj][m][n], 0, 0, 0); __builtin_amdgcn_s_setprio(0); } while (0)
#define PG8_WAIT_V(n) asm volatile("s_waitcnt vmcnt(" #n ")" ::: "memory")
#define PG8_WAIT_L(n) asm volatile("s_waitcnt lgkmcnt(" #n ")" ::: "memory")
#define PG8_BAR __builtin_amdgcn_s_barrier()
#define PG8_SCHED __builtin_amdgcn_sched_barrier(0)
    UnitM cur, nxt; int ui = 0;
    if (!S.next(0, cur)) return;
    f32x4 acc[2][2][4][2];
#pragma unroll
    for (int a = 0; a < 2; ++a)
#pragma unroll
        for (int b = 0; b < 2; ++b)
#pragma unroll
            for (int m = 0; m < 4; ++m)
#pragma unroll
                for (int n = 0; n < 2; ++n) acc[a][b][m][n] = (f32x4){0.f, 0.f, 0.f, 0.f};
    bf16x8 At[4][2], B0[2][2], B1[2][2];
    const char* cA = (const char*)g.a(cur.sub) + (size_t)cur.pm * tstepA; const char* cB = (const char*)g.b(cur.sub) + (size_t)cur.pn * tstepB; nt = g.nt(cur.sub);
    S.a_ready(cur);
    if constexpr (SP2) {
        PG8_STAGE(PG8_SB(0, 0), cB, voffB); PG8_STAGE(PG8_SB(0, 1), cB + hstepB, voffB); PG8_STAGE(PG8_SA(0, 0), cA, voffA); PG8_STAGE(PG8_SA(0, 1), cA + hstepA, voffA);
        if (wr == 1) PG8_BAR;
        PG8_WAIT_V(2); PG8_BAR;
        PG8_STAGE(PG8_SB(1, 0), cB + kstep, voffB); PG8_STAGE(PG8_SA(1, 0), cA + kstep, voffA); PG8_STAGE(PG8_SB(1, 1), cB + hstepB + kstep, voffB);
        PG8_WAIT_V(6); PG8_BAR;
    } else {
        PG8_STAGE(PG8_SB(0, 0), cB, voffB); PG8_STAGE(PG8_SA(0, 0), cA, voffA); PG8_STAGE(PG8_SB(0, 1), cB + hstepB, voffB); PG8_STAGE(PG8_SA(0, 1), cA + hstepA, voffA);
        if (wr == 1) PG8_BAR;
        PG8_WAIT_V(4); PG8_BAR;
        PG8_STAGE(PG8_SB(1, 0), cB + kstep, voffB); PG8_STAGE(PG8_SA(1, 0), cA + kstep, voffA); PG8_STAGE(PG8_SB(1, 1), cB + hstepB + kstep, voffB);
        PG8_WAIT_V(6); PG8_BAR;
    }
    for (;;) {
        const bool has_next = S.next(ui + 1, nxt);
        const char* nA = has_next ? (const char*)g.a(nxt.sub) + (size_t)nxt.pm * tstepA : cA; const char* nB = has_next ? (const char*)g.b(nxt.sub) + (size_t)nxt.pn * tstepB : cB;
        for (int t = 0; t < nt; t += 2) {
            const bool last = (t == nt - 2);
            const char* a1 = cA + (size_t)(t + 1) * kstep;
            const char* a2 = last ? nA : cA + (size_t)(t + 2) * kstep; const char* b2 = last ? nB : cB + (size_t)(t + 2) * kstep;
            const char* a3 = a2 + kstep; const char* b3 = b2 + kstep;
            if (last && has_next) S.a_ready(nxt);
            if constexpr (SP2) {
            PG8_LDB(B0, 0, 0); PG8_LDB(B1, 0, 1); PG8_SCHED; PG8_LDA(At, 0, 0); PG8_STAGE(PG8_SA(1, 1), a1 + hstepA, voffA);
            PG8_WAIT_V(8); PG8_WAIT_L(0); PG8_BAR; PG8_MMA(0, 0, At, B0); PG8_MMA(0, 1, At, B1); PG8_BAR; PG8_SCHED;
            PG8_LDA(At, 0, 1); PG8_STAGE(PG8_SB(0, 0), b2, voffB); PG8_STAGE(PG8_SB(0, 1), b2 + hstepB, voffB); PG8_STAGE(PG8_SA(0, 0), a2, voffA);
            PG8_WAIT_V(8); PG8_WAIT_L(0); PG8_BAR; PG8_MMA(1, 0, At, B0); PG8_MMA(1, 1, At, B1); PG8_BAR; PG8_SCHED;
            PG8_LDB(B0, 1, 0); PG8_LDB(B1, 1, 1); PG8_SCHED; PG8_LDA(At, 1, 0); PG8_STAGE(PG8_SA(0, 1), a2 + hstepA, voffA);
            PG8_WAIT_V(8); PG8_WAIT_L(0); PG8_BAR; PG8_MMA(0, 0, At, B0); PG8_MMA(0, 1, At, B1); PG8_BAR; PG8_SCHED;
            PG8_LDA(At, 1, 1); PG8_STAGE(PG8_SB(1, 0), b3, voffB); PG8_STAGE(PG8_SB(1, 1), b3 + hstepB, voffB); PG8_STAGE(PG8_SA(1, 0), a3, voffA);
            PG8_WAIT_V(8); PG8_WAIT_L(0); PG8_BAR; PG8_MMA(1, 0, At, B0); PG8_MMA(1, 1, At, B1); PG8_BAR; PG8_SCHED;
            } else {
            PG8_LDB(B0, 0, 0); PG8_SCHED; PG8_LDA(At, 0, 0); PG8_STAGE(PG8_SA(1, 1), a1 + hstepA, voffA);
            PG8_WAIT_L(8); PG8_BAR; PG8_WAIT_L(0); PG8_MMA(0, 0, At, B0); PG8_BAR; PG8_SCHED;
            PG8_LDB(B1, 0, 1); PG8_STAGE(PG8_SB(0, 0), b2, voffB);
            PG8_BAR; PG8_WAIT_L(0); PG8_MMA(0, 1, At, B1); PG8_BAR;
            PG8_LDA(At, 0, 1); PG8_STAGE(PG8_SA(0, 0), a2, voffA);
            PG8_BAR; PG8_WAIT_L(0); PG8_MMA(1, 0, At, B0); PG8_BAR; PG8_SCHED;
            PG8_STAGE(PG8_SB(0, 1), b2 + hstepB, voffB);
            PG8_WAIT_V(6); PG8_BAR; PG8_MMA(1, 1, At, B1); PG8_BAR;
            PG8_LDB(B0, 1, 0); PG8_SCHED; PG8_LDA(At, 1, 0); PG8_STAGE(PG8_SA(0, 1), a2 + hstepA, voffA);
            PG8_WAIT_L(8); PG8_BAR; PG8_WAIT_L(0); PG8_MMA(0, 0, At, B0); PG8_BAR; PG8_SCHED;
            PG8_LDB(B1, 1, 1); PG8_STAGE(PG8_SB(1, 0), b3, voffB);
            PG8_BAR; PG8_WAIT_L(0); PG8_MMA(0, 1, At, B1); PG8_BAR;
            PG8_LDA(At, 1, 1); PG8_STAGE(PG8_SA(1, 0), a3, voffA);
            PG8_BAR; PG8_WAIT_L(0); PG8_MMA(1, 0, At, B0); PG8_BAR; PG8_SCHED;
            PG8_STAGE(PG8_SB(1, 1), b3 + hstepB, voffB);
            PG8_WAIT_V(6); PG8_BAR; PG8_MMA(1, 1, At, B1); PG8_BAR;
            }
        }
        if constexpr (ALIGN_EPI) { if (wr == 0) PG8_BAR; }
        if constexpr (!Epi::AFTER_DRAIN) { E(acc, cur, wr, wc, fr, fq); S.done(cur); }
        if (!has_next) break;
        if (nxt.sub == 0) {
#pragma unroll
        for (int a = 0; a < 2; ++a)
#pragma unroll
            for (int b = 0; b < 2; ++b)
#pragma unroll
                for (int m = 0; m < 4; ++m)
#pragma unroll
                    for (int n = 0; n < 2; ++n) acc[a][b][m][n] = (f32x4){0.f, 0.f, 0.f, 0.f}; }
        cur = nxt; cA = nA; cB = nB; ++ui; nt = g.nt(cur.sub);
        if constexpr (ALIGN_EPI) { if (wr == 1) PG8_BAR; }
    }
    PG8_WAIT_V(0);
    if constexpr (!ALIGN_EPI) { if (wr == 0) PG8_BAR; }
    PG8_BAR;
    if constexpr (Epi::AFTER_DRAIN) { E.fused(acc, cur, wr, wc, fr, fq, lds, wid, lane); S.done(cur); }
#undef PG8_SA
#undef PG8_SB
#undef PG8_STAGE
#undef PG8_LDA
#undef PG8_LDB
#undef PG8_MMA
#undef PG8_WAIT_V
#undef PG8_WAIT_L
#undef PG8_BAR
#undef PG8_SCHED
}
}

namespace pg8 {
typedef float f32x2 __attribute__((ext_vector_type(2)));
__device__ __forceinline__ unsigned cvt_pk_bf16(float lo, float hi) { unsigned r; asm volatile("v_cvt_pk_bf16_f32 %0, %1, %2" : "=v"(r) : "v"(lo), "v"(hi)); return r; }
__device__ __forceinline__ void store8(bf16_t* p, const f32x4 v0, const f32x4 v1) {
    u32x4 w; w.x = cvt_pk_bf16(v0[0], v0[1]); w.y = cvt_pk_bf16(v0[2], v0[3]); w.z = cvt_pk_bf16(v1[0], v1[1]); w.w = cvt_pk_bf16(v1[2], v1[3]); *(u32x4*)p = w; }
__device__ __forceinline__ float fsigmoid(float x) { return __builtin_amdgcn_rcpf(1.0f + __builtin_amdgcn_exp2f(-1.4426950408889634f * x)); }
__device__ __forceinline__ f32x4 act4(const f32x4 v, const int ACT) {
    if (ACT == 0) return v;
    f32x4 o;
#pragma unroll
    for (int j = 0; j < 4; ++j) { const float s = fsigmoid(v[j]); o[j] = (ACT == 1) ? v[j] * s : s; }
    return o; }
__device__ __forceinline__ void bf8_to_f32(const u32x4 w, f32x4& a, f32x4& b) {
    a[0] = __uint_as_float(w.x << 16); a[1] = __uint_as_float(w.x & 0xffff0000u); a[2] = __uint_as_float(w.y << 16); a[3] = __uint_as_float(w.y & 0xffff0000u);
    b[0] = __uint_as_float(w.z << 16); b[1] = __uint_as_float(w.z & 0xffff0000u); b[2] = __uint_as_float(w.w << 16); b[3] = __uint_as_float(w.w & 0xffff0000u); }

constexpr int SEQ_MASK = 4095;
__device__ __forceinline__ void rope4(const float* tab, const f32x4 a, const f32x4 b, float sc, bf16_t* p1, bf16_t* p2) {
    typedef unsigned u32x2 __attribute__((ext_vector_type(2)));
    const f32x4 t0 = *(const f32x4*)(tab), t1 = *(const f32x4*)(tab + 4);
    const float o10 = (a[0] * t0[0] - b[0] * t0[1]) * sc, o20 = (b[0] * t0[0] + a[0] * t0[1]) * sc;
    const float o11 = (a[1] * t0[2] - b[1] * t0[3]) * sc, o21 = (b[1] * t0[2] + a[1] * t0[3]) * sc;
    const float o12 = (a[2] * t1[0] - b[2] * t1[1]) * sc, o22 = (b[2] * t1[0] + a[2] * t1[1]) * sc;
    const float o13 = (a[3] * t1[2] - b[3] * t1[3]) * sc, o23 = (b[3] * t1[2] + a[3] * t1[3]) * sc;
    u32x2 w1, w2; w1.x = cvt_pk_bf16(o10, o11); w1.y = cvt_pk_bf16(o12, o13); w2.x = cvt_pk_bf16(o20, o21); w2.y = cvt_pk_bf16(o22, o23);
    *(u32x2*)p1 = w1; *(u32x2*)p2 = w2;
}
#define EPI_FENCE() asm volatile("" ::: "memory")

struct EpiInProj {
    static constexpr bool PERM = true, AFTER_DRAIN = false;
    unsigned char* ws; size_t o_fqkv, o_cq, o_ckv, o_kr, o_rq, o_rk, o_rv, o_rg, o_gates, o_ff, o_t128, o_t64; int skip;
    __device__ __forceinline__ void plain(const f32x4 (&acc)[2][2][4][2], bf16_t* dst, int ld, int colbase, int act, int row0, int wc, int fq) const {
        const int col0 = colbase + wc * 32 + 8 * fq;
#pragma unroll
        for (int ai = 0; ai < 2; ++ai)
#pragma unroll
            for (int m = 0; m < 4; ++m) { bf16_t* rowp = dst + (size_t)(row0 + ai * HALF + m * 16) * ld + col0;
#pragma unroll
                for (int bj = 0; bj < 2; ++bj) { f32x4 v0 = acc[ai][bj][m][0], v1 = acc[ai][bj][m][1];
                    if (act) {
#pragma unroll
                        for (int j = 0; j < 4; ++j) { const float s0 = fsigmoid(v0[j]), s1 = fsigmoid(v1[j]); v0[j] = (act == 1) ? v0[j] * s0 : s0; v1[j] = (act == 1) ? v1[j] * s1 : s1; } }
                    if (skip == 2) { u32x4 w; w.x = cvt_pk_bf16(v0[0], v0[1]); w.y = cvt_pk_bf16(v0[2], v0[3]); w.z = cvt_pk_bf16(v1[0], v1[1]); w.w = cvt_pk_bf16(v1[2], v1[3]); asm volatile("" :: "v"(w)); }
                    else store8(rowp + bj * HALF, v0, v1); }
                EPI_FENCE(); }
    }
    __device__ __forceinline__ void rope128(const f32x4 (&acc)[2][2][4][2], bf16_t* dst, int t, float sc, int row0, int wc, int fq) const {
        const int x = 32 * wc + 8 * fq, hh = x >> 6, i0 = x & 63, head = 2 * t + hh; const float* T128 = (const float*)(ws + o_t128);
#pragma unroll
        for (int ai = 0; ai < 2; ++ai)
#pragma unroll
            for (int m = 0; m < 4; ++m) { const int row = row0 + ai * HALF + m * 16, pos = row & SEQ_MASK;
                const float* tp = T128 + ((size_t)pos * 64 + i0) * 2; bf16_t* p = dst + (size_t)row * 512 + 128 * head + i0;
                rope4(tp, acc[ai][0][m][0], acc[ai][1][m][0], sc, p, p + 64); rope4(tp + 8, acc[ai][0][m][1], acc[ai][1][m][1], sc, p + 4, p + 68);
                EPI_FENCE(); }
    }
    __device__ __forceinline__ void misc(const f32x4 (&acc)[2][2][4][2], int row0, int wc, int fq) const {
        if (wc == 0) { const int i0 = 8 * fq; const float* T64 = (const float*)(ws + o_t64); bf16_t* kr = (bf16_t*)(ws + o_kr);
#pragma unroll
            for (int ai = 0; ai < 2; ++ai)
#pragma unroll
                for (int m = 0; m < 4; ++m) { const int row = row0 + ai * HALF + m * 16, pos = row & SEQ_MASK;
                    const float* tp = T64 + ((size_t)pos * 32 + i0) * 2; bf16_t* p = kr + (size_t)row * 64 + i0;
                    rope4(tp, acc[ai][0][m][0], acc[ai][1][m][0], 1.0f, p, p + 32); rope4(tp + 8, acc[ai][0][m][1], acc[ai][1][m][1], 1.0f, p + 4, p + 36);
                    EPI_FENCE(); }
        } else if (wc == 1) { if (fq == 0) { float* ff = (float*)(ws + o_ff);
#pragma unroll
            for (int ai = 0; ai < 2; ++ai)
#pragma unroll
                for (int m = 0; m < 4; ++m) { const int row = row0 + ai * HALF + m * 16; float* p = ff + (size_t)row * 8; *(f32x4*)p = acc[ai][0][m][0]; *(f32x4*)(p + 4) = acc[ai][0][m][1]; } } }
    }
    __device__ __forceinline__ void operator()(const f32x4 (&acc)[2][2][4][2], const Unit& u, int wr, int wc, int fr, int fq) const {
        const int pn = u.pn, row0 = u.pm * BM + wr * 64 + fr;
        if (skip == 1) {
#pragma unroll
            for (int ai = 0; ai < 2; ++ai)
#pragma unroll
                for (int bj = 0; bj < 2; ++bj)
#pragma unroll
                    for (int m = 0; m < 4; ++m) asm volatile("" :: "v"(acc[ai][bj][m][0]), "v"(acc[ai][bj][m][1]));
            return; }
        if (pn == 12) misc(acc, row0, wc, fq);
        else if (pn >= 13 && pn < 17) { const bool isk = pn >= 15; rope128(acc, (bf16_t*)(ws + (isk ? o_rk : o_rq)), isk ? pn - 15 : pn - 13, isk ? 0.08838834764831845f : 1.0f, row0, wc, fq); }
        else { size_t off; int ld, cb, act = 0;
            if (pn < 9) { off = o_fqkv; ld = 2304; cb = 256 * pn; }
            else if (pn < 11) { off = o_cq; ld = 512; cb = 256 * (pn - 9); }
            else if (pn == 11) { off = o_ckv; ld = 256; cb = 0; }
            else if (pn < 21) { off = o_rv; ld = 1024; cb = 256 * (pn - 17); }
            else if (pn < 25) { off = o_rg; ld = 1024; cb = 256 * (pn - 21); act = 1; }
            else { off = o_gates; ld = 6144; cb = 256 * (pn - 25); act = 2; }
            plain(acc, (bf16_t*)(ws + off), ld, cb, act, row0, wc, fq); }
    }
};

struct EpiUq {
    static constexpr bool PERM = true, AFTER_DRAIN = false;
    bf16_t* qm; const float* rstd; const float* T64;
    __device__ __forceinline__ void operator()(const f32x4 (&acc)[2][2][4][2], const Unit& u, int wr, int wc, int fr, int fq) const {
        const int pn = u.pn, row0 = u.pm * BM + wr * 64 + fr;
        float rsv[2][4];
#pragma unroll
        for (int ai = 0; ai < 2; ++ai)
#pragma unroll
            for (int m = 0; m < 4; ++m) rsv[ai][m] = rstd[row0 + ai * HALF + m * 16];
        if (pn < 3) {
#pragma unroll
            for (int ai = 0; ai < 2; ++ai)
#pragma unroll
                for (int m = 0; m < 4; ++m) { const int row = row0 + ai * HALF + m * 16; const float rs = rsv[ai][m];
#pragma unroll
                    for (int bj = 0; bj < 2; ++bj) store8(qm + (size_t)row * 1152 + 192 * (2 * pn + bj) + 32 * wc + 8 * fq, acc[ai][bj][m][0] * rs, acc[ai][bj][m][1] * rs);
                    EPI_FENCE(); }
        } else { const int head = (pn == 3) ? wc : 4 + wc; if (head < 6) { const int i0 = 8 * fq;
#pragma unroll
            for (int ai = 0; ai < 2; ++ai)
#pragma unroll
                for (int m = 0; m < 4; ++m) { const int row = row0 + ai * HALF + m * 16, pos = row & SEQ_MASK; const float rs = rsv[ai][m];
                    const float* tp = T64 + ((size_t)pos * 32 + i0) * 2; bf16_t* p = qm + (size_t)row * 1152 + 192 * head + 128 + i0;
                    rope4(tp, acc[ai][0][m][0], acc[ai][1][m][0], rs, p, p + 32); rope4(tp + 8, acc[ai][0][m][1], acc[ai][1][m][1], rs, p + 4, p + 36);
                    EPI_FENCE(); } } }
    }
};
struct EpiUkv {
    static constexpr bool PERM = true, AFTER_DRAIN = false;
    bf16_t* kvm; const float* rstd;
    __device__ __forceinline__ void operator()(const f32x4 (&acc)[2][2][4][2], const Unit& u, int wr, int wc, int fr, int fq) const {
        const int row0 = u.pm * BM + wr * 64 + fr, col0 = u.pn * BM + wc * 32 + 8 * fq;
        float rsv[2][4];
#pragma unroll
        for (int ai = 0; ai < 2; ++ai)
#pragma unroll
            for (int m = 0; m < 4; ++m) rsv[ai][m] = rstd[row0 + ai * HALF + m * 16];
#pragma unroll
        for (int ai = 0; ai < 2; ++ai)
#pragma unroll
            for (int m = 0; m < 4; ++m) { const int row = row0 + ai * HALF + m * 16; const float rs = rsv[ai][m];
#pragma unroll
                for (int bj = 0; bj < 2; ++bj) store8(kvm + (size_t)row * 1536 + col0 + bj * HALF, acc[ai][bj][m][0] * rs, acc[ai][bj][m][1] * rs);
                EPI_FENCE(); }
    }
};
template <int PASS> struct EpiMerge {
    static constexpr bool PERM = true, AFTER_DRAIN = false;
    const bf16_t* gates; float* tmp; bf16_t* out;
    __device__ __forceinline__ void operator()(const f32x4 (&acc)[2][2][4][2], const Unit& u, int wr, int wc, int fr, int fq) const {
        const int row0 = u.pm * BM + wr * 64 + fr, col0 = u.pn * BM + wc * 32 + 8 * fq;
#pragma unroll
        for (int ai = 0; ai < 2; ++ai)
#pragma unroll
            for (int m = 0; m < 4; ++m) { const int row = row0 + ai * HALF + m * 16;
#pragma unroll
                for (int bj = 0; bj < 2; ++bj) { const int col = col0 + bj * HALF;
                    f32x4 g0, g1; bf8_to_f32(*(const u32x4*)(gates + (size_t)row * 6144 + 2048 * PASS + col), g0, g1);
                    f32x4 v0 = g0 * acc[ai][bj][m][0], v1 = g1 * acc[ai][bj][m][1];
                    float* tp = tmp + (size_t)row * 2048 + col;
                    if (PASS > 0) { v0 += *(const f32x4*)tp; v1 += *(const f32x4*)(tp + 4); }
                    if (PASS < 2) { *(f32x4*)tp = v0; *(f32x4*)(tp + 4) = v1; }
                    else store8(out + (size_t)row * 2048 + col, v0, v1);
                    EPI_FENCE(); } }
    }
};
struct EpiMergeM {
    static constexpr bool PERM = true, AFTER_DRAIN = false;
    const bf16_t* gates; bf16_t* out;
    __device__ __forceinline__ void operator()(f32x4 (&acc)[2][2][4][2], const UnitM& u, int wr, int wc, int fr, int fq) const {
        int t_ = threadIdx.x; asm volatile("" : "+v"(t_)); (void)fr; (void)fq; const int lrow0 = wr * 64 + (t_ & 15), lcol0 = wc * 32 + 8 * ((t_ >> 4) & 3);
        const int sub = u.sub;
#pragma unroll
        for (int ai = 0; ai < 2; ++ai) {
            u32x4 ga[4][2], gb[4][2];
#pragma unroll
            for (int m = 0; m < 4; ++m)
#pragma unroll
                for (int bj = 0; bj < 2; ++bj) { const bf16_t* gp = gates + ((size_t)u.pm * BM + lrow0 + ai * HALF + m * 16) * 6144 + 2048 * sub + u.pn * BM + lcol0 + bj * HALF;
                    ga[m][bj] = *(const u32x4*)gp; if (sub < 2) gb[m][bj] = *(const u32x4*)(gp + 2048); }
#pragma unroll
            for (int m = 0; m < 4; ++m)
#pragma unroll
                for (int bj = 0; bj < 2; ++bj) { f32x4 a0, a1; bf8_to_f32(ga[m][bj], a0, a1);
#pragma unroll
                    for (int j = 0; j < 4; ++j) { a0[j] = fmaxf(a0[j], 1e-30f); a1[j] = fmaxf(a1[j], 1e-30f); }
                    if (sub < 2) { f32x4 b0, b1; bf8_to_f32(gb[m][bj], b0, b1);
#pragma unroll
                        for (int j = 0; j < 4; ++j) { a0[j] *= __builtin_amdgcn_rcpf(fmaxf(b0[j], 1e-30f)); a1[j] *= __builtin_amdgcn_rcpf(fmaxf(b1[j], 1e-30f)); }
                        acc[ai][bj][m][0] *= a0; acc[ai][bj][m][1] *= a1; }
                    else store8(out + ((size_t)u.pm * BM + lrow0 + ai * HALF + m * 16) * 2048 + u.pn * BM + lcol0 + bj * HALF, acc[ai][bj][m][0] * a0, acc[ai][bj][m][1] * a1); }
            EPI_FENCE(); }
    }
};
struct EpiResid {
    static constexpr bool PERM = true, AFTER_DRAIN = false;
    bf16_t* xb;
    __device__ __forceinline__ void operator()(const f32x4 (&acc)[2][2][4][2], const Unit& u, int wr, int wc, int fr, int fq) const {
        int t_ = threadIdx.x; asm volatile("" : "+v"(t_)); (void)fr; (void)fq;
        const int row0 = u.pm * BM + wr * 64 + (t_ & 15), col0 = u.pn * BM + wc * 32 + 8 * ((t_ >> 4) & 3);
#pragma unroll
        for (int ai = 0; ai < 2; ++ai) {
            u32x4 b[4][2];
#pragma unroll
            for (int m = 0; m < 4; ++m)
#pragma unroll
                for (int bj = 0; bj < 2; ++bj) b[m][bj] = *(const u32x4*)(xb + (size_t)(row0 + ai * HALF + m * 16) * 4096 + col0 + bj * HALF);
#pragma unroll
            for (int m = 0; m < 4; ++m)
#pragma unroll
                for (int bj = 0; bj < 2; ++bj) { f32x4 x0, x1; bf8_to_f32(b[m][bj], x0, x1);
                    store8(xb + (size_t)(row0 + ai * HALF + m * 16) * 4096 + col0 + bj * HALF, x0 + acc[ai][bj][m][0], x1 + acc[ai][bj][m][1]); }
            EPI_FENCE(); }
    }
};
__device__ __forceinline__ float gelu_gate(float xc, float g) {
    const float z = xc * __builtin_fmaf(0.044715f * xc, xc, 1.0f);
    return xc * __builtin_amdgcn_rcpf(1.0f + __builtin_amdgcn_exp2f(-2.3022081985378545f * z)) * g;
}
template <int CTRL> __device__ __forceinline__ float dpp_f(float old, float src) {
    return __builtin_bit_cast(float, __builtin_amdgcn_update_dpp(__builtin_bit_cast(int, old), __builtin_bit_cast(int, src), CTRL, 0xf, 0xf, false)); }
struct EpiConvAct {
    static constexpr bool PERM = true, AFTER_DRAIN = false;
    bf16_t* act; float* utail; float* uhead; float* ghead; const float* cw; const float* cb; PG8_LAS float* xbuf;
    __device__ __forceinline__ void operator()(const f32x4 (&acc)[2][2][4][2], const Unit& u, int wr_, int wc_, int fr_, int fq_) const {
        int t_ = threadIdx.x; asm volatile("" : "+v"(t_)); const int fr = t_ & 15, fq = (t_ >> 4) & 3, wr = wr_, wc = wc_; (void)fr_; (void)fq_;
        const int lc = 32 * wc + 8 * fq, f0 = u.pn * HALF + lc;
        if (fr >= 14) {
#pragma unroll
            for (int ai = 0; ai < 2; ++ai) { PG8_LAS float* xp = xbuf + ((2 * ai + wr) * 2 + (fr - 14)) * 128 + lc; *(PG8_LAS f32x4*)xp = acc[ai][0][3][0]; *(PG8_LAS f32x4*)(xp + 4) = acc[ai][0][3][1]; }
            if (wr == 1) { float* tp = utail + ((size_t)u.pm * 2 + (fr - 14)) * 5632 + f0; *(f32x4*)tp = acc[1][0][3][0]; *(f32x4*)(tp + 4) = acc[1][0][3][1]; } }
        if (fr < 2 && wr == 0) { const size_t o = ((size_t)u.pm * 2 + fr) * 5632 + f0;
            *(f32x4*)(uhead + o) = acc[0][0][0][0]; *(f32x4*)(uhead + o + 4) = acc[0][0][0][1]; *(f32x4*)(ghead + o) = acc[0][1][0][0]; *(f32x4*)(ghead + o + 4) = acc[0][1][0][1]; }
        asm volatile("s_waitcnt lgkmcnt(0)" ::: "memory"); __builtin_amdgcn_s_barrier(); asm volatile("" ::: "memory");
        float w0[8], w1[8], w2[8], bb[8];
#pragma unroll
        for (int h = 0; h < 2; ++h) { const f32x4 a = *(const f32x4*)(cw + f0 + 4 * h), b = *(const f32x4*)(cw + 5632 + f0 + 4 * h), c = *(const f32x4*)(cw + 2 * 5632 + f0 + 4 * h), d = *(const f32x4*)(cb + f0 + 4 * h);
#pragma unroll
            for (int j = 0; j < 4; ++j) { w0[4 * h + j] = a[j]; w1[4 * h + j] = b[j]; w2[4 * h + j] = c[j]; bb[4 * h + j] = d[j]; } }
        const int row0 = u.pm * BM + wr * 64 + fr;
#pragma unroll
        for (int ai = 0; ai < 2; ++ai) {
            f32x4 t0a = {0.f, 0.f, 0.f, 0.f}, t0b = t0a, t1a = t0a, t1b = t0a;
            if (2 * ai + wr > 0) { const PG8_LAS float* xp = xbuf + ((2 * ai + wr - 1) * 2) * 128 + lc; t0a = *(const PG8_LAS f32x4*)xp; t0b = *(const PG8_LAS f32x4*)(xp + 4); t1a = *(const PG8_LAS f32x4*)(xp + 128); t1b = *(const PG8_LAS f32x4*)(xp + 132); }
#pragma unroll
            for (int m = 0; m < 4; ++m) { f32x4 o0, o1;
#pragma unroll
                for (int n = 0; n < 2; ++n)
#pragma unroll
                    for (int j = 0; j < 4; ++j) { const int k = 4 * n + j; const float cur = acc[ai][0][m][n][j];
                        float a1, a2;
                        if (m == 0) { const float T0 = n ? t0b[j] : t0a[j], T1 = n ? t1b[j] : t1a[j]; a1 = T1; a2 = (fr == 0) ? T0 : T1; }
                        else { const float pv = acc[ai][0][m - 1][n][j]; a1 = dpp_f<0x10F>(pv, pv); a2 = dpp_f<0x10E>(pv, pv); }
                        const float s1 = dpp_f<0x111>(a1, cur), s2 = dpp_f<0x112>(a2, cur);
                        const float xc = __builtin_fmaf(w2[k], cur, __builtin_fmaf(w1[k], s1, __builtin_fmaf(w0[k], s2, bb[k])));
                        const float r = gelu_gate(xc, acc[ai][1][m][n][j]);
                        if (n == 0) o0[j] = r; else o1[j] = r; }
                store8(act + (size_t)(row0 + ai * HALF + m * 16) * 5632 + f0, o0, o1);
                EPI_FENCE(); } }
    }
};
}

namespace att {
#define ATT_LAS __attribute__((address_space(3)))
typedef unsigned short bf16_t;
typedef short bf16x8 __attribute__((ext_vector_type(8)));
typedef short s16x4 __attribute__((ext_vector_type(4)));
typedef float f32x16 __attribute__((ext_vector_type(16)));
typedef float f32x4 __attribute__((ext_vector_type(4)));
typedef unsigned u32x4 __attribute__((ext_vector_type(4)));
typedef unsigned u32x2 __attribute__((ext_vector_type(2)));
constexpr int SHM_T = 16384;
#define KSWZ(row, colB) ((row) * 256 + ((colB) ^ (((row) & 15) << 4)))
#define KSWZ64(row, colB) ((row) * 128 + ((colB) ^ ((((row) >> 1) & 7) << 4)))
#define SBAR() __builtin_amdgcn_sched_barrier(0)
__device__ __forceinline__ int v_st(int k, int c) { const int kk = (k & ~0xC) | ((k & 4) << 1) | ((k & 8) >> 1); return ((kk >> 3) * 4 + (c >> 5)) * 512 + ((kk & 7) * 32 + (c & 31)) * 2; }
__device__ __forceinline__ int v_rd_base(int lane) { return ((lane & 3) << 3) | (((lane >> 2) & 3) << 6) | (((lane >> 4) & 1) << 5) | (((lane >> 5) & 1) << 8); }
constexpr int v_rd_off(int d0, int ks, int half) { return d0 * 512 + ks * 4096 + half * 2048; }
__device__ __forceinline__ unsigned cvtpk(float lo, float hi) { unsigned r; asm volatile("v_cvt_pk_bf16_f32 %0, %1, %2" : "=v"(r) : "v"(lo), "v"(hi)); return r; }

template <bool ROPE>
__device__ __forceinline__ void qkt(f32x16& p0, f32x16& p1, const ATT_LAS char* Kt, const ATT_LAS char* Kr, int r32, int hi, const bf16x8* qr) {
    p0 = f32x16{}; p1 = f32x16{};
#pragma unroll
    for (int d0 = 0; d0 < 8; ++d0) { const ATT_LAS char* a = Kt + KSWZ(r32, (d0 * 16 + hi * 8) * 2);
        const bf16x8 b0 = *(const ATT_LAS bf16x8*)a, b1 = *(const ATT_LAS bf16x8*)(a + 32 * 256);
        p0 = __builtin_amdgcn_mfma_f32_32x32x16_bf16(b0, qr[d0], p0, 0, 0, 0);
        p1 = __builtin_amdgcn_mfma_f32_32x32x16_bf16(b1, qr[d0], p1, 0, 0, 0); }
    if (ROPE) {
#pragma unroll
        for (int d0 = 0; d0 < 4; ++d0) { const ATT_LAS char* a = Kr + KSWZ64(r32, (d0 * 16 + hi * 8) * 2);
            const bf16x8 b0 = *(const ATT_LAS bf16x8*)a, b1 = *(const ATT_LAS bf16x8*)(a + 32 * 128);
            p0 = __builtin_amdgcn_mfma_f32_32x32x16_bf16(b0, qr[8 + d0], p0, 0, 0, 0);
            p1 = __builtin_amdgcn_mfma_f32_32x32x16_bf16(b1, qr[8 + d0], p1, 0, 0, 0); } }
}
__device__ __forceinline__ void pv_tile_T(f32x16* o, int vb, bf16x8 pa0, bf16x8 pa1, bf16x8 pa2, bf16x8 pa3) {
#define TRRD(dst, off) asm volatile("ds_read_b64_tr_b16 %0, %1 offset:%2" : "=&v"(dst) : "v"(vb), "i"(off) : "memory")
#define PV_D0(d0) do { s16x4 l0, l1, l2, l3, h0, h1, h2, h3; constexpr int b_ = v_rd_off(d0, 0, 0); \
        TRRD(l0, b_); TRRD(h0, b_ + 2048); TRRD(l1, b_ + 4096); TRRD(h1, b_ + 6144); TRRD(l2, b_ + 8192); TRRD(h2, b_ + 10240); TRRD(l3, b_ + 12288); TRRD(h3, b_ + 14336); \
        asm volatile("s_waitcnt lgkmcnt(0)" ::: "memory"); SBAR(); \
        o[d0] = __builtin_amdgcn_mfma_f32_32x32x16_bf16((bf16x8){l0[0], l0[1], l0[2], l0[3], h0[0], h0[1], h0[2], h0[3]}, pa0, o[d0], 0, 0, 0); \
        o[d0] = __builtin_amdgcn_mfma_f32_32x32x16_bf16((bf16x8){l1[0], l1[1], l1[2], l1[3], h1[0], h1[1], h1[2], h1[3]}, pa1, o[d0], 0, 0, 0); \
        o[d0] = __builtin_amdgcn_mfma_f32_32x32x16_bf16((bf16x8){l2[0], l2[1], l2[2], l2[3], h2[0], h2[1], h2[2], h2[3]}, pa2, o[d0], 0, 0, 0); \
        o[d0] = __builtin_amdgcn_mfma_f32_32x32x16_bf16((bf16x8){l3[0], l3[1], l3[2], l3[3], h3[0], h3[1], h3[2], h3[3]}, pa3, o[d0], 0, 0, 0); } while (0)
    PV_D0(0); PV_D0(1); PV_D0(2); PV_D0(3);
#undef PV_D0
#undef TRRD
}
__device__ __forceinline__ void pack_p(const f32x16& p0, const f32x16& p1, bf16x8& pa0, bf16x8& pa1, bf16x8& pa2, bf16x8& pa3) {
#define PK4(P, B_, OUT) do { unsigned a0 = cvtpk(P[B_+0], P[B_+1]), a1 = cvtpk(P[B_+2], P[B_+3]); \
        unsigned b0 = cvtpk(P[B_+4], P[B_+5]), b1 = cvtpk(P[B_+6], P[B_+7]); \
        auto r0 = __builtin_amdgcn_permlane32_swap(a0, b0, false, false); auto r1 = __builtin_amdgcn_permlane32_swap(a1, b1, false, false); \
        u32x4 w = {r0[0], r1[0], r0[1], r1[1]}; OUT = *reinterpret_cast<bf16x8*>(&w); } while (0)
    PK4(p0, 0, pa0); PK4(p0, 8, pa1); PK4(p1, 0, pa2); PK4(p1, 8, pa3);
#undef PK4
}
__device__ __forceinline__ float swap_max(float v) { auto rr = __builtin_amdgcn_permlane32_swap(__float_as_uint(v), __float_as_uint(v), false, false); return fmaxf(__uint_as_float(rr[0]), __uint_as_float(rr[1])); }
__device__ __forceinline__ float swap_sum(float v) { auto rr = __builtin_amdgcn_permlane32_swap(__float_as_uint(v), __float_as_uint(v), false, false); return __uint_as_float(rr[0]) + __uint_as_float(rr[1]); }

struct UnitPtrs {
    const bf16_t* Q; int ldq;
    const bf16_t* K; int ldk;
    const bf16_t* V; int ldv;
    const bf16_t* KR;
    const float* bias;
    const bf16_t* G;
    bf16_t* O; int ldo;
    int P0;
    float c2;
    const bf16_t* ST;
    int T0;
};
template <int MODE>
__device__ __forceinline__ void mixer_unit(const UnitPtrs& U, ATT_LAS char* lds) {
    constexpr bool ROPE = (MODE == 1);
    constexpr int NQ = ROPE ? 12 : 8;
    constexpr int K_OFF = 0, KR_OFF = 32768, V_OFF = (MODE == 1) ? 49152 : 32768, V_SZ = (MODE == 2) ? 32768 : 16384, BIAS_OFF = 65536, SCR_OFF = 98304;
    int tid_ = threadIdx.x; asm volatile("" : "+v"(tid_));
    const int tid = tid_, wid = __builtin_amdgcn_readfirstlane(tid >> 6), lane = tid & 63, r32 = lane & 31, hi = lane >> 5;
    const int rg = (MODE == 2) ? (wid >> 1) : wid;
    const int vhalf = (MODE == 2) ? (wid & 1) : 0;
    const int qlo = U.P0 + 32 * rg;
    const int tbase = (MODE == 2) ? (U.T0 >> 6) : 0;
    const int NT = (U.P0 + ((MODE == 2) ? 128 : 256)) / 64 - tbase;
    const int tlast = (qlo >> 6) - tbase;
    bf16x8 qr[NQ];
    { const bf16_t* qp = U.Q + (size_t)(32 * rg + r32) * U.ldq + hi * 8;
#pragma unroll
      for (int d0 = 0; d0 < NQ; ++d0) qr[d0] = *(const bf16x8*)(qp + d0 * 16); }
    const int sr = tid >> 4, sc = (tid & 15) * 8;
    const int kws = KSWZ(sr, sc * 2), vst0 = v_st(sr, sc), vst1 = v_st(32 + sr, sc);
    const int rr = tid >> 3, rc = (tid & 7) * 8, krs = KSWZ64(rr, rc * 2);
    const int vbase = (int)(unsigned)(uintptr_t)(lds + V_OFF) + v_rd_base(lane) + vhalf * SHM_T;
    bf16x8 st_k0, st_k1, st_v0, st_v1, st_v2, st_v3, st_r;
#define ST_LOAD(kb_) do { const bf16_t* kp_ = U.K + (size_t)((kb_) + sr) * U.ldk + sc; st_k0 = *(const bf16x8*)kp_; st_k1 = *(const bf16x8*)(kp_ + (size_t)32 * U.ldk); \
        const bf16_t* vp_ = U.V + (size_t)((kb_) + sr) * U.ldv + sc; st_v0 = *(const bf16x8*)vp_; st_v1 = *(const bf16x8*)(vp_ + (size_t)32 * U.ldv); \
        if (MODE == 2) { st_v2 = *(const bf16x8*)(vp_ + 128); st_v3 = *(const bf16x8*)(vp_ + (size_t)32 * U.ldv + 128); } \
        if (MODE == 1) { st_r = *(const bf16x8*)(U.KR + (size_t)((kb_) + rr) * 64 + rc); } } while (0)
#define ST_WRITE(bf) do { ATT_LAS char* kd_ = lds + K_OFF + (bf) * SHM_T; *(ATT_LAS bf16x8*)(kd_ + kws) = st_k0; *(ATT_LAS bf16x8*)(kd_ + kws + 32 * 256) = st_k1; \
        ATT_LAS char* vd_ = lds + V_OFF + (bf) * V_SZ; *(ATT_LAS bf16x8*)(vd_ + vst0) = st_v0; *(ATT_LAS bf16x8*)(vd_ + vst1) = st_v1; \
        if (MODE == 2) { *(ATT_LAS bf16x8*)(vd_ + SHM_T + vst0) = st_v2; *(ATT_LAS bf16x8*)(vd_ + SHM_T + vst1) = st_v3; } \
        if (MODE == 1) { *(ATT_LAS bf16x8*)(lds + KR_OFF + (bf) * 8192 + krs) = st_r; } } while (0)
    float m_reg = -1e30f, l_reg = 0.f; f32x16 o[4] = {};
    float colf[(MODE == 2) ? 32 : 1];
    if (MODE == 2) {
#pragma unroll
        for (int r = 0; r < 16; ++r) { const int c = (r & 3) + 8 * (r >> 2); colf[r] = __builtin_amdgcn_exp2f(-U.c2 * (float)c); colf[16 + r] = __builtin_amdgcn_exp2f(-U.c2 * (float)(c + 32)); } }
    const int qpos = qlo + r32;
    ST_LOAD(tbase * 64);
    if (MODE == 0) { const int nk = U.P0 + 256; ATT_LAS float* bl = (ATT_LAS float*)(lds + BIAS_OFF); for (int i = tid; i < nk; i += 512) bl[i] = -U.bias[i]; }
    ST_WRITE(0);
    __syncthreads();
    if (MODE == 2) { if (U.ST) {
        const bf16_t* sp = U.ST + (size_t)(vhalf * 128 + r32) * 128 + hi * 8;
        bf16x8 sa[4][8];
#pragma unroll
        for (int d0 = 0; d0 < 4; ++d0)
#pragma unroll
            for (int ks = 0; ks < 8; ++ks) sa[d0][ks] = *(const bf16x8*)(sp + (size_t)d0 * 32 * 128 + ks * 16);
#pragma unroll
        for (int d0 = 0; d0 < 4; ++d0)
#pragma unroll
            for (int ks = 0; ks < 8; ++ks) o[d0] = __builtin_amdgcn_mfma_f32_32x32x16_bf16(sa[d0][ks], qr[ks], o[d0], 0, 0, 0);
        const float rf = __builtin_amdgcn_exp2f(U.c2 * (float)(qpos - U.T0 + 1));
#pragma unroll
        for (int d0 = 0; d0 < 4; ++d0)
#pragma unroll
            for (int r = 0; r < 16; ++r) o[d0][r] *= rf; } }
#define STEP(t, B) do { const int t_ = (t); const bool more_ = (t_ + 1 < NT); \
        if (more_) ST_LOAD((tbase + t_ + 1) * 64); \
        if (t_ <= tlast) { f32x16 p0, p1; bf16x8 pa0, pa1, pa2, pa3; \
            qkt<ROPE>(p0, p1, lds + K_OFF + (B) * SHM_T, lds + KR_OFF + (B) * 8192, r32, hi, qr); \
            const int dq = qpos - (tbase + t_) * 64 - 4 * hi; \
            if (MODE == 2) { \
                if (t_ < tlast) { const float rowf = __builtin_amdgcn_exp2f(U.c2 * (float)dq);     \
                    _Pragma("unroll") for (int r = 0; r < 16; ++r) { p0[r] *= rowf * colf[r]; p1[r] *= rowf * colf[16 + r]; } \
                } else { \
                    _Pragma("unroll") for (int r = 0; r < 16; ++r) { const int c = (r & 3) + 8 * (r >> 2); \
                        p0[r] *= __builtin_amdgcn_exp2f(U.c2 * fabsf((float)(dq - c))); p1[r] *= __builtin_amdgcn_exp2f(U.c2 * fabsf((float)(dq - c - 32))); } } \
            } else { \
                if (MODE == 0) { const ATT_LAS float* bl = (const ATT_LAS float*)(lds + BIAS_OFF) + t_ * 64 + 4 * hi; \
                    _Pragma("unroll") for (int g = 0; g < 4; ++g) { const f32x4 b0 = *(const ATT_LAS f32x4*)(bl + 8 * g), b1 = *(const ATT_LAS f32x4*)(bl + 32 + 8 * g); \
                        _Pragma("unroll") for (int j = 0; j < 4; ++j) { p0[4 * g + j] = fmaf(p0[4 * g + j], U.c2, b0[j]); p1[4 * g + j] = fmaf(p1[4 * g + j], U.c2, b1[j]); } } \
                    if (t_ == tlast) { const float NEG = -__builtin_inff(); \
                        _Pragma("unroll") for (int r = 0; r < 16; ++r) { const int c = (r & 3) + 8 * (r >> 2); if (dq - c < 0) p0[r] = NEG; if (dq - c - 32 < 0) p1[r] = NEG; } } \
                } else { _Pragma("unroll") for (int r = 0; r < 16; ++r) { p0[r] *= U.c2; p1[r] *= U.c2; } } \
                float pmax = p0[0]; \
                _Pragma("unroll") for (int r = 1; r < 16; ++r) pmax = fmaxf(pmax, p0[r]); \
                _Pragma("unroll") for (int r = 0; r < 16; ++r) pmax = fmaxf(pmax, p1[r]); \
                pmax = swap_max(pmax); \
                const float mn = fmaxf(m_reg, pmax), alpha = __builtin_amdgcn_exp2f(m_reg - mn); m_reg = mn; \
                if (!__all(alpha == 1.0f)) { _Pragma("unroll") for (int d_ = 0; d_ < 4; ++d_) _Pragma("unroll") for (int r = 0; r < 16; ++r) o[d_][r] *= alpha; } \
                float ps = 0.f; \
                _Pragma("unroll") for (int r = 0; r < 16; ++r) { p0[r] = __builtin_amdgcn_exp2f(p0[r] - mn); p1[r] = __builtin_amdgcn_exp2f(p1[r] - mn); ps += p0[r] + p1[r]; } \
                ps = swap_sum(ps); l_reg = l_reg * alpha + ps; \
            } \
            pack_p(p0, p1, pa0, pa1, pa2, pa3); \
            pv_tile_T(o, vbase + (B) * V_SZ, pa0, pa1, pa2, pa3); } \
        if (more_) ST_WRITE((B) ^ 1); \
        __syncthreads(); } while (0)
    for (int t = 0; t < NT; t += 2) { STEP(t, 0); STEP(t + 1, 1); }
#undef STEP
#undef ST_LOAD
#undef ST_WRITE
    bf16_t* orow = U.O + (size_t)(32 * rg + r32) * U.ldo + vhalf * 128 + 4 * hi;
    if (MODE == 2) {
        float ss = 0.f;
#pragma unroll
        for (int d0 = 0; d0 < 4; ++d0)
#pragma unroll
            for (int r = 0; r < 16; ++r) ss += o[d0][r] * o[d0][r];
        ss = swap_sum(ss);
        ATT_LAS float* scr = (ATT_LAS float*)(lds + SCR_OFF);
        if (hi == 0) scr[wid * 32 + r32] = ss;
        __syncthreads();
        const float tot = ss + scr[(wid ^ 1) * 32 + r32];
        const float rstd = __builtin_amdgcn_rsqf(tot * (1.0f / 256.0f) + 1e-6f);
        const bf16_t* grow = U.G + (size_t)(32 * rg + r32) * 1024 + vhalf * 128 + 4 * hi;
#pragma unroll
        for (int d0 = 0; d0 < 4; ++d0)
#pragma unroll
            for (int g = 0; g < 4; ++g) { const u32x2 gw = *(const u32x2*)(grow + 32 * d0 + 8 * g);
                const float g0 = __uint_as_float(gw.x << 16), g1 = __uint_as_float(gw.x & 0xffff0000u), g2 = __uint_as_float(gw.y << 16), g3 = __uint_as_float(gw.y & 0xffff0000u);
                u32x2 w; w.x = cvtpk(o[d0][4 * g] * rstd * g0, o[d0][4 * g + 1] * rstd * g1); w.y = cvtpk(o[d0][4 * g + 2] * rstd * g2, o[d0][4 * g + 3] * rstd * g3);
                *(u32x2*)(orow + 32 * d0 + 8 * g) = w; }
        __syncthreads();
    } else {
        const float inv = 1.0f / l_reg;
#pragma unroll
        for (int d0 = 0; d0 < 4; ++d0)
#pragma unroll
            for (int g = 0; g < 4; ++g) { u32x2 w; w.x = cvtpk(o[d0][4 * g] * inv, o[d0][4 * g + 1] * inv); w.y = cvtpk(o[d0][4 * g + 2] * inv, o[d0][4 * g + 3] * inv);
                *(u32x2*)(orow + 32 * d0 + 8 * g) = w; }
    }
}

__device__ __forceinline__ void ret_state_unit(const bf16_t* K, int ldk, const bf16_t* V, int ldv, float c2, float* SL, ATT_LAS char* lds) {
    int tid_ = threadIdx.x; asm volatile("" : "+v"(tid_));
    const int tid = tid_, wid = __builtin_amdgcn_readfirstlane(tid >> 6), lane = tid & 63, r32 = lane & 31, hi = lane >> 5;
    const int sr = tid >> 4, sc = (tid & 15) * 8, vst0 = v_st(sr, sc), vst1 = v_st(32 + sr, sc);
    constexpr int KI = 0, VI = 16384;
    const int kb = (int)(unsigned)(uintptr_t)(lds + KI) + v_rd_base(lane), vb = (int)(unsigned)(uintptr_t)(lds + VI) + v_rd_base(lane) + (wid >> 2) * SHM_T;
    f32x16 acc[4] = {};
    for (int t = 0; t < 4; ++t) {
        const bf16_t* kp = K + (size_t)(t * 64 + sr) * ldk + sc; const bf16_t* vp = V + (size_t)(t * 64 + sr) * ldv + sc;
        const u32x4 k0 = *(const u32x4*)kp, k1 = *(const u32x4*)(kp + (size_t)32 * ldk);
        const bf16x8 v0 = *(const bf16x8*)vp, v1 = *(const bf16x8*)(vp + (size_t)32 * ldv), v2 = *(const bf16x8*)(vp + 128), v3 = *(const bf16x8*)(vp + (size_t)32 * ldv + 128);
        const float w0 = __builtin_amdgcn_exp2f(c2 * (float)(255 - (t * 64 + sr))), w1 = __builtin_amdgcn_exp2f(c2 * (float)(255 - (t * 64 + 32 + sr)));
        u32x4 q0, q1;
#define WSC(w, s) cvtpk(__uint_as_float((w) << 16) * (s), __uint_as_float((w) & 0xffff0000u) * (s))
        q0.x = WSC(k0.x, w0); q0.y = WSC(k0.y, w0); q0.z = WSC(k0.z, w0); q0.w = WSC(k0.w, w0); q1.x = WSC(k1.x, w1); q1.y = WSC(k1.y, w1); q1.z = WSC(k1.z, w1); q1.w = WSC(k1.w, w1);
#undef WSC
        __syncthreads();
        *(ATT_LAS u32x4*)(lds + KI + vst0) = q0; *(ATT_LAS u32x4*)(lds + KI + vst1) = q1;
        *(ATT_LAS bf16x8*)(lds + VI + vst0) = v0; *(ATT_LAS bf16x8*)(lds + VI + vst1) = v1; *(ATT_LAS bf16x8*)(lds + VI + SHM_T + vst0) = v2; *(ATT_LAS bf16x8*)(lds + VI + SHM_T + vst1) = v3;
        __syncthreads();
#define TRR(dst, base, off) asm volatile("ds_read_b64_tr_b16 %0, %1 offset:%2" : "=&v"(dst) : "v"(base), "i"(off) : "memory")
#define KS_STEP(ks) do { s16x4 vl, vh, kl0, kh0, kl1, kh1, kl2, kh2, kl3, kh3; \
        TRR(vl, vbw, (ks) * 4096); TRR(vh, vbw, (ks) * 4096 + 2048); \
        TRR(kl0, kb, 0 * 512 + (ks) * 4096); TRR(kh0, kb, 0 * 512 + (ks) * 4096 + 2048); TRR(kl1, kb, 1 * 512 + (ks) * 4096); TRR(kh1, kb, 1 * 512 + (ks) * 4096 + 2048); \
        TRR(kl2, kb, 2 * 512 + (ks) * 4096); TRR(kh2, kb, 2 * 512 + (ks) * 4096 + 2048); TRR(kl3, kb, 3 * 512 + (ks) * 4096); TRR(kh3, kb, 3 * 512 + (ks) * 4096 + 2048); \
        asm volatile("s_waitcnt lgkmcnt(0)" ::: "memory"); SBAR(); \
        const bf16x8 vf = (bf16x8){vl[0], vl[1], vl[2], vl[3], vh[0], vh[1], vh[2], vh[3]}; \
        acc[0] = __builtin_amdgcn_mfma_f32_32x32x16_bf16(vf, (bf16x8){kl0[0], kl0[1], kl0[2], kl0[3], kh0[0], kh0[1], kh0[2], kh0[3]}, acc[0], 0, 0, 0); \
        acc[1] = __builtin_amdgcn_mfma_f32_32x32x16_bf16(vf, (bf16x8){kl1[0], kl1[1], kl1[2], kl1[3], kh1[0], kh1[1], kh1[2], kh1[3]}, acc[1], 0, 0, 0); \
        acc[2] = __builtin_amdgcn_mfma_f32_32x32x16_bf16(vf, (bf16x8){kl2[0], kl2[1], kl2[2], kl2[3], kh2[0], kh2[1], kh2[2], kh2[3]}, acc[2], 0, 0, 0); \
        acc[3] = __builtin_amdgcn_mfma_f32_32x32x16_bf16(vf, (bf16x8){kl3[0], kl3[1], kl3[2], kl3[3], kh3[0], kh3[1], kh3[2], kh3[3]}, acc[3], 0, 0, 0); } while (0)
        const int vbw = vb + (wid & 3) * 512;
        KS_STEP(0); KS_STEP(1); KS_STEP(2); KS_STEP(3);
#undef KS_STEP
#undef TRR
    }
#pragma unroll
    for (int e0 = 0; e0 < 4; ++e0)
#pragma unroll
        for (int r = 0; r < 16; ++r) SL[(size_t)(32 * wid + (r & 3) + 8 * (r >> 2) + 4 * hi) * 128 + 32 * e0 + r32] = acc[e0][r];
    __syncthreads();
}
}

constexpr int DM = 2048, NBATCH = 8, SEQ = 4096, DEPTH = 4, M = NBATCH * SEQ;
constexpr int IN_W = 12358, NIN = 12544, DFF = 5632, NUG = 2 * DFF, NUQ = 1280, NUKV = 1536;
constexpr float NORM_EPS = 1e-6f;
constexpr int NWAVES = 8;
constexpr int PH = 11, NPHASE = DEPTH * PH + 1;

constexpr size_t MiB = 1u << 20;
constexpr size_t WS_CTL = 0, CTL_ZERO_BYTES = 1 * MiB;
constexpr size_t WS_T128 = 1 * MiB, WS_T64 = 3 * MiB, WS_CL = 4 * MiB, WS_RSQ = 5 * MiB, WS_RSKV = 5 * MiB + 512 * 1024, WS_FF = 6 * MiB;
constexpr size_t WS_W = 8 * MiB;
constexpr size_t WO_IN = 0, WO_UQ = WO_IN + (size_t)NIN * DM * 2, WO_UKV = WO_UQ + (size_t)NUQ * 512 * 2, WO_BF = WO_UKV + (size_t)NUKV * 256 * 2, WO_BM = WO_BF + (size_t)DM * 1024 * 2,
                 WO_BR = WO_BM + (size_t)DM * 1024 * 2, WO_OUT = WO_BR + (size_t)DM * 1024 * 2, WO_UG = WO_OUT + (size_t)DM * DM * 2, WO_DN = WO_UG + (size_t)NUG * DM * 2, WO_END = WO_DN + (size_t)DM * DFF * 2;
static_assert(WO_END == 137 * MiB, "weight region");
constexpr size_t WS_H = 146 * MiB;
constexpr size_t WS_BIG = 274 * MiB;
constexpr size_t WS_GATES = WS_BIG, WS_FQKV = WS_GATES + 384 * MiB, WS_CQ = WS_FQKV + 144 * MiB, WS_CKV = WS_CQ + 32 * MiB, WS_RQ = WS_CKV + 16 * MiB, WS_RK = WS_RQ + 32 * MiB,
                 WS_RV = WS_RK + 32 * MiB, WS_RG = WS_RV + 64 * MiB, WS_KR = WS_RG + 64 * MiB, WS_QM = WS_KR + 4 * MiB, WS_KVM = WS_QM + 72 * MiB, WS_A = WS_KVM + 96 * MiB,
                 WS_BM = WS_A + 64 * MiB, WS_C = WS_BM + 64 * MiB, WS_SLOC = WS_C + 64 * MiB, WS_SST = WS_SLOC + 64 * MiB, WS_MIX_END = WS_SST + 32 * MiB;
constexpr size_t WS_TMP = WS_FQKV;
static_assert(WS_RV - WS_FQKV == 256 * MiB, "tmp overlay");
constexpr size_t WS_U = WS_BIG, WS_GT = WS_U + 352 * MiB, WS_ACT = WS_GT + 352 * MiB, WS_FFN_END = WS_ACT + 352 * MiB;
constexpr size_t WS_UTAIL = WS_U, WS_UHEAD = WS_U + 8 * MiB, WS_GHEAD = WS_U + 16 * MiB;
constexpr size_t WS_END = WS_MIX_END > WS_FFN_END ? WS_MIX_END : WS_FFN_END;
constexpr int CW_BAR = 4096;
constexpr int CW_QUEUE = 16384;

constexpr int RING_OFF = 0, RING_BYTES = 131072;
constexpr int LDSCTL_OFF = RING_BYTES, MISC_OFF = LDSCTL_OFF + 320;
constexpr int LDS_BYTES = 147456;
static_assert(MISC_OFF + 128 <= LDS_BYTES, "LDS map");

#define LAS __attribute__((address_space(3)))
typedef unsigned short bf16;
typedef unsigned v4u __attribute__((ext_vector_type(4)));
typedef float f32x4 __attribute__((ext_vector_type(4)));
#define LDS_WAIT() asm volatile("s_waitcnt lgkmcnt(0)" ::: "memory")
__device__ __forceinline__ unsigned f2bf(float f) { unsigned u = __builtin_bit_cast(unsigned, f); return (u + 0x7fffu + ((u >> 16) & 1u)) >> 16; }
__device__ __forceinline__ unsigned pk2(float lo, float hi) { return f2bf(lo) | (f2bf(hi) << 16); }

#define XB_TMO      128
#define XB_XCNT(j)  (256  + 64 * (j))
#define XB_XSUB(j)  (1280 + 64 * (j))
#define XB_XGEN(j)  (2304 + 64 * (j))
#define XB_TOP      3328
#define XB_TOPGEN   3392
#define XCD_BAR_WORDS 3456
#define XB_SPIN_CAP (1u << 18)
__device__ __forceinline__ unsigned xb_ld(unsigned* p)              { return __hip_atomic_load(p, __ATOMIC_RELAXED, __HIP_MEMORY_SCOPE_AGENT); }
__device__ __forceinline__ unsigned xb_add(unsigned* p, unsigned v) { return __hip_atomic_fetch_add(p, v, __ATOMIC_RELAXED, __HIP_MEMORY_SCOPE_AGENT); }
__device__ __forceinline__ unsigned xb_xcc_id() { return (unsigned)__builtin_amdgcn_s_getreg((3 << 11) | 20) & 0xFu; }
#define XB_SPIN(cond, bar) do { unsigned _sp = 0; while (cond) { __builtin_amdgcn_s_sleep(1); \
    if ((++_sp & 255u) == 0u) { if (xb_ld(&(bar)[XB_TMO])) break; if (_sp > XB_SPIN_CAP) { atomicAdd(&(bar)[XB_TMO], 1u); break; } } } } while (0)
struct XcdBarrier { unsigned* bar; unsigned x; volatile LAS unsigned* st; };
__device__ __forceinline__ XcdBarrier xcd_barrier_post(unsigned* bar, volatile LAS unsigned* st) {
    XcdBarrier b; b.bar = bar; b.x = xb_xcc_id(); b.st = st;
    if (threadIdx.x == 0) (void)xb_add(&bar[XB_XCNT(b.x)], 1u);
    return b;
}
__device__ __forceinline__ void xcd_barrier_complete(unsigned* bar, unsigned x, unsigned& nloc, unsigned& nx) {
    const unsigned G = gridDim.x * gridDim.y * gridDim.z;
    unsigned sum, cnt, mine, sp = 0u;
    for (;;) {
        sum = 0u; cnt = 0u; mine = 0u;
#pragma unroll
        for (unsigned j = 0; j < 16; ++j) { const unsigned c = xb_ld(&bar[XB_XCNT(j)]); sum += c; cnt += (c > 0u) ? 1u : 0u; mine = (j == x) ? c : mine; }
        if (sum == G) break;
        __builtin_amdgcn_s_sleep(1);
        if ((++sp & 255u) == 0u) { if (xb_ld(&bar[XB_TMO])) break; if (sp > XB_SPIN_CAP) { atomicAdd(&bar[XB_TMO], 1u); break; } }
    }
    nloc = mine > 0u ? mine : 1u; nx = cnt > 0u ? cnt : 1u;
}
__device__ __forceinline__ void xcd_barrier(const XcdBarrier& b) {
    asm volatile("s_waitcnt vmcnt(0)" ::: "memory");
    __syncthreads();
    if (threadIdx.x == 0) {
        unsigned bx = b.x; size_t bz_ = 0; asm volatile("" : "+s"(bz_), "+s"(bx)); unsigned* bar = b.bar + bz_;
        __builtin_amdgcn_s_waitcnt(0);
        unsigned nloc = b.st[0], nx = b.st[1];
        if (nloc == 0u) { xcd_barrier_complete(bar, bx, nloc, nx); b.st[0] = nloc; b.st[1] = nx; }
        const unsigned old = xb_add(&bar[XB_XSUB(bx)], 1u);
        const unsigned gen = old / nloc;
        if (old + 1u == (gen + 1u) * nloc) {
            __builtin_amdgcn_fence(__ATOMIC_RELEASE, "agent");
            asm volatile("s_waitcnt vmcnt(0)" ::: "memory");
            const unsigned og = xb_add(&bar[XB_TOP], 1u);
            const unsigned tg = og / nx;
            if (og + 1u == (tg + 1u) * nx) xb_add(&bar[XB_TOPGEN], 1u);
            else XB_SPIN(xb_ld(&bar[XB_TOPGEN]) == tg, bar);
            __builtin_amdgcn_fence(__ATOMIC_ACQUIRE, "agent");
            xb_add(&bar[XB_XGEN(bx)], 1u);
            asm volatile("s_waitcnt vmcnt(0)" ::: "memory");
        } else {
            XB_SPIN(xb_ld(&bar[XB_XGEN(bx)]) == gen, bar);
            __builtin_amdgcn_fence(__ATOMIC_ACQUIRE, "agent");
            asm volatile("s_waitcnt vmcnt(0)" ::: "memory");
        }
    }
    __syncthreads();
}

__device__ __forceinline__ float wave_sum(float v, int lane) {
#pragma unroll
    for (int o = 1; o < 64; o <<= 1) v += __builtin_bit_cast(float, __builtin_amdgcn_ds_bpermute((lane ^ o) << 2, __builtin_bit_cast(int, v)));
    return v;
}
__device__ __forceinline__ double lane_up_d(double v, int lane, int o) {
    const int src = (lane >= o ? lane - o : lane) << 2; const unsigned long long u = __builtin_bit_cast(unsigned long long, v);
    const unsigned lo = (unsigned)__builtin_amdgcn_ds_bpermute(src, (int)(unsigned)u), hi = (unsigned)__builtin_amdgcn_ds_bpermute(src, (int)(unsigned)(u >> 32));
    return __builtin_bit_cast(double, ((unsigned long long)hi << 32) | lo);
}
__device__ __forceinline__ void wconv_item(const float* W, int ldw, int src, int valid, const float* kscale, bf16* dst, int K, int k0, LAS float* scr, int lane) {
    const int j = lane & 31; const bool ok = j < valid;
    float wv[32];
#pragma unroll
    for (int i = 0; i < 32; ++i) { const int kk = 2 * i + (lane >> 5); wv[i] = ok ? W[(size_t)(k0 + kk) * ldw + src + j] : 0.f; }
    if (kscale) {
#pragma unroll
        for (int i = 0; i < 32; ++i) wv[i] *= kscale[k0 + 2 * i + (lane >> 5)]; }
#pragma unroll
    for (int i = 0; i < 32; ++i) scr[(2 * i + (lane >> 5)) * 33 + j] = wv[i];
    LDS_WAIT(); asm volatile("" ::: "memory");
    const int c = lane & 7;
#pragma unroll
    for (int jj = 0; jj < 4; ++jj) { const int n = (lane >> 3) + 8 * jj; const LAS float* s = scr + (8 * c) * 33 + n;
        v4u o; o.x = pk2(s[0 * 33], s[1 * 33]); o.y = pk2(s[2 * 33], s[3 * 33]); o.z = pk2(s[4 * 33], s[5 * 33]); o.w = pk2(s[6 * 33], s[7 * 33]);
        *(v4u*)(dst + (size_t)n * K + k0 + 8 * c) = o; }
    LDS_WAIT(); asm volatile("" ::: "memory");
}
__device__ __forceinline__ void inproj_src(int g, int& src, int& valid) {
    const int n = g * 32; valid = 32;
    if (n < 2304) src = n;
    else if (n < 2816) src = 2310 + (n - 2304);
    else if (n < 3072) src = 2822 + (n - 2816);
    else if (n < 3328) { const int p = n - 3072; if (p == 0) src = 3078; else if (p == 32) { src = 2304; valid = 6; } else if (p == 128) src = 3110; else { src = 0; valid = 0; } }
    else if (n < 4352) { const int base = (n < 3840) ? 3142 : 3654; const int p = (n < 3840) ? n - 3328 : n - 3840; const int t = p >> 8, q = p & 255, bj = q >> 7, x = q & 127, hh = x >> 6, i = x & 63;
        src = base + 128 * (2 * t + hh) + 64 * bj + i; }
    else if (n < 5376) src = 4166 + (n - 4352);
    else if (n < 6400) src = 5190 + (n - 5376);
    else src = 6214 + (n - 6400);
}
__device__ __forceinline__ void uq_src(int g, int& src, int& valid) {
    const int n = g * 32; valid = 32;
    if (n < 768) { const int t = n >> 8, q = n & 255, bj = q >> 7, x = q & 127; src = 192 * (2 * t + bj) + x; }
    else { const int t4 = (n >= 1024) ? 1 : 0; const int q = n - 768 - 256 * t4, bj = q >> 7, x = q & 127, hh = (x >> 5) + 4 * t4; if (hh < 6) src = 192 * hh + 128 + 32 * bj; else { src = 0; valid = 0; } }
}

struct Args {
    const float* in[19]; float* out; unsigned char* ws;
    float invf128[64]; float invf64[32];
    int ph_lo, ph_hi;
};

static_assert(sizeof(Args) == 560, "Args layout");

#define KAS __attribute__((address_space(4)))
#define GAS1 __attribute__((address_space(1)))
__device__ __forceinline__ const KAS char* karg_base() { size_t z = 0; asm volatile("" : "+s"(z)); return (const KAS char*)__builtin_amdgcn_kernarg_segment_ptr() + z; }
__device__ __forceinline__ const float* arg_in(int i) { typedef const GAS1 float* gp; return (const float*)(*(const KAS gp*)(karg_base() + 8 * i)); }
__device__ __forceinline__ float* arg_out() { typedef GAS1 float* gp; return (float*)(*(const KAS gp*)(karg_base() + 152)); }
__device__ __forceinline__ unsigned char* arg_ws() { typedef GAS1 unsigned char* gp; return (unsigned char*)(*(const KAS gp*)(karg_base() + 160)); }
__device__ __forceinline__ float arg_invf128(int i) { return *(const KAS float*)(karg_base() + 168 + 4 * i); }
__device__ __forceinline__ float arg_invf64(int i) { return *(const KAS float*)(karg_base() + 424 + 4 * i); }
struct Ctx { int tid, lane, wave, G, vcu, gw, NGW; LAS unsigned char* lds; unsigned char* ws; };
__device__ __forceinline__ Ctx ctx_local(const Ctx& C0) { Ctx C = C0; int t_ = threadIdx.x; asm volatile("" : "+v"(t_)); C.tid = t_; C.lane = t_ & 63; size_t z_ = 0; asm volatile("" : "+s"(C.wave), "+s"(C.gw), "+s"(C.vcu), "+s"(z_)); C.ws = arg_ws() + z_; return C; }

constexpr int XPITCH = 4096;
__device__ __forceinline__ void cvt8(const v4u w, float (&v)[8]) {
    v[0] = __uint_as_float(w.x << 16); v[1] = __uint_as_float(w.x & 0xffff0000u); v[2] = __uint_as_float(w.y << 16); v[3] = __uint_as_float(w.y & 0xffff0000u);
    v[4] = __uint_as_float(w.z << 16); v[5] = __uint_as_float(w.z & 0xffff0000u); v[6] = __uint_as_float(w.w << 16); v[7] = __uint_as_float(w.w & 0xffff0000u); }
__device__ __forceinline__ void rows_rmsnorm_first(const Ctx& C0, const float* x, const float* gain, bf16* xb, bf16* out) { const Ctx C = ctx_local(C0);
    f32x4 g[8];
#pragma unroll
    for (int j = 0; j < 8; ++j) g[j] = ((const f32x4*)gain + C.lane)[64 * j];
    for (int m = C.gw; m < M; m += 2 * C.NGW) {
        const int m2 = m + C.NGW; const bool has2 = m2 < M;
        const f32x4* xa = (const f32x4*)(x + (size_t)m * DM) + C.lane; const f32x4* xq = (const f32x4*)(x + (size_t)(has2 ? m2 : m) * DM) + C.lane;
        f32x4 va[8], vb[8]; float sa = 0.f, sb = 0.f;
#pragma unroll
        for (int j = 0; j < 8; ++j) va[j] = xa[64 * j];
#pragma unroll
        for (int j = 0; j < 8; ++j) vb[j] = xq[64 * j];
#pragma unroll
        for (int j = 0; j < 8; ++j) { sa += (va[j].x * va[j].x + va[j].y * va[j].y) + (va[j].z * va[j].z + va[j].w * va[j].w); sb += (vb[j].x * vb[j].x + vb[j].y * vb[j].y) + (vb[j].z * vb[j].z + vb[j].w * vb[j].w); }
        const float ra = __builtin_amdgcn_rsqf(wave_sum(sa, C.lane) * (1.0f / DM) + NORM_EPS), rb = __builtin_amdgcn_rsqf(wave_sum(sb, C.lane) * (1.0f / DM) + NORM_EPS);
        unsigned long long* oa = (unsigned long long*)(out + (size_t)m * DM) + C.lane; unsigned long long* ya = (unsigned long long*)(xb + (size_t)m * XPITCH) + C.lane;
#pragma unroll
        for (int j = 0; j < 8; ++j) { oa[64 * j] = (unsigned long long)pk2(va[j].x * ra * g[j].x, va[j].y * ra * g[j].y) | ((unsigned long long)pk2(va[j].z * ra * g[j].z, va[j].w * ra * g[j].w) << 32);
            ya[64 * j] = (unsigned long long)pk2(va[j].x, va[j].y) | ((unsigned long long)pk2(va[j].z, va[j].w) << 32); }
        if (has2) { unsigned long long* ob = (unsigned long long*)(out + (size_t)m2 * DM) + C.lane; unsigned long long* yb = (unsigned long long*)(xb + (size_t)m2 * XPITCH) + C.lane;
#pragma unroll
            for (int j = 0; j < 8; ++j) { ob[64 * j] = (unsigned long long)pk2(vb[j].x * rb * g[j].x, vb[j].y * rb * g[j].y) | ((unsigned long long)pk2(vb[j].z * rb * g[j].z, vb[j].w * rb * g[j].w) << 32);
                yb[64 * j] = (unsigned long long)pk2(vb[j].x, vb[j].y) | ((unsigned long long)pk2(vb[j].z, vb[j].w) << 32); } }
    }
}
__device__ __forceinline__ void rows_rmsnorm_bf16(const Ctx& C0, const bf16* xb, const float* gain, bf16* out) { const Ctx C = ctx_local(C0);
    f32x4 g[4][2];
#pragma unroll
    for (int j = 0; j < 4; ++j) { g[j][0] = *(const f32x4*)(gain + 8 * (C.lane + 64 * j)); g[j][1] = *(const f32x4*)(gain + 8 * (C.lane + 64 * j) + 4); }
    for (int m0 = C.gw; m0 < M; m0 += 4 * C.NGW) {
        v4u w[4][4];
#pragma unroll
        for (int q = 0; q < 4; ++q) { const int m = m0 + q * C.NGW; const v4u* xr = (const v4u*)(xb + (size_t)(m < M ? m : m0) * XPITCH) + C.lane;
#pragma unroll
            for (int j = 0; j < 4; ++j) w[q][j] = xr[64 * j]; }
#pragma unroll
        for (int q = 0; q < 4; ++q) { const int m = m0 + q * C.NGW; float s = 0.f;
#pragma unroll
            for (int j = 0; j < 4; ++j) { float v[8]; cvt8(w[q][j], v);
#pragma unroll
                for (int e = 0; e < 8; ++e) s += v[e] * v[e]; }
            const float r = __builtin_amdgcn_rsqf(wave_sum(s, C.lane) * (1.0f / DM) + NORM_EPS);
            if (m < M) { v4u* orow = (v4u*)(out + (size_t)m * DM) + C.lane;
#pragma unroll
                for (int j = 0; j < 4; ++j) { float v[8]; cvt8(w[q][j], v);
                    v4u o; o.x = pk2(v[0] * r * g[j][0][0], v[1] * r * g[j][0][1]); o.y = pk2(v[2] * r * g[j][0][2], v[3] * r * g[j][0][3]); o.z = pk2(v[4] * r * g[j][1][0], v[5] * r * g[j][1][1]); o.w = pk2(v[6] * r * g[j][1][2], v[7] * r * g[j][1][3]);
                    orow[64 * j] = o; } } }
    }
}
__device__ __forceinline__ void rows_rmsnorm_final(const Ctx& C0, float* outp, const float* gain) { const Ctx C = ctx_local(C0);
    f32x4 g[4][2];
#pragma unroll
    for (int j = 0; j < 4; ++j) { g[j][0] = *(const f32x4*)(gain + 8 * (C.lane + 64 * j)); g[j][1] = *(const f32x4*)(gain + 8 * (C.lane + 64 * j) + 4); }
    for (int m0 = C.gw; m0 < M; m0 += 4 * C.NGW) {
        v4u w[4][4];
#pragma unroll
        for (int q = 0; q < 4; ++q) { const int m = m0 + q * C.NGW; const v4u* xr = (const v4u*)((const bf16*)outp + (size_t)(m < M ? m : m0) * XPITCH) + C.lane;
#pragma unroll
            for (int j = 0; j < 4; ++j) w[q][j] = xr[64 * j]; }
        asm volatile("s_waitcnt vmcnt(0)" ::: "memory");
#pragma unroll
        for (int q = 0; q < 4; ++q) { const int m = m0 + q * C.NGW; float s = 0.f;
#pragma unroll
            for (int j = 0; j < 4; ++j) { float v[8]; cvt8(w[q][j], v);
#pragma unroll
                for (int e = 0; e < 8; ++e) s += v[e] * v[e]; }
            const float r = __builtin_amdgcn_rsqf(wave_sum(s, C.lane) * (1.0f / DM) + NORM_EPS);
            if (m < M) { float* orow = outp + (size_t)m * DM + 8 * C.lane;
#pragma unroll
                for (int j = 0; j < 4; ++j) { float v[8]; cvt8(w[q][j], v);
                    *(f32x4*)(orow + 512 * j) = (f32x4){v[0] * r * g[j][0][0], v[1] * r * g[j][0][1], v[2] * r * g[j][0][2], v[3] * r * g[j][0][3]};
                    *(f32x4*)(orow + 512 * j + 4) = (f32x4){v[4] * r * g[j][1][0], v[5] * r * g[j][1][1], v[6] * r * g[j][1][2], v[7] * r * g[j][1][3]}; } } }
    }
}
__device__ __forceinline__ void sincos_d(float angf, float& co, float& si) {
    const double a = (double)angf; const double k = __builtin_rint(a * 0.15915494309189535); double r = a - k * 6.283185307179586477;
    const double q = __builtin_rint(r * 0.63661977236758134308); const double y = r - q * 1.57079632679489661923; const double y2 = y * y;
    const double sy = y * (1.0 + y2 * (-1.0 / 6 + y2 * (1.0 / 120 + y2 * (-1.0 / 5040 + y2 * (1.0 / 362880 + y2 * (-1.0 / 39916800 + y2 * (1.0 / 6227020800.0)))))));
    const double cy = 1.0 + y2 * (-0.5 + y2 * (1.0 / 24 + y2 * (-1.0 / 720 + y2 * (1.0 / 40320 + y2 * (-1.0 / 3628800 + y2 * (1.0 / 479001600 + y2 * (-1.0 / 87178291200.0)))))));
    const int qi = ((int)q) & 3;
    const double s = (qi == 0) ? sy : (qi == 1) ? cy : (qi == 2) ? -sy : -cy;
    const double c = (qi == 0) ? cy : (qi == 1) ? -sy : (qi == 2) ? -cy : sy;
    co = (float)c; si = (float)s;
}
__device__ __forceinline__ void rope_tables(const Ctx& C0, const Args& A) { const Ctx C = ctx_local(C0);
    float* T128 = (float*)(C.ws + WS_T128); float* T64 = (float*)(C.ws + WS_T64);
    const int gt = (C.vcu * NWAVES + C.wave) * 64 + C.lane, NGT = C.NGW * 64;
    for (int e = gt; e < SEQ * 64; e += NGT) { const int pos = e >> 6, i = e & 63; float c, s; sincos_d((float)pos * arg_invf128(i), c, s); T128[2 * e] = c; T128[2 * e + 1] = s; }
    for (int e = gt; e < SEQ * 32; e += NGT) { const int pos = e >> 5, i = e & 31; float c, s; sincos_d((float)pos * arg_invf64(i), c, s); T64[2 * e] = c; T64[2 * e + 1] = s; }
}
__device__ __forceinline__ void p0_phase(const Ctx& C0, const Args& A, int layer) { const Ctx C = ctx_local(C0);
    LAS float* scr = (LAS float*)(C.lds + RING_OFF + C.wave * 16384);
    const float* w_in = arg_in(2) + (size_t)layer * DM * IN_W;
    const float* w_uq = arg_in(5) + (size_t)layer * 512 * 1152; const float* w_ukv = arg_in(6) + (size_t)layer * 256 * 1536;
    const float* qg = arg_in(3) + (size_t)layer * 512; const float* kvg = arg_in(4) + (size_t)layer * 256;
    const float* w_bf = arg_in(8) + (size_t)layer * 768 * DM; const float* w_bm = arg_in(9) + (size_t)layer * 768 * DM; const float* w_br = arg_in(10) + (size_t)layer * 1024 * DM;
    const float* w_out = arg_in(11) + (size_t)layer * DM * DM;
    const float* w_up = arg_in(13) + (size_t)layer * DM * DFF; const float* w_gate = arg_in(14) + (size_t)layer * DM * DFF; const float* w_dn = arg_in(17) + (size_t)layer * DFF * DM;
    bf16* Wb = (bf16*)(C.ws + WS_W);
    constexpr int I_IN = (NIN / 32) * (DM / 64), I_UQ = (NUQ / 32) * (512 / 64), I_UKV = (NUKV / 32) * (256 / 64), I_BF = (DM / 32) * (768 / 64), I_BR = (DM / 32) * (1024 / 64),
                  I_OUT = (DM / 32) * (DM / 64), I_UG = (NUG / 32) * (DM / 64), I_DN = (DM / 32) * (DFF / 64);
    constexpr int NITEMS = I_IN + I_UQ + I_UKV + 2 * I_BF + I_BR + I_OUT;
    for (int it = C.gw; it < NITEMS; it += C.NGW) {
        int r = it, src, valid;
        if (r < I_IN) { const int g = r / (DM / 64), kb = r % (DM / 64); inproj_src(g, src, valid); wconv_item(w_in, IN_W, src, valid, nullptr, (bf16*)((char*)Wb + WO_IN) + (size_t)g * 32 * DM, DM, kb * 64, scr, C.lane); continue; } r -= I_IN;
        if (r < I_UQ) { const int g = r / 8, kb = r % 8; uq_src(g, src, valid); wconv_item(w_uq, 1152, src, valid, qg, (bf16*)((char*)Wb + WO_UQ) + (size_t)g * 32 * 512, 512, kb * 64, scr, C.lane); continue; } r -= I_UQ;
        if (r < I_UKV) { const int g = r / 4, kb = r % 4; wconv_item(w_ukv, 1536, g * 32, 32, kvg, (bf16*)((char*)Wb + WO_UKV) + (size_t)g * 32 * 256, 256, kb * 64, scr, C.lane); continue; } r -= I_UKV;
        if (r < I_BF) { const int g = r / 12, kb = r % 12; wconv_item(w_bf, DM, g * 32, 32, nullptr, (bf16*)((char*)Wb + WO_BF) + (size_t)g * 32 * 1024, 1024, kb * 64, scr, C.lane); continue; } r -= I_BF;
        if (r < I_BF) { const int g = r / 12, kb = r % 12; wconv_item(w_bm, DM, g * 32, 32, nullptr, (bf16*)((char*)Wb + WO_BM) + (size_t)g * 32 * 1024, 1024, kb * 64, scr, C.lane); continue; } r -= I_BF;
        if (r < I_BR) { const int g = r / 16, kb = r % 16; wconv_item(w_br, DM, g * 32, 32, nullptr, (bf16*)((char*)Wb + WO_BR) + (size_t)g * 32 * 1024, 1024, kb * 64, scr, C.lane); continue; } r -= I_BR;
        if (r < I_OUT) { const int g = r / 32, kb = r % 32; wconv_item(w_out, DM, g * 32, 32, nullptr, (bf16*)((char*)Wb + WO_OUT) + (size_t)g * 32 * DM, DM, kb * 64, scr, C.lane); }
    }
    if (layer == 0) rows_rmsnorm_first(C, arg_in(0), arg_in(1), (bf16*)arg_out(), (bf16*)(C.ws + WS_H));
    else rows_rmsnorm_bf16(C, (const bf16*)arg_out(), arg_in(1) + (size_t)layer * DM, (bf16*)(C.ws + WS_H));
}
__device__ __forceinline__ void wconv_ffn(const Ctx& C0, int layer, int first, int nblk) { const Ctx C = ctx_local(C0);
    LAS float* scr = (LAS float*)(C.lds + RING_OFF + C.wave * 16384);
    const float* w_up = arg_in(13) + (size_t)layer * DM * DFF; const float* w_gate = arg_in(14) + (size_t)layer * DM * DFF; const float* w_dn = arg_in(17) + (size_t)layer * DFF * DM;
    bf16* Wb = (bf16*)(C.ws + WS_W);
    constexpr int I_UG = (NUG / 32) * (DM / 64), I_DN = (DM / 32) * (DFF / 64);
    for (int it = first * NWAVES + C.wave; it < I_UG + I_DN; it += nblk * NWAVES) {
        int r = it;
        if (r < I_UG) { const int g = r / 32, kb = r % 32; const int n = g * 32, t = n >> 8, bj = (n >> 7) & 1, x = n & 127;
            wconv_item(bj ? w_gate : w_up, DFF, 128 * t + x, 32, nullptr, (bf16*)((char*)Wb + WO_UG) + (size_t)g * 32 * DM, DM, kb * 64, scr, C.lane); continue; } r -= I_UG;
        { const int g = r / 88, kb = r % 88; wconv_item(w_dn, DM, g * 32, 32, nullptr, (bf16*)((char*)Wb + WO_DN) + (size_t)g * 32 * DFF, DFF, kb * 64, scr, C.lane); }
    }
}
__device__ __forceinline__ void p2_phase(const Ctx& C0, const Args& A, int layer) { const Ctx C = ctx_local(C0);
    const float* ff = (const float*)(C.ws + WS_FF); float* cL = (float*)(C.ws + WS_CL);
    LAS double* red = (LAS double*)(C.lds + RING_OFF);
    for (int sq = C.vcu; sq < NBATCH * 6; sq += C.G) {
        const int b = sq / 6, h = sq % 6; const float bias = arg_in(7)[layer * 6 + h];
        double v[8]; double run = 0.0;
#pragma unroll
        for (int j = 0; j < 8; ++j) { const float xf = ff[((size_t)b * SEQ + C.tid * 8 + j) * 8 + h] + bias;
            const float ls = fminf(xf, 0.f) - 0.6931471805599453f * __builtin_amdgcn_logf(1.0f + __builtin_amdgcn_exp2f(-1.4426950408889634f * fabsf(xf)));
            run += (double)ls; v[j] = run; }
        double incl = run;
#pragma unroll
        for (int o = 1; o < 64; o <<= 1) { const double t = lane_up_d(incl, C.lane, o); if (C.lane >= o) incl += t; }
        __syncthreads();
        if (C.lane == 63) red[C.wave] = incl;
        __syncthreads();
        double base = incl - run;
        for (int w = 0; w < C.wave; ++w) base += red[w];
        float* dst = cL + (size_t)sq * SEQ + C.tid * 8;
#pragma unroll
        for (int j = 0; j < 8; ++j) dst[j] = (float)((base + v[j]) * 1.4426950408889634);
    }
    const bf16* cq = (const bf16*)(C.ws + WS_CQ); const bf16* ckv = (const bf16*)(C.ws + WS_CKV); float* rq = (float*)(C.ws + WS_RSQ); float* rkv = (float*)(C.ws + WS_RSKV);
    for (int m0 = C.gw; m0 < M; m0 += 4 * C.NGW) {
        v4u a[4], c[4];
#pragma unroll
        for (int q = 0; q < 4; ++q) { const int m = m0 + q * C.NGW; const int mm = m < M ? m : m0; a[q] = *((const v4u*)(cq + (size_t)mm * 512) + C.lane); c[q] = *((const v4u*)(ckv + (size_t)mm * 256) + (C.lane & 31)); }
#pragma unroll
        for (int q = 0; q < 4; ++q) { const int m = m0 + q * C.NGW;
            float s = 0.f, s2 = 0.f; const unsigned w[4] = {a[q].x, a[q].y, a[q].z, a[q].w}, w2[4] = {c[q].x, c[q].y, c[q].z, c[q].w};
#pragma unroll
            for (int j = 0; j < 4; ++j) { const float lo = __uint_as_float(w[j] << 16), hi = __uint_as_float(w[j] & 0xffff0000u); s += lo * lo + hi * hi;
                const float lo2 = __uint_as_float(w2[j] << 16), hi2 = __uint_as_float(w2[j] & 0xffff0000u); if (C.lane < 32) s2 += lo2 * lo2 + hi2 * hi2; }
            s = wave_sum(s, C.lane); s2 = wave_sum(s2, C.lane);
            if (C.lane == 0 && m < M) { rq[m] = __builtin_amdgcn_rsqf(s * (1.0f / 512.0f) + NORM_EPS); rkv[m] = __builtin_amdgcn_rsqf(s2 * (1.0f / 256.0f) + NORM_EPS); } }
    }
    { const bf16* rk = (const bf16*)(C.ws + WS_RK); const bf16* rv = (const bf16*)(C.ws + WS_RV); float* sloc = (float*)(C.ws + WS_SLOC);
      for (int u = C.vcu; u < NBATCH * 4 * 16; u += C.G) { const int k = u & 15, h = (u >> 4) & 3, b = u >> 6; const size_t row0 = (size_t)b * SEQ + 256 * k;
          att::ret_state_unit(rk + row0 * 512 + 128 * h, 512, rv + row0 * 1024 + 256 * h, 1024, __builtin_amdgcn_logf(1.0f - __builtin_amdgcn_exp2f(-5.0f - (float)h)), sloc + (size_t)u * 32768, (LAS char*)(C.lds + RING_OFF)); } }
}
__device__ __forceinline__ void ret_scan(const Ctx& C0) { const Ctx C = ctx_local(C0);
    const float* sloc = (const float*)(C.ws + WS_SLOC); bf16* sst = (bf16*)(C.ws + WS_SST);
    for (int it = C.gw * 64 + C.lane; it < NBATCH * 4 * 8192; it += C.NGW * 64) {
        const int bh = it >> 13, e4 = (it & 8191) * 4, h = bh & 3;
        const float g256 = __builtin_amdgcn_exp2f(256.0f * __builtin_amdgcn_logf(1.0f - __builtin_amdgcn_exp2f(-5.0f - (float)h)));
        f32x4 s = {0.f, 0.f, 0.f, 0.f};
        f32x4 l[16];
#pragma unroll
        for (int k = 0; k < 15; ++k) l[k] = *(const f32x4*)(sloc + ((size_t)bh * 16 + k) * 32768 + e4);
#pragma unroll
        for (int k = 0; k < 16; ++k) { const size_t o = ((size_t)bh * 16 + k) * 32768 + e4;
            *(unsigned long long*)(sst + o) = (unsigned long long)pk2(s[0], s[1]) | ((unsigned long long)pk2(s[2], s[3]) << 32);
            if (k < 15) s = s * g256 + l[k]; }
    }
}
__device__ __forceinline__ void p9_phase(const Ctx& C0, const Args& A, int layer) { const Ctx C = ctx_local(C0);
    const float* utail = (const float*)(C.ws + WS_UTAIL); const float* uhead = (const float*)(C.ws + WS_UHEAD); const float* ghead = (const float*)(C.ws + WS_GHEAD); bf16* act = (bf16*)(C.ws + WS_ACT);
    const float* cw = arg_in(15) + (size_t)layer * 3 * DFF; const float* cb = arg_in(16) + (size_t)layer * DFF;
    constexpr int NCH = DFF / 8, NITEM = (M / 256) * 2 * NCH;
    for (int it = C.gw * 64 + C.lane; it < NITEM; it += C.NGW * 64) {
        const int ch = it % NCH, rr = (it / NCH) & 1, pm = it / (2 * NCH), f0 = ch * 8;
        if ((pm & 15) == 0) continue;
        const float* p2 = rr ? utail + ((size_t)(pm - 1) * 2 + 1) * DFF : utail + ((size_t)(pm - 1) * 2) * DFF;
        const float* p1 = rr ? uhead + ((size_t)pm * 2) * DFF : utail + ((size_t)(pm - 1) * 2 + 1) * DFF;
        const float* p0 = uhead + ((size_t)pm * 2 + rr) * DFF; const float* pg = ghead + ((size_t)pm * 2 + rr) * DFF;
        unsigned o[4];
#pragma unroll
        for (int h = 0; h < 2; ++h) { const f32x4 x2 = *(const f32x4*)(p2 + f0 + 4 * h), x1 = *(const f32x4*)(p1 + f0 + 4 * h), x0 = *(const f32x4*)(p0 + f0 + 4 * h), g = *(const f32x4*)(pg + f0 + 4 * h);
            const f32x4 a = *(const f32x4*)(cw + f0 + 4 * h), b = *(const f32x4*)(cw + DFF + f0 + 4 * h), c = *(const f32x4*)(cw + 2 * DFF + f0 + 4 * h), d = *(const f32x4*)(cb + f0 + 4 * h);
            float r[4];
#pragma unroll
            for (int j = 0; j < 4; ++j) r[j] = pg8::gelu_gate(d[j] + a[j] * x2[j] + b[j] * x1[j] + c[j] * x0[j], g[j]);
            o[2 * h] = pg8::cvt_pk_bf16(r[0], r[1]); o[2 * h + 1] = pg8::cvt_pk_bf16(r[2], r[3]); }
        *(v4u*)(act + (size_t)(pm * 256 + rr) * DFF + f0) = (v4u){o[0], o[1], o[2], o[3]};
    }
}
#ifndef PROBE_SKIP_EPI
#define PROBE_SKIP_EPI 0
#endif
#ifndef KIND_MASK
#define KIND_MASK 7
#endif

__device__ __forceinline__ int queue_next(unsigned* head, volatile LAS unsigned* slot) {
    __syncthreads();
    if (threadIdx.x == 0) *slot = __hip_atomic_fetch_add(head, 1u, __ATOMIC_RELAXED, __HIP_MEMORY_SCOPE_AGENT);
    __syncthreads();
    return (int)*slot;
}
__device__ __forceinline__ void p4_phase(const Ctx& C0, const Args& A, int layer, volatile LAS unsigned* slot, int rep) { const Ctx C = ctx_local(C0);
    unsigned* qh = (unsigned*)(C.ws + WS_CTL) + CW_QUEUE + 64 * 3 * layer + 64 * 12 * rep;
    const bool k0 = rep == 0 || (KIND_MASK & 1), k1 = rep == 0 || (KIND_MASK & 2), k2 = rep == 0 || (KIND_MASK & 4);
    LAS char* lds = (LAS char*)(C.lds + RING_OFF);
    const bf16* fqkv = (const bf16*)(C.ws + WS_FQKV); const float* cL = (const float*)(C.ws + WS_CL);
    const bf16* qm = (const bf16*)(C.ws + WS_QM); const bf16* kvm = (const bf16*)(C.ws + WS_KVM); const bf16* kr = (const bf16*)(C.ws + WS_KR);
    const bf16* rq = (const bf16*)(C.ws + WS_RQ); const bf16* rk = (const bf16*)(C.ws + WS_RK); const bf16* rv = (const bf16*)(C.ws + WS_RV); const bf16* rg = (const bf16*)(C.ws + WS_RG);
    bf16* oa = (bf16*)(C.ws + WS_A); bf16* ob = (bf16*)(C.ws + WS_BM); bf16* oc = (bf16*)(C.ws + WS_C);
    if (k2) for (;;) { const int i = queue_next(qh + 128, slot); if (i >= 1024) break;
        const int qb = 31 - i / 32, bh = i % 32, b = bh >> 2, h = bh & 3; const size_t row0 = (size_t)b * SEQ + 128 * qb, seq0 = (size_t)b * SEQ;
        att::UnitPtrs U; U.Q = rq + row0 * 512 + 128 * h; U.ldq = 512; U.K = rk + seq0 * 512 + 128 * h; U.ldk = 512; U.V = rv + seq0 * 1024 + 256 * h; U.ldv = 1024; U.KR = nullptr; U.bias = nullptr;
        U.G = rg + row0 * 1024 + 256 * h; U.O = oc + row0 * 1024 + 256 * h; U.ldo = 1024; U.P0 = 128 * qb; U.T0 = 256 * (qb >> 1);
        U.ST = (qb >> 1) ? (const bf16*)(C.ws + WS_SST) + ((size_t)bh * 16 + (qb >> 1)) * 32768 : nullptr; U.c2 = __builtin_amdgcn_logf(1.0f - __builtin_amdgcn_exp2f(-5.0f - (float)h));
        att::mixer_unit<2>(U, lds); }
    if (k1) for (;;) { const int i = queue_next(qh + 64, slot); if (i >= 768) break;
        const int qb = 15 - i / 48, bh = i % 48, b = bh / 6, h = bh % 6; const size_t row0 = (size_t)b * SEQ + 256 * qb, seq0 = (size_t)b * SEQ;
        att::UnitPtrs U; U.Q = qm + row0 * 1152 + 192 * h; U.ldq = 1152; U.K = kvm + seq0 * 1536 + 256 * h; U.ldk = 1536; U.V = U.K + 128; U.ldv = 1536; U.KR = kr + seq0 * 64; U.bias = nullptr; U.G = nullptr; U.ST = nullptr; U.T0 = 0;
        U.O = ob + row0 * 1024 + 128 * h; U.ldo = 1024; U.P0 = 256 * qb; U.c2 = 0.07216878364870322f * 1.4426950408889634f;
        att::mixer_unit<1>(U, lds); }
    if (k0) for (;;) { const int i = queue_next(qh, slot); if (i >= 768) break;
        const int qb = 15 - i / 48, bh = i % 48, b = bh / 6, h = bh % 6; const size_t row0 = (size_t)b * SEQ + 256 * qb, seq0 = (size_t)b * SEQ;
        att::UnitPtrs U; U.Q = fqkv + row0 * 2304 + 128 * h; U.ldq = 2304; U.K = fqkv + seq0 * 2304 + 768 + 128 * h; U.ldk = 2304; U.V = U.K + 768; U.ldv = 2304; U.KR = nullptr; U.G = nullptr; U.ST = nullptr; U.T0 = 0;
        U.bias = cL + (size_t)bh * SEQ; U.O = oa + row0 * 1024 + 128 * h; U.ldo = 1024; U.P0 = 256 * qb; U.c2 = 0.08838834764831845f * 1.4426950408889634f;
        att::mixer_unit<0>(U, lds); }
}

__global__ void __launch_bounds__(NWAVES * 64, 2) hyb_fwd(Args args) {
    extern __shared__ __attribute__((aligned(16))) unsigned char lds_raw[];
    Ctx C;
    C.lds = (LAS unsigned char*)lds_raw;
    volatile LAS unsigned* MISC = (volatile LAS unsigned*)(C.lds + MISC_OFF);
    C.tid = 0; C.lane = 0; C.wave = __builtin_amdgcn_readfirstlane((int)threadIdx.x >> 6);
    C.G = gridDim.x; { const int bx = blockIdx.x; C.vcu = (C.G % 8 == 0) ? (bx % 8) * (C.G / 8) + bx / 8 : bx; }
    C.gw = C.vcu * NWAVES + C.wave; C.NGW = C.G * NWAVES; C.ws = arg_ws();
    unsigned* ctl = (unsigned*)(C.ws + WS_CTL);
    for (int u = threadIdx.x; u < (LDS_BYTES - LDSCTL_OFF) / 4; u += NWAVES * 64) ((LAS unsigned*)(C.lds + LDSCTL_OFF))[u] = 0u;
    __syncthreads();
#if MK_PER_PHASE
    XcdBarrier bar; bar.bar = ctl + CW_BAR; bar.x = 0; bar.st = nullptr; (void)bar;
#define GRID_BAR() do { } while (0)
#else
    XcdBarrier bar = xcd_barrier_post(ctl + CW_BAR, MISC + 8);
#define GRID_BAR() xcd_barrier(bar)
#endif
    const int lo = args.ph_lo, hi = args.ph_hi;
#define IN(k) (lo <= (k) && (k) < hi)
#ifndef PHASE_MASK
#define PHASE_MASK 0xFFFF
#endif
#define PHM(k) (((PHASE_MASK) >> (k)) & 1)
#ifndef SUB_MASK
#define SUB_MASK 0xFF
#endif
#define SUBM(k) (((SUB_MASK) >> (k)) & 1)
#ifndef REPEAT_MASK
#define REPEAT_MASK 0
#endif
#define REPS(k) (1 + (((REPEAT_MASK) >> (k)) & 1))

#define SEAM(k) do { if (IN(k) && IN((k) + 1)) GRID_BAR(); } while (0)
    PG8_LAS unsigned char* ring = (PG8_LAS unsigned char*)(C.lds + RING_OFF);
    const int bid = (int)blockIdx.x;
    if (PHM(0) && IN(0)) rope_tables(C, args);
    for (int layer = 0; layer < DEPTH; ++layer) {
        const int p = layer * PH;
        _Pragma("unroll") for (int rep = 0; rep < REPS(0); ++rep) if (PHM(0) && IN(p + 0)) { p0_phase(C, args, layer); if (rep + 1 < REPS(0)) GRID_BAR(); else SEAM(p + 0); }
        _Pragma("unroll") for (int rep = 0; rep < REPS(1); ++rep) if (PHM(1) && IN(p + 1)) { size_t wz_ = 0; asm volatile("" : "+s"(wz_)); unsigned char* wsl = arg_ws() + wz_; pg8::bf16_t* Wb = (pg8::bf16_t*)(wsl + WS_W); pg8::bf16_t* Hb = (pg8::bf16_t*)(wsl + WS_H);
            pg8::Gemm g{Hb, (const pg8::bf16_t*)((char*)Wb + WO_IN), M, NIN, DM}; pg8::StaticOrder S; S.init(M, NIN, C.G, bid);
            pg8::EpiInProj E{wsl, WS_FQKV, WS_CQ, WS_CKV, WS_KR, WS_RQ, WS_RK, WS_RV, WS_RG, WS_GATES, WS_FF, WS_T128, WS_T64, (rep + 1 < REPS(1)) ? PROBE_SKIP_EPI : 0};
            pg8::gemm_phase<pg8::EpiInProj, pg8::StaticOrder, true, true>(ring, g, S, E);
            { const int nfull = (M / 256) * (NIN / 256) % C.G; if (rep + 1 == REPS(1)) { if (nfull == 0) wconv_ffn(C, layer, bid, C.G); else if (bid >= nfull) wconv_ffn(C, layer, bid - nfull, C.G - nfull); } }
            if (rep + 1 < REPS(1)) GRID_BAR(); else SEAM(p + 1); }
        _Pragma("unroll") for (int rep = 0; rep < REPS(2); ++rep) if (PHM(2) && IN(p + 2)) { p2_phase(C, args, layer); if (rep + 1 < REPS(2)) GRID_BAR(); else SEAM(p + 2); }
        _Pragma("unroll") for (int rep = 0; rep < REPS(3); ++rep) if (PHM(3) && IN(p + 3)) { size_t wz_ = 0; asm volatile("" : "+s"(wz_)); unsigned char* wsl = arg_ws() + wz_; pg8::bf16_t* Wb = (pg8::bf16_t*)(wsl + WS_W); pg8::bf16_t* Hb = (pg8::bf16_t*)(wsl + WS_H);
            if (SUBM(0)) { pg8::Gemm g{(const pg8::bf16_t*)(wsl + WS_CQ), (const pg8::bf16_t*)((char*)Wb + WO_UQ), M, NUQ, 512}; pg8::StaticOrder S; S.init(M, NUQ, C.G, bid);
              pg8::EpiUq E{(pg8::bf16_t*)(wsl + WS_QM), (const float*)(wsl + WS_RSQ), (const float*)(wsl + WS_T64)};
              pg8::gemm_phase<pg8::EpiUq, pg8::StaticOrder, true, true>(ring, g, S, E); }
            if (SUBM(1)) { pg8::Gemm g{(const pg8::bf16_t*)(wsl + WS_CKV), (const pg8::bf16_t*)((char*)Wb + WO_UKV), M, NUKV, 256}; pg8::StaticOrder S; S.init(M, NUKV, C.G, bid);
              pg8::EpiUkv E{(pg8::bf16_t*)(wsl + WS_KVM), (const float*)(wsl + WS_RSKV)};
              pg8::gemm_phase<pg8::EpiUkv, pg8::StaticOrder, true, true>(ring, g, S, E); }
            ret_scan(C);
            if (rep + 1 < REPS(3)) GRID_BAR(); else SEAM(p + 3); }
        _Pragma("unroll") for (int rep = 0; rep < REPS(4); ++rep) if (PHM(4) && IN(p + 4)) { p4_phase(C, args, layer, MISC + 16, rep); if (rep + 1 < REPS(4)) GRID_BAR(); else SEAM(p + 4); }
        _Pragma("unroll") for (int rep = 0; rep < REPS(5); ++rep) if (PHM(5) && IN(p + 5)) { size_t wz_ = 0; asm volatile("" : "+s"(wz_)); unsigned char* wsl = arg_ws() + wz_; pg8::bf16_t* Wb = (pg8::bf16_t*)(wsl + WS_W); pg8::bf16_t* Hb = (pg8::bf16_t*)(wsl + WS_H);
            { static_assert(WS_BM - WS_A == WS_C - WS_BM && WO_BM - WO_BF == WO_BR - WO_BM, "equally spaced sub-GEMM operands");
              pg8::GemmM g{(const pg8::bf16_t*)(wsl + WS_A), (const pg8::bf16_t*)((char*)Wb + WO_BF), (WS_BM - WS_A) / 2, (WO_BM - WO_BF) / 2, 12, 4, 1024, 1024};
              pg8::StaticOrder3 S; S.init(M, DM, C.G, bid);
              pg8::EpiMergeM E{(const pg8::bf16_t*)(wsl + WS_GATES), Hb};
              pg8::gemm_phase_m<pg8::EpiMergeM, pg8::StaticOrder3, true, true>(ring, g, S, E); }
            if (rep + 1 < REPS(5)) GRID_BAR(); else SEAM(p + 5); }
        _Pragma("unroll") for (int rep = 0; rep < REPS(6); ++rep) if (PHM(6) && IN(p + 6)) { size_t wz_ = 0; asm volatile("" : "+s"(wz_)); unsigned char* wsl = arg_ws() + wz_; pg8::bf16_t* Wb = (pg8::bf16_t*)(wsl + WS_W); pg8::bf16_t* Hb = (pg8::bf16_t*)(wsl + WS_H);
            pg8::Gemm g{Hb, (const pg8::bf16_t*)((char*)Wb + WO_OUT), M, DM, DM}; pg8::StaticOrder S; S.init(M, DM, C.G, bid);
            pg8::EpiResid E{(pg8::bf16_t*)arg_out()}; pg8::gemm_phase<pg8::EpiResid, pg8::StaticOrder, true, true>(ring, g, S, E);
            if (rep + 1 < REPS(6)) GRID_BAR(); else SEAM(p + 6); }
        _Pragma("unroll") for (int rep = 0; rep < REPS(7); ++rep) if (PHM(7) && IN(p + 7)) { rows_rmsnorm_bf16(C, (const bf16*)arg_out(), arg_in(12) + (size_t)layer * DM, (bf16*)(C.ws + WS_H)); if (rep + 1 < REPS(7)) GRID_BAR(); else SEAM(p + 7); }
        _Pragma("unroll") for (int rep = 0; rep < REPS(8); ++rep) if (PHM(8) && IN(p + 8)) { size_t wz_ = 0; asm volatile("" : "+s"(wz_)); unsigned char* wsl = arg_ws() + wz_; pg8::bf16_t* Wb = (pg8::bf16_t*)(wsl + WS_W); pg8::bf16_t* Hb = (pg8::bf16_t*)(wsl + WS_H);
            pg8::Gemm g{Hb, (const pg8::bf16_t*)((char*)Wb + WO_UG), M, NUG, DM}; pg8::StaticOrder S; S.init(M, NUG, C.G, bid);
            pg8::EpiConvAct E{(pg8::bf16_t*)(wsl + WS_ACT), (float*)(wsl + WS_UTAIL), (float*)(wsl + WS_UHEAD), (float*)(wsl + WS_GHEAD), arg_in(15) + (size_t)layer * 3 * DFF, arg_in(16) + (size_t)layer * DFF, (PG8_LAS float*)(C.lds + LDSCTL_OFF + 1024)};
            pg8::gemm_phase<pg8::EpiConvAct, pg8::StaticOrder, true, true>(ring, g, S, E);
            if (rep + 1 < REPS(8)) GRID_BAR(); else SEAM(p + 8); }
        _Pragma("unroll") for (int rep = 0; rep < REPS(9); ++rep) if (PHM(9) && IN(p + 9)) { p9_phase(C, args, layer); if (rep + 1 < REPS(9)) GRID_BAR(); else SEAM(p + 9); }
        _Pragma("unroll") for (int rep = 0; rep < REPS(10); ++rep) if (PHM(10) && IN(p + 10)) { size_t wz_ = 0; asm volatile("" : "+s"(wz_)); unsigned char* wsl = arg_ws() + wz_; pg8::bf16_t* Wb = (pg8::bf16_t*)(wsl + WS_W); pg8::bf16_t* Hb = (pg8::bf16_t*)(wsl + WS_H);
            pg8::Gemm g{(const pg8::bf16_t*)(wsl + WS_ACT), (const pg8::bf16_t*)((char*)Wb + WO_DN), M, DM, DFF}; pg8::StaticOrder S; S.init(M, DM, C.G, bid);
            pg8::EpiResid E{(pg8::bf16_t*)arg_out()}; pg8::gemm_phase<pg8::EpiResid, pg8::StaticOrder, true, true>(ring, g, S, E);
            if (rep + 1 < REPS(10)) GRID_BAR(); else SEAM(p + 10); }
    }
    if (IN(DEPTH * PH)) rows_rmsnorm_final(C, arg_out(), arg_in(18));
#if defined(PROBE_EXTRA_BARRIERS) && !MK_PER_PHASE
    for (int i = 0; i < PROBE_EXTRA_BARRIERS; ++i) GRID_BAR();
#endif
#undef IN
#undef SEAM
#undef GRID_BAR
}

extern "C" void kernel_launch(void* const* d_in, const int* in_sizes, int n_in, void* d_out, int out_size, void* d_ws, size_t ws_size, hipStream_t stream) {
    static int grid = 0;
    if (grid == 0) {
        if (n_in != 19 || out_size != M * DM || ws_size < WS_END) { fprintf(stderr, "kernel_launch: unexpected problem (n_in %d, out %d, ws %zu < %zu); nothing launched\n", n_in, out_size, ws_size, (size_t)WS_END); grid = -1; return; }
        int dev = 0, cus = 0, per_cu = 0;
        if (hipGetDevice(&dev) != hipSuccess || hipDeviceGetAttribute(&cus, hipDeviceAttributeMultiprocessorCount, dev) != hipSuccess) { grid = -1; return; }
        if (hipFuncSetAttribute((const void*)hyb_fwd, hipFuncAttributeMaxDynamicSharedMemorySize, LDS_BYTES) != hipSuccess) { fprintf(stderr, "kernel_launch: hipFuncSetAttribute failed\n"); grid = -1; return; }
        if (hipOccupancyMaxActiveBlocksPerMultiprocessor(&per_cu, (const void*)hyb_fwd, NWAVES * 64, LDS_BYTES) != hipSuccess || per_cu < 1) { fprintf(stderr, "kernel_launch: occupancy query says %d\n", per_cu); }
        (void)hipGetLastError();
        grid = cus;
    }
    if (grid < 0) return;
    (void)in_sizes;
    if (hipMemsetAsync((char*)d_ws + WS_CTL, 0, CTL_ZERO_BYTES, stream) != hipSuccess) return;
    Args a; memset(&a, 0, sizeof(a));
    for (int i = 0; i < 19; ++i) a.in[i] = (const float*)d_in[i];
    a.out = (float*)d_out; a.ws = (unsigned char*)d_ws;
    for (int i = 0; i < 64; ++i) a.invf128[i] = (float)pow(10000.0, -(double)(2 * i) / 128.0);
    for (int i = 0; i < 32; ++i) a.invf64[i] = (float)pow(10000.0, -(double)(2 * i) / 64.0);
#if MK_PER_PHASE
    for (int ph = 0; ph < NPHASE; ++ph) { a.ph_lo = ph; a.ph_hi = ph + 1; hipLaunchKernelGGL(hyb_fwd, dim3(grid), dim3(NWAVES * 64), LDS_BYTES, stream, a); }
#else
    a.ph_lo = 0; a.ph_hi = NPHASE; hipLaunchKernelGGL(hyb_fwd, dim3(grid), dim3(NWAVES * 64), LDS_BYTES, stream, a);
#endif
    const hipError_t le = hipPeekAtLastError();
    if (le != hipSuccess) fprintf(stderr, "kernel_launch: launch failed: %s\n", hipGetErrorName(le));
}
```

```cpp
#include <hip/hip_runtime.h>
#include <cstdio>
#include <cstdint>
#include <cmath>
#ifndef MK_PER_PHASE
#define MK_PER_PHASE 0
#endif
#include <cstring>
namespace pg8 {
#define PG8_LAS __attribute__((address_space(3)))
typedef unsigned short bf16_t;
typedef short bf16x8 __attribute__((ext_vector_type(8)));
typedef float f32x4 __attribute__((ext_vector_type(4)));
typedef unsigned u32x4 __attribute__((ext_vector_type(4)));
constexpr int BM = 256, BK = 64, HALF = 128, HTB = HALF * BK * 2  , STAGE_BYTES = 8 * HTB, NXCD = 8, WGM = 8;

__host__ __device__ __forceinline__ int lds_byte(int r, int c) { const int st = (r >> 4) * 2 + (c >> 5), rr = r & 15, cc = c & 31, ob = rr * 64 + cc * 2; return st * 1024 + (ob ^ (((ob >> 9) & 1) << 5)); }
__host__ __device__ __forceinline__ void stage_rc(int b, int& R, int& C) { const int st = b / 1024, sb = b % 1024, swz = sb ^ (((sb >> 9) & 1) << 5); R = (st >> 1) * 16 + swz / 64; C = (st & 1) * 32 + (swz % 64) / 2; }
__host__ __device__ __forceinline__ int perm32(int rho) { const int n = rho >> 4, i = rho & 15; return 8 * (i >> 2) + 4 * n + (i & 3); }

struct Unit { int pm, pn; };
struct Gemm { const bf16_t* A; const bf16_t* Bt; int M, N, K; };

struct StaticOrder {
    int nM, nN, nwg, G, c;
    __host__ __device__ void init(int M, int N, int G_, int c_) { nM = M / BM; nN = N / BM; nwg = nM * nN; G = G_; c = c_; }
    __host__ __device__ bool next(int i, Unit& u) const {
        const long L = (long)i * G + c; if (L >= nwg) return false;
        int wgid = (int)L; { const int q = nwg / NXCD, r = nwg % NXCD, xcd = wgid % NXCD, off = wgid / NXCD; wgid = (xcd < r ? xcd * (q + 1) : r * (q + 1) + (xcd - r) * q) + off; }
        const int nig = WGM * nN, gid = wgid / nig, fm = gid * WGM, gsz = (nM - fm) < WGM ? (nM - fm) : WGM;
        u.pm = fm + ((wgid % nig) % gsz); u.pn = (wgid % nig) / gsz; return true;
    }
    __device__ __forceinline__ void a_ready(const Unit&) const {}
    __device__ __forceinline__ void done(const Unit&) const {}
};

template <class Epi, class Sched, bool ALIGN_EPI = false, bool SP2 = false>
__device__ __forceinline__ void gemm_phase(PG8_LAS unsigned char* lds, const Gemm g, const Sched& S, const Epi& E) {
    int tid_ = threadIdx.x; asm volatile("" : "+v"(tid_));
    const int tid = tid_, wid = __builtin_amdgcn_readfirstlane(tid >> 6), lane = tid & 63, wr = wid >> 2, wc = wid & 3, fr = lane & 15, fq = lane >> 4;
    int K_ = g.K; asm volatile("" : "+s"(K_)); const int K = K_, nt = K / BK;
    unsigned voffA[2], voffB[2];
#pragma unroll
    for (int i = 0; i < 2; ++i) { int R, C; stage_rc(tid * 16 + i * 8192, R, C); const int Rb = Epi::PERM ? ((R & ~31) + perm32(R & 31)) : R;
        voffA[i] = (unsigned)(R * K + C) * 2u; voffB[i] = (unsigned)(Rb * K + C) * 2u; }
    const size_t kstep = (size_t)(BK * 2);
    const size_t hstep = (size_t)HALF * K * 2;
    const size_t tstep = 2 * hstep;
    const unsigned ldsw = (unsigned)wid * 1024u;
    const int aoff = lds_byte(wr * 64 + fr, fq * 8), boff = lds_byte(wc * 32 + fr, fq * 8);
#define PG8_SA(b, h) (((b) * 2 + (h)) * HTB)
#define PG8_SB(b, h) ((4 + (b) * 2 + (h)) * HTB)
#define PG8_STAGE(bufoff, gbase, voff) do { _Pragma("unroll") for (int _i = 0; _i < 2; ++_i) \
        __builtin_amdgcn_global_load_lds((const unsigned*)((const char*)(gbase) + (voff)[_i]), (PG8_LAS unsigned*)(lds + (bufoff) + ldsw + _i * 8192), 16, 0, 0); } while (0)
#define PG8_LDA(dst, b, h) do { _Pragma("unroll") for (int m = 0; m < 4; ++m) _Pragma("unroll") for (int k = 0; k < 2; ++k) dst[m][k] = *(const PG8_LAS bf16x8*)(lds + PG8_SA(b, h) + aoff + m * 2048 + k * 1024); } while (0)
#define PG8_LDB(dst, b, h) do { _Pragma("unroll") for (int n = 0; n < 2; ++n) _Pragma("unroll") for (int k = 0; k < 2; ++k) dst[n][k] = *(const PG8_LAS bf16x8*)(lds + PG8_SB(b, h) + boff + n * 2048 + k * 1024); } while (0)
#define PG8_MMA(ai, bj, At, Bt) do { __builtin_amdgcn_s_setprio(1); _Pragma("unroll") for (int m = 0; m < 4; ++m) _Pragma("unroll") for (int n = 0; n < 2; ++n) _Pragma("unroll") for (int k = 0; k < 2; ++k) \
        acc[ai][bj][m][n] = __builtin_amdgcn_mfma_f32_16x16x32_bf16(Bt[n][k], At[m][k], acc[ai][bj][m][n], 0, 0, 0); __builtin_amdgcn_s_setprio(0); } while (0)
#define PG8_WAIT_V(n) asm volatile("s_waitcnt vmcnt(" #n ")" ::: "memory")
#define PG8_WAIT_L(n) asm volatile("s_waitcnt lgkmcnt(" #n ")" ::: "memory")
#define PG8_BAR __builtin_amdgcn_s_barrier()
#define PG8_SCHED __builtin_amdgcn_sched_barrier(0)
    Unit cur, nxt; int ui = 0;
    if (!S.next(0, cur)) return;
    f32x4 acc[2][2][4][2];
#pragma unroll
    for (int a = 0; a < 2; ++a)
#pragma unroll
        for (int b = 0; b < 2; ++b)
#pragma unroll
            for (int m = 0; m < 4; ++m)
#pragma unroll
                for (int n = 0; n < 2; ++n) acc[a][b][m][n] = (f32x4){0.f, 0.f, 0.f, 0.f};
    bf16x8 At[4][2], B0[2][2], B1[2][2];
    const char* cA = (const char*)g.A + (size_t)cur.pm * tstep; const char* cB = (const char*)g.Bt + (size_t)cur.pn * tstep;
    S.a_ready(cur);
    if constexpr (SP2) {
        PG8_STAGE(PG8_SB(0, 0), cB, voffB); PG8_STAGE(PG8_SB(0, 1), cB + hstep, voffB); PG8_STAGE(PG8_SA(0, 0), cA, voffA); PG8_STAGE(PG8_SA(0, 1), cA + hstep, voffA);
        if (wr == 1) PG8_BAR;
        PG8_WAIT_V(2); PG8_BAR;
        PG8_STAGE(PG8_SB(1, 0), cB + kstep, voffB); PG8_STAGE(PG8_SA(1, 0), cA + kstep, voffA); PG8_STAGE(PG8_SB(1, 1), cB + hstep + kstep, voffB);
        PG8_WAIT_V(6); PG8_BAR;
    } else {
        PG8_STAGE(PG8_SB(0, 0), cB, voffB); PG8_STAGE(PG8_SA(0, 0), cA, voffA); PG8_STAGE(PG8_SB(0, 1), cB + hstep, voffB); PG8_STAGE(PG8_SA(0, 1), cA + hstep, voffA);
        if (wr == 1) PG8_BAR;
        PG8_WAIT_V(4); PG8_BAR;
        PG8_STAGE(PG8_SB(1, 0), cB + kstep, voffB); PG8_STAGE(PG8_SA(1, 0), cA + kstep, voffA); PG8_STAGE(PG8_SB(1, 1), cB + hstep + kstep, voffB);
        PG8_WAIT_V(6); PG8_BAR;
    }
    for (;;) {
        const bool has_next = S.next(ui + 1, nxt);
        const char* nA = has_next ? (const char*)g.A + (size_t)nxt.pm * tstep : cA; const char* nB = has_next ? (const char*)g.Bt + (size_t)nxt.pn * tstep : cB;
        for (int t = 0; t < nt; t += 2) {
            const bool last = (t == nt - 2);
            const char* a1 = cA + (size_t)(t + 1) * kstep;
            const char* a2 = last ? nA : cA + (size_t)(t + 2) * kstep; const char* b2 = last ? nB : cB + (size_t)(t + 2) * kstep;
            const char* a3 = a2 + kstep; const char* b3 = b2 + kstep;
            if (last && has_next) S.a_ready(nxt);
            if constexpr (SP2) {
            PG8_LDB(B0, 0, 0); PG8_LDB(B1, 0, 1); PG8_SCHED; PG8_LDA(At, 0, 0); PG8_STAGE(PG8_SA(1, 1), a1 + hstep, voffA);
            PG8_WAIT_V(8); PG8_WAIT_L(0); PG8_BAR; PG8_MMA(0, 0, At, B0); PG8_MMA(0, 1, At, B1); PG8_BAR; PG8_SCHED;
            PG8_LDA(At, 0, 1); PG8_STAGE(PG8_SB(0, 0), b2, voffB); PG8_STAGE(PG8_SB(0, 1), b2 + hstep, voffB); PG8_STAGE(PG8_SA(0, 0), a2, voffA);
            PG8_WAIT_V(8); PG8_WAIT_L(0); PG8_BAR; PG8_MMA(1, 0, At, B0); PG8_MMA(1, 1, At, B1); PG8_BAR; PG8_SCHED;
            PG8_LDB(B0, 1, 0); PG8_LDB(B1, 1, 1); PG8_SCHED; PG8_LDA(At, 1, 0); PG8_STAGE(PG8_SA(0, 1), a2 + hstep, voffA);
            PG8_WAIT_V(8); PG8_WAIT_L(0); PG8_BAR; PG8_MMA(0, 0, At, B0); PG8_MMA(0, 1, At, B1); PG8_BAR; PG8_SCHED;
            PG8_LDA(At, 1, 1); PG8_STAGE(PG8_SB(1, 0), b3, voffB); PG8_STAGE(PG8_SB(1, 1), b3 + hstep, voffB); PG8_STAGE(PG8_SA(1, 0), a3, voffA);
            PG8_WAIT_V(8); PG8_WAIT_L(0); PG8_BAR; PG8_MMA(1, 0, At, B0); PG8_MMA(1, 1, At, B1); PG8_BAR; PG8_SCHED;
            } else {
            PG8_LDB(B0, 0, 0); PG8_SCHED; PG8_LDA(At, 0, 0); PG8_STAGE(PG8_SA(1, 1), a1 + hstep, voffA);
            PG8_WAIT_L(8); PG8_BAR; PG8_WAIT_L(0); PG8_MMA(0, 0, At, B0); PG8_BAR; PG8_SCHED;
            PG8_LDB(B1, 0, 1); PG8_STAGE(PG8_SB(0, 0), b2, voffB);
            PG8_BAR; PG8_WAIT_L(0); PG8_MMA(0, 1, At, B1); PG8_BAR;
            PG8_LDA(At, 0, 1); PG8_STAGE(PG8_SA(0, 0), a2, voffA);
            PG8_BAR; PG8_WAIT_L(0); PG8_MMA(1, 0, At, B0); PG8_BAR; PG8_SCHED;
            PG8_STAGE(PG8_SB(0, 1), b2 + hstep, voffB);
            PG8_WAIT_V(6); PG8_BAR; PG8_MMA(1, 1, At, B1); PG8_BAR;
            PG8_LDB(B0, 1, 0); PG8_SCHED; PG8_LDA(At, 1, 0); PG8_STAGE(PG8_SA(0, 1), a2 + hstep, voffA);
            PG8_WAIT_L(8); PG8_BAR; PG8_WAIT_L(0); PG8_MMA(0, 0, At, B0); PG8_BAR; PG8_SCHED;
            PG8_LDB(B1, 1, 1); PG8_STAGE(PG8_SB(1, 0), b3, voffB);
            PG8_BAR; PG8_WAIT_L(0); PG8_MMA(0, 1, At, B1); PG8_BAR;
            PG8_LDA(At, 1, 1); PG8_STAGE(PG8_SA(1, 0), a3, voffA);
            PG8_BAR; PG8_WAIT_L(0); PG8_MMA(1, 0, At, B0); PG8_BAR; PG8_SCHED;
            PG8_STAGE(PG8_SB(1, 1), b3 + hstep, voffB);
            PG8_WAIT_V(6); PG8_BAR; PG8_MMA(1, 1, At, B1); PG8_BAR;
            }
        }
        if constexpr (ALIGN_EPI) { if (wr == 0) PG8_BAR; }
        if constexpr (!Epi::AFTER_DRAIN) { E(acc, cur, wr, wc, fr, fq); S.done(cur); }
        if (!has_next) break;
#pragma unroll
        for (int a = 0; a < 2; ++a)
#pragma unroll
            for (int b = 0; b < 2; ++b)
#pragma unroll
                for (int m = 0; m < 4; ++m)
#pragma unroll
                    for (int n = 0; n < 2; ++n) acc[a][b][m][n] = (f32x4){0.f, 0.f, 0.f, 0.f};
        cur = nxt; cA = nA; cB = nB; ++ui;
        if constexpr (ALIGN_EPI) { if (wr == 1) PG8_BAR; }
    }
    PG8_WAIT_V(0);
    if constexpr (!ALIGN_EPI) { if (wr == 0) PG8_BAR; }
    PG8_BAR;
    if constexpr (Epi::AFTER_DRAIN) { E.fused(acc, cur, wr, wc, fr, fq, lds, wid, lane); S.done(cur); }
#undef PG8_SA
#undef PG8_SB
#undef PG8_STAGE
#undef PG8_LDA
#undef PG8_LDB
#undef PG8_MMA
#undef PG8_WAIT_V
#undef PG8_WAIT_L
#undef PG8_BAR
#undef PG8_SCHED
}

struct UnitM { int pm, pn, sub; };
struct GemmM { const bf16_t* A0; const bf16_t* B0; size_t strideA, strideB; int nt0, dnt2; int lda, ldb;
    __device__ __forceinline__ const bf16_t* a(int s) const { return A0 + (size_t)s * strideA; }
    __device__ __forceinline__ const bf16_t* b(int s) const { return B0 + (size_t)s * strideB; }
    __device__ __forceinline__ int nt(int s) const { return nt0 + (s >> 1) * dnt2; } };
struct StaticOrder3 {
    StaticOrder S;
    __device__ void init(int M, int N, int G_, int c_) { S.init(M, N, G_, c_); }
    __device__ bool next(int i, UnitM& u) const { Unit t; if (!S.next(i / 3, t)) return false; u.pm = t.pm; u.pn = t.pn; u.sub = i - 3 * (i / 3); return true; }
    __device__ __forceinline__ void a_ready(const UnitM&) const {}
    __device__ __forceinline__ void done(const UnitM&) const {}
};
template <class Epi, class Sched, bool ALIGN_EPI = false, bool SP2 = false>
__device__ __forceinline__ void gemm_phase_m(PG8_LAS unsigned char* lds, const GemmM g, const Sched& S, const Epi& E) {
    int tid_ = threadIdx.x; asm volatile("" : "+v"(tid_));
    const int tid = tid_, wid = __builtin_amdgcn_readfirstlane(tid >> 6), lane = tid & 63, wr = wid >> 2, wc = wid & 3, fr = lane & 15, fq = lane >> 4;
    int lda_ = g.lda, ldb_ = g.ldb; asm volatile("" : "+s"(lda_), "+s"(ldb_)); const int lda = lda_, ldb = ldb_; int nt;
    unsigned voffA[2], voffB[2];
#pragma unroll
    for (int i = 0; i < 2; ++i) { int R, C; stage_rc(tid * 16 + i * 8192, R, C); const int Rb = Epi::PERM ? ((R & ~31) + perm32(R & 31)) : R;
        voffA[i] = (unsigned)(R * lda + C) * 2u; voffB[i] = (unsigned)(Rb * ldb + C) * 2u; }
    const size_t kstep = (size_t)(BK * 2);
    const size_t hstepA = (size_t)HALF * lda * 2, hstepB = (size_t)HALF * ldb * 2;
    const size_t tstepA = 2 * hstepA, tstepB = 2 * hstepB;
    const unsigned ldsw = (unsigned)wid * 1024u;
    const int aoff = lds_byte(wr * 64 + fr, fq * 8), boff = lds_byte(wc * 32 + fr, fq * 8);
#define PG8_SA(b, h) (((b) * 2 + (h)) * HTB)
#define PG8_SB(b, h) ((4 + (b) * 2 + (h)) * HTB)
#define PG8_STAGE(bufoff, gbase, voff) do { _Pragma("unroll") for (int _i = 0; _i < 2; ++_i) \
        __builtin_amdgcn_global_load_lds((const unsigned*)((const char*)(gbase) + (voff)[_i]), (PG8_LAS unsigned*)(lds + (bufoff) + ldsw + _i * 8192), 16, 0, 0); } while (0)
#define PG8_LDA(dst, b, h) do { _Pragma("unroll") for (int m = 0; m < 4; ++m) _Pragma("unroll") for (int k = 0; k < 2; ++k) dst[m][k] = *(const PG8_LAS bf16x8*)(lds + PG8_SA(b, h) + aoff + m * 2048 + k * 1024); } while (0)
#define PG8_LDB(dst, b, h) do { _Pragma("unroll") for (int n = 0; n < 2; ++n) _Pragma("unroll") for (int k = 0; k < 2; ++k) dst[n][k] = *(const PG8_LAS bf16x8*)(lds + PG8_SB(b, h) + boff + n * 2048 + k * 1024); } while (0)
#define PG8_MMA(ai, bj, At, Bt) do { __builtin_amdgcn_s_setprio(1); _Pragma("unroll") for (int m = 0; m < 4; ++m) _Pragma("unroll") for (int n = 0; n < 2; ++n) _Pragma("unroll") for (int k = 0; k < 2; ++k) \
        acc[ai][bj][m][n] = __builtin_amdgcn_mfma_f32_16x16x32_bf16(Bt[n][k], At[m][k], acc[ai][bj][m][n], 0, 0, 0); __builtin_amdgcn_s_setprio(0); } while (0)
#define PG8_WAIT_V(n) asm volatile("s_waitcnt vmcnt(" #n ")" ::: "memory")
#define PG8_WAIT_L(n) asm volatile("s_waitcnt lgkmcnt(" #n ")" ::: "memory")
#define PG8_BAR __builtin_amdgcn_s_barrier()
#define PG8_SCHED __builtin_amdgcn_sched_barrier(0)
    UnitM cur, nxt; int ui = 0;
    if (!S.next(0, cur)) return;
    f32x4 acc[2][2][4][2];
#pragma unroll
    for (int a = 0; a < 2; ++a)
#pragma unroll
        for (int b = 0; b < 2; ++b)
#pragma unroll
            for (int m = 0; m < 4; ++m)
#pragma unroll
                for (int n = 0; n < 2; ++n) acc[a][b][m][n] = (f32x4){0.f, 0.f, 0.f, 0.f};
    bf16x8 At[4][2], B0[2][2], B1[2][2];
    const char* cA = (const char*)g.a(cur.sub) + (size_t)cur.pm * tstepA; const char* cB = (const char*)g.b(cur.sub) + (size_t)cur.pn * tstepB; nt = g.nt(cur.sub);
    S.a_ready(cur);
    if constexpr (SP2) {
        PG8_STAGE(PG8_SB(0, 0), cB, voffB); PG8_STAGE(PG8_SB(0, 1), cB + hstepB, voffB); PG8_STAGE(PG8_SA(0, 0), cA, voffA); PG8_STAGE(PG8_SA(0, 1), cA + hstepA, voffA);
        if (wr == 1) PG8_BAR;
        PG8_WAIT_V(2); PG8_BAR;
        PG8_STAGE(PG8_SB(1, 0), cB + kstep, voffB); PG8_STAGE(PG8_SA(1, 0), cA + kstep, voffA); PG8_STAGE(PG8_SB(1, 1), cB + hstepB + kstep, voffB);
        PG8_WAIT_V(6); PG8_BAR;
    } else {
        PG8_STAGE(PG8_SB(0, 0), cB, voffB); PG8_STAGE(PG8_SA(0, 0), cA, voffA); PG8_STAGE(PG8_SB(0, 1), cB + hstepB, voffB); PG8_STAGE(PG8_SA(0, 1), cA + hstepA, voffA);
        if (wr == 1) PG8_BAR;
        PG8_WAIT_V(4); PG8_BAR;
        PG8_STAGE(PG8_SB(1, 0), cB + kstep, voffB); PG8_STAGE(PG8_SA(1, 0), cA + kstep, voffA); PG8_STAGE(PG8_SB(1, 1), cB + hstepB + kstep, voffB);
        PG8_WAIT_V(6); PG8_BAR;
    }
    for (;;) {
        const bool has_next = S.next(ui + 1, nxt);
        const char* nA = has_next ? (const char*)g.a(nxt.sub) + (size_t)nxt.pm * tstepA : cA; const char* nB = has_next ? (const char*)g.b(nxt.sub) + (size_t)nxt.pn * tstepB : cB;
        for (int t = 0; t < nt; t += 2) {
            const bool last = (t == nt - 2);
            const char* a1 = cA + (size_t)(t + 1) * kstep;
            const char* a2 = last ? nA : cA + (size_t)(t + 2) * kstep; const char* b2 = last ? nB : cB + (size_t)(t + 2) * kstep;
            const char* a3 = a2 + kstep; const char* b3 = b2 + kstep;
            if (last && has_next) S.a_ready(nxt);
            if constexpr (SP2) {
            PG8_LDB(B0, 0, 0); PG8_LDB(B1, 0, 1); PG8_SCHED; PG8_LDA(At, 0, 0); PG8_STAGE(PG8_SA(1, 1), a1 + hstepA, voffA);
            PG8_WAIT_V(8); PG8_WAIT_L(0); PG8_BAR; PG8_MMA(0, 0, At, B0); PG8_MMA(0, 1, At, B1); PG8_BAR; PG8_SCHED;
            PG8_LDA(At, 0, 1); PG8_STAGE(PG8_SB(0, 0), b2, voffB); PG8_STAGE(PG8_SB(0, 1), b2 + hstepB, voffB); PG8_STAGE(PG8_SA(0, 0), a2, voffA);
            PG8_WAIT_V(8); PG8_WAIT_L(0); PG8_BAR; PG8_MMA(1, 0, At, B0); PG8_MMA(1, 1, At, B1); PG8_BAR; PG8_SCHED;
            PG8_LDB(B0, 1, 0); PG8_LDB(B1, 1, 1); PG8_SCHED; PG8_LDA(At, 1, 0); PG8_STAGE(PG8_SA(0, 1), a2 + hstepA, voffA);
            PG8_WAIT_V(8); PG8_WAIT_L(0); PG8_BAR; PG8_MMA(0, 0, At, B0); PG8_MMA(0, 1, At, B1); PG8_BAR; PG8_SCHED;
            PG8_LDA(At, 1, 1); PG8_STAGE(PG8_SB(1, 0), b3, voffB); PG8_STAGE(PG8_SB(1, 1), b3 + hstepB, voffB); PG8_STAGE(PG8_SA(1, 0), a3, voffA);
            PG8_WAIT_V(8); PG8_WAIT_L(0); PG8_BAR; PG8_MMA(1, 0, At, B0); PG8_MMA(1, 1, At, B1); PG8_BAR; PG8_SCHED;
            } else {
            PG8_LDB(B0, 0, 0); PG8_SCHED; PG8_LDA(At, 0, 0); PG8_STAGE(PG8_SA(1, 1), a1 + hstepA, voffA);
            PG8_WAIT_L(8); PG8_BAR; PG8_WAIT_L(0); PG8_MMA(0, 0, At, B0); PG8_BAR; PG8_SCHED;
            PG8_LDB(B1, 0, 1); PG8_STAGE(PG8_SB(0, 0), b2, voffB);
            PG8_BAR; PG8_WAIT_L(0); PG8_MMA(0, 1, At, B1); PG8_BAR;
            PG8_LDA(At, 0, 1); PG8_STAGE(PG8_SA(0, 0), a2, voffA);
            PG8_BAR; PG8_WAIT_L(0); PG8_MMA(1, 0, At, B0); PG8_BAR; PG8_SCHED;
            PG8_STAGE(PG8_SB(0, 1), b2 + hstepB, voffB);
            PG8_WAIT_V(6); PG8_BAR; PG8_MMA(1, 1, At, B1); PG8_BAR;
            PG8_LDB(B0, 1, 0); PG8_SCHED; PG8_LDA(At, 1, 0); PG8_STAGE(PG8_SA(0, 1), a2 + hstepA, voffA);
            PG8_WAIT_L(8); PG8_BAR; PG8_WAIT_L(0); PG8_MMA(0, 0, At, B0); PG8_BAR; PG8_SCHED;
            PG8_LDB(B1, 1, 1); PG8_STAGE(PG8_SB(1, 0), b3, voffB);
            PG8_BAR; PG8_WAIT_L(0); PG8_MMA(0, 1, At, B1); PG8_BAR;
            PG8_LDA(At, 1, 1); PG8_STAGE(PG8_SA(1, 0), a3, voffA);
            PG8_BAR; PG8_WAIT_L(0); PG8_MMA(1, 0, At, B0); PG8_BAR; PG8_SCHED;
            PG8_STAGE(PG8_SB(1, 1), b3 + hstepB, voffB);
            PG8_WAIT_V(6); PG8_BAR; PG8_MMA(1, 1, At, B1); PG8_BAR;
            }
        }
        if constexpr (ALIGN_EPI) { if (wr == 0) PG8_BAR; }
        if constexpr (!Epi::AFTER_DRAIN) { E(acc, cur, wr, wc, fr, fq); S.done(cur); }
        if (!has_next) break;
        if (nxt.sub == 0) {
#pragma unroll
        for (int a = 0; a < 2; ++a)
#pragma unroll
            for (int b = 0; b < 2; ++b)
#pragma unroll
                for (int m = 0; m < 4; ++m)
#pragma unroll
                    for (int n = 0; n < 2; ++n) acc[a][b][m][n] = (f32x4){0.f, 0.f, 0.f, 0.f}; }
        cur = nxt; cA = nA; cB = nB; ++ui; nt = g.nt(cur.sub);
        if constexpr (ALIGN_EPI) { if (wr == 1) PG8_BAR; }
    }
    PG8_WAIT_V(0);
    if constexpr (!ALIGN_EPI) { if (wr == 0) PG8_BAR; }
    PG8_BAR;
    if constexpr (Epi::AFTER_DRAIN) { E.fused(acc, cur, wr, wc, fr, fq, lds, wid, lane); S.done(cur); }
#undef PG8_SA
#undef PG8_SB
#undef PG8_STAGE
#undef PG8_LDA
#undef PG8_LDB
#undef PG8_MMA
#undef PG8_WAIT_V
#undef PG8_WAIT_L
#undef PG8_BAR
#undef PG8_SCHED
}
}

namespace pg8 {
typedef float f32x2 __attribute__((ext_vector_type(2)));
__device__ __forceinline__ unsigned cvt_pk_bf16(float lo, float hi) { unsigned r; asm volatile("v_cvt_pk_bf16_f32 %0, %1, %2" : "=v"(r) : "v"(lo), "v"(hi)); return r; }
__device__ __forceinline__ void store8(bf16_t* p, const f32x4 v0, const f32x4 v1) {
    u32x4 w; w.x = cvt_pk_bf16(v0[0], v0[1]); w.y = cvt_pk_bf16(v0[2], v0[3]); w.z = cvt_pk_bf16(v1[0], v1[1]); w.w = cvt_pk_bf16(v1[2], v1[3]); *(u32x4*)p = w; }
__device__ __forceinline__ float fsigmoid(float x) { return __builtin_amdgcn_rcpf(1.0f + __builtin_amdgcn_exp2f(-1.4426950408889634f * x)); }
__device__ __forceinline__ f32x4 act4(const f32x4 v, const int ACT) {
    if (ACT == 0) return v;
    f32x4 o;
#pragma unroll
    for (int j = 0; j < 4; ++j) { const float s = fsigmoid(v[j]); o[j] = (ACT == 1) ? v[j] * s : s; }
    return o; }
__device__ __forceinline__ void bf8_to_f32(const u32x4 w, f32x4& a, f32x4& b) {
    a[0] = __uint_as_float(w.x << 16); a[1] = __uint_as_float(w.x & 0xffff0000u); a[2] = __uint_as_float(w.y << 16); a[3] = __uint_as_float(w.y & 0xffff0000u);
    b[0] = __uint_as_float(w.z << 16); b[1] = __uint_as_float(w.z & 0xffff0000u); b[2] = __uint_as_float(w.w << 16); b[3] = __uint_as_float(w.w & 0xffff0000u); }

constexpr int SEQ_MASK = 4095;
__device__ __forceinline__ void rope4(const float* tab, const f32x4 a, const f32x4 b, float sc, bf16_t* p1, bf16_t* p2) {
    typedef unsigned u32x2 __attribute__((ext_vector_type(2)));
    const f32x4 t0 = *(const f32x4*)(tab), t1 = *(const f32x4*)(tab + 4);
    const float o10 = (a[0] * t0[0] - b[0] * t0[1]) * sc, o20 = (b[0] * t0[0] + a[0] * t0[1]) * sc;
    const float o11 = (a[1] * t0[2] - b[1] * t0[3]) * sc, o21 = (b[1] * t0[2] + a[1] * t0[3]) * sc;
    const float o12 = (a[2] * t1[0] - b[2] * t1[1]) * sc, o22 = (b[2] * t1[0] + a[2] * t1[1]) * sc;
    const float o13 = (a[3] * t1[2] - b[3] * t1[3]) * sc, o23 = (b[3] * t1[2] + a[3] * t1[3]) * sc;
    u32x2 w1, w2; w1.x = cvt_pk_bf16(o10, o11); w1.y = cvt_pk_bf16(o12, o13); w2.x = cvt_pk_bf16(o20, o21); w2.y = cvt_pk_bf16(o22, o23);
    *(u32x2*)p1 = w1; *(u32x2*)p2 = w2;
}
#define EPI_FENCE() asm volatile("" ::: "memory")

struct EpiInProj {
    static constexpr bool PERM = true, AFTER_DRAIN = false;
    unsigned char* ws; size_t o_fqkv, o_cq, o_ckv, o_kr, o_rq, o_rk, o_rv, o_rg, o_gates, o_ff, o_t128, o_t64; int skip;
    __device__ __forceinline__ void plain(const f32x4 (&acc)[2][2][4][2], bf16_t* dst, int ld, int colbase, int act, int row0, int wc, int fq) const {
        const int col0 = colbase + wc * 32 + 8 * fq;
#pragma unroll
        for (int ai = 0; ai < 2; ++ai)
#pragma unroll
            for (int m = 0; m < 4; ++m) { bf16_t* rowp = dst + (size_t)(row0 + ai * HALF + m * 16) * ld + col0;
#pragma unroll
                for (int bj = 0; bj < 2; ++bj) { f32x4 v0 = acc[ai][bj][m][0], v1 = acc[ai][bj][m][1];
                    if (act) {
#pragma unroll
                        for (int j = 0; j < 4; ++j) { const float s0 = fsigmoid(v0[j]), s1 = fsigmoid(v1[j]); v0[j] = (act == 1) ? v0[j] * s0 : s0; v1[j] = (act == 1) ? v1[j] * s1 : s1; } }
                    if (skip == 2) { u32x4 w; w.x = cvt_pk_bf16(v0[0], v0[1]); w.y = cvt_pk_bf16(v0[2], v0[3]); w.z = cvt_pk_bf16(v1[0], v1[1]); w.w = cvt_pk_bf16(v1[2], v1[3]); asm volatile("" :: "v"(w)); }
                    else store8(rowp + bj * HALF, v0, v1); }
                EPI_FENCE(); }
    }
    __device__ __forceinline__ void rope128(const f32x4 (&acc)[2][2][4][2], bf16_t* dst, int t, float sc, int row0, int wc, int fq) const {
        const int x = 32 * wc + 8 * fq, hh = x >> 6, i0 = x & 63, head = 2 * t + hh; const float* T128 = (const float*)(ws + o_t128);
#pragma unroll
        for (int ai = 0; ai < 2; ++ai)
#pragma unroll
            for (int m = 0; m < 4; ++m) { const int row = row0 + ai * HALF + m * 16, pos = row & SEQ_MASK;
                const float* tp = T128 + ((size_t)pos * 64 + i0) * 2; bf16_t* p = dst + (size_t)row * 512 + 128 * head + i0;
                rope4(tp, acc[ai][0][m][0], acc[ai][1][m][0], sc, p, p + 64); rope4(tp + 8, acc[ai][0][m][1], acc[ai][1][m][1], sc, p + 4, p + 68);
                EPI_FENCE(); }
    }
    __device__ __forceinline__ void misc(const f32x4 (&acc)[2][2][4][2], int row0, int wc, int fq) const {
        if (wc == 0) { const int i0 = 8 * fq; const float* T64 = (const float*)(ws + o_t64); bf16_t* kr = (bf16_t*)(ws + o_kr);
#pragma unroll
            for (int ai = 0; ai < 2; ++ai)
#pragma unroll
                for (int m = 0; m < 4; ++m) { const int row = row0 + ai * HALF + m * 16, pos = row & SEQ_MASK;
                    const float* tp = T64 + ((size_t)pos * 32 + i0) * 2; bf16_t* p = kr + (size_t)row * 64 + i0;
                    rope4(tp, acc[ai][0][m][0], acc[ai][1][m][0], 1.0f, p, p + 32); rope4(tp + 8, acc[ai][0][m][1], acc[ai][1][m][1], 1.0f, p + 4, p + 36);
                    EPI_FENCE(); }
        } else if (wc == 1) { if (fq == 0) { float* ff = (float*)(ws + o_ff);
#pragma unroll
            for (int ai = 0; ai < 2; ++ai)
#pragma unroll
                for (int m = 0; m < 4; ++m) { const int row = row0 + ai * HALF + m * 16; float* p = ff + (size_t)row * 8; *(f32x4*)p = acc[ai][0][m][0]; *(f32x4*)(p + 4) = acc[ai][0][m][1]; } } }
    }
    __device__ __forceinline__ void operator()(const f32x4 (&acc)[2][2][4][2], const Unit& u, int wr, int wc, int fr, int fq) const {
        const int pn = u.pn, row0 = u.pm * BM + wr * 64 + fr;
        if (skip == 1) {
#pragma unroll
            for (int ai = 0; ai < 2; ++ai)
#pragma unroll
                for (int bj = 0; bj < 2; ++bj)
#pragma unroll
                    for (int m = 0; m < 4; ++m) asm volatile("" :: "v"(acc[ai][bj][m][0]), "v"(acc[ai][bj][m][1]));
            return; }
        if (pn == 12) misc(acc, row0, wc, fq);
        else if (pn >= 13 && pn < 17) { const bool isk = pn >= 15; rope128(acc, (bf16_t*)(ws + (isk ? o_rk : o_rq)), isk ? pn - 15 : pn - 13, isk ? 0.08838834764831845f : 1.0f, row0, wc, fq); }
        else { size_t off; int ld, cb, act = 0;
            if (pn < 9) { off = o_fqkv; ld = 2304; cb = 256 * pn; }
            else if (pn < 11) { off = o_cq; ld = 512; cb = 256 * (pn - 9); }
            else if (pn == 11) { off = o_ckv; ld = 256; cb = 0; }
            else if (pn < 21) { off = o_rv; ld = 1024; cb = 256 * (pn - 17); }
            else if (pn < 25) { off = o_rg; ld = 1024; cb = 256 * (pn - 21); act = 1; }
            else { off = o_gates; ld = 6144; cb = 256 * (pn - 25); act = 2; }
            plain(acc, (bf16_t*)(ws + off), ld, cb, act, row0, wc, fq); }
    }
};

struct EpiUq {
    static constexpr bool PERM = true, AFTER_DRAIN = false;
    bf16_t* qm; const float* rstd; const float* T64;
    __device__ __forceinline__ void operator()(const f32x4 (&acc)[2][2][4][2], const Unit& u, int wr, int wc, int fr, int fq) const {
        const int pn = u.pn, row0 = u.pm * BM + wr * 64 + fr;
        float rsv[2][4];
#pragma unroll
        for (int ai = 0; ai < 2; ++ai)
#pragma unroll
            for (int m = 0; m < 4; ++m) rsv[ai][m] = rstd[row0 + ai * HALF + m * 16];
        if (pn < 3) {
#pragma unroll
            for (int ai = 0; ai < 2; ++ai)
#pragma unroll
                for (int m = 0; m < 4; ++m) { const int row = row0 + ai * HALF + m * 16; const float rs = rsv[ai][m];
#pragma unroll
                    for (int bj = 0; bj < 2; ++bj) store8(qm + (size_t)row * 1152 + 192 * (2 * pn + bj) + 32 * wc + 8 * fq, acc[ai][bj][m][0] * rs, acc[ai][bj][m][1] * rs);
                    EPI_FENCE(); }
        } else { const int head = (pn == 3) ? wc : 4 + wc; if (head < 6) { const int i0 = 8 * fq;
#pragma unroll
            for (int ai = 0; ai < 2; ++ai)
#pragma unroll
                for (int m = 0; m < 4; ++m) { const int row = row0 + ai * HALF + m * 16, pos = row & SEQ_MASK; const float rs = rsv[ai][m];
                    const float* tp = T64 + ((size_t)pos * 32 + i0) * 2; bf16_t* p = qm + (size_t)row * 1152 + 192 * head + 128 + i0;
                    rope4(tp, acc[ai][0][m][0], acc[ai][1][m][0], rs, p, p + 32); rope4(tp + 8, acc[ai][0][m][1], acc[ai][1][m][1], rs, p + 4, p + 36);
                    EPI_FENCE(); } } }
    }
};
struct EpiUkv {
    static constexpr bool PERM = true, AFTER_DRAIN = false;
    bf16_t* kvm; const float* rstd;
    __device__ __forceinline__ void operator()(const f32x4 (&acc)[2][2][4][2], const Unit& u, int wr, int wc, int fr, int fq) const {
        const int row0 = u.pm * BM + wr * 64 + fr, col0 = u.pn * BM + wc * 32 + 8 * fq;
        float rsv[2][4];
#pragma unroll
        for (int ai = 0; ai < 2; ++ai)
#pragma unroll
            for (int m = 0; m < 4; ++m) rsv[ai][m] = rstd[row0 + ai * HALF + m * 16];
#pragma unroll
        for (int ai = 0; ai < 2; ++ai)
#pragma unroll
            for (int m = 0; m < 4; ++m) { const int row = row0 + ai * HALF + m * 16; const float rs = rsv[ai][m];
#pragma unroll
                for (int bj = 0; bj < 2; ++bj) store8(kvm + (size_t)row * 1536 + col0 + bj * HALF, acc[ai][bj][m][0] * rs, acc[ai][bj][m][1] * rs);
                EPI_FENCE(); }
    }
};
template <int PASS> struct EpiMerge {
    static constexpr bool PERM = true, AFTER_DRAIN = false;
    const bf16_t* gates; float* tmp; bf16_t* out;
    __device__ __forceinline__ void operator()(const f32x4 (&acc)[2][2][4][2], const Unit& u, int wr, int wc, int fr, int fq) const {
        const int row0 = u.pm * BM + wr * 64 + fr, col0 = u.pn * BM + wc * 32 + 8 * fq;
#pragma unroll
        for (int ai = 0; ai < 2; ++ai)
#pragma unroll
            for (int m = 0; m < 4; ++m) { const int row = row0 + ai * HALF + m * 16;
#pragma unroll
                for (int bj = 0; bj < 2; ++bj) { const int col = col0 + bj * HALF;
                    f32x4 g0, g1; bf8_to_f32(*(const u32x4*)(gates + (size_t)row * 6144 + 2048 * PASS + col), g0, g1);
                    f32x4 v0 = g0 * acc[ai][bj][m][0], v1 = g1 * acc[ai][bj][m][1];
                    float* tp = tmp + (size_t)row * 2048 + col;
                    if (PASS > 0) { v0 += *(const f32x4*)tp; v1 += *(const f32x4*)(tp + 4); }
                    if (PASS < 2) { *(f32x4*)tp = v0; *(f32x4*)(tp + 4) = v1; }
                    else store8(out + (size_t)row * 2048 + col, v0, v1);
                    EPI_FENCE(); } }
    }
};
struct EpiMergeM {
    static constexpr bool PERM = true, AFTER_DRAIN = false;
    const bf16_t* gates; bf16_t* out;
    __device__ __forceinline__ void operator()(f32x4 (&acc)[2][2][4][2], const UnitM& u, int wr, int wc, int fr, int fq) const {
        int t_ = threadIdx.x; asm volatile("" : "+v"(t_)); (void)fr; (void)fq; const int lrow0 = wr * 64 + (t_ & 15), lcol0 = wc * 32 + 8 * ((t_ >> 4) & 3);
        const int sub = u.sub;
#pragma unroll
        for (int ai = 0; ai < 2; ++ai) {
            u32x4 ga[4][2], gb[4][2];
#pragma unroll
            for (int m = 0; m < 4; ++m)
#pragma unroll
                for (int bj = 0; bj < 2; ++bj) { const bf16_t* gp = gates + ((size_t)u.pm * BM + lrow0 + ai * HALF + m * 16) * 6144 + 2048 * sub + u.pn * BM + lcol0 + bj * HALF;
                    ga[m][bj] = *(const u32x4*)gp; if (sub < 2) gb[m][bj] = *(const u32x4*)(gp + 2048); }
#pragma unroll
            for (int m = 0; m < 4; ++m)
#pragma unroll
                for (int bj = 0; bj < 2; ++bj) { f32x4 a0, a1; bf8_to_f32(ga[m][bj], a0, a1);
#pragma unroll
                    for (int j = 0; j < 4; ++j) { a0[j] = fmaxf(a0[j], 1e-30f); a1[j] = fmaxf(a1[j], 1e-30f); }
                    if (sub < 2) { f32x4 b0, b1; bf8_to_f32(gb[m][bj], b0, b1);
#pragma unroll
                        for (int j = 0; j < 4; ++j) { a0[j] *= __builtin_amdgcn_rcpf(fmaxf(b0[j], 1e-30f)); a1[j] *= __builtin_amdgcn_rcpf(fmaxf(b1[j], 1e-30f)); }
                        acc[ai][bj][m][0] *= a0; acc[ai][bj][m][1] *= a1; }
                    else store8(out + ((size_t)u.pm * BM + lrow0 + ai * HALF + m * 16) * 2048 + u.pn * BM + lcol0 + bj * HALF, acc[ai][bj][m][0] * a0, acc[ai][bj][m][1] * a1); }
            EPI_FENCE(); }
    }
};
struct EpiResid {
    static constexpr bool PERM = true, AFTER_DRAIN = false;
    bf16_t* xb;
    __device__ __forceinline__ void operator()(const f32x4 (&acc)[2][2][4][2], const Unit& u, int wr, int wc, int fr, int fq) const {
        int t_ = threadIdx.x; asm volatile("" : "+v"(t_)); (void)fr; (void)fq;
        const int row0 = u.pm * BM + wr * 64 + (t_ & 15), col0 = u.pn * BM + wc * 32 + 8 * ((t_ >> 4) & 3);
#pragma unroll
        for (int ai = 0; ai < 2; ++ai) {
            u32x4 b[4][2];
#pragma unroll
            for (int m = 0; m < 4; ++m)
#pragma unroll
                for (int bj = 0; bj < 2; ++bj) b[m][bj] = *(const u32x4*)(xb + (size_t)(row0 + ai * HALF + m * 16) * 4096 + col0 + bj * HALF);
#pragma unroll
            for (int m = 0; m < 4; ++m)
#pragma unroll
                for (int bj = 0; bj < 2; ++bj) { f32x4 x0, x1; bf8_to_f32(b[m][bj], x0, x1);
                    store8(xb + (size_t)(row0 + ai * HALF + m * 16) * 4096 + col0 + bj * HALF, x0 + acc[ai][bj][m][0], x1 + acc[ai][bj][m][1]); }
            EPI_FENCE(); }
    }
};
__device__ __forceinline__ float gelu_gate(float xc, float g) {
    const float z = xc * __builtin_fmaf(0.044715f * xc, xc, 1.0f);
    return xc * __builtin_amdgcn_rcpf(1.0f + __builtin_amdgcn_exp2f(-2.3022081985378545f * z)) * g;
}
template <int CTRL> __device__ __forceinline__ float dpp_f(float old, float src) {
    return __builtin_bit_cast(float, __builtin_amdgcn_update_dpp(__builtin_bit_cast(int, old), __builtin_bit_cast(int, src), CTRL, 0xf, 0xf, false)); }
struct EpiConvAct {
    static constexpr bool PERM = true, AFTER_DRAIN = false;
    bf16_t* act; float* utail; float* uhead; float* ghead; const float* cw; const float* cb; PG8_LAS float* xbuf;
    __device__ __forceinline__ void operator()(const f32x4 (&acc)[2][2][4][2], const Unit& u, int wr_, int wc_, int fr_, int fq_) const {
        int t_ = threadIdx.x; asm volatile("" : "+v"(t_)); const int fr = t_ & 15, fq = (t_ >> 4) & 3, wr = wr_, wc = wc_; (void)fr_; (void)fq_;
        const int lc = 32 * wc + 8 * fq, f0 = u.pn * HALF + lc;
        if (fr >= 14) {
#pragma unroll
            for (int ai = 0; ai < 2; ++ai) { PG8_LAS float* xp = xbuf + ((2 * ai + wr) * 2 + (fr - 14)) * 128 + lc; *(PG8_LAS f32x4*)xp = acc[ai][0][3][0]; *(PG8_LAS f32x4*)(xp + 4) = acc[ai][0][3][1]; }
            if (wr == 1) { float* tp = utail + ((size_t)u.pm * 2 + (fr - 14)) * 5632 + f0; *(f32x4*)tp = acc[1][0][3][0]; *(f32x4*)(tp + 4) = acc[1][0][3][1]; } }
        if (fr < 2 && wr == 0) { const size_t o = ((size_t)u.pm * 2 + fr) * 5632 + f0;
            *(f32x4*)(uhead + o) = acc[0][0][0][0]; *(f32x4*)(uhead + o + 4) = acc[0][0][0][1]; *(f32x4*)(ghead + o) = acc[0][1][0][0]; *(f32x4*)(ghead + o + 4) = acc[0][1][0][1]; }
        asm volatile("s_waitcnt lgkmcnt(0)" ::: "memory"); __builtin_amdgcn_s_barrier(); asm volatile("" ::: "memory");
        float w0[8], w1[8], w2[8], bb[8];
#pragma unroll
        for (int h = 0; h < 2; ++h) { const f32x4 a = *(const f32x4*)(cw + f0 + 4 * h), b = *(const f32x4*)(cw + 5632 + f0 + 4 * h), c = *(const f32x4*)(cw + 2 * 5632 + f0 + 4 * h), d = *(const f32x4*)(cb + f0 + 4 * h);
#pragma unroll
            for (int j = 0; j < 4; ++j) { w0[4 * h + j] = a[j]; w1[4 * h + j] = b[j]; w2[4 * h + j] = c[j]; bb[4 * h + j] = d[j]; } }
        const int row0 = u.pm * BM + wr * 64 + fr;
#pragma unroll
        for (int ai = 0; ai < 2; ++ai) {
            f32x4 t0a = {0.f, 0.f, 0.f, 0.f}, t0b = t0a, t1a = t0a, t1b = t0a;
            if (2 * ai + wr > 0) { const PG8_LAS float* xp = xbuf + ((2 * ai + wr - 1) * 2) * 128 + lc; t0a = *(const PG8_LAS f32x4*)xp; t0b = *(const PG8_LAS f32x4*)(xp + 4); t1a = *(const PG8_LAS f32x4*)(xp + 128); t1b = *(const PG8_LAS f32x4*)(xp + 132); }
#pragma unroll
            for (int m = 0; m < 4; ++m) { f32x4 o0, o1;
#pragma unroll
                for (int n = 0; n < 2; ++n)
#pragma unroll
                    for (int j = 0; j < 4; ++j) { const int k = 4 * n + j; const float cur = acc[ai][0][m][n][j];
                        float a1, a2;
                        if (m == 0) { const float T0 = n ? t0b[j] : t0a[j], T1 = n ? t1b[j] : t1a[j]; a1 = T1; a2 = (fr == 0) ? T0 : T1; }
                        else { const float pv = acc[ai][0][m - 1][n][j]; a1 = dpp_f<0x10F>(pv, pv); a2 = dpp_f<0x10E>(pv, pv); }
                        const float s1 = dpp_f<0x111>(a1, cur), s2 = dpp_f<0x112>(a2, cur);
                        const float xc = __builtin_fmaf(w2[k], cur, __builtin_fmaf(w1[k], s1, __builtin_fmaf(w0[k], s2, bb[k])));
                        const float r = gelu_gate(xc, acc[ai][1][m][n][j]);
                        if (n == 0) o0[j] = r; else o1[j] = r; }
                store8(act + (size_t)(row0 + ai * HALF + m * 16) * 5632 + f0, o0, o1);
                EPI_FENCE(); } }
    }
};
}

namespace att {
#define ATT_LAS __attribute__((address_space(3)))
typedef unsigned short bf16_t;
typedef short bf16x8 __attribute__((ext_vector_type(8)));
typedef short s16x4 __attribute__((ext_vector_type(4)));
typedef float f32x16 __attribute__((ext_vector_type(16)));
typedef float f32x4 __attribute__((ext_vector_type(4)));
typedef unsigned u32x4 __attribute__((ext_vector_type(4)));
typedef unsigned u32x2 __attribute__((ext_vector_type(2)));
constexpr int SHM_T = 16384;
#define KSWZ(row, colB) ((row) * 256 + ((colB) ^ (((row) & 15) << 4)))
#define KSWZ64(row, colB) ((row) * 128 + ((colB) ^ ((((row) >> 1) & 7) << 4)))
#define SBAR() __builtin_amdgcn_sched_barrier(0)
__device__ __forceinline__ int v_st(int k, int c) { const int kk = (k & ~0xC) | ((k & 4) << 1) | ((k & 8) >> 1); return ((kk >> 3) * 4 + (c >> 5)) * 512 + ((kk & 7) * 32 + (c & 31)) * 2; }
__device__ __forceinline__ int v_rd_base(int lane) { return ((lane & 3) << 3) | (((lane >> 2) & 3) << 6) | (((lane >> 4) & 1) << 5) | (((lane >> 5) & 1) << 8); }
constexpr int v_rd_off(int d0, int ks, int half) { return d0 * 512 + ks * 4096 + half * 2048; }
__device__ __forceinline__ unsigned cvtpk(float lo, float hi) { unsigned r; asm volatile("v_cvt_pk_bf16_f32 %0, %1, %2" : "=v"(r) : "v"(lo), "v"(hi)); return r; }

template <bool ROPE>
__device__ __forceinline__ void qkt(f32x16& p0, f32x16& p1, const ATT_LAS char* Kt, const ATT_LAS char* Kr, int r32, int hi, const bf16x8* qr) {
    p0 = f32x16{}; p1 = f32x16{};
#pragma unroll
    for (int d0 = 0; d0 < 8; ++d0) { const ATT_LAS char* a = Kt + KSWZ(r32, (d0 * 16 + hi * 8) * 2);
        const bf16x8 b0 = *(const ATT_LAS bf16x8*)a, b1 = *(const ATT_LAS bf16x8*)(a + 32 * 256);
        p0 = __builtin_amdgcn_mfma_f32_32x32x16_bf16(b0, qr[d0], p0, 0, 0, 0);
        p1 = __builtin_amdgcn_mfma_f32_32x32x16_bf16(b1, qr[d0], p1, 0, 0, 0); }
    if (ROPE) {
#pragma unroll
        for (int d0 = 0; d0 < 4; ++d0) { const ATT_LAS char* a = Kr + KSWZ64(r32, (d0 * 16 + hi * 8) * 2);
            const bf16x8 b0 = *(const ATT_LAS bf16x8*)a, b1 = *(const ATT_LAS bf16x8*)(a + 32 * 128);
            p0 = __builtin_amdgcn_mfma_f32_32x32x16_bf16(b0, qr[8 + d0], p0, 0, 0, 0);
            p1 = __builtin_amdgcn_mfma_f32_32x32x16_bf16(b1, qr[8 + d0], p1, 0, 0, 0); } }
}
__device__ __forceinline__ void pv_tile_T(f32x16* o, int vb, bf16x8 pa0, bf16x8 pa1, bf16x8 pa2, bf16x8 pa3) {
#define TRRD(dst, off) asm volatile("ds_read_b64_tr_b16 %0, %1 offset:%2" : "=&v"(dst) : "v"(vb), "i"(off) : "memory")
#define PV_D0(d0) do { s16x4 l0, l1, l2, l3, h0, h1, h2, h3; constexpr int b_ = v_rd_off(d0, 0, 0); \
        TRRD(l0, b_); TRRD(h0, b_ + 2048); TRRD(l1, b_ + 4096); TRRD(h1, b_ + 6144); TRRD(l2, b_ + 8192); TRRD(h2, b_ + 10240); TRRD(l3, b_ + 12288); TRRD(h3, b_ + 14336); \
        asm volatile("s_waitcnt lgkmcnt(0)" ::: "memory"); SBAR(); \
        o[d0] = __builtin_amdgcn_mfma_f32_32x32x16_bf16((bf16x8){l0[0], l0[1], l0[2], l0[3], h0[0], h0[1], h0[2], h0[3]}, pa0, o[d0], 0, 0, 0); \
        o[d0] = __builtin_amdgcn_mfma_f32_32x32x16_bf16((bf16x8){l1[0], l1[1], l1[2], l1[3], h1[0], h1[1], h1[2], h1[3]}, pa1, o[d0], 0, 0, 0); \
        o[d0] = __builtin_amdgcn_mfma_f32_32x32x16_bf16((bf16x8){l2[0], l2[1], l2[2], l2[3], h2[0], h2[1], h2[2], h2[3]}, pa2, o[d0], 0, 0, 0); \
        o[d0] = __builtin_amdgcn_mfma_f32_32x32x16_bf16((bf16x8){l3[0], l3[1], l3[2], l3[3], h3[0], h3[1], h3[2], h3[3]}, pa3, o[d0], 0, 0, 0); } while (0)
    PV_D0(0); PV_D0(1); PV_D0(2); PV_D0(3);
#undef PV_D0
#undef TRRD
}
__device__ __forceinline__ void pack_p(const f32x16& p0, const f32x16& p1, bf16x8& pa0, bf16x8& pa1, bf16x8& pa2, bf16x8& pa3) {
#define PK4(P, B_, OUT) do { unsigned a0 = cvtpk(P[B_+0], P[B_+1]), a1 = cvtpk(P[B_+2], P[B_+3]); \
        unsigned b0 = cvtpk(P[B_+4], P[B_+5]), b1 = cvtpk(P[B_+6], P[B_+7]); \
        auto r0 = __builtin_amdgcn_permlane32_swap(a0, b0, false, false); auto r1 = __builtin_amdgcn_permlane32_swap(a1, b1, false, false); \
        u32x4 w = {r0[0], r1[0], r0[1], r1[1]}; OUT = *reinterpret_cast<bf16x8*>(&w); } while (0)
    PK4(p0, 0, pa0); PK4(p0, 8, pa1); PK4(p1, 0, pa2); PK4(p1, 8, pa3);
#undef PK4
}
__device__ __forceinline__ float swap_max(float v) { auto rr = __builtin_amdgcn_permlane32_swap(__float_as_uint(v), __float_as_uint(v), false, false); return fmaxf(__uint_as_float(rr[0]), __uint_as_float(rr[1])); }
__device__ __forceinline__ float swap_sum(float v) { auto rr = __builtin_amdgcn_permlane32_swap(__float_as_uint(v), __float_as_uint(v), false, false); return __uint_as_float(rr[0]) + __uint_as_float(rr[1]); }

__device__ __forceinline__ void store_pair16(bf16_t* row_pair_base  , u32x2 a, u32x2 b) {
    auto rx = __builtin_amdgcn_permlane32_swap(a.x, b.x, false, false); auto ry = __builtin_amdgcn_permlane32_swap(a.y, b.y, false, false);
    const u32x4 w = {rx[0], ry[0], rx[1], ry[1]}; *(u32x4*)row_pair_base = w; }
struct UnitPtrs {
    const bf16_t* Q; int ldq;
    const bf16_t* K; int ldk;
    const bf16_t* V; int ldv;
    const bf16_t* KR;
    const float* bias;
    const bf16_t* G;
    bf16_t* O; int ldo;
    int P0;
    float c2;
    const bf16_t* ST;
    int T0;
};
template <int MODE>
__device__ __forceinline__ void mixer_unit(const UnitPtrs& U, ATT_LAS char* lds) {
    constexpr bool ROPE = (MODE == 1);
    constexpr int NQ = ROPE ? 12 : 8;
    constexpr int K_OFF = 0, KR_OFF = 32768, V_OFF = (MODE == 1) ? 49152 : 32768, V_SZ = (MODE == 2) ? 32768 : 16384, BIAS_OFF = 65536, SCR_OFF = 98304;
    int tid_ = threadIdx.x; asm volatile("" : "+v"(tid_));
    const int tid = tid_, wid = __builtin_amdgcn_readfirstlane(tid >> 6), lane = tid & 63, r32 = lane & 31, hi = lane >> 5;
    const int rg = (MODE == 2) ? (wid >> 1) : wid;
    const int vhalf = (MODE == 2) ? (wid & 1) : 0;
    const int qlo = U.P0 + 32 * rg;
    const int tbase = (MODE == 2) ? (U.T0 >> 6) : 0;
    const int NT = (U.P0 + ((MODE == 2) ? 128 : 256)) / 64 - tbase;
    const int tlast = (qlo >> 6) - tbase;
    bf16x8 qr[NQ];
    { const bf16_t* qp = U.Q + (size_t)(32 * rg + r32) * U.ldq + hi * 8;
#pragma unroll
      for (int d0 = 0; d0 < NQ; ++d0) qr[d0] = *(const bf16x8*)(qp + d0 * 16); }
    const int sr = tid >> 4, sc = (tid & 15) * 8;
    const int kws = KSWZ(sr, sc * 2), vst0 = v_st(sr, sc), vst1 = v_st(32 + sr, sc);
    const int rr = tid >> 3, rc = (tid & 7) * 8, krs = KSWZ64(rr, rc * 2);
    const int vbase = (int)(unsigned)(uintptr_t)(lds + V_OFF) + v_rd_base(lane) + vhalf * SHM_T;
    bf16x8 st_k0, st_k1, st_v0, st_v1, st_v2, st_v3, st_r;
#define ST_LOAD(kb_) do { const bf16_t* kp_ = U.K + (size_t)((kb_) + sr) * U.ldk + sc; st_k0 = *(const bf16x8*)kp_; st_k1 = *(const bf16x8*)(kp_ + (size_t)32 * U.ldk); \
        const bf16_t* vp_ = U.V + (size_t)((kb_) + sr) * U.ldv + sc; st_v0 = *(const bf16x8*)vp_; st_v1 = *(const bf16x8*)(vp_ + (size_t)32 * U.ldv); \
        if (MODE == 2) { st_v2 = *(const bf16x8*)(vp_ + 128); st_v3 = *(const bf16x8*)(vp_ + (size_t)32 * U.ldv + 128); } \
        if (MODE == 1) { st_r = *(const bf16x8*)(U.KR + (size_t)((kb_) + rr) * 64 + rc); } } while (0)
#define ST_WRITE(bf) do { ATT_LAS char* kd_ = lds + K_OFF + (bf) * SHM_T; *(ATT_LAS bf16x8*)(kd_ + kws) = st_k0; *(ATT_LAS bf16x8*)(kd_ + kws + 32 * 256) = st_k1; \
        ATT_LAS char* vd_ = lds + V_OFF + (bf) * V_SZ; *(ATT_LAS bf16x8*)(vd_ + vst0) = st_v0; *(ATT_LAS bf16x8*)(vd_ + vst1) = st_v1; \
        if (MODE == 2) { *(ATT_LAS bf16x8*)(vd_ + SHM_T + vst0) = st_v2; *(ATT_LAS bf16x8*)(vd_ + SHM_T + vst1) = st_v3; } \
        if (MODE == 1) { *(ATT_LAS bf16x8*)(lds + KR_OFF + (bf) * 8192 + krs) = st_r; } } while (0)
    float m_reg = -1e30f, l_reg = 0.f; f32x16 o[4] = {};
    float colf[(MODE == 2) ? 32 : 1];
    if (MODE == 2) {
#pragma unroll
        for (int r = 0; r < 16; ++r) { const int c = (r & 3) + 8 * (r >> 2); colf[r] = __builtin_amdgcn_exp2f(-U.c2 * (float)c); colf[16 + r] = __builtin_amdgcn_exp2f(-U.c2 * (float)(c + 32)); } }
    const int qpos = qlo + r32;
    ST_LOAD(tbase * 64);
    if (MODE == 0) { const int nk = U.P0 + 256; ATT_LAS float* bl = (ATT_LAS float*)(lds + BIAS_OFF); for (int i = tid; i < nk; i += 512) bl[i] = -U.bias[i]; }
    ST_WRITE(0);
    __syncthreads();
    if (MODE == 2) { if (U.ST) {
        const bf16_t* sp = U.ST + (size_t)(vhalf * 128 + r32) * 128 + hi * 8;
        bf16x8 sa[4][8];
#pragma unroll
        for (int d0 = 0; d0 < 4; ++d0)
#pragma unroll
            for (int ks = 0; ks < 8; ++ks) sa[d0][ks] = *(const bf16x8*)(sp + (size_t)d0 * 32 * 128 + ks * 16);
#pragma unroll
        for (int d0 = 0; d0 < 4; ++d0)
#pragma unroll
            for (int ks = 0; ks < 8; ++ks) o[d0] = __builtin_amdgcn_mfma_f32_32x32x16_bf16(sa[d0][ks], qr[ks], o[d0], 0, 0, 0);
        const float rf = __builtin_amdgcn_exp2f(U.c2 * (float)(qpos - U.T0 + 1));
#pragma unroll
        for (int d0 = 0; d0 < 4; ++d0)
#pragma unroll
            for (int r = 0; r < 16; ++r) o[d0][r] *= rf; } }
#define STEP(t, B) do { const int t_ = (t); const bool more_ = (t_ + 1 < NT); \
        if (more_) ST_LOAD((tbase + t_ + 1) * 64); \
        if (t_ <= tlast) { f32x16 p0, p1; bf16x8 pa0, pa1, pa2, pa3; \
            qkt<ROPE>(p0, p1, lds + K_OFF + (B) * SHM_T, lds + KR_OFF + (B) * 8192, r32, hi, qr); \
            const int dq = qpos - (tbase + t_) * 64 - 4 * hi; \
            if (MODE == 2) { \
                if (t_ < tlast) { const float rowf = __builtin_amdgcn_exp2f(U.c2 * (float)dq);     \
                    _Pragma("unroll") for (int r = 0; r < 16; ++r) { p0[r] *= rowf * colf[r]; p1[r] *= rowf * colf[16 + r]; } \
                } else { \
                    _Pragma("unroll") for (int r = 0; r < 16; ++r) { const int c = (r & 3) + 8 * (r >> 2); \
                        p0[r] *= __builtin_amdgcn_exp2f(U.c2 * fabsf((float)(dq - c))); p1[r] *= __builtin_amdgcn_exp2f(U.c2 * fabsf((float)(dq - c - 32))); } } \
            } else { \
                if (MODE == 0) { const ATT_LAS float* bl = (const ATT_LAS float*)(lds + BIAS_OFF) + t_ * 64 + 4 * hi; \
                    _Pragma("unroll") for (int g = 0; g < 4; ++g) { const f32x4 b0 = *(const ATT_LAS f32x4*)(bl + 8 * g), b1 = *(const ATT_LAS f32x4*)(bl + 32 + 8 * g); \
                        _Pragma("unroll") for (int j = 0; j < 4; ++j) { p0[4 * g + j] = fmaf(p0[4 * g + j], U.c2, b0[j]); p1[4 * g + j] = fmaf(p1[4 * g + j], U.c2, b1[j]); } } \
                    if (t_ == tlast) { const float NEG = -__builtin_inff(); \
                        _Pragma("unroll") for (int r = 0; r < 16; ++r) { const int c = (r & 3) + 8 * (r >> 2); if (dq - c < 0) p0[r] = NEG; if (dq - c - 32 < 0) p1[r] = NEG; } } \
                } else { _Pragma("unroll") for (int r = 0; r < 16; ++r) { p0[r] *= U.c2; p1[r] *= U.c2; } } \
                float pmax = p0[0]; \
                _Pragma("unroll") for (int r = 1; r < 16; ++r) pmax = fmaxf(pmax, p0[r]); \
                _Pragma("unroll") for (int r = 0; r < 16; ++r) pmax = fmaxf(pmax, p1[r]); \
                pmax = swap_max(pmax); \
                const float mn = fmaxf(m_reg, pmax), alpha = __builtin_amdgcn_exp2f(m_reg - mn); m_reg = mn; \
                if (!__all(alpha == 1.0f)) { _Pragma("unroll") for (int d_ = 0; d_ < 4; ++d_) _Pragma("unroll") for (int r = 0; r < 16; ++r) o[d_][r] *= alpha; } \
                float ps = 0.f; \
                _Pragma("unroll") for (int r = 0; r < 16; ++r) { p0[r] = __builtin_amdgcn_exp2f(p0[r] - mn); p1[r] = __builtin_amdgcn_exp2f(p1[r] - mn); ps += p0[r] + p1[r]; } \
                ps = swap_sum(ps); l_reg = l_reg * alpha + ps; \
            } \
            pack_p(p0, p1, pa0, pa1, pa2, pa3); \
            pv_tile_T(o, vbase + (B) * V_SZ, pa0, pa1, pa2, pa3); } \
        if (more_) ST_WRITE((B) ^ 1); \
        __syncthreads(); } while (0)
    for (int t = 0; t < NT; t += 2) { STEP(t, 0); STEP(t + 1, 1); }
#undef STEP
#undef ST_LOAD
#undef ST_WRITE
    bf16_t* orow = U.O + (size_t)(32 * rg + r32) * U.ldo + vhalf * 128 + 8 * hi;
    if (MODE == 2) {
        float ss = 0.f;
#pragma unroll
        for (int d0 = 0; d0 < 4; ++d0)
#pragma unroll
            for (int r = 0; r < 16; ++r) ss += o[d0][r] * o[d0][r];
        ss = swap_sum(ss);
        ATT_LAS float* scr = (ATT_LAS float*)(lds + SCR_OFF);
        if (hi == 0) scr[wid * 32 + r32] = ss;
        __syncthreads();
        const float tot = ss + scr[(wid ^ 1) * 32 + r32];
        const float rstd = __builtin_amdgcn_rsqf(tot * (1.0f / 256.0f) + 1e-6f);
        const bf16_t* grow = U.G + (size_t)(32 * rg + r32) * 1024 + vhalf * 128 + 4 * hi;
#pragma unroll
        for (int d0 = 0; d0 < 4; ++d0)
#pragma unroll
            for (int gp = 0; gp < 4; gp += 2) { u32x2 w[2];
#pragma unroll
                for (int e = 0; e < 2; ++e) { const int g = gp + e; const u32x2 gw = *(const u32x2*)(grow + 32 * d0 + 8 * g);
                    const float g0 = __uint_as_float(gw.x << 16), g1 = __uint_as_float(gw.x & 0xffff0000u), g2 = __uint_as_float(gw.y << 16), g3 = __uint_as_float(gw.y & 0xffff0000u);
                    w[e].x = cvtpk(o[d0][4 * g] * rstd * g0, o[d0][4 * g + 1] * rstd * g1); w[e].y = cvtpk(o[d0][4 * g + 2] * rstd * g2, o[d0][4 * g + 3] * rstd * g3); }
                store_pair16(orow + 32 * d0 + 8 * gp, w[0], w[1]); }
        __syncthreads();
    } else {
        const float inv = 1.0f / l_reg;
#pragma unroll
        for (int d0 = 0; d0 < 4; ++d0)
#pragma unroll
            for (int gp = 0; gp < 4; gp += 2) { u32x2 w[2];
#pragma unroll
                for (int e = 0; e < 2; ++e) { const int g = gp + e; w[e].x = cvtpk(o[d0][4 * g] * inv, o[d0][4 * g + 1] * inv); w[e].y = cvtpk(o[d0][4 * g + 2] * inv, o[d0][4 * g + 3] * inv); }
                store_pair16(orow + 32 * d0 + 8 * gp, w[0], w[1]); }
    }
}

__device__ __forceinline__ void ret_state_unit(const bf16_t* K, int ldk, const bf16_t* V, int ldv, float c2, float* SL, ATT_LAS char* lds) {
    int tid_ = threadIdx.x; asm volatile("" : "+v"(tid_));
    const int tid = tid_, wid = __builtin_amdgcn_readfirstlane(tid >> 6), lane = tid & 63, r32 = lane & 31, hi = lane >> 5;
    const int sr = tid >> 4, sc = (tid & 15) * 8, vst0 = v_st(sr, sc), vst1 = v_st(32 + sr, sc);
    constexpr int KI = 0, VI = 16384;
    const int kb = (int)(unsigned)(uintptr_t)(lds + KI) + v_rd_base(lane), vb = (int)(unsigned)(uintptr_t)(lds + VI) + v_rd_base(lane) + (wid >> 2) * SHM_T;
    f32x16 acc[4] = {};
    for (int t = 0; t < 4; ++t) {
        const bf16_t* kp = K + (size_t)(t * 64 + sr) * ldk + sc; const bf16_t* vp = V + (size_t)(t * 64 + sr) * ldv + sc;
        const u32x4 k0 = *(const u32x4*)kp, k1 = *(const u32x4*)(kp + (size_t)32 * ldk);
        const bf16x8 v0 = *(const bf16x8*)vp, v1 = *(const bf16x8*)(vp + (size_t)32 * ldv), v2 = *(const bf16x8*)(vp + 128), v3 = *(const bf16x8*)(vp + (size_t)32 * ldv + 128);
        const float w0 = __builtin_amdgcn_exp2f(c2 * (float)(255 - (t * 64 + sr))), w1 = __builtin_amdgcn_exp2f(c2 * (float)(255 - (t * 64 + 32 + sr)));
        u32x4 q0, q1;
#define WSC(w, s) cvtpk(__uint_as_float((w) << 16) * (s), __uint_as_float((w) & 0xffff0000u) * (s))
        q0.x = WSC(k0.x, w0); q0.y = WSC(k0.y, w0); q0.z = WSC(k0.z, w0); q0.w = WSC(k0.w, w0); q1.x = WSC(k1.x, w1); q1.y = WSC(k1.y, w1); q1.z = WSC(k1.z, w1); q1.w = WSC(k1.w, w1);
#undef WSC
        __syncthreads();
        *(ATT_LAS u32x4*)(lds + KI + vst0) = q0; *(ATT_LAS u32x4*)(lds + KI + vst1) = q1;
        *(ATT_LAS bf16x8*)(lds + VI + vst0) = v0; *(ATT_LAS bf16x8*)(lds + VI + vst1) = v1; *(ATT_LAS bf16x8*)(lds + VI + SHM_T + vst0) = v2; *(ATT_LAS bf16x8*)(lds + VI + SHM_T + vst1) = v3;
        __syncthreads();
#define TRR(dst, base, off) asm volatile("ds_read_b64_tr_b16 %0, %1 offset:%2" : "=&v"(dst) : "v"(base), "i"(off) : "memory")
#define KS_STEP(ks) do { s16x4 vl, vh, kl0, kh0, kl1, kh1, kl2, kh2, kl3, kh3; \
        TRR(vl, vbw, (ks) * 4096); TRR(vh, vbw, (ks) * 4096 + 2048); \
        TRR(kl0, kb, 0 * 512 + (ks) * 4096); TRR(kh0, kb, 0 * 512 + (ks) * 4096 + 2048); TRR(kl1, kb, 1 * 512 + (ks) * 4096); TRR(kh1, kb, 1 * 512 + (ks) * 4096 + 2048); \
        TRR(kl2, kb, 2 * 512 + (ks) * 4096); TRR(kh2, kb, 2 * 512 + (ks) * 4096 + 2048); TRR(kl3, kb, 3 * 512 + (ks) * 4096); TRR(kh3, kb, 3 * 512 + (ks) * 4096 + 2048); \
        asm volatile("s_waitcnt lgkmcnt(0)" ::: "memory"); SBAR(); \
        const bf16x8 vf = (bf16x8){vl[0], vl[1], vl[2], vl[3], vh[0], vh[1], vh[2], vh[3]}; \
        acc[0] = __builtin_amdgcn_mfma_f32_32x32x16_bf16(vf, (bf16x8){kl0[0], kl0[1], kl0[2], kl0[3], kh0[0], kh0[1], kh0[2], kh0[3]}, acc[0], 0, 0, 0); \
        acc[1] = __builtin_amdgcn_mfma_f32_32x32x16_bf16(vf, (bf16x8){kl1[0], kl1[1], kl1[2], kl1[3], kh1[0], kh1[1], kh1[2], kh1[3]}, acc[1], 0, 0, 0); \
        acc[2] = __builtin_amdgcn_mfma_f32_32x32x16_bf16(vf, (bf16x8){kl2[0], kl2[1], kl2[2], kl2[3], kh2[0], kh2[1], kh2[2], kh2[3]}, acc[2], 0, 0, 0); \
        acc[3] = __builtin_amdgcn_mfma_f32_32x32x16_bf16(vf, (bf16x8){kl3[0], kl3[1], kl3[2], kl3[3], kh3[0], kh3[1], kh3[2], kh3[3]}, acc[3], 0, 0, 0); } while (0)
        const int vbw = vb + (wid & 3) * 512;
        KS_STEP(0); KS_STEP(1); KS_STEP(2); KS_STEP(3);
#undef KS_STEP
#undef TRR
    }
#pragma unroll
    for (int e0 = 0; e0 < 4; ++e0)
#pragma unroll
        for (int r = 0; r < 16; ++r) SL[(size_t)(32 * wid + (r & 3) + 8 * (r >> 2) + 4 * hi) * 128 + 32 * e0 + r32] = acc[e0][r];
    __syncthreads();
}
}

constexpr int DM = 2048, NBATCH = 8, SEQ = 4096, DEPTH = 4, M = NBATCH * SEQ;
constexpr int IN_W = 12358, NIN = 12544, DFF = 5632, NUG = 2 * DFF, NUQ = 1280, NUKV = 1536;
constexpr float NORM_EPS = 1e-6f;
constexpr int NWAVES = 8;
constexpr int PH = 11, NPHASE = DEPTH * PH + 1;

constexpr size_t MiB = 1u << 20;
constexpr size_t WS_CTL = 0, CTL_ZERO_BYTES = 1 * MiB;
constexpr size_t WS_T128 = 1 * MiB, WS_T64 = 3 * MiB, WS_CL = 4 * MiB, WS_RSQ = 5 * MiB, WS_RSKV = 5 * MiB + 512 * 1024, WS_FF = 6 * MiB;
constexpr size_t WS_W = 8 * MiB;
constexpr size_t WO_IN = 0, WO_UQ = WO_IN + (size_t)NIN * DM * 2, WO_UKV = WO_UQ + (size_t)NUQ * 512 * 2, WO_BF = WO_UKV + (size_t)NUKV * 256 * 2, WO_BM = WO_BF + (size_t)DM * 1024 * 2,
                 WO_BR = WO_BM + (size_t)DM * 1024 * 2, WO_OUT = WO_BR + (size_t)DM * 1024 * 2, WO_UG = WO_OUT + (size_t)DM * DM * 2, WO_DN = WO_UG + (size_t)NUG * DM * 2, WO_END = WO_DN + (size_t)DM * DFF * 2;
static_assert(WO_END == 137 * MiB, "weight region");
constexpr size_t WS_H = 146 * MiB;
constexpr size_t WS_BIG = 274 * MiB;
constexpr size_t WS_GATES = WS_BIG, WS_FQKV = WS_GATES + 384 * MiB, WS_CQ = WS_FQKV + 144 * MiB, WS_CKV = WS_CQ + 32 * MiB, WS_RQ = WS_CKV + 16 * MiB, WS_RK = WS_RQ + 32 * MiB,
                 WS_RV = WS_RK + 32 * MiB, WS_RG = WS_RV + 64 * MiB, WS_KR = WS_RG + 64 * MiB, WS_QM = WS_KR + 4 * MiB, WS_KVM = WS_QM + 72 * MiB, WS_A = WS_KVM + 96 * MiB,
                 WS_BM = WS_A + 64 * MiB, WS_C = WS_BM + 64 * MiB, WS_SLOC = WS_C + 64 * MiB, WS_SST = WS_SLOC + 64 * MiB, WS_MIX_END = WS_SST + 32 * MiB;
constexpr size_t WS_TMP = WS_FQKV;
static_assert(WS_RV - WS_FQKV == 256 * MiB, "tmp overlay");
constexpr size_t WS_U = WS_BIG, WS_GT = WS_U + 352 * MiB, WS_ACT = WS_GT + 352 * MiB, WS_FFN_END = WS_ACT + 352 * MiB;
constexpr size_t WS_UTAIL = WS_U, WS_UHEAD = WS_U + 8 * MiB, WS_GHEAD = WS_U + 16 * MiB;
constexpr size_t WS_END = WS_MIX_END > WS_FFN_END ? WS_MIX_END : WS_FFN_END;
constexpr int CW_BAR = 4096;
constexpr int CW_QUEUE = 16384;

constexpr int RING_OFF = 0, RING_BYTES = 131072;
constexpr int LDSCTL_OFF = RING_BYTES, MISC_OFF = LDSCTL_OFF + 320;
constexpr int LDS_BYTES = 147456;
static_assert(MISC_OFF + 128 <= LDS_BYTES, "LDS map");

#define LAS __attribute__((address_space(3)))
typedef unsigned short bf16;
typedef unsigned v4u __attribute__((ext_vector_type(4)));
typedef float f32x4 __attribute__((ext_vector_type(4)));
#define LDS_WAIT() asm volatile("s_waitcnt lgkmcnt(0)" ::: "memory")
__device__ __forceinline__ unsigned f2bf(float f) { unsigned u = __builtin_bit_cast(unsigned, f); return (u + 0x7fffu + ((u >> 16) & 1u)) >> 16; }
__device__ __forceinline__ unsigned pk2(float lo, float hi) { return f2bf(lo) | (f2bf(hi) << 16); }

#define XB_TMO      128
#define XB_XCNT(j)  (256  + 64 * (j))
#define XB_XSUB(j)  (1280 + 64 * (j))
#define XB_XGEN(j)  (2304 + 64 * (j))
#define XB_TOP      3328
#define XB_TOPGEN   3392
#define XCD_BAR_WORDS 3456
#define XB_SPIN_CAP (1u << 18)
__device__ __forceinline__ unsigned xb_ld(unsigned* p)              { return __hip_atomic_load(p, __ATOMIC_RELAXED, __HIP_MEMORY_SCOPE_AGENT); }
__device__ __forceinline__ unsigned xb_add(unsigned* p, unsigned v) { return __hip_atomic_fetch_add(p, v, __ATOMIC_RELAXED, __HIP_MEMORY_SCOPE_AGENT); }
__device__ __forceinline__ unsigned xb_xcc_id() { return (unsigned)__builtin_amdgcn_s_getreg((3 << 11) | 20) & 0xFu; }
#define XB_SPIN(cond, bar) do { unsigned _sp = 0; while (cond) { __builtin_amdgcn_s_sleep(1); \
    if ((++_sp & 255u) == 0u) { if (xb_ld(&(bar)[XB_TMO])) break; if (_sp > XB_SPIN_CAP) { atomicAdd(&(bar)[XB_TMO], 1u); break; } } } } while (0)
struct XcdBarrier { unsigned* bar; unsigned x; volatile LAS unsigned* st; };
__device__ __forceinline__ XcdBarrier xcd_barrier_post(unsigned* bar, volatile LAS unsigned* st) {
    XcdBarrier b; b.bar = bar; b.x = xb_xcc_id(); b.st = st;
    if (threadIdx.x == 0) (void)xb_add(&bar[XB_XCNT(b.x)], 1u);
    return b;
}
__device__ __forceinline__ void xcd_barrier_complete(unsigned* bar, unsigned x, unsigned& nloc, unsigned& nx) {
    const unsigned G = gridDim.x * gridDim.y * gridDim.z;
    unsigned sum, cnt, mine, sp = 0u;
    for (;;) {
        sum = 0u; cnt = 0u; mine = 0u;
#pragma unroll
        for (unsigned j = 0; j < 16; ++j) { const unsigned c = xb_ld(&bar[XB_XCNT(j)]); sum += c; cnt += (c > 0u) ? 1u : 0u; mine = (j == x) ? c : mine; }
        if (sum == G) break;
        __builtin_amdgcn_s_sleep(1);
        if ((++sp & 255u) == 0u) { if (xb_ld(&bar[XB_TMO])) break; if (sp > XB_SPIN_CAP) { atomicAdd(&bar[XB_TMO], 1u); break; } }
    }
    nloc = mine > 0u ? mine : 1u; nx = cnt > 0u ? cnt : 1u;
}
__device__ __forceinline__ void xcd_barrier(const XcdBarrier& b) {
    asm volatile("s_waitcnt vmcnt(0)" ::: "memory");
    __syncthreads();
    if (threadIdx.x == 0) {
        unsigned bx = b.x; size_t bz_ = 0; asm volatile("" : "+s"(bz_), "+s"(bx)); unsigned* bar = b.bar + bz_;
        __builtin_amdgcn_s_waitcnt(0);
        unsigned nloc = b.st[0], nx = b.st[1];
        if (nloc == 0u) { xcd_barrier_complete(bar, bx, nloc, nx); b.st[0] = nloc; b.st[1] = nx; }
        const unsigned old = xb_add(&bar[XB_XSUB(bx)], 1u);
        const unsigned gen = old / nloc;
        if (old + 1u == (gen + 1u) * nloc) {
            __builtin_amdgcn_fence(__ATOMIC_RELEASE, "agent");
            asm volatile("s_waitcnt vmcnt(0)" ::: "memory");
            const unsigned og = xb_add(&bar[XB_TOP], 1u);
            const unsigned tg = og / nx;
            if (og + 1u == (tg + 1u) * nx) xb_add(&bar[XB_TOPGEN], 1u);
            else XB_SPIN(xb_ld(&bar[XB_TOPGEN]) == tg, bar);
            __builtin_amdgcn_fence(__ATOMIC_ACQUIRE, "agent");
            xb_add(&bar[XB_XGEN(bx)], 1u);
            asm volatile("s_waitcnt vmcnt(0)" ::: "memory");
        } else {
            XB_SPIN(xb_ld(&bar[XB_XGEN(bx)]) == gen, bar);
            __builtin_amdgcn_fence(__ATOMIC_ACQUIRE, "agent");
            asm volatile("s_waitcnt vmcnt(0)" ::: "memory");
        }
    }
    __syncthreads();
}

__device__ __forceinline__ float wave_sum(float v, int lane) {
#pragma unroll
    for (int o = 1; o < 64; o <<= 1) v += __builtin_bit_cast(float, __builtin_amdgcn_ds_bpermute((lane ^ o) << 2, __builtin_bit_cast(int, v)));
    return v;
}
__device__ __forceinline__ double lane_up_d(double v, int lane, int o) {
    const int src = (lane >= o ? lane - o : lane) << 2; const unsigned long long u = __builtin_bit_cast(unsigned long long, v);
    const unsigned lo = (unsigned)__builtin_amdgcn_ds_bpermute(src, (int)(unsigned)u), hi = (unsigned)__builtin_amdgcn_ds_bpermute(src, (int)(unsigned)(u >> 32));
    return __builtin_bit_cast(double, ((unsigned long long)hi << 32) | lo);
}
__device__ __forceinline__ void wconv_item(const float* W, int ldw, int src, int valid, const float* kscale, bf16* dst, int K, int k0, LAS float* scr, int lane) {
    const int j = lane & 31; const bool ok = j < valid;
    float wv[32];
#pragma unroll
    for (int i = 0; i < 32; ++i) { const int kk = 2 * i + (lane >> 5); wv[i] = ok ? W[(size_t)(k0 + kk) * ldw + src + j] : 0.f; }
    if (kscale) {
#pragma unroll
        for (int i = 0; i < 32; ++i) wv[i] *= kscale[k0 + 2 * i + (lane >> 5)]; }
#pragma unroll
    for (int i = 0; i < 32; ++i) scr[(2 * i + (lane >> 5)) * 33 + j] = wv[i];
    LDS_WAIT(); asm volatile("" ::: "memory");
    const int c = lane & 7;
#pragma unroll
    for (int jj = 0; jj < 4; ++jj) { const int n = (lane >> 3) + 8 * jj; const LAS float* s = scr + (8 * c) * 33 + n;
        v4u o; o.x = pk2(s[0 * 33], s[1 * 33]); o.y = pk2(s[2 * 33], s[3 * 33]); o.z = pk2(s[4 * 33], s[5 * 33]); o.w = pk2(s[6 * 33], s[7 * 33]);
        *(v4u*)(dst + (size_t)n * K + k0 + 8 * c) = o; }
    LDS_WAIT(); asm volatile("" ::: "memory");
}
__device__ __forceinline__ void inproj_src(int g, int& src, int& valid) {
    const int n = g * 32; valid = 32;
    if (n < 2304) src = n;
    else if (n < 2816) src = 2310 + (n - 2304);
    else if (n < 3072) src = 2822 + (n - 2816);
    else if (n < 3328) { const int p = n - 3072; if (p == 0) src = 3078; else if (p == 32) { src = 2304; valid = 6; } else if (p == 128) src = 3110; else { src = 0; valid = 0; } }
    else if (n < 4352) { const int base = (n < 3840) ? 3142 : 3654; const int p = (n < 3840) ? n - 3328 : n - 3840; const int t = p >> 8, q = p & 255, bj = q >> 7, x = q & 127, hh = x >> 6, i = x & 63;
        src = base + 128 * (2 * t + hh) + 64 * bj + i; }
    else if (n < 5376) src = 4166 + (n - 4352);
    else if (n < 6400) src = 5190 + (n - 5376);
    else src = 6214 + (n - 6400);
}
__device__ __forceinline__ void uq_src(int g, int& src, int& valid) {
    const int n = g * 32; valid = 32;
    if (n < 768) { const int t = n >> 8, q = n & 255, bj = q >> 7, x = q & 127; src = 192 * (2 * t + bj) + x; }
    else { const int t4 = (n >= 1024) ? 1 : 0; const int q = n - 768 - 256 * t4, bj = q >> 7, x = q & 127, hh = (x >> 5) + 4 * t4; if (hh < 6) src = 192 * hh + 128 + 32 * bj; else { src = 0; valid = 0; } }
}

struct Args {
    const float* in[19]; float* out; unsigned char* ws;
    float invf128[64]; float invf64[32];
    int ph_lo, ph_hi;
};

static_assert(sizeof(Args) == 560, "Args layout");

#define KAS __attribute__((address_space(4)))
#define GAS1 __attribute__((address_space(1)))
__device__ __forceinline__ const KAS char* karg_base() { size_t z = 0; asm volatile("" : "+s"(z)); return (const KAS char*)__builtin_amdgcn_kernarg_segment_ptr() + z; }
__device__ __forceinline__ const float* arg_in(int i) { typedef const GAS1 float* gp; return (const float*)(*(const KAS gp*)(karg_base() + 8 * i)); }
__device__ __forceinline__ float* arg_out() { typedef GAS1 float* gp; return (float*)(*(const KAS gp*)(karg_base() + 152)); }
__device__ __forceinline__ unsigned char* arg_ws() { typedef GAS1 unsigned char* gp; return (unsigned char*)(*(const KAS gp*)(karg_base() + 160)); }
__device__ __forceinline__ float arg_invf128(int i) { return *(const KAS float*)(karg_base() + 168 + 4 * i); }
__device__ __forceinline__ float arg_invf64(int i) { return *(const KAS float*)(karg_base() + 424 + 4 * i); }
struct Ctx { int tid, lane, wave, G, vcu, gw, NGW; LAS unsigned char* lds; unsigned char* ws; };
__device__ __forceinline__ Ctx ctx_local(const Ctx& C0) { Ctx C = C0; int t_ = threadIdx.x; asm volatile("" : "+v"(t_)); C.tid = t_; C.lane = t_ & 63; size_t z_ = 0; asm volatile("" : "+s"(C.wave), "+s"(C.gw), "+s"(C.vcu), "+s"(z_)); C.ws = arg_ws() + z_; return C; }

constexpr int XPITCH = 4096;
__device__ __forceinline__ void cvt8(const v4u w, float (&v)[8]) {
    v[0] = __uint_as_float(w.x << 16); v[1] = __uint_as_float(w.x & 0xffff0000u); v[2] = __uint_as_float(w.y << 16); v[3] = __uint_as_float(w.y & 0xffff0000u);
    v[4] = __uint_as_float(w.z << 16); v[5] = __uint_as_float(w.z & 0xffff0000u); v[6] = __uint_as_float(w.w << 16); v[7] = __uint_as_float(w.w & 0xffff0000u); }
__device__ __forceinline__ void rows_rmsnorm_first(const Ctx& C0, const float* x, const float* gain, bf16* xb, bf16* out) { const Ctx C = ctx_local(C0);
    f32x4 g[8];
#pragma unroll
    for (int j = 0; j < 8; ++j) g[j] = ((const f32x4*)gain + C.lane)[64 * j];
    for (int m = C.gw; m < M; m += 2 * C.NGW) {
        const int m2 = m + C.NGW; const bool has2 = m2 < M;
        const f32x4* xa = (const f32x4*)(x + (size_t)m * DM) + C.lane; const f32x4* xq = (const f32x4*)(x + (size_t)(has2 ? m2 : m) * DM) + C.lane;
        f32x4 va[8], vb[8]; float sa = 0.f, sb = 0.f;
#pragma unroll
        for (int j = 0; j < 8; ++j) va[j] = xa[64 * j];
#pragma unroll
        for (int j = 0; j < 8; ++j) vb[j] = xq[64 * j];
#pragma unroll
        for (int j = 0; j < 8; ++j) { sa += (va[j].x * va[j].x + va[j].y * va[j].y) + (va[j].z * va[j].z + va[j].w * va[j].w); sb += (vb[j].x * vb[j].x + vb[j].y * vb[j].y) + (vb[j].z * vb[j].z + vb[j].w * vb[j].w); }
        const float ra = __builtin_amdgcn_rsqf(wave_sum(sa, C.lane) * (1.0f / DM) + NORM_EPS), rb = __builtin_amdgcn_rsqf(wave_sum(sb, C.lane) * (1.0f / DM) + NORM_EPS);
        unsigned long long* oa = (unsigned long long*)(out + (size_t)m * DM) + C.lane; unsigned long long* ya = (unsigned long long*)(xb + (size_t)m * XPITCH) + C.lane;
#pragma unroll
        for (int j = 0; j < 8; ++j) { oa[64 * j] = (unsigned long long)pk2(va[j].x * ra * g[j].x, va[j].y * ra * g[j].y) | ((unsigned long long)pk2(va[j].z * ra * g[j].z, va[j].w * ra * g[j].w) << 32);
            ya[64 * j] = (unsigned long long)pk2(va[j].x, va[j].y) | ((unsigned long long)pk2(va[j].z, va[j].w) << 32); }
        if (has2) { unsigned long long* ob = (unsigned long long*)(out + (size_t)m2 * DM) + C.lane; unsigned long long* yb = (unsigned long long*)(xb + (size_t)m2 * XPITCH) + C.lane;
#pragma unroll
            for (int j = 0; j < 8; ++j) { ob[64 * j] = (unsigned long long)pk2(vb[j].x * rb * g[j].x, vb[j].y * rb * g[j].y) | ((unsigned long long)pk2(vb[j].z * rb * g[j].z, vb[j].w * rb * g[j].w) << 32);
                yb[64 * j] = (unsigned long long)pk2(vb[j].x, vb[j].y) | ((unsigned long long)pk2(vb[j].z, vb[j].w) << 32); } }
    }
}
__device__ __forceinline__ void rows_rmsnorm_bf16(const Ctx& C0, const bf16* xb, const float* gain, bf16* out) { const Ctx C = ctx_local(C0);
    f32x4 g[4][2];
#pragma unroll
    for (int j = 0; j < 4; ++j) { g[j][0] = *(const f32x4*)(gain + 8 * (C.lane + 64 * j)); g[j][1] = *(const f32x4*)(gain + 8 * (C.lane + 64 * j) + 4); }
    for (int m0 = C.gw; m0 < M; m0 += 4 * C.NGW) {
        v4u w[4][4];
#pragma unroll
        for (int q = 0; q < 4; ++q) { const int m = m0 + q * C.NGW; const v4u* xr = (const v4u*)(xb + (size_t)(m < M ? m : m0) * XPITCH) + C.lane;
#pragma unroll
            for (int j = 0; j < 4; ++j) w[q][j] = xr[64 * j]; }
#pragma unroll
        for (int q = 0; q < 4; ++q) { const int m = m0 + q * C.NGW; float s = 0.f;
#pragma unroll
            for (int j = 0; j < 4; ++j) { float v[8]; cvt8(w[q][j], v);
#pragma unroll
                for (int e = 0; e < 8; ++e) s += v[e] * v[e]; }
            const float r = __builtin_amdgcn_rsqf(wave_sum(s, C.lane) * (1.0f / DM) + NORM_EPS);
            if (m < M) { v4u* orow = (v4u*)(out + (size_t)m * DM) + C.lane;
#pragma unroll
                for (int j = 0; j < 4; ++j) { float v[8]; cvt8(w[q][j], v);
                    v4u o; o.x = pk2(v[0] * r * g[j][0][0], v[1] * r * g[j][0][1]); o.y = pk2(v[2] * r * g[j][0][2], v[3] * r * g[j][0][3]); o.z = pk2(v[4] * r * g[j][1][0], v[5] * r * g[j][1][1]); o.w = pk2(v[6] * r * g[j][1][2], v[7] * r * g[j][1][3]);
                    orow[64 * j] = o; } } }
    }
}
__device__ __forceinline__ void rows_rmsnorm_final(const Ctx& C0, float* outp, const float* gain) { const Ctx C = ctx_local(C0);
    f32x4 g[4][2];
#pragma unroll
    for (int j = 0; j < 4; ++j) { g[j][0] = *(const f32x4*)(gain + 8 * (C.lane + 64 * j)); g[j][1] = *(const f32x4*)(gain + 8 * (C.lane + 64 * j) + 4); }
    for (int m0 = C.gw; m0 < M; m0 += 4 * C.NGW) {
        v4u w[4][4];
#pragma unroll
        for (int q = 0; q < 4; ++q) { const int m = m0 + q * C.NGW; const v4u* xr = (const v4u*)((const bf16*)outp + (size_t)(m < M ? m : m0) * XPITCH) + C.lane;
#pragma unroll
            for (int j = 0; j < 4; ++j) w[q][j] = xr[64 * j]; }
        asm volatile("s_waitcnt vmcnt(0)" ::: "memory");
#pragma unroll
        for (int q = 0; q < 4; ++q) { const int m = m0 + q * C.NGW; float s = 0.f;
#pragma unroll
            for (int j = 0; j < 4; ++j) { float v[8]; cvt8(w[q][j], v);
#pragma unroll
                for (int e = 0; e < 8; ++e) s += v[e] * v[e]; }
            const float r = __builtin_amdgcn_rsqf(wave_sum(s, C.lane) * (1.0f / DM) + NORM_EPS);
            if (m < M) { float* orow = outp + (size_t)m * DM + 8 * C.lane;
#pragma unroll
                for (int j = 0; j < 4; ++j) { float v[8]; cvt8(w[q][j], v);
                    *(f32x4*)(orow + 512 * j) = (f32x4){v[0] * r * g[j][0][0], v[1] * r * g[j][0][1], v[2] * r * g[j][0][2], v[3] * r * g[j][0][3]};
                    *(f32x4*)(orow + 512 * j + 4) = (f32x4){v[4] * r * g[j][1][0], v[5] * r * g[j][1][1], v[6] * r * g[j][1][2], v[7] * r * g[j][1][3]}; } } }
    }
}
__device__ __forceinline__ void sincos_d(float angf, float& co, float& si) {
    const double a = (double)angf; const double k = __builtin_rint(a * 0.15915494309189535); double r = a - k * 6.283185307179586477;
    const double q = __builtin_rint(r * 0.63661977236758134308); const double y = r - q * 1.57079632679489661923; const double y2 = y * y;
    const double sy = y * (1.0 + y2 * (-1.0 / 6 + y2 * (1.0 / 120 + y2 * (-1.0 / 5040 + y2 * (1.0 / 362880 + y2 * (-1.0 / 39916800 + y2 * (1.0 / 6227020800.0)))))));
    const double cy = 1.0 + y2 * (-0.5 + y2 * (1.0 / 24 + y2 * (-1.0 / 720 + y2 * (1.0 / 40320 + y2 * (-1.0 / 3628800 + y2 * (1.0 / 479001600 + y2 * (-1.0 / 87178291200.0)))))));
    const int qi = ((int)q) & 3;
    const double s = (qi == 0) ? sy : (qi == 1) ? cy : (qi == 2) ? -sy : -cy;
    const double c = (qi == 0) ? cy : (qi == 1) ? -sy : (qi == 2) ? -cy : sy;
    co = (float)c; si = (float)s;
}
__device__ __forceinline__ void rope_tables(const Ctx& C0, const Args& A) { const Ctx C = ctx_local(C0);
    float* T128 = (float*)(C.ws + WS_T128); float* T64 = (float*)(C.ws + WS_T64);
    const int gt = (C.vcu * NWAVES + C.wave) * 64 + C.lane, NGT = C.NGW * 64;
    for (int e = gt; e < SEQ * 64; e += NGT) { const int pos = e >> 6, i = e & 63; float c, s; sincos_d((float)pos * arg_invf128(i), c, s); T128[2 * e] = c; T128[2 * e + 1] = s; }
    for (int e = gt; e < SEQ * 32; e += NGT) { const int pos = e >> 5, i = e & 31; float c, s; sincos_d((float)pos * arg_invf64(i), c, s); T64[2 * e] = c; T64[2 * e + 1] = s; }
}
__device__ __forceinline__ void p0_phase(const Ctx& C0, const Args& A, int layer) { const Ctx C = ctx_local(C0);
    LAS float* scr = (LAS float*)(C.lds + RING_OFF + C.wave * 16384);
    const float* w_in = arg_in(2) + (size_t)layer * DM * IN_W;
    const float* w_uq = arg_in(5) + (size_t)layer * 512 * 1152; const float* w_ukv = arg_in(6) + (size_t)layer * 256 * 1536;
    const float* qg = arg_in(3) + (size_t)layer * 512; const float* kvg = arg_in(4) + (size_t)layer * 256;
    const float* w_bf = arg_in(8) + (size_t)layer * 768 * DM; const float* w_bm = arg_in(9) + (size_t)layer * 768 * DM; const float* w_br = arg_in(10) + (size_t)layer * 1024 * DM;
    const float* w_out = arg_in(11) + (size_t)layer * DM * DM;
    const float* w_up = arg_in(13) + (size_t)layer * DM * DFF; const float* w_gate = arg_in(14) + (size_t)layer * DM * DFF; const float* w_dn = arg_in(17) + (size_t)layer * DFF * DM;
    bf16* Wb = (bf16*)(C.ws + WS_W);
    constexpr int I_IN = (NIN / 32) * (DM / 64), I_UQ = (NUQ / 32) * (512 / 64), I_UKV = (NUKV / 32) * (256 / 64), I_BF = (DM / 32) * (768 / 64), I_BR = (DM / 32) * (1024 / 64),
                  I_OUT = (DM / 32) * (DM / 64), I_UG = (NUG / 32) * (DM / 64), I_DN = (DM / 32) * (DFF / 64);
    constexpr int NITEMS = I_IN + I_UQ + I_UKV + 2 * I_BF + I_BR + I_OUT;
    for (int it = C.gw; it < NITEMS; it += C.NGW) {
        int r = it, src, valid;
        if (r < I_IN) { const int g = r / (DM / 64), kb = r % (DM / 64); inproj_src(g, src, valid); wconv_item(w_in, IN_W, src, valid, nullptr, (bf16*)((char*)Wb + WO_IN) + (size_t)g * 32 * DM, DM, kb * 64, scr, C.lane); continue; } r -= I_IN;
        if (r < I_UQ) { const int g = r / 8, kb = r % 8; uq_src(g, src, valid); wconv_item(w_uq, 1152, src, valid, qg, (bf16*)((char*)Wb + WO_UQ) + (size_t)g * 32 * 512, 512, kb * 64, scr, C.lane); continue; } r -= I_UQ;
        if (r < I_UKV) { const int g = r / 4, kb = r % 4; wconv_item(w_ukv, 1536, g * 32, 32, kvg, (bf16*)((char*)Wb + WO_UKV) + (size_t)g * 32 * 256, 256, kb * 64, scr, C.lane); continue; } r -= I_UKV;
        if (r < I_BF) { const int g = r / 12, kb = r % 12; wconv_item(w_bf, DM, g * 32, 32, nullptr, (bf16*)((char*)Wb + WO_BF) + (size_t)g * 32 * 1024, 1024, kb * 64, scr, C.lane); continue; } r -= I_BF;
        if (r < I_BF) { const int g = r / 12, kb = r % 12; wconv_item(w_bm, DM, g * 32, 32, nullptr, (bf16*)((char*)Wb + WO_BM) + (size_t)g * 32 * 1024, 1024, kb * 64, scr, C.lane); continue; } r -= I_BF;
        if (r < I_BR) { const int g = r / 16, kb = r % 16; wconv_item(w_br, DM, g * 32, 32, nullptr, (bf16*)((char*)Wb + WO_BR) + (size_t)g * 32 * 1024, 1024, kb * 64, scr, C.lane); continue; } r -= I_BR;
        if (r < I_OUT) { const int g = r / 32, kb = r % 32; wconv_item(w_out, DM, g * 32, 32, nullptr, (bf16*)((char*)Wb + WO_OUT) + (size_t)g * 32 * DM, DM, kb * 64, scr, C.lane); }
    }
    if (layer == 0) rows_rmsnorm_first(C, arg_in(0), arg_in(1), (bf16*)arg_out(), (bf16*)(C.ws + WS_H));
    else rows_rmsnorm_bf16(C, (const bf16*)arg_out(), arg_in(1) + (size_t)layer * DM, (bf16*)(C.ws + WS_H));
}
__device__ __forceinline__ void wconv_ffn(const Ctx& C0, int layer, int first, int nblk) { const Ctx C = ctx_local(C0);
    LAS float* scr = (LAS float*)(C.lds + RING_OFF + C.wave * 16384);
    const float* w_up = arg_in(13) + (size_t)layer * DM * DFF; const float* w_gate = arg_in(14) + (size_t)layer * DM * DFF; const float* w_dn = arg_in(17) + (size_t)layer * DFF * DM;
    bf16* Wb = (bf16*)(C.ws + WS_W);
    constexpr int I_UG = (NUG / 32) * (DM / 64), I_DN = (DM / 32) * (DFF / 64);
    for (int it = first * NWAVES + C.wave; it < I_UG + I_DN; it += nblk * NWAVES) {
        int r = it;
        if (r < I_UG) { const int g = r / 32, kb = r % 32; const int n = g * 32, t = n >> 8, bj = (n >> 7) & 1, x = n & 127;
            wconv_item(bj ? w_gate : w_up, DFF, 128 * t + x, 32, nullptr, (bf16*)((char*)Wb + WO_UG) + (size_t)g * 32 * DM, DM, kb * 64, scr, C.lane); continue; } r -= I_UG;
        { const int g = r / 88, kb = r % 88; wconv_item(w_dn, DM, g * 32, 32, nullptr, (bf16*)((char*)Wb + WO_DN) + (size_t)g * 32 * DFF, DFF, kb * 64, scr, C.lane); }
    }
}
__device__ __forceinline__ void p2_phase(const Ctx& C0, const Args& A, int layer) { const Ctx C = ctx_local(C0);
    const float* ff = (const float*)(C.ws + WS_FF); float* cL = (float*)(C.ws + WS_CL);
    LAS double* red = (LAS double*)(C.lds + RING_OFF);
    for (int sq = C.vcu; sq < NBATCH * 6; sq += C.G) {
        const int b = sq / 6, h = sq % 6; const float bias = arg_in(7)[layer * 6 + h];
        double v[8]; double run = 0.0;
#pragma unroll
        for (int j = 0; j < 8; ++j) { const float xf = ff[((size_t)b * SEQ + C.tid * 8 + j) * 8 + h] + bias;
            const float ls = fminf(xf, 0.f) - 0.6931471805599453f * __builtin_amdgcn_logf(1.0f + __builtin_amdgcn_exp2f(-1.4426950408889634f * fabsf(xf)));
            run += (double)ls; v[j] = run; }
        double incl = run;
#pragma unroll
        for (int o = 1; o < 64; o <<= 1) { const double t = lane_up_d(incl, C.lane, o); if (C.lane >= o) incl += t; }
        __syncthreads();
        if (C.lane == 63) red[C.wave] = incl;
        __syncthreads();
        double base = incl - run;
        for (int w = 0; w < C.wave; ++w) base += red[w];
        float* dst = cL + (size_t)sq * SEQ + C.tid * 8;
#pragma unroll
        for (int j = 0; j < 8; ++j) dst[j] = (float)((base + v[j]) * 1.4426950408889634);
    }
    const bf16* cq = (const bf16*)(C.ws + WS_CQ); const bf16* ckv = (const bf16*)(C.ws + WS_CKV); float* rq = (float*)(C.ws + WS_RSQ); float* rkv = (float*)(C.ws + WS_RSKV);
    for (int m0 = C.gw; m0 < M; m0 += 4 * C.NGW) {
        v4u a[4], c[4];
#pragma unroll
        for (int q = 0; q < 4; ++q) { const int m = m0 + q * C.NGW; const int mm = m < M ? m : m0; a[q] = *((const v4u*)(cq + (size_t)mm * 512) + C.lane); c[q] = *((const v4u*)(ckv + (size_t)mm * 256) + (C.lane & 31)); }
#pragma unroll
        for (int q = 0; q < 4; ++q) { const int m = m0 + q * C.NGW;
            float s = 0.f, s2 = 0.f; const unsigned w[4] = {a[q].x, a[q].y, a[q].z, a[q].w}, w2[4] = {c[q].x, c[q].y, c[q].z, c[q].w};
#pragma unroll
            for (int j = 0; j < 4; ++j) { const float lo = __uint_as_float(w[j] << 16), hi = __uint_as_float(w[j] & 0xffff0000u); s += lo * lo + hi * hi;
                const float lo2 = __uint_as_float(w2[j] << 16), hi2 = __uint_as_float(w2[j] & 0xffff0000u); if (C.lane < 32) s2 += lo2 * lo2 + hi2 * hi2; }
            s = wave_sum(s, C.lane); s2 = wave_sum(s2, C.lane);
            if (C.lane == 0 && m < M) { rq[m] = __builtin_amdgcn_rsqf(s * (1.0f / 512.0f) + NORM_EPS); rkv[m] = __builtin_amdgcn_rsqf(s2 * (1.0f / 256.0f) + NORM_EPS); } }
    }
    { const bf16* rk = (const bf16*)(C.ws + WS_RK); const bf16* rv = (const bf16*)(C.ws + WS_RV); float* sloc = (float*)(C.ws + WS_SLOC);
      for (int u = C.vcu; u < NBATCH * 4 * 16; u += C.G) { const int k = u & 15, h = (u >> 4) & 3, b = u >> 6; const size_t row0 = (size_t)b * SEQ + 256 * k;
          att::ret_state_unit(rk + row0 * 512 + 128 * h, 512, rv + row0 * 1024 + 256 * h, 1024, __builtin_amdgcn_logf(1.0f - __builtin_amdgcn_exp2f(-5.0f - (float)h)), sloc + (size_t)u * 32768, (LAS char*)(C.lds + RING_OFF)); } }
}
__device__ __forceinline__ void ret_scan(const Ctx& C0) { const Ctx C = ctx_local(C0);
    const float* sloc = (const float*)(C.ws + WS_SLOC); bf16* sst = (bf16*)(C.ws + WS_SST);
    for (int it = C.gw * 64 + C.lane; it < NBATCH * 4 * 8192; it += C.NGW * 64) {
        const int bh = it >> 13, e4 = (it & 8191) * 4, h = bh & 3;
        const float g256 = __builtin_amdgcn_exp2f(256.0f * __builtin_amdgcn_logf(1.0f - __builtin_amdgcn_exp2f(-5.0f - (float)h)));
        f32x4 s = {0.f, 0.f, 0.f, 0.f};
        f32x4 l[16];
#pragma unroll
        for (int k = 0; k < 15; ++k) l[k] = *(const f32x4*)(sloc + ((size_t)bh * 16 + k) * 32768 + e4);
#pragma unroll
        for (int k = 0; k < 16; ++k) { const size_t o = ((size_t)bh * 16 + k) * 32768 + e4;
            *(unsigned long long*)(sst + o) = (unsigned long long)pk2(s[0], s[1]) | ((unsigned long long)pk2(s[2], s[3]) << 32);
            if (k < 15) s = s * g256 + l[k]; }
    }
}
__device__ __forceinline__ void p9_phase(const Ctx& C0, const Args& A, int layer) { const Ctx C = ctx_local(C0);
    const float* utail = (const float*)(C.ws + WS_UTAIL); const float* uhead = (const float*)(C.ws + WS_UHEAD); const float* ghead = (const float*)(C.ws + WS_GHEAD); bf16* act = (bf16*)(C.ws + WS_ACT);
    const float* cw = arg_in(15) + (size_t)layer * 3 * DFF; const float* cb = arg_in(16) + (size_t)layer * DFF;
    constexpr int NCH = DFF / 8, NITEM = (M / 256) * 2 * NCH;
    for (int it = C.gw * 64 + C.lane; it < NITEM; it += C.NGW * 64) {
        const int ch = it % NCH, rr = (it / NCH) & 1, pm = it / (2 * NCH), f0 = ch * 8;
        if ((pm & 15) == 0) continue;
        const float* p2 = rr ? utail + ((size_t)(pm - 1) * 2 + 1) * DFF : utail + ((size_t)(pm - 1) * 2) * DFF;
        const float* p1 = rr ? uhead + ((size_t)pm * 2) * DFF : utail + ((size_t)(pm - 1) * 2 + 1) * DFF;
        const float* p0 = uhead + ((size_t)pm * 2 + rr) * DFF; const float* pg = ghead + ((size_t)pm * 2 + rr) * DFF;
        unsigned o[4];
#pragma unroll
        for (int h = 0; h < 2; ++h) { const f32x4 x2 = *(const f32x4*)(p2 + f0 + 4 * h), x1 = *(const f32x4*)(p1 + f0 + 4 * h), x0 = *(const f32x4*)(p0 + f0 + 4 * h), g = *(const f32x4*)(pg + f0 + 4 * h);
            const f32x4 a = *(const f32x4*)(cw + f0 + 4 * h), b = *(const f32x4*)(cw + DFF + f0 + 4 * h), c = *(const f32x4*)(cw + 2 * DFF + f0 + 4 * h), d = *(const f32x4*)(cb + f0 + 4 * h);
            float r[4];
#pragma unroll
            for (int j = 0; j < 4; ++j) r[j] = pg8::gelu_gate(d[j] + a[j] * x2[j] + b[j] * x1[j] + c[j] * x0[j], g[j]);
            o[2 * h] = pg8::cvt_pk_bf16(r[0], r[1]); o[2 * h + 1] = pg8::cvt_pk_bf16(r[2], r[3]); }
        *(v4u*)(act + (size_t)(pm * 256 + rr) * DFF + f0) = (v4u){o[0], o[1], o[2], o[3]};
    }
}
#ifndef PROBE_SKIP_EPI
#define PROBE_SKIP_EPI 0
#endif
#ifndef KIND_MASK
#define KIND_MASK 7
#endif

__device__ __forceinline__ int queue_next(unsigned* head, volatile LAS unsigned* slot) {
    __syncthreads();
    if (threadIdx.x == 0) *slot = __hip_atomic_fetch_add(head, 1u, __ATOMIC_RELAXED, __HIP_MEMORY_SCOPE_AGENT);
    __syncthreads();
    return (int)*slot;
}
__device__ __forceinline__ void p4_phase(const Ctx& C0, const Args& A, int layer, volatile LAS unsigned* slot, int rep) { const Ctx C = ctx_local(C0);
    unsigned* qh = (unsigned*)(C.ws + WS_CTL) + CW_QUEUE + 64 * 3 * layer + 64 * 12 * rep;
    const bool k0 = rep == 0 || (KIND_MASK & 1), k1 = rep == 0 || (KIND_MASK & 2), k2 = rep == 0 || (KIND_MASK & 4);
    LAS char* lds = (LAS char*)(C.lds + RING_OFF);
    const bf16* fqkv = (const bf16*)(C.ws + WS_FQKV); const float* cL = (const float*)(C.ws + WS_CL);
    const bf16* qm = (const bf16*)(C.ws + WS_QM); const bf16* kvm = (const bf16*)(C.ws + WS_KVM); const bf16* kr = (const bf16*)(C.ws + WS_KR);
    const bf16* rq = (const bf16*)(C.ws + WS_RQ); const bf16* rk = (const bf16*)(C.ws + WS_RK); const bf16* rv = (const bf16*)(C.ws + WS_RV); const bf16* rg = (const bf16*)(C.ws + WS_RG);
    bf16* oa = (bf16*)(C.ws + WS_A); bf16* ob = (bf16*)(C.ws + WS_BM); bf16* oc = (bf16*)(C.ws + WS_C);
    if (k2) for (;;) { const int i = queue_next(qh + 128, slot); if (i >= 1024) break;
        const int qb = 31 - i / 32, bh = i % 32, b = bh >> 2, h = bh & 3; const size_t row0 = (size_t)b * SEQ + 128 * qb, seq0 = (size_t)b * SEQ;
        att::UnitPtrs U; U.Q = rq + row0 * 512 + 128 * h; U.ldq = 512; U.K = rk + seq0 * 512 + 128 * h; U.ldk = 512; U.V = rv + seq0 * 1024 + 256 * h; U.ldv = 1024; U.KR = nullptr; U.bias = nullptr;
        U.G = rg + row0 * 1024 + 256 * h; U.O = oc + row0 * 1024 + 256 * h; U.ldo = 1024; U.P0 = 128 * qb; U.T0 = 256 * (qb >> 1);
        U.ST = (qb >> 1) ? (const bf16*)(C.ws + WS_SST) + ((size_t)bh * 16 + (qb >> 1)) * 32768 : nullptr; U.c2 = __builtin_amdgcn_logf(1.0f - __builtin_amdgcn_exp2f(-5.0f - (float)h));
        att::mixer_unit<2>(U, lds); }
    if (k1) for (;;) { const int i = queue_next(qh + 64, slot); if (i >= 768) break;
        const int qb = 15 - i / 48, bh = i % 48, b = bh / 6, h = bh % 6; const size_t row0 = (size_t)b * SEQ + 256 * qb, seq0 = (size_t)b * SEQ;
        att::UnitPtrs U; U.Q = qm + row0 * 1152 + 192 * h; U.ldq = 1152; U.K = kvm + seq0 * 1536 + 256 * h; U.ldk = 1536; U.V = U.K + 128; U.ldv = 1536; U.KR = kr + seq0 * 64; U.bias = nullptr; U.G = nullptr; U.ST = nullptr; U.T0 = 0;
        U.O = ob + row0 * 1024 + 128 * h; U.ldo = 1024; U.P0 = 256 * qb; U.c2 = 0.07216878364870322f * 1.4426950408889634f;
        att::mixer_unit<1>(U, lds); }
    if (k0) for (;;) { const int i = queue_next(qh, slot); if (i >= 768) break;
        const int qb = 15 - i / 48, bh = i % 48, b = bh / 6, h = bh % 6; const size_t row0 = (size_t)b * SEQ + 256 * qb, seq0 = (size_t)b * SEQ;
        att::UnitPtrs U; U.Q = fqkv + row0 * 2304 + 128 * h; U.ldq = 2304; U.K = fqkv + seq0 * 2304 + 768 + 128 * h; U.ldk = 2304; U.V = U.K + 768; U.ldv = 2304; U.KR = nullptr; U.G = nullptr; U.ST = nullptr; U.T0 = 0;
        U.bias = cL + (size_t)bh * SEQ; U.O = oa + row0 * 1024 + 128 * h; U.ldo = 1024; U.P0 = 256 * qb; U.c2 = 0.08838834764831845f * 1.4426950408889634f;
        att::mixer_unit<0>(U, lds); }
}

__global__ void __launch_bounds__(NWAVES * 64, 2) hyb_fwd(Args args) {
    extern __shared__ __attribute__((aligned(16))) unsigned char lds_raw[];
    Ctx C;
    C.lds = (LAS unsigned char*)lds_raw;
    volatile LAS unsigned* MISC = (volatile LAS unsigned*)(C.lds + MISC_OFF);
    C.tid = 0; C.lane = 0; C.wave = __builtin_amdgcn_readfirstlane((int)threadIdx.x >> 6);
    C.G = gridDim.x; { const int bx = blockIdx.x; C.vcu = (C.G % 8 == 0) ? (bx % 8) * (C.G / 8) + bx / 8 : bx; }
    C.gw = C.vcu * NWAVES + C.wave; C.NGW = C.G * NWAVES; C.ws = arg_ws();
    unsigned* ctl = (unsigned*)(C.ws + WS_CTL);
    for (int u = threadIdx.x; u < (LDS_BYTES - LDSCTL_OFF) / 4; u += NWAVES * 64) ((LAS unsigned*)(C.lds + LDSCTL_OFF))[u] = 0u;
    __syncthreads();
#if MK_PER_PHASE
    XcdBarrier bar; bar.bar = ctl + CW_BAR; bar.x = 0; bar.st = nullptr; (void)bar;
#define GRID_BAR() do { } while (0)
#else
    XcdBarrier bar = xcd_barrier_post(ctl + CW_BAR, MISC + 8);
#define GRID_BAR() xcd_barrier(bar)
#endif
    const int lo = args.ph_lo, hi = args.ph_hi;
#define IN(k) (lo <= (k) && (k) < hi)
#ifndef PHASE_MASK
#define PHASE_MASK 0xFFFF
#endif
#define PHM(k) (((PHASE_MASK) >> (k)) & 1)
#ifndef SUB_MASK
#define SUB_MASK 0xFF
#endif
#define SUBM(k) (((SUB_MASK) >> (k)) & 1)
#ifndef REPEAT_MASK
#define REPEAT_MASK 0
#endif
#define REPS(k) (1 + (((REPEAT_MASK) >> (k)) & 1))

#define SEAM(k) do { if (IN(k) && IN((k) + 1)) GRID_BAR(); } while (0)
    PG8_LAS unsigned char* ring = (PG8_LAS unsigned char*)(C.lds + RING_OFF);
    const int bid = (int)blockIdx.x;
    if (PHM(0) && IN(0)) rope_tables(C, args);
    for (int layer = 0; layer < DEPTH; ++layer) {
        const int p = layer * PH;
        _Pragma("unroll") for (int rep = 0; rep < REPS(0); ++rep) if (PHM(0) && IN(p + 0)) { p0_phase(C, args, layer); if (rep + 1 < REPS(0)) GRID_BAR(); else SEAM(p + 0); }
        _Pragma("unroll") for (int rep = 0; rep < REPS(1); ++rep) if (PHM(1) && IN(p + 1)) { size_t wz_ = 0; asm volatile("" : "+s"(wz_)); unsigned char* wsl = arg_ws() + wz_; pg8::bf16_t* Wb = (pg8::bf16_t*)(wsl + WS_W); pg8::bf16_t* Hb = (pg8::bf16_t*)(wsl + WS_H);
            pg8::Gemm g{Hb, (const pg8::bf16_t*)((char*)Wb + WO_IN), M, NIN, DM}; pg8::StaticOrder S; S.init(M, NIN, C.G, bid);
            pg8::EpiInProj E{wsl, WS_FQKV, WS_CQ, WS_CKV, WS_KR, WS_RQ, WS_RK, WS_RV, WS_RG, WS_GATES, WS_FF, WS_T128, WS_T64, (rep + 1 < REPS(1)) ? PROBE_SKIP_EPI : 0};
            pg8::gemm_phase<pg8::EpiInProj, pg8::StaticOrder, true, true>(ring, g, S, E);
            { const int nfull = (M / 256) * (NIN / 256) % C.G; if (rep + 1 == REPS(1)) { if (nfull == 0) wconv_ffn(C, layer, bid, C.G); else if (bid >= nfull) wconv_ffn(C, layer, bid - nfull, C.G - nfull); } }
            if (rep + 1 < REPS(1)) GRID_BAR(); else SEAM(p + 1); }
        _Pragma("unroll") for (int rep = 0; rep < REPS(2); ++rep) if (PHM(2) && IN(p + 2)) { p2_phase(C, args, layer); if (rep + 1 < REPS(2)) GRID_BAR(); else SEAM(p + 2); }
        _Pragma("unroll") for (int rep = 0; rep < REPS(3); ++rep) if (PHM(3) && IN(p + 3)) { size_t wz_ = 0; asm volatile("" : "+s"(wz_)); unsigned char* wsl = arg_ws() + wz_; pg8::bf16_t* Wb = (pg8::bf16_t*)(wsl + WS_W); pg8::bf16_t* Hb = (pg8::bf16_t*)(wsl + WS_H);
            if (SUBM(0)) { pg8::Gemm g{(const pg8::bf16_t*)(wsl + WS_CQ), (const pg8::bf16_t*)((char*)Wb + WO_UQ), M, NUQ, 512}; pg8::StaticOrder S; S.init(M, NUQ, C.G, bid);
              pg8::EpiUq E{(pg8::bf16_t*)(wsl + WS_QM), (const float*)(wsl + WS_RSQ), (const float*)(wsl + WS_T64)};
              pg8::gemm_phase<pg8::EpiUq, pg8::StaticOrder, true, true>(ring, g, S, E); }
            if (SUBM(1)) { pg8::Gemm g{(const pg8::bf16_t*)(wsl + WS_CKV), (const pg8::bf16_t*)((char*)Wb + WO_UKV), M, NUKV, 256}; pg8::StaticOrder S; S.init(M, NUKV, C.G, bid);
              pg8::EpiUkv E{(pg8::bf16_t*)(wsl + WS_KVM), (const float*)(wsl + WS_RSKV)};
              pg8::gemm_phase<pg8::EpiUkv, pg8::StaticOrder, true, true>(ring, g, S, E); }
            ret_scan(C);
            if (rep + 1 < REPS(3)) GRID_BAR(); else SEAM(p + 3); }
        _Pragma("unroll") for (int rep = 0; rep < REPS(4); ++rep) if (PHM(4) && IN(p + 4)) { p4_phase(C, args, layer, MISC + 16, rep); if (rep + 1 < REPS(4)) GRID_BAR(); else SEAM(p + 4); }
        _Pragma("unroll") for (int rep = 0; rep < REPS(5); ++rep) if (PHM(5) && IN(p + 5)) { size_t wz_ = 0; asm volatile("" : "+s"(wz_)); unsigned char* wsl = arg_ws() + wz_; pg8::bf16_t* Wb = (pg8::bf16_t*)(wsl + WS_W); pg8::bf16_t* Hb = (pg8::bf16_t*)(wsl + WS_H);
            { static_assert(WS_BM - WS_A == WS_C - WS_BM && WO_BM - WO_BF == WO_BR - WO_BM, "equally spaced sub-GEMM operands");
              pg8::GemmM g{(const pg8::bf16_t*)(wsl + WS_A), (const pg8::bf16_t*)((char*)Wb + WO_BF), (WS_BM - WS_A) / 2, (WO_BM - WO_BF) / 2, 12, 4, 1024, 1024};
              pg8::StaticOrder3 S; S.init(M, DM, C.G, bid);
              pg8::EpiMergeM E{(const pg8::bf16_t*)(wsl + WS_GATES), Hb};
              pg8::gemm_phase_m<pg8::EpiMergeM, pg8::StaticOrder3, true, true>(ring, g, S, E); }
            if (rep + 1 < REPS(5)) GRID_BAR(); else SEAM(p + 5); }
        _Pragma("unroll") for (int rep = 0; rep < REPS(6); ++rep) if (PHM(6) && IN(p + 6)) { size_t wz_ = 0; asm volatile("" : "+s"(wz_)); unsigned char* wsl = arg_ws() + wz_; pg8::bf16_t* Wb = (pg8::bf16_t*)(wsl + WS_W); pg8::bf16_t* Hb = (pg8::bf16_t*)(wsl + WS_H);
            pg8::Gemm g{Hb, (const pg8::bf16_t*)((char*)Wb + WO_OUT), M, DM, DM}; pg8::StaticOrder S; S.init(M, DM, C.G, bid);
            pg8::EpiResid E{(pg8::bf16_t*)arg_out()}; pg8::gemm_phase<pg8::EpiResid, pg8::StaticOrder, true, true>(ring, g, S, E);
            if (rep + 1 < REPS(6)) GRID_BAR(); else SEAM(p + 6); }
        _Pragma("unroll") for (int rep = 0; rep < REPS(7); ++rep) if (PHM(7) && IN(p + 7)) { rows_rmsnorm_bf16(C, (const bf16*)arg_out(), arg_in(12) + (size_t)layer * DM, (bf16*)(C.ws + WS_H)); if (rep + 1 < REPS(7)) GRID_BAR(); else SEAM(p + 7); }
        _Pragma("unroll") for (int rep = 0; rep < REPS(8); ++rep) if (PHM(8) && IN(p + 8)) { size_t wz_ = 0; asm volatile("" : "+s"(wz_)); unsigned char* wsl = arg_ws() + wz_; pg8::bf16_t* Wb = (pg8::bf16_t*)(wsl + WS_W); pg8::bf16_t* Hb = (pg8::bf16_t*)(wsl + WS_H);
            pg8::Gemm g{Hb, (const pg8::bf16_t*)((char*)Wb + WO_UG), M, NUG, DM}; pg8::StaticOrder S; S.init(M, NUG, C.G, bid);
            pg8::EpiConvAct E{(pg8::bf16_t*)(wsl + WS_ACT), (float*)(wsl + WS_UTAIL), (float*)(wsl + WS_UHEAD), (float*)(wsl + WS_GHEAD), arg_in(15) + (size_t)layer * 3 * DFF, arg_in(16) + (size_t)layer * DFF, (PG8_LAS float*)(C.lds + LDSCTL_OFF + 1024)};
            pg8::gemm_phase<pg8::EpiConvAct, pg8::StaticOrder, true, true>(ring, g, S, E);
            if (rep + 1 < REPS(8)) GRID_BAR(); else SEAM(p + 8); }
        _Pragma("unroll") for (int rep = 0; rep < REPS(9); ++rep) if (PHM(9) && IN(p + 9)) { p9_phase(C, args, layer); if (rep + 1 < REPS(9)) GRID_BAR(); else SEAM(p + 9); }
        _Pragma("unroll") for (int rep = 0; rep < REPS(10); ++rep) if (PHM(10) && IN(p + 10)) { size_t wz_ = 0; asm volatile("" : "+s"(wz_)); unsigned char* wsl = arg_ws() + wz_; pg8::bf16_t* Wb = (pg8::bf16_t*)(wsl + WS_W); pg8::bf16_t* Hb = (pg8::bf16_t*)(wsl + WS_H);
            pg8::Gemm g{(const pg8::bf16_t*)(wsl + WS_ACT), (const pg8::bf16_t*)((char*)Wb + WO_DN), M, DM, DFF}; pg8::StaticOrder S; S.init(M, DM, C.G, bid);
            pg8::EpiResid E{(pg8::bf16_t*)arg_out()}; pg8::gemm_phase<pg8::EpiResid, pg8::StaticOrder, true, true>(ring, g, S, E);
            if (rep + 1 < REPS(10)) GRID_BAR(); else SEAM(p + 10); }
    }
    if (IN(DEPTH * PH)) rows_rmsnorm_final(C, arg_out(), arg_in(18));
#if defined(PROBE_EXTRA_BARRIERS) && !MK_PER_PHASE
    for (int i = 0; i < PROBE_EXTRA_BARRIERS; ++i) GRID_BAR();
#endif
#undef IN
#undef SEAM
#undef GRID_BAR
}

extern "C" void kernel_launch(void* const* d_in, const int* in_sizes, int n_in, void* d_out, int out_size, void* d_ws, size_t ws_size, hipStream_t stream) {
    static int grid = 0;
    if (grid == 0) {
        if (n_in != 19 || out_size != M * DM || ws_size < WS_END) { fprintf(stderr, "kernel_launch: unexpected problem (n_in %d, out %d, ws %zu < %zu); nothing launched\n", n_in, out_size, ws_size, (size_t)WS_END); grid = -1; return; }
        int dev = 0, cus = 0, per_cu = 0;
        if (hipGetDevice(&dev) != hipSuccess || hipDeviceGetAttribute(&cus, hipDeviceAttributeMultiprocessorCount, dev) != hipSuccess) { grid = -1; return; }
        if (hipFuncSetAttribute((const void*)hyb_fwd, hipFuncAttributeMaxDynamicSharedMemorySize, LDS_BYTES) != hipSuccess) { fprintf(stderr, "kernel_launch: hipFuncSetAttribute failed\n"); grid = -1; return; }
        if (hipOccupancyMaxActiveBlocksPerMultiprocessor(&per_cu, (const void*)hyb_fwd, NWAVES * 64, LDS_BYTES) != hipSuccess || per_cu < 1) { fprintf(stderr, "kernel_launch: occupancy query says %d\n", per_cu); }
        (void)hipGetLastError();
        grid = cus;
    }
    if (grid < 0) return;
    (void)in_sizes;
    if (hipMemsetAsync((char*)d_ws + WS_CTL, 0, CTL_ZERO_BYTES, stream) != hipSuccess) return;
    Args a; memset(&a, 0, sizeof(a));
    for (int i = 0; i < 19; ++i) a.in[i] = (const float*)d_in[i];
    a.out = (float*)d_out; a.ws = (unsigned char*)d_ws;
    for (int i = 0; i < 64; ++i) a.invf128[i] = (float)pow(10000.0, -(double)(2 * i) / 128.0);
    for (int i = 0; i < 32; ++i) a.invf64[i] = (float)pow(10000.0, -(double)(2 * i) / 64.0);
#if MK_PER_PHASE
    for (int ph = 0; ph < NPHASE; ++ph) { a.ph_lo = ph; a.ph_hi = ph + 1; hipLaunchKernelGGL(hyb_fwd, dim3(grid), dim3(NWAVES * 64), LDS_BYTES, stream, a); }
#else
    a.ph_lo = 0; a.ph_hi = NPHASE; hipLaunchKernelGGL(hyb_fwd, dim3(grid), dim3(NWAVES * 64), LDS_BYTES, stream, a);
#endif
    const hipError_t le = hipPeekAtLastError();
    if (le != hipSuccess) fprintf(stderr, "kernel_launch: launch failed: %s\n", hipGetErrorName(le));
}
```

```cpp
#include <hip/hip_runtime.h>
#include <cstdio>
#include <cstdint>
#include <cmath>
#ifndef MK_PER_PHASE
#define MK_PER_PHASE 0
#endif
#include <cstring>
namespace pg8 {
#define PG8_LAS __attribute__((address_space(3)))
typedef unsigned short bf16_t;
typedef short bf16x8 __attribute__((ext_vector_type(8)));
typedef float f32x4 __attribute__((ext_vector_type(4)));
typedef unsigned u32x4 __attribute__((ext_vector_type(4)));
constexpr int BM = 256, BK = 64, HALF = 128, HTB = HALF * BK * 2  , STAGE_BYTES = 8 * HTB, NXCD = 8, WGM = 8;

__host__ __device__ __forceinline__ int lds_byte(int r, int c) { const int st = (r >> 4) * 2 + (c >> 5), rr = r & 15, cc = c & 31, ob = rr * 64 + cc * 2; return st * 1024 + (ob ^ (((ob >> 9) & 1) << 5)); }
__host__ __device__ __forceinline__ void stage_rc(int b, int& R, int& C) { const int st = b / 1024, sb = b % 1024, swz = sb ^ (((sb >> 9) & 1) << 5); R = (st >> 1) * 16 + swz / 64; C = (st & 1) * 32 + (swz % 64) / 2; }
__host__ __device__ __forceinline__ int perm32(int rho) { const int n = rho >> 4, i = rho & 15; return 8 * (i >> 2) + 4 * n + (i & 3); }

struct Unit { int pm, pn; };
struct Gemm { const bf16_t* A; const bf16_t* Bt; int M, N, K; };

struct StaticOrder {
    int nM, nN, nwg, G, c;
    __host__ __device__ void init(int M, int N, int G_, int c_) { nM = M / BM; nN = N / BM; nwg = nM * nN; G = G_; c = c_; }
    __host__ __device__ bool next(int i, Unit& u) const {
        const long L = (long)i * G + c; if (L >= nwg) return false;
        int wgid = (int)L; { const int q = nwg / NXCD, r = nwg % NXCD, xcd = wgid % NXCD, off = wgid / NXCD; wgid = (xcd < r ? xcd * (q + 1) : r * (q + 1) + (xcd - r) * q) + off; }
        const int nig = WGM * nN, gid = wgid / nig, fm = gid * WGM, gsz = (nM - fm) < WGM ? (nM - fm) : WGM;
        u.pm = fm + ((wgid % nig) % gsz); u.pn = (wgid % nig) / gsz; return true;
    }
    __device__ __forceinline__ void a_ready(const Unit&) const {}
    __device__ __forceinline__ void done(const Unit&) const {}
};

template <class Epi, class Sched, bool ALIGN_EPI = false, bool SP2 = false>
__device__ __forceinline__ void gemm_phase(PG8_LAS unsigned char* lds, const Gemm g, const Sched& S, const Epi& E) {
    int tid_ = threadIdx.x; asm volatile("" : "+v"(tid_));
    const int tid = tid_, wid = __builtin_amdgcn_readfirstlane(tid >> 6), lane = tid & 63, wr = wid >> 2, wc = wid & 3, fr = lane & 15, fq = lane >> 4;
    int K_ = g.K; asm volatile("" : "+s"(K_)); const int K = K_, nt = K / BK;
    unsigned voffA[2], voffB[2];
#pragma unroll
    for (int i = 0; i < 2; ++i) { int R, C; stage_rc(tid * 16 + i * 8192, R, C); const int Rb = Epi::PERM ? ((R & ~31) + perm32(R & 31)) : R;
        voffA[i] = (unsigned)(R * K + C) * 2u; voffB[i] = (unsigned)(Rb * K + C) * 2u; }
    const size_t kstep = (size_t)(BK * 2);
    const size_t hstep = (size_t)HALF * K * 2;
    const size_t tstep = 2 * hstep;
    const unsigned ldsw = (unsigned)wid * 1024u;
    const int aoff = lds_byte(wr * 64 + fr, fq * 8), boff = lds_byte(wc * 32 + fr, fq * 8);
#define PG8_SA(b, h) (((b) * 2 + (h)) * HTB)
#define PG8_SB(b, h) ((4 + (b) * 2 + (h)) * HTB)
#define PG8_STAGE(bufoff, gbase, voff) do { _Pragma("unroll") for (int _i = 0; _i < 2; ++_i) \
        __builtin_amdgcn_global_load_lds((const unsigned*)((const char*)(gbase) + (voff)[_i]), (PG8_LAS unsigned*)(lds + (bufoff) + ldsw + _i * 8192), 16, 0, 0); } while (0)
#define PG8_LDA(dst, b, h) do { _Pragma("unroll") for (int m = 0; m < 4; ++m) _Pragma("unroll") for (int k = 0; k < 2; ++k) dst[m][k] = *(const PG8_LAS bf16x8*)(lds + PG8_SA(b, h) + aoff + m * 2048 + k * 1024); } while (0)
#define PG8_LDB(dst, b, h) do { _Pragma("unroll") for (int n = 0; n < 2; ++n) _Pragma("unroll") for (int k = 0; k < 2; ++k) dst[n][k] = *(const PG8_LAS bf16x8*)(lds + PG8_SB(b, h) + boff + n * 2048 + k * 1024); } while (0)
#define PG8_MMA(ai, bj, At, Bt) do { __builtin_amdgcn_s_setprio(1); _Pragma("unroll") for (int m = 0; m < 4; ++m) _Pragma("unroll") for (int n = 0; n < 2; ++n) _Pragma("unroll") for (int k = 0; k < 2; ++k) \
        acc[ai][bj][m][n] = __builtin_amdgcn_mfma_f32_16x16x32_bf16(Bt[n][k], At[m][k], acc[ai][bj][m][n], 0, 0, 0); __builtin_amdgcn_s_setprio(0); } while (0)
#define PG8_WAIT_V(n) asm volatile("s_waitcnt vmcnt(" #n ")" ::: "memory")
#define PG8_WAIT_L(n) asm volatile("s_waitcnt lgkmcnt(" #n ")" ::: "memory")
#define PG8_BAR __builtin_amdgcn_s_barrier()
#define PG8_SCHED __builtin_amdgcn_sched_barrier(0)
    Unit cur, nxt; int ui = 0;
    if (!S.next(0, cur)) return;
    f32x4 acc[2][2][4][2];
#pragma unroll
    for (int a = 0; a < 2; ++a)
#pragma unroll
        for (int b = 0; b < 2; ++b)
#pragma unroll
            for (int m = 0; m < 4; ++m)
#pragma unroll
                for (int n = 0; n < 2; ++n) acc[a][b][m][n] = (f32x4){0.f, 0.f, 0.f, 0.f};
    bf16x8 At[4][2], B0[2][2], B1[2][2];
    const char* cA = (const char*)g.A + (size_t)cur.pm * tstep; const char* cB = (const char*)g.Bt + (size_t)cur.pn * tstep;
    S.a_ready(cur);
    if constexpr (SP2) {
        PG8_STAGE(PG8_SB(0, 0), cB, voffB); PG8_STAGE(PG8_SB(0, 1), cB + hstep, voffB); PG8_STAGE(PG8_SA(0, 0), cA, voffA); PG8_STAGE(PG8_SA(0, 1), cA + hstep, voffA);
        if (wr == 1) PG8_BAR;
        PG8_WAIT_V(2); PG8_BAR;
        PG8_STAGE(PG8_SB(1, 0), cB + kstep, voffB); PG8_STAGE(PG8_SA(1, 0), cA + kstep, voffA); PG8_STAGE(PG8_SB(1, 1), cB + hstep + kstep, voffB);
        PG8_WAIT_V(6); PG8_BAR;
    } else {
        PG8_STAGE(PG8_SB(0, 0), cB, voffB); PG8_STAGE(PG8_SA(0, 0), cA, voffA); PG8_STAGE(PG8_SB(0, 1), cB + hstep, voffB); PG8_STAGE(PG8_SA(0, 1), cA + hstep, voffA);
        if (wr == 1) PG8_BAR;
        PG8_WAIT_V(4); PG8_BAR;
        PG8_STAGE(PG8_SB(1, 0), cB + kstep, voffB); PG8_STAGE(PG8_SA(1, 0), cA + kstep, voffA); PG8_STAGE(PG8_SB(1, 1), cB + hstep + kstep, voffB);
        PG8_WAIT_V(6); PG8_BAR;
    }
    for (;;) {
        const bool has_next = S.next(ui + 1, nxt);
        const char* nA = has_next ? (const char*)g.A + (size_t)nxt.pm * tstep : cA; const char* nB = has_next ? (const char*)g.Bt + (size_t)nxt.pn * tstep : cB;
        for (int t = 0; t < nt; t += 2) {
            const bool last = (t == nt - 2);
            const char* a1 = cA + (size_t)(t + 1) * kstep;
            const char* a2 = last ? nA : cA + (size_t)(t + 2) * kstep; const char* b2 = last ? nB : cB + (size_t)(t + 2) * kstep;
            const char* a3 = a2 + kstep; const char* b3 = b2 + kstep;
            if (last && has_next) S.a_ready(nxt);
            if constexpr (SP2) {
            PG8_LDB(B0, 0, 0); PG8_LDB(B1, 0, 1); PG8_SCHED; PG8_LDA(At, 0, 0); PG8_STAGE(PG8_SA(1, 1), a1 + hstep, voffA);
            PG8_WAIT_V(8); PG8_WAIT_L(0); PG8_BAR; PG8_MMA(0, 0, At, B0); PG8_MMA(0, 1, At, B1); PG8_BAR; PG8_SCHED;
            PG8_LDA(At, 0, 1); PG8_STAGE(PG8_SB(0, 0), b2, voffB); PG8_STAGE(PG8_SB(0, 1), b2 + hstep, voffB); PG8_STAGE(PG8_SA(0, 0), a2, voffA);
            PG8_WAIT_V(8); PG8_WAIT_L(0); PG8_BAR; PG8_MMA(1, 0, At, B0); PG8_MMA(1, 1, At, B1); PG8_BAR; PG8_SCHED;
            PG8_LDB(B0, 1, 0); PG8_LDB(B1, 1, 1); PG8_SCHED; PG8_LDA(At, 1, 0); PG8_STAGE(PG8_SA(0, 1), a2 + hstep, voffA);
            PG8_WAIT_V(8); PG8_WAIT_L(0); PG8_BAR; PG8_MMA(0, 0, At, B0); PG8_MMA(0, 1, At, B1); PG8_BAR; PG8_SCHED;
            PG8_LDA(At, 1, 1); PG8_STAGE(PG8_SB(1, 0), b3, voffB); PG8_STAGE(PG8_SB(1, 1), b3 + hstep, voffB); PG8_STAGE(PG8_SA(1, 0), a3, voffA);
            PG8_WAIT_V(8); PG8_WAIT_L(0); PG8_BAR; PG8_MMA(1, 0, At, B0); PG8_MMA(1, 1, At, B1); PG8_BAR; PG8_SCHED;
            } else {
            PG8_LDB(B0, 0, 0); PG8_SCHED; PG8_LDA(At, 0, 0); PG8_STAGE(PG8_SA(1, 1), a1 + hstep, voffA);
            PG8_WAIT_L(8); PG8_BAR; PG8_WAIT_L(0); PG8_MMA(0, 0, At, B0); PG8_BAR; PG8_SCHED;
            PG8_LDB(B1, 0, 1); PG8_STAGE(PG8_SB(0, 0), b2, voffB);
            PG8_BAR; PG8_WAIT_L(0); PG8_MMA(0, 1, At, B1); PG8_BAR;
            PG8_LDA(At, 0, 1); PG8_STAGE(PG8_SA(0, 0), a2, voffA);
            PG8_BAR; PG8_WAIT_L(0); PG8_MMA(1, 0, At, B0); PG8_BAR; PG8_SCHED;
            PG8_STAGE(PG8_SB(0, 1), b2 + hstep, voffB);
            PG8_WAIT_V(6); PG8_BAR; PG8_MMA(1, 1, At, B1); PG8_BAR;
            PG8_LDB(B0, 1, 0); PG8_SCHED; PG8_LDA(At, 1, 0); PG8_STAGE(PG8_SA(0, 1), a2 + hstep, voffA);
            PG8_WAIT_L(8); PG8_BAR; PG8_WAIT_L(0); PG8_MMA(0, 0, At, B0); PG8_BAR; PG8_SCHED;
            PG8_LDB(B1, 1, 1); PG8_STAGE(PG8_SB(1, 0), b3, voffB);
            PG8_BAR; PG8_WAIT_L(0); PG8_MMA(0, 1, At, B1); PG8_BAR;
            PG8_LDA(At, 1, 1); PG8_STAGE(PG8_SA(1, 0), a3, voffA);
            PG8_BAR; PG8_WAIT_L(0); PG8_MMA(1, 0, At, B0); PG8_BAR; PG8_SCHED;
            PG8_STAGE(PG8_SB(1, 1), b3 + hstep, voffB);
            PG8_WAIT_V(6); PG8_BAR; PG8_MMA(1, 1, At, B1); PG8_BAR;
            }
        }
        if constexpr (ALIGN_EPI) { if (wr == 0) PG8_BAR; }
        if constexpr (!Epi::AFTER_DRAIN) { E(acc, cur, wr, wc, fr, fq); S.done(cur); }
        if (!has_next) break;
#pragma unroll
        for (int a = 0; a < 2; ++a)
#pragma unroll
            for (int b = 0; b < 2; ++b)
#pragma unroll
                for (int m = 0; m < 4; ++m)
#pragma unroll
                    for (int n = 0; n < 2; ++n) acc[a][b][m][n] = (f32x4){0.f, 0.f, 0.f, 0.f};
        cur = nxt; cA = nA; cB = nB; ++ui;
        if constexpr (ALIGN_EPI) { if (wr == 1) PG8_BAR; }
    }
    PG8_WAIT_V(0);
    if constexpr (!ALIGN_EPI) { if (wr == 0) PG8_BAR; }
    PG8_BAR;
    if constexpr (Epi::AFTER_DRAIN) { E.fused(acc, cur, wr, wc, fr, fq, lds, wid, lane); S.done(cur); }
#undef PG8_SA
#undef PG8_SB
#undef PG8_STAGE
#undef PG8_LDA
#undef PG8_LDB
#undef PG8_MMA
#undef PG8_WAIT_V
#undef PG8_WAIT_L
#undef PG8_BAR
#undef PG8_SCHED
}

struct UnitM { int pm, pn, sub; };
struct GemmM { const bf16_t* A0; const bf16_t* B0; size_t strideA, strideB; int nt0, dnt2; int lda, ldb;
    __device__ __forceinline__ const bf16_t* a(int s) const { return A0 + (size_t)s * strideA; }
    __device__ __forceinline__ const bf16_t* b(int s) const { return B0 + (size_t)s * strideB; }
    __device__ __forceinline__ int nt(int s) const { return nt0 + (s >> 1) * dnt2; } };
struct StaticOrder3 {
    StaticOrder S;
    __device__ void init(int M, int N, int G_, int c_) { S.init(M, N, G_, c_); }
    __device__ bool next(int i, UnitM& u) const { Unit t; if (!S.next(i / 3, t)) return false; u.pm = t.pm; u.pn = t.pn; u.sub = i - 3 * (i / 3); return true; }
    __device__ __forceinline__ void a_ready(const UnitM&) const {}
    __device__ __forceinline__ void done(const UnitM&) const {}
};
template <class Epi, class Sched, bool ALIGN_EPI = false, bool SP2 = false>
__device__ __forceinline__ void gemm_phase_m(PG8_LAS unsigned char* lds, const GemmM g, const Sched& S, const Epi& E) {
    int tid_ = threadIdx.x; asm volatile("" : "+v"(tid_));
    const int tid = tid_, wid = __builtin_amdgcn_readfirstlane(tid >> 6), lane = tid & 63, wr = wid >> 2, wc = wid & 3, fr = lane & 15, fq = lane >> 4;
    int lda_ = g.lda, ldb_ = g.ldb; asm volatile("" : "+s"(lda_), "+s"(ldb_)); const int lda = lda_, ldb = ldb_; int nt;
    unsigned voffA[2], voffB[2];
#pragma unroll
    for (int i = 0; i < 2; ++i) { int R, C; stage_rc(tid * 16 + i * 8192, R, C); const int Rb = Epi::PERM ? ((R & ~31) + perm32(R & 31)) : R;
        voffA[i] = (unsigned)(R * lda + C) * 2u; voffB[i] = (unsigned)(Rb * ldb + C) * 2u; }
    const size_t kstep = (size_t)(BK * 2);
    const size_t hstepA = (size_t)HALF * lda * 2, hstepB = (size_t)HALF * ldb * 2;
    const size_t tstepA = 2 * hstepA, tstepB = 2 * hstepB;
    const unsigned ldsw = (unsigned)wid * 1024u;
    const int aoff = lds_byte(wr * 64 + fr, fq * 8), boff = lds_byte(wc * 32 + fr, fq * 8);
#define PG8_SA(b, h) (((b) * 2 + (h)) * HTB)
#define PG8_SB(b, h) ((4 + (b) * 2 + (h)) * HTB)
#define PG8_STAGE(bufoff, gbase, voff) do { _Pragma("unroll") for (int _i = 0; _i < 2; ++_i) \
        __builtin_amdgcn_global_load_lds((const unsigned*)((const char*)(gbase) + (voff)[_i]), (PG8_LAS unsigned*)(lds + (bufoff) + ldsw + _i * 8192), 16, 0, 0); } while (0)
#define PG8_LDA(dst, b, h) do { _Pragma("unroll") for (int m = 0; m < 4; ++m) _Pragma("unroll") for (int k = 0; k < 2; ++k) dst[m][k] = *(const PG8_LAS bf16x8*)(lds + PG8_SA(b, h) + aoff + m * 2048 + k * 1024); } while (0)
#define PG8_LDB(dst, b, h) do { _Pragma("unroll") for (int n = 0; n < 2; ++n) _Pragma("unroll") for (int k = 0; k < 2; ++k) dst[n][k] = *(const PG8_LAS bf16x8*)(lds + PG8_SB(b, h) + boff + n * 2048 + k * 1024); } while (0)
#define PG8_MMA(ai, bj, At, Bt) do { __builtin_amdgcn_s_setprio(1); _Pragma("unroll") for (int m = 0; m < 4; ++m) _Pragma("unroll") for (int n = 0; n < 2; ++n) _Pragma("unroll") for (int k = 0; k < 2; ++k) \
        acc[ai][bj][m][n] = __builtin_amdgcn_mfma_f32_16x16x32_bf16(Bt[n][k], At[m][k], acc[ai][bj][m][n], 0, 0, 0); __builtin_amdgcn_s_setprio(0); } while (0)
#define PG8_WAIT_V(n) asm volatile("s_waitcnt vmcnt(" #n ")" ::: "memory")
#define PG8_WAIT_L(n) asm volatile("s_waitcnt lgkmcnt(" #n ")" ::: "memory")
#define PG8_BAR __builtin_amdgcn_s_barrier()
#define PG8_SCHED __builtin_amdgcn_sched_barrier(0)
    UnitM cur, nxt; int ui = 0;
    if (!S.next(0, cur)) return;
    f32x4 acc[2][2][4][2];
#pragma unroll
    for (int a = 0; a < 2; ++a)
#pragma unroll
        for (int b = 0; b < 2; ++b)
#pragma unroll
            for (int m = 0; m < 4; ++m)
#pragma unroll
                for (int n = 0; n < 2; ++n) acc[a][b][m][n] = (f32x4){0.f, 0.f, 0.f, 0.f};
    bf16x8 At[4][2], B0[2][2], B1[2][2];
    const char* cA = (const char*)g.a(cur.sub) + (size_t)cur.pm * tstepA; const char* cB = (const char*)g.b(cur.sub) + (size_t)cur.pn * tstepB; nt = g.nt(cur.sub);
    S.a_ready(cur);
    if constexpr (SP2) {
        PG8_STAGE(PG8_SB(0, 0), cB, voffB); PG8_STAGE(PG8_SB(0, 1), cB + hstepB, voffB); PG8_STAGE(PG8_SA(0, 0), cA, voffA); PG8_STAGE(PG8_SA(0, 1), cA + hstepA, voffA);
        if (wr == 1) PG8_BAR;
        PG8_WAIT_V(2); PG8_BAR;
        PG8_STAGE(PG8_SB(1, 0), cB + kstep, voffB); PG8_STAGE(PG8_SA(1, 0), cA + kstep, voffA); PG8_STAGE(PG8_SB(1, 1), cB + hstepB + kstep, voffB);
        PG8_WAIT_V(6); PG8_BAR;
    } else {
        PG8_STAGE(PG8_SB(0, 0), cB, voffB); PG8_STAGE(PG8_SA(0, 0), cA, voffA); PG8_STAGE(PG8_SB(0, 1), cB + hstepB, voffB); PG8_STAGE(PG8_SA(0, 1), cA + hstepA, voffA);
        if (wr == 1) PG8_BAR;
        PG8_WAIT_V(4); PG8_BAR;
        PG8_STAGE(PG8_SB(1, 0), cB + kstep, voffB); PG8_STAGE(PG8_SA(1, 0), cA + kstep, voffA); PG8_STAGE(PG8_SB(1, 1), cB + hstepB + kstep, voffB);
        PG8_WAIT_V(6); PG8_BAR;
    }
    for (;;) {
        const bool has_next = S.next(ui + 1, nxt);
        const char* nA = has_next ? (const char*)g.a(nxt.sub) + (size_t)nxt.pm * tstepA : cA; const char* nB = has_next ? (const char*)g.b(nxt.sub) + (size_t)nxt.pn * tstepB : cB;
        for (int t = 0; t < nt; t += 2) {
            const bool last = (t == nt - 2);
            const char* a1 = cA + (size_t)(t + 1) * kstep;
            const char* a2 = last ? nA : cA + (size_t)(t + 2) * kstep; const char* b2 = last ? nB : cB + (size_t)(t + 2) * kstep;
            const char* a3 = a2 + kstep; const char* b3 = b2 + kstep;
            if (last && has_next) S.a_ready(nxt);
            if constexpr (SP2) {
            PG8_LDB(B0, 0, 0); PG8_LDB(B1, 0, 1); PG8_SCHED; PG8_LDA(At, 0, 0); PG8_STAGE(PG8_SA(1, 1), a1 + hstepA, voffA);
            PG8_WAIT_V(8); PG8_WAIT_L(0); PG8_BAR; PG8_MMA(0, 0, At, B0); PG8_MMA(0, 1, At, B1); PG8_BAR; PG8_SCHED;
            PG8_LDA(At, 0, 1); PG8_STAGE(PG8_SB(0, 0), b2, voffB); PG8_STAGE(PG8_SB(0, 1), b2 + hstepB, voffB); PG8_STAGE(PG8_SA(0, 0), a2, voffA);
            PG8_WAIT_V(8); PG8_WAIT_L(0); PG8_BAR; PG8_MMA(1, 0, At, B0); PG8_MMA(1, 1, At, B1); PG8_BAR; PG8_SCHED;
            PG8_LDB(B0, 1, 0); PG8_LDB(B1, 1, 1); PG8_SCHED; PG8_LDA(At, 1, 0); PG8_STAGE(PG8_SA(0, 1), a2 + hstepA, voffA);
            PG8_WAIT_V(8); PG8_WAIT_L(0); PG8_BAR; PG8_MMA(0, 0, At, B0); PG8_MMA(0, 1, At, B1); PG8_BAR; PG8_SCHED;
            PG8_LDA(At, 1, 1); PG8_STAGE(PG8_SB(1, 0), b3, voffB); PG8_STAGE(PG8_SB(1, 1), b3 + hstepB, voffB); PG8_STAGE(PG8_SA(1, 0), a3, voffA);
            PG8_WAIT_V(8); PG8_WAIT_L(0); PG8_BAR; PG8_MMA(1, 0, At, B0); PG8_MMA(1, 1, At, B1); PG8_BAR; PG8_SCHED;
            } else {
            PG8_LDB(B0, 0, 0); PG8_SCHED; PG8_LDA(At, 0, 0); PG8_STAGE(PG8_SA(1, 1), a1 + hstepA, voffA);
            PG8_WAIT_L(8); PG8_BAR; PG8_WAIT_L(0); PG8_MMA(0, 0, At, B0); PG8_BAR; PG8_SCHED;
            PG8_LDB(B1, 0, 1); PG8_STAGE(PG8_SB(0, 0), b2, voffB);
            PG8_BAR; PG8_WAIT_L(0); PG8_MMA(0, 1, At, B1); PG8_BAR;
            PG8_LDA(At, 0, 1); PG8_STAGE(PG8_SA(0, 0), a2, voffA);
            PG8_BAR; PG8_WAIT_L(0); PG8_MMA(1, 0, At, B0); PG8_BAR; PG8_SCHED;
            PG8_STAGE(PG8_SB(0, 1), b2 + hstepB, voffB);
            PG8_WAIT_V(6); PG8_BAR; PG8_MMA(1, 1, At, B1); PG8_BAR;
            PG8_LDB(B0, 1, 0); PG8_SCHED; PG8_LDA(At, 1, 0); PG8_STAGE(PG8_SA(0, 1), a2 + hstepA, voffA);
            PG8_WAIT_L(8); PG8_BAR; PG8_WAIT_L(0); PG8_MMA(0, 0, At, B0); PG8_BAR; PG8_SCHED;
            PG8_LDB(B1, 1, 1); PG8_STAGE(PG8_SB(1, 0), b3, voffB);
            PG8_BAR; PG8_WAIT_L(0); PG8_MMA(0, 1, At, B1); PG8_BAR;
            PG8_LDA(At, 1, 1); PG8_STAGE(PG8_SA(1, 0), a3, voffA);
            PG8_BAR; PG8_WAIT_L(0); PG8_MMA(1, 0, At, B0); PG8_BAR; PG8_SCHED;
            PG8_STAGE(PG8_SB(1, 1), b3 + hstepB, voffB);
            PG8_WAIT_V(6); PG8_BAR; PG8_MMA(1, 1, At, B1); PG8_BAR;
            }
        }
        if constexpr (ALIGN_EPI) { if (wr == 0) PG8_BAR; }
        if constexpr (!Epi::AFTER_DRAIN) { E(acc, cur, wr, wc, fr, fq); S.done(cur); }
        if (!has_next) break;
        if (nxt.sub == 0) {
#pragma unroll
        for (int a = 0; a < 2; ++a)
#pragma unroll
            for (int b = 0; b < 2; ++b)
#pragma unroll
                for (int m = 0; m < 4; ++m)
#pragma unroll
                    for (int n = 0; n < 2; ++n) acc[a][b][m][n] = (f32x4){0.f, 0.f, 0.f, 0.f}; }
        cur = nxt; cA = nA; cB = nB; ++ui; nt = g.nt(cur.sub);
        if constexpr (ALIGN_EPI) { if (wr == 1) PG8_BAR; }
    }
    PG8_WAIT_V(0);
    if constexpr (!ALIGN_EPI) { if (wr == 0) PG8_BAR; }
    PG8_BAR;
    if constexpr (Epi::AFTER_DRAIN) { E.fused(acc, cur, wr, wc, fr, fq, lds, wid, lane); S.done(cur); }
#undef PG8_SA
#undef PG8_SB
#undef PG8_STAGE
#undef PG8_LDA
#undef PG8_LDB
#undef PG8_MMA
#undef PG8_WAIT_V
#undef PG8_WAIT_L
#undef PG8_BAR
#undef PG8_SCHED
}
}

namespace pg8 {
typedef float f32x2 __attribute__((ext_vector_type(2)));
__device__ __forceinline__ unsigned cvt_pk_bf16(float lo, float hi) { unsigned r; asm volatile("v_cvt_pk_bf16_f32 %0, %1, %2" : "=v"(r) : "v"(lo), "v"(hi)); return r; }
__device__ __forceinline__ void store8(bf16_t* p, const f32x4 v0, const f32x4 v1) {
    u32x4 w; w.x = cvt_pk_bf16(v0[0], v0[1]); w.y = cvt_pk_bf16(v0[2], v0[3]); w.z = cvt_pk_bf16(v1[0], v1[1]); w.w = cvt_pk_bf16(v1[2], v1[3]); *(u32x4*)p = w; }
__device__ __forceinline__ float fsigmoid(float x) { return __builtin_amdgcn_rcpf(1.0f + __builtin_amdgcn_exp2f(-1.4426950408889634f * x)); }
__device__ __forceinline__ f32x4 act4(const f32x4 v, const int ACT) {
    if (ACT == 0) return v;
    f32x4 o;
#pragma unroll
    for (int j = 0; j < 4; ++j) { const float s = fsigmoid(v[j]); o[j] = (ACT == 1) ? v[j] * s : s; }
    return o; }
__device__ __forceinline__ void bf8_to_f32(const u32x4 w, f32x4& a, f32x4& b) {
    a[0] = __uint_as_float(w.x << 16); a[1] = __uint_as_float(w.x & 0xffff0000u); a[2] = __uint_as_float(w.y << 16); a[3] = __uint_as_float(w.y & 0xffff0000u);
    b[0] = __uint_as_float(w.z << 16); b[1] = __uint_as_float(w.z & 0xffff0000u); b[2] = __uint_as_float(w.w << 16); b[3] = __uint_as_float(w.w & 0xffff0000u); }

constexpr int SEQ_MASK = 4095;
__device__ __forceinline__ void rope4(const float* tab, const f32x4 a, const f32x4 b, float sc, bf16_t* p1, bf16_t* p2) {
    typedef unsigned u32x2 __attribute__((ext_vector_type(2)));
    const f32x4 t0 = *(const f32x4*)(tab), t1 = *(const f32x4*)(tab + 4);
    const float o10 = (a[0] * t0[0] - b[0] * t0[1]) * sc, o20 = (b[0] * t0[0] + a[0] * t0[1]) * sc;
    const float o11 = (a[1] * t0[2] - b[1] * t0[3]) * sc, o21 = (b[1] * t0[2] + a[1] * t0[3]) * sc;
    const float o12 = (a[2] * t1[0] - b[2] * t1[1]) * sc, o22 = (b[2] * t1[0] + a[2] * t1[1]) * sc;
    const float o13 = (a[3] * t1[2] - b[3] * t1[3]) * sc, o23 = (b[3] * t1[2] + a[3] * t1[3]) * sc;
    u32x2 w1, w2; w1.x = cvt_pk_bf16(o10, o11); w1.y = cvt_pk_bf16(o12, o13); w2.x = cvt_pk_bf16(o20, o21); w2.y = cvt_pk_bf16(o22, o23);
    *(u32x2*)p1 = w1; *(u32x2*)p2 = w2;
}
#define EPI_FENCE() asm volatile("" ::: "memory")

struct EpiInProj {
    static constexpr bool PERM = true, AFTER_DRAIN = false;
    unsigned char* ws; size_t o_fqkv, o_cq, o_ckv, o_kr, o_rq, o_rk, o_rv, o_rg, o_gates, o_ff, o_t128, o_t64; int skip;
    __device__ __forceinline__ void plain(const f32x4 (&acc)[2][2][4][2], bf16_t* dst, int ld, int colbase, int act, int row0, int wc, int fq) const {
        const int col0 = colbase + wc * 32 + 8 * fq;
#pragma unroll
        for (int ai = 0; ai < 2; ++ai)
#pragma unroll
            for (int m = 0; m < 4; ++m) { bf16_t* rowp = dst + (size_t)(row0 + ai * HALF + m * 16) * ld + col0;
#pragma unroll
                for (int bj = 0; bj < 2; ++bj) { f32x4 v0 = acc[ai][bj][m][0], v1 = acc[ai][bj][m][1];
                    if (act) {
#pragma unroll
                        for (int j = 0; j < 4; ++j) { const float s0 = fsigmoid(v0[j]), s1 = fsigmoid(v1[j]); v0[j] = (act == 1) ? v0[j] * s0 : s0; v1[j] = (act == 1) ? v1[j] * s1 : s1; } }
                    if (skip == 2) { u32x4 w; w.x = cvt_pk_bf16(v0[0], v0[1]); w.y = cvt_pk_bf16(v0[2], v0[3]); w.z = cvt_pk_bf16(v1[0], v1[1]); w.w = cvt_pk_bf16(v1[2], v1[3]); asm volatile("" :: "v"(w)); }
                    else store8(rowp + bj * HALF, v0, v1); }
                EPI_FENCE(); }
    }
    __device__ __forceinline__ void rope128(const f32x4 (&acc)[2][2][4][2], bf16_t* dst, int t, float sc, int row0, int wc, int fq) const {
        const int x = 32 * wc + 8 * fq, hh = x >> 6, i0 = x & 63, head = 2 * t + hh; const float* T128 = (const float*)(ws + o_t128);
#pragma unroll
        for (int ai = 0; ai < 2; ++ai)
#pragma unroll
            for (int m = 0; m < 4; ++m) { const int row = row0 + ai * HALF + m * 16, pos = row & SEQ_MASK;
                const float* tp = T128 + ((size_t)pos * 64 + i0) * 2; bf16_t* p = dst + (size_t)row * 512 + 128 * head + i0;
                rope4(tp, acc[ai][0][m][0], acc[ai][1][m][0], sc, p, p + 64); rope4(tp + 8, acc[ai][0][m][1], acc[ai][1][m][1], sc, p + 4, p + 68);
                EPI_FENCE(); }
    }
    __device__ __forceinline__ void misc(const f32x4 (&acc)[2][2][4][2], int row0, int wc, int fq) const {
        if (wc == 0) { const int i0 = 8 * fq; const float* T64 = (const float*)(ws + o_t64); bf16_t* kr = (bf16_t*)(ws + o_kr);
#pragma unroll
            for (int ai = 0; ai < 2; ++ai)
#pragma unroll
                for (int m = 0; m < 4; ++m) { const int row = row0 + ai * HALF + m * 16, pos = row & SEQ_MASK;
                    const float* tp = T64 + ((size_t)pos * 32 + i0) * 2; bf16_t* p = kr + (size_t)row * 64 + i0;
                    rope4(tp, acc[ai][0][m][0], acc[ai][1][m][0], 1.0f, p, p + 32); rope4(tp + 8, acc[ai][0][m][1], acc[ai][1][m][1], 1.0f, p + 4, p + 36);
                    EPI_FENCE(); }
        } else if (wc == 1) { if (fq == 0) { float* ff = (float*)(ws + o_ff);
#pragma unroll
            for (int ai = 0; ai < 2; ++ai)
#pragma unroll
                for (int m = 0; m < 4; ++m) { const int row = row0 + ai * HALF + m * 16; float* p = ff + (size_t)row * 8; *(f32x4*)p = acc[ai][0][m][0]; *(f32x4*)(p + 4) = acc[ai][0][m][1]; } } }
    }
    __device__ __forceinline__ void operator()(const f32x4 (&acc)[2][2][4][2], const Unit& u, int wr, int wc, int fr, int fq) const {
        const int pn = u.pn, row0 = u.pm * BM + wr * 64 + fr;
        if (skip == 1) {
#pragma unroll
            for (int ai = 0; ai < 2; ++ai)
#pragma unroll
                for (int bj = 0; bj < 2; ++bj)
#pragma unroll
                    for (int m = 0; m < 4; ++m) asm volatile("" :: "v"(acc[ai][bj][m][0]), "v"(acc[ai][bj][m][1]));
            return; }
        if (pn == 12) misc(acc, row0, wc, fq);
        else if (pn >= 13 && pn < 17) { const bool isk = pn >= 15; rope128(acc, (bf16_t*)(ws + (isk ? o_rk : o_rq)), isk ? pn - 15 : pn - 13, isk ? 0.08838834764831845f : 1.0f, row0, wc, fq); }
        else { size_t off; int ld, cb, act = 0;
            if (pn < 9) { off = o_fqkv; ld = 2304; cb = 256 * pn; }
            else if (pn < 11) { off = o_cq; ld = 512; cb = 256 * (pn - 9); }
            else if (pn == 11) { off = o_ckv; ld = 256; cb = 0; }
            else if (pn < 21) { off = o_rv; ld = 1024; cb = 256 * (pn - 17); }
            else if (pn < 25) { off = o_rg; ld = 1024; cb = 256 * (pn - 21); act = 1; }
            else { off = o_gates; ld = 6144; cb = 256 * (pn - 25); act = 2; }
            plain(acc, (bf16_t*)(ws + off), ld, cb, act, row0, wc, fq); }
    }
};

struct EpiUq {
    static constexpr bool PERM = true, AFTER_DRAIN = false;
    bf16_t* qm; const float* rstd; const float* T64;
    __device__ __forceinline__ void operator()(const f32x4 (&acc)[2][2][4][2], const Unit& u, int wr, int wc, int fr, int fq) const {
        const int pn = u.pn, row0 = u.pm * BM + wr * 64 + fr;
        float rsv[2][4];
#pragma unroll
        for (int ai = 0; ai < 2; ++ai)
#pragma unroll
            for (int m = 0; m < 4; ++m) rsv[ai][m] = rstd[row0 + ai * HALF + m * 16];
        if (pn < 3) {
#pragma unroll
            for (int ai = 0; ai < 2; ++ai)
#pragma unroll
                for (int m = 0; m < 4; ++m) { const int row = row0 + ai * HALF + m * 16; const float rs = rsv[ai][m];
#pragma unroll
                    for (int bj = 0; bj < 2; ++bj) store8(qm + (size_t)row * 1152 + 192 * (2 * pn + bj) + 32 * wc + 8 * fq, acc[ai][bj][m][0] * rs, acc[ai][bj][m][1] * rs);
                    EPI_FENCE(); }
        } else { const int head = (pn == 3) ? wc : 4 + wc; if (head < 6) { const int i0 = 8 * fq;
#pragma unroll
            for (int ai = 0; ai < 2; ++ai)
#pragma unroll
                for (int m = 0; m < 4; ++m) { const int row = row0 + ai * HALF + m * 16, pos = row & SEQ_MASK; const float rs = rsv[ai][m];
                    const float* tp = T64 + ((size_t)pos * 32 + i0) * 2; bf16_t* p = qm + (size_t)row * 1152 + 192 * head + 128 + i0;
                    rope4(tp, acc[ai][0][m][0], acc[ai][1][m][0], rs, p, p + 32); rope4(tp + 8, acc[ai][0][m][1], acc[ai][1][m][1], rs, p + 4, p + 36);
                    EPI_FENCE(); } } }
    }
};
struct EpiUkv {
    static constexpr bool PERM = true, AFTER_DRAIN = false;
    bf16_t* kvm; const float* rstd;
    __device__ __forceinline__ void operator()(const f32x4 (&acc)[2][2][4][2], const Unit& u, int wr, int wc, int fr, int fq) const {
        const int row0 = u.pm * BM + wr * 64 + fr, col0 = u.pn * BM + wc * 32 + 8 * fq;
        float rsv[2][4];
#pragma unroll
        for (int ai = 0; ai < 2; ++ai)
#pragma unroll
            for (int m = 0; m < 4; ++m) rsv[ai][m] = rstd[row0 + ai * HALF + m * 16];
#pragma unroll
        for (int ai = 0; ai < 2; ++ai)
#pragma unroll
            for (int m = 0; m < 4; ++m) { const int row = row0 + ai * HALF + m * 16; const float rs = rsv[ai][m];
#pragma unroll
                for (int bj = 0; bj < 2; ++bj) store8(kvm + (size_t)row * 1536 + col0 + bj * HALF, acc[ai][bj][m][0] * rs, acc[ai][bj][m][1] * rs);
                EPI_FENCE(); }
    }
};
template <int PASS> struct EpiMerge {
    static constexpr bool PERM = true, AFTER_DRAIN = false;
    const bf16_t* gates; float* tmp; bf16_t* out;
    __device__ __forceinline__ void operator()(const f32x4 (&acc)[2][2][4][2], const Unit& u, int wr, int wc, int fr, int fq) const {
        const int row0 = u.pm * BM + wr * 64 + fr, col0 = u.pn * BM + wc * 32 + 8 * fq;
#pragma unroll
        for (int ai = 0; ai < 2; ++ai)
#pragma unroll
            for (int m = 0; m < 4; ++m) { const int row = row0 + ai * HALF + m * 16;
#pragma unroll
                for (int bj = 0; bj < 2; ++bj) { const int col = col0 + bj * HALF;
                    f32x4 g0, g1; bf8_to_f32(*(const u32x4*)(gates + (size_t)row * 6144 + 2048 * PASS + col), g0, g1);
                    f32x4 v0 = g0 * acc[ai][bj][m][0], v1 = g1 * acc[ai][bj][m][1];
                    float* tp = tmp + (size_t)row * 2048 + col;
                    if (PASS > 0) { v0 += *(const f32x4*)tp; v1 += *(const f32x4*)(tp + 4); }
                    if (PASS < 2) { *(f32x4*)tp = v0; *(f32x4*)(tp + 4) = v1; }
                    else store8(out + (size_t)row * 2048 + col, v0, v1);
                    EPI_FENCE(); } }
    }
};
struct EpiMergeM {
    static constexpr bool PERM = true, AFTER_DRAIN = false;
    const bf16_t* gates; bf16_t* out;
    __device__ __forceinline__ void operator()(f32x4 (&acc)[2][2][4][2], const UnitM& u, int wr, int wc, int fr, int fq) const {
        int t_ = threadIdx.x; asm volatile("" : "+v"(t_)); (void)fr; (void)fq; const int lrow0 = wr * 64 + (t_ & 15), lcol0 = wc * 32 + 8 * ((t_ >> 4) & 3);
        const int sub = u.sub;
#pragma unroll
        for (int ai = 0; ai < 2; ++ai) {
            u32x4 ga[4][2], gb[4][2];
#pragma unroll
            for (int m = 0; m < 4; ++m)
#pragma unroll
                for (int bj = 0; bj < 2; ++bj) { const bf16_t* gp = gates + ((size_t)u.pm * BM + lrow0 + ai * HALF + m * 16) * 6144 + 2048 * sub + u.pn * BM + lcol0 + bj * HALF;
                    ga[m][bj] = *(const u32x4*)gp; if (sub < 2) gb[m][bj] = *(const u32x4*)(gp + 2048); }
#pragma unroll
            for (int m = 0; m < 4; ++m)
#pragma unroll
                for (int bj = 0; bj < 2; ++bj) { f32x4 a0, a1; bf8_to_f32(ga[m][bj], a0, a1);
#pragma unroll
                    for (int j = 0; j < 4; ++j) { a0[j] = fmaxf(a0[j], 1e-30f); a1[j] = fmaxf(a1[j], 1e-30f); }
                    if (sub < 2) { f32x4 b0, b1; bf8_to_f32(gb[m][bj], b0, b1);
#pragma unroll
                        for (int j = 0; j < 4; ++j) { a0[j] *= __builtin_amdgcn_rcpf(fmaxf(b0[j], 1e-30f)); a1[j] *= __builtin_amdgcn_rcpf(fmaxf(b1[j], 1e-30f)); }
                        acc[ai][bj][m][0] *= a0; acc[ai][bj][m][1] *= a1; }
                    else store8(out + ((size_t)u.pm * BM + lrow0 + ai * HALF + m * 16) * 2048 + u.pn * BM + lcol0 + bj * HALF, acc[ai][bj][m][0] * a0, acc[ai][bj][m][1] * a1); }
            EPI_FENCE(); }
    }
};
struct EpiResid {
    static constexpr bool PERM = true, AFTER_DRAIN = false;
    bf16_t* xb;
    __device__ __forceinline__ void operator()(const f32x4 (&acc)[2][2][4][2], const Unit& u, int wr, int wc, int fr, int fq) const {
        int t_ = threadIdx.x; asm volatile("" : "+v"(t_)); (void)fr; (void)fq;
        const int row0 = u.pm * BM + wr * 64 + (t_ & 15), col0 = u.pn * BM + wc * 32 + 8 * ((t_ >> 4) & 3);
#pragma unroll
        for (int ai = 0; ai < 2; ++ai) {
            u32x4 b[4][2];
#pragma unroll
            for (int m = 0; m < 4; ++m)
#pragma unroll
                for (int bj = 0; bj < 2; ++bj) b[m][bj] = *(const u32x4*)(xb + (size_t)(row0 + ai * HALF + m * 16) * 4096 + col0 + bj * HALF);
#pragma unroll
            for (int m = 0; m < 4; ++m)
#pragma unroll
                for (int bj = 0; bj < 2; ++bj) { f32x4 x0, x1; bf8_to_f32(b[m][bj], x0, x1);
                    store8(xb + (size_t)(row0 + ai * HALF + m * 16) * 4096 + col0 + bj * HALF, x0 + acc[ai][bj][m][0], x1 + acc[ai][bj][m][1]); }
            EPI_FENCE(); }
    }
};
__device__ __forceinline__ float gelu_gate(float xc, float g) {
    const float z = xc * __builtin_fmaf(0.044715f * xc, xc, 1.0f);
    return xc * __builtin_amdgcn_rcpf(1.0f + __builtin_amdgcn_exp2f(-2.3022081985378545f * z)) * g;
}
template <int CTRL> __device__ __forceinline__ float dpp_f(float old, float src) {
    return __builtin_bit_cast(float, __builtin_amdgcn_update_dpp(__builtin_bit_cast(int, old), __builtin_bit_cast(int, src), CTRL, 0xf, 0xf, false)); }
struct EpiConvAct {
    static constexpr bool PERM = true, AFTER_DRAIN = false;
    bf16_t* act; float* utail; float* uhead; float* ghead; const float* cw; const float* cb; PG8_LAS float* xbuf;
    __device__ __forceinline__ void operator()(const f32x4 (&acc)[2][2][4][2], const Unit& u, int wr_, int wc_, int fr_, int fq_) const {
        int t_ = threadIdx.x; asm volatile("" : "+v"(t_)); const int fr = t_ & 15, fq = (t_ >> 4) & 3, wr = wr_, wc = wc_; (void)fr_; (void)fq_;
        const int lc = 32 * wc + 8 * fq, f0 = u.pn * HALF + lc;
        if (fr >= 14) {
#pragma unroll
            for (int ai = 0; ai < 2; ++ai) { PG8_LAS float* xp = xbuf + ((2 * ai + wr) * 2 + (fr - 14)) * 128 + lc; *(PG8_LAS f32x4*)xp = acc[ai][0][3][0]; *(PG8_LAS f32x4*)(xp + 4) = acc[ai][0][3][1]; }
            if (wr == 1) { float* tp = utail + ((size_t)u.pm * 2 + (fr - 14)) * 5632 + f0; *(f32x4*)tp = acc[1][0][3][0]; *(f32x4*)(tp + 4) = acc[1][0][3][1]; } }
        if (fr < 2 && wr == 0) { const size_t o = ((size_t)u.pm * 2 + fr) * 5632 + f0;
            *(f32x4*)(uhead + o) = acc[0][0][0][0]; *(f32x4*)(uhead + o + 4) = acc[0][0][0][1]; *(f32x4*)(ghead + o) = acc[0][1][0][0]; *(f32x4*)(ghead + o + 4) = acc[0][1][0][1]; }
        asm volatile("s_waitcnt lgkmcnt(0)" ::: "memory"); __builtin_amdgcn_s_barrier(); asm volatile("" ::: "memory");
        float w0[8], w1[8], w2[8], bb[8];
#pragma unroll
        for (int h = 0; h < 2; ++h) { const f32x4 a = *(const f32x4*)(cw + f0 + 4 * h), b = *(const f32x4*)(cw + 5632 + f0 + 4 * h), c = *(const f32x4*)(cw + 2 * 5632 + f0 + 4 * h), d = *(const f32x4*)(cb + f0 + 4 * h);
#pragma unroll
            for (int j = 0; j < 4; ++j) { w0[4 * h + j] = a[j]; w1[4 * h + j] = b[j]; w2[4 * h + j] = c[j]; bb[4 * h + j] = d[j]; } }
        const int row0 = u.pm * BM + wr * 64 + fr;
#pragma unroll
        for (int ai = 0; ai < 2; ++ai) {
            f32x4 t0a = {0.f, 0.f, 0.f, 0.f}, t0b = t0a, t1a = t0a, t1b = t0a;
            if (2 * ai + wr > 0) { const PG8_LAS float* xp = xbuf + ((2 * ai + wr - 1) * 2) * 128 + lc; t0a = *(const PG8_LAS f32x4*)xp; t0b = *(const PG8_LAS f32x4*)(xp + 4); t1a = *(const PG8_LAS f32x4*)(xp + 128); t1b = *(const PG8_LAS f32x4*)(xp + 132); }
#pragma unroll
            for (int m = 0; m < 4; ++m) { f32x4 o0, o1;
#pragma unroll
                for (int n = 0; n < 2; ++n)
#pragma unroll
                    for (int j = 0; j < 4; ++j) { const int k = 4 * n + j; const float cur = acc[ai][0][m][n][j];
                        float a1, a2;
                        if (m == 0) { const float T0 = n ? t0b[j] : t0a[j], T1 = n ? t1b[j] : t1a[j]; a1 = T1; a2 = (fr == 0) ? T0 : T1; }
                        else { const float pv = acc[ai][0][m - 1][n][j]; a1 = dpp_f<0x10F>(pv, pv); a2 = dpp_f<0x10E>(pv, pv); }
                        const float s1 = dpp_f<0x111>(a1, cur), s2 = dpp_f<0x112>(a2, cur);
                        const float xc = __builtin_fmaf(w2[k], cur, __builtin_fmaf(w1[k], s1, __builtin_fmaf(w0[k], s2, bb[k])));
                        const float r = gelu_gate(xc, acc[ai][1][m][n][j]);
                        if (n == 0) o0[j] = r; else o1[j] = r; }
                store8(act + (size_t)(row0 + ai * HALF + m * 16) * 5632 + f0, o0, o1);
                EPI_FENCE(); } }
    }
};
}

namespace att {
#define ATT_LAS __attribute__((address_space(3)))
typedef unsigned short bf16_t;
typedef short bf16x8 __attribute__((ext_vector_type(8)));
typedef short s16x4 __attribute__((ext_vector_type(4)));
typedef float f32x16 __attribute__((ext_vector_type(16)));
typedef float f32x4 __attribute__((ext_vector_type(4)));
typedef unsigned u32x4 __attribute__((ext_vector_type(4)));
typedef unsigned u32x2 __attribute__((ext_vector_type(2)));
constexpr int SHM_T = 16384;
#define KSWZ(row, colB) ((row) * 256 + ((colB) ^ (((row) & 15) << 4)))
#define KSWZ64(row, colB) ((row) * 128 + ((colB) ^ ((((row) >> 1) & 7) << 4)))
#define SBAR() __builtin_amdgcn_sched_barrier(0)
__device__ __forceinline__ int v_st(int k, int c) { const int kk = (k & ~0xC) | ((k & 4) << 1) | ((k & 8) >> 1); return ((kk >> 3) * 4 + (c >> 5)) * 512 + ((kk & 7) * 32 + (c & 31)) * 2; }
__device__ __forceinline__ int v_rd_base(int lane) { return ((lane & 3) << 3) | (((lane >> 2) & 3) << 6) | (((lane >> 4) & 1) << 5) | (((lane >> 5) & 1) << 8); }
constexpr int v_rd_off(int d0, int ks, int half) { return d0 * 512 + ks * 4096 + half * 2048; }
__device__ __forceinline__ unsigned cvtpk(float lo, float hi) { unsigned r; asm volatile("v_cvt_pk_bf16_f32 %0, %1, %2" : "=v"(r) : "v"(lo), "v"(hi)); return r; }

template <bool ROPE>
__device__ __forceinline__ void qkt(f32x16& p0, f32x16& p1, const ATT_LAS char* Kt, const ATT_LAS char* Kr, int r32, int hi, const bf16x8* qr) {
    p0 = f32x16{}; p1 = f32x16{};
#pragma unroll
    for (int d0 = 0; d0 < 8; ++d0) { const ATT_LAS char* a = Kt + KSWZ(r32, (d0 * 16 + hi * 8) * 2);
        const bf16x8 b0 = *(const ATT_LAS bf16x8*)a, b1 = *(const ATT_LAS bf16x8*)(a + 32 * 256);
        p0 = __builtin_amdgcn_mfma_f32_32x32x16_bf16(b0, qr[d0], p0, 0, 0, 0);
        p1 = __builtin_amdgcn_mfma_f32_32x32x16_bf16(b1, qr[d0], p1, 0, 0, 0); }
    if (ROPE) {
#pragma unroll
        for (int d0 = 0; d0 < 4; ++d0) { const ATT_LAS char* a = Kr + KSWZ64(r32, (d0 * 16 + hi * 8) * 2);
            const bf16x8 b0 = *(const ATT_LAS bf16x8*)a, b1 = *(const ATT_LAS bf16x8*)(a + 32 * 128);
            p0 = __builtin_amdgcn_mfma_f32_32x32x16_bf16(b0, qr[8 + d0], p0, 0, 0, 0);
            p1 = __builtin_amdgcn_mfma_f32_32x32x16_bf16(b1, qr[8 + d0], p1, 0, 0, 0); } }
}
__device__ __forceinline__ void pv_tile_T(f32x16* o, int vb, bf16x8 pa0, bf16x8 pa1, bf16x8 pa2, bf16x8 pa3) {
#define TRRD(dst, off) asm volatile("ds_read_b64_tr_b16 %0, %1 offset:%2" : "=&v"(dst) : "v"(vb), "i"(off) : "memory")
#define PV_D0(d0) do { s16x4 l0, l1, l2, l3, h0, h1, h2, h3; constexpr int b_ = v_rd_off(d0, 0, 0); \
        TRRD(l0, b_); TRRD(h0, b_ + 2048); TRRD(l1, b_ + 4096); TRRD(h1, b_ + 6144); TRRD(l2, b_ + 8192); TRRD(h2, b_ + 10240); TRRD(l3, b_ + 12288); TRRD(h3, b_ + 14336); \
        asm volatile("s_waitcnt lgkmcnt(0)" ::: "memory"); SBAR(); \
        o[d0] = __builtin_amdgcn_mfma_f32_32x32x16_bf16((bf16x8){l0[0], l0[1], l0[2], l0[3], h0[0], h0[1], h0[2], h0[3]}, pa0, o[d0], 0, 0, 0); \
        o[d0] = __builtin_amdgcn_mfma_f32_32x32x16_bf16((bf16x8){l1[0], l1[1], l1[2], l1[3], h1[0], h1[1], h1[2], h1[3]}, pa1, o[d0], 0, 0, 0); \
        o[d0] = __builtin_amdgcn_mfma_f32_32x32x16_bf16((bf16x8){l2[0], l2[1], l2[2], l2[3], h2[0], h2[1], h2[2], h2[3]}, pa2, o[d0], 0, 0, 0); \
        o[d0] = __builtin_amdgcn_mfma_f32_32x32x16_bf16((bf16x8){l3[0], l3[1], l3[2], l3[3], h3[0], h3[1], h3[2], h3[3]}, pa3, o[d0], 0, 0, 0); } while (0)
    PV_D0(0); PV_D0(1); PV_D0(2); PV_D0(3);
#undef PV_D0
#undef TRRD
}
__device__ __forceinline__ void pack_p(const f32x16& p0, const f32x16& p1, bf16x8& pa0, bf16x8& pa1, bf16x8& pa2, bf16x8& pa3) {
#define PK4(P, B_, OUT) do { unsigned a0 = cvtpk(P[B_+0], P[B_+1]), a1 = cvtpk(P[B_+2], P[B_+3]); \
        unsigned b0 = cvtpk(P[B_+4], P[B_+5]), b1 = cvtpk(P[B_+6], P[B_+7]); \
        auto r0 = __builtin_amdgcn_permlane32_swap(a0, b0, false, false); auto r1 = __builtin_amdgcn_permlane32_swap(a1, b1, false, false); \
        u32x4 w = {r0[0], r1[0], r0[1], r1[1]}; OUT = *reinterpret_cast<bf16x8*>(&w); } while (0)
    PK4(p0, 0, pa0); PK4(p0, 8, pa1); PK4(p1, 0, pa2); PK4(p1, 8, pa3);
#undef PK4
}
__device__ __forceinline__ float swap_max(float v) { auto rr = __builtin_amdgcn_permlane32_swap(__float_as_uint(v), __float_as_uint(v), false, false); return fmaxf(__uint_as_float(rr[0]), __uint_as_float(rr[1])); }
__device__ __forceinline__ float swap_sum(float v) { auto rr = __builtin_amdgcn_permlane32_swap(__float_as_uint(v), __float_as_uint(v), false, false); return __uint_as_float(rr[0]) + __uint_as_float(rr[1]); }

__device__ __forceinline__ void store_pair16(bf16_t* row_pair_base  , u32x2 a, u32x2 b) {
    auto rx = __builtin_amdgcn_permlane32_swap(a.x, b.x, false, false); auto ry = __builtin_amdgcn_permlane32_swap(a.y, b.y, false, false);
    const u32x4 w = {rx[0], ry[0], rx[1], ry[1]}; *(u32x4*)row_pair_base = w; }
struct UnitPtrs {
    const bf16_t* Q; int ldq;
    const bf16_t* K; int ldk;
    const bf16_t* V; int ldv;
    const bf16_t* KR;
    const float* bias;
    const bf16_t* G;
    bf16_t* O; int ldo;
    int P0;
    float c2;
    const bf16_t* ST;
    int T0;
};
template <int MODE>
__device__ __forceinline__ void mixer_unit(const UnitPtrs& U, ATT_LAS char* lds) {
    constexpr bool ROPE = (MODE == 1);
    constexpr int NQ = ROPE ? 12 : 8;
    constexpr int K_OFF = 0, KR_OFF = 32768, V_OFF = (MODE == 1) ? 49152 : 32768, V_SZ = (MODE == 2) ? 32768 : 16384, BIAS_OFF = 65536, SCR_OFF = 98304;
    int tid_ = threadIdx.x; asm volatile("" : "+v"(tid_));
    const int tid = tid_, wid = __builtin_amdgcn_readfirstlane(tid >> 6), lane = tid & 63, r32 = lane & 31, hi = lane >> 5;
    const int rg = (MODE == 2) ? (wid >> 1) : wid;
    const int vhalf = (MODE == 2) ? (wid & 1) : 0;
    const int qlo = U.P0 + 32 * rg;
    const int tbase = (MODE == 2) ? (U.T0 >> 6) : 0;
    const int NT = (U.P0 + ((MODE == 2) ? 128 : 256)) / 64 - tbase;
    const int tlast = (qlo >> 6) - tbase;
    bf16x8 qr[NQ];
    { const bf16_t* qp = U.Q + (size_t)(32 * rg + r32) * U.ldq + hi * 8;
#pragma unroll
      for (int d0 = 0; d0 < NQ; ++d0) qr[d0] = *(const bf16x8*)(qp + d0 * 16); }
    const int sr = tid >> 4, sc = (tid & 15) * 8;
    const int kws = KSWZ(sr, sc * 2), vst0 = v_st(sr, sc), vst1 = v_st(32 + sr, sc);
    const int rr = tid >> 3, rc = (tid & 7) * 8, krs = KSWZ64(rr, rc * 2);
    const int vbase = (int)(unsigned)(uintptr_t)(lds + V_OFF) + v_rd_base(lane) + vhalf * SHM_T;
    bf16x8 st_k0, st_k1, st_v0, st_v1, st_v2, st_v3, st_r;
#define ST_LOAD(kb_) do { const bf16_t* kp_ = U.K + (size_t)((kb_) + sr) * U.ldk + sc; st_k0 = *(const bf16x8*)kp_; st_k1 = *(const bf16x8*)(kp_ + (size_t)32 * U.ldk); \
        const bf16_t* vp_ = U.V + (size_t)((kb_) + sr) * U.ldv + sc; st_v0 = *(const bf16x8*)vp_; st_v1 = *(const bf16x8*)(vp_ + (size_t)32 * U.ldv); \
        if (MODE == 2) { st_v2 = *(const bf16x8*)(vp_ + 128); st_v3 = *(const bf16x8*)(vp_ + (size_t)32 * U.ldv + 128); } \
        if (MODE == 1) { st_r = *(const bf16x8*)(U.KR + (size_t)((kb_) + rr) * 64 + rc); } } while (0)
#define ST_WRITE(bf) do { ATT_LAS char* kd_ = lds + K_OFF + (bf) * SHM_T; *(ATT_LAS bf16x8*)(kd_ + kws) = st_k0; *(ATT_LAS bf16x8*)(kd_ + kws + 32 * 256) = st_k1; \
        ATT_LAS char* vd_ = lds + V_OFF + (bf) * V_SZ; *(ATT_LAS bf16x8*)(vd_ + vst0) = st_v0; *(ATT_LAS bf16x8*)(vd_ + vst1) = st_v1; \
        if (MODE == 2) { *(ATT_LAS bf16x8*)(vd_ + SHM_T + vst0) = st_v2; *(ATT_LAS bf16x8*)(vd_ + SHM_T + vst1) = st_v3; } \
        if (MODE == 1) { *(ATT_LAS bf16x8*)(lds + KR_OFF + (bf) * 8192 + krs) = st_r; } } while (0)
    float m_reg = -1e30f, l_reg = 0.f; f32x16 o[4] = {};
    float colf[(MODE == 2) ? 32 : 1];
    if (MODE == 2) {
#pragma unroll
        for (int r = 0; r < 16; ++r) { const int c = (r & 3) + 8 * (r >> 2); colf[r] = __builtin_amdgcn_exp2f(-U.c2 * (float)c); colf[16 + r] = __builtin_amdgcn_exp2f(-U.c2 * (float)(c + 32)); } }
    const int qpos = qlo + r32;
#define TIDX(t) ((MODE == 0) ? (NT - 1 - (t)) : (t))
    ST_LOAD((tbase + TIDX(0)) * 64);
    if (MODE == 0) { const int nk = U.P0 + 256; ATT_LAS float* bl = (ATT_LAS float*)(lds + BIAS_OFF); for (int i = tid; i < nk; i += 512) bl[i] = -U.bias[i]; }
    ST_WRITE(0);
    __syncthreads();
    if (MODE == 2) { if (U.ST) {
        const bf16_t* sp = U.ST + (size_t)(vhalf * 128 + r32) * 128 + hi * 8;
        bf16x8 sa[4][8];
#pragma unroll
        for (int d0 = 0; d0 < 4; ++d0)
#pragma unroll
            for (int ks = 0; ks < 8; ++ks) sa[d0][ks] = *(const bf16x8*)(sp + (size_t)d0 * 32 * 128 + ks * 16);
#pragma unroll
        for (int d0 = 0; d0 < 4; ++d0)
#pragma unroll
            for (int ks = 0; ks < 8; ++ks) o[d0] = __builtin_amdgcn_mfma_f32_32x32x16_bf16(sa[d0][ks], qr[ks], o[d0], 0, 0, 0);
        const float rf = __builtin_amdgcn_exp2f(U.c2 * (float)(qpos - U.T0 + 1));
#pragma unroll
        for (int d0 = 0; d0 < 4; ++d0)
#pragma unroll
            for (int r = 0; r < 16; ++r) o[d0][r] *= rf; } }
#define STEP(t, B) do { const int t_ = TIDX(t); const bool more_ = ((t) + 1 < NT); \
        if (more_) ST_LOAD((tbase + TIDX((t) + 1)) * 64); \
        if (t_ <= tlast) { f32x16 p0, p1; bf16x8 pa0, pa1, pa2, pa3; \
            qkt<ROPE>(p0, p1, lds + K_OFF + (B) * SHM_T, lds + KR_OFF + (B) * 8192, r32, hi, qr); \
            const int dq = qpos - (tbase + t_) * 64 - 4 * hi; \
            if (MODE == 2) { \
                if (t_ < tlast) { const float rowf = __builtin_amdgcn_exp2f(U.c2 * (float)dq);     \
                    _Pragma("unroll") for (int r = 0; r < 16; ++r) { p0[r] *= rowf * colf[r]; p1[r] *= rowf * colf[16 + r]; } \
                } else { \
                    _Pragma("unroll") for (int r = 0; r < 16; ++r) { const int c = (r & 3) + 8 * (r >> 2); \
                        p0[r] *= __builtin_amdgcn_exp2f(U.c2 * fabsf((float)(dq - c))); p1[r] *= __builtin_amdgcn_exp2f(U.c2 * fabsf((float)(dq - c - 32))); } } \
            } else { \
                if (MODE == 0) { const ATT_LAS float* bl = (const ATT_LAS float*)(lds + BIAS_OFF) + t_ * 64 + 4 * hi; \
                    _Pragma("unroll") for (int g = 0; g < 4; ++g) { const f32x4 b0 = *(const ATT_LAS f32x4*)(bl + 8 * g), b1 = *(const ATT_LAS f32x4*)(bl + 32 + 8 * g); \
                        _Pragma("unroll") for (int j = 0; j < 4; ++j) { p0[4 * g + j] = fmaf(p0[4 * g + j], U.c2, b0[j]); p1[4 * g + j] = fmaf(p1[4 * g + j], U.c2, b1[j]); } } \
                    if (t_ == tlast) { const float NEG = -__builtin_inff(); \
                        _Pragma("unroll") for (int r = 0; r < 16; ++r) { const int c = (r & 3) + 8 * (r >> 2); if (dq - c < 0) p0[r] = NEG; if (dq - c - 32 < 0) p1[r] = NEG; } } \
                } else { _Pragma("unroll") for (int r = 0; r < 16; ++r) { p0[r] *= U.c2; p1[r] *= U.c2; } } \
                float pmax = p0[0]; \
                _Pragma("unroll") for (int r = 1; r < 16; ++r) pmax = fmaxf(pmax, p0[r]); \
                _Pragma("unroll") for (int r = 0; r < 16; ++r) pmax = fmaxf(pmax, p1[r]); \
                pmax = swap_max(pmax); \
                if (__any(pmax > m_reg + ((MODE == 1) ? 8.0f : 0.0f))) { const float mn = fmaxf(m_reg, pmax), alpha = __builtin_amdgcn_exp2f(m_reg - mn); m_reg = mn; l_reg *= alpha; \
                    _Pragma("unroll") for (int d_ = 0; d_ < 4; ++d_) _Pragma("unroll") for (int r = 0; r < 16; ++r) o[d_][r] *= alpha; } \
                float ps = 0.f; \
                _Pragma("unroll") for (int r = 0; r < 16; ++r) { p0[r] = __builtin_amdgcn_exp2f(p0[r] - m_reg); p1[r] = __builtin_amdgcn_exp2f(p1[r] - m_reg); ps += p0[r] + p1[r]; } \
                ps = swap_sum(ps); l_reg += ps; \
            } \
            pack_p(p0, p1, pa0, pa1, pa2, pa3); \
            pv_tile_T(o, vbase + (B) * V_SZ, pa0, pa1, pa2, pa3); } \
        if (more_) ST_WRITE((B) ^ 1); \
        __syncthreads(); } while (0)
    for (int t = 0; t < NT; t += 2) { STEP(t, 0); STEP(t + 1, 1); }
#undef STEP
#undef TIDX
#undef ST_LOAD
#undef ST_WRITE
    bf16_t* orow = U.O + (size_t)(32 * rg + r32) * U.ldo + vhalf * 128 + 8 * hi;
    if (MODE == 2) {
        float ss = 0.f;
#pragma unroll
        for (int d0 = 0; d0 < 4; ++d0)
#pragma unroll
            for (int r = 0; r < 16; ++r) ss += o[d0][r] * o[d0][r];
        ss = swap_sum(ss);
        ATT_LAS float* scr = (ATT_LAS float*)(lds + SCR_OFF);
        if (hi == 0) scr[wid * 32 + r32] = ss;
        __syncthreads();
        const float tot = ss + scr[(wid ^ 1) * 32 + r32];
        const float rstd = __builtin_amdgcn_rsqf(tot * (1.0f / 256.0f) + 1e-6f);
        const bf16_t* grow = U.G + (size_t)(32 * rg + r32) * 1024 + vhalf * 128 + 4 * hi;
#pragma unroll
        for (int d0 = 0; d0 < 4; ++d0)
#pragma unroll
            for (int gp = 0; gp < 4; gp += 2) { u32x2 w[2];
#pragma unroll
                for (int e = 0; e < 2; ++e) { const int g = gp + e; const u32x2 gw = *(const u32x2*)(grow + 32 * d0 + 8 * g);
                    const float g0 = __uint_as_float(gw.x << 16), g1 = __uint_as_float(gw.x & 0xffff0000u), g2 = __uint_as_float(gw.y << 16), g3 = __uint_as_float(gw.y & 0xffff0000u);
                    w[e].x = cvtpk(o[d0][4 * g] * rstd * g0, o[d0][4 * g + 1] * rstd * g1); w[e].y = cvtpk(o[d0][4 * g + 2] * rstd * g2, o[d0][4 * g + 3] * rstd * g3); }
                store_pair16(orow + 32 * d0 + 8 * gp, w[0], w[1]); }
        __syncthreads();
    } else {
        const float inv = 1.0f / l_reg;
#pragma unroll
        for (int d0 = 0; d0 < 4; ++d0)
#pragma unroll
            for (int gp = 0; gp < 4; gp += 2) { u32x2 w[2];
#pragma unroll
                for (int e = 0; e < 2; ++e) { const int g = gp + e; w[e].x = cvtpk(o[d0][4 * g] * inv, o[d0][4 * g + 1] * inv); w[e].y = cvtpk(o[d0][4 * g + 2] * inv, o[d0][4 * g + 3] * inv); }
                store_pair16(orow + 32 * d0 + 8 * gp, w[0], w[1]); }
    }
}

__device__ __forceinline__ void ret_state_unit(const bf16_t* K, int ldk, const bf16_t* V, int ldv, float c2, float* SL, ATT_LAS char* lds) {
    int tid_ = threadIdx.x; asm volatile("" : "+v"(tid_));
    const int tid = tid_, wid = __builtin_amdgcn_readfirstlane(tid >> 6), lane = tid & 63, r32 = lane & 31, hi = lane >> 5;
    const int sr = tid >> 4, sc = (tid & 15) * 8, vst0 = v_st(sr, sc), vst1 = v_st(32 + sr, sc);
    constexpr int KI = 0, VI = 16384;
    const int kb = (int)(unsigned)(uintptr_t)(lds + KI) + v_rd_base(lane), vb = (int)(unsigned)(uintptr_t)(lds + VI) + v_rd_base(lane) + (wid >> 2) * SHM_T;
    f32x16 acc[4] = {};
    for (int t = 0; t < 4; ++t) {
        const bf16_t* kp = K + (size_t)(t * 64 + sr) * ldk + sc; const bf16_t* vp = V + (size_t)(t * 64 + sr) * ldv + sc;
        const u32x4 k0 = *(const u32x4*)kp, k1 = *(const u32x4*)(kp + (size_t)32 * ldk);
        const bf16x8 v0 = *(const bf16x8*)vp, v1 = *(const bf16x8*)(vp + (size_t)32 * ldv), v2 = *(const bf16x8*)(vp + 128), v3 = *(const bf16x8*)(vp + (size_t)32 * ldv + 128);
        const float w0 = __builtin_amdgcn_exp2f(c2 * (float)(255 - (t * 64 + sr))), w1 = __builtin_amdgcn_exp2f(c2 * (float)(255 - (t * 64 + 32 + sr)));
        u32x4 q0, q1;
#define WSC(w, s) cvtpk(__uint_as_float((w) << 16) * (s), __uint_as_float((w) & 0xffff0000u) * (s))
        q0.x = WSC(k0.x, w0); q0.y = WSC(k0.y, w0); q0.z = WSC(k0.z, w0); q0.w = WSC(k0.w, w0); q1.x = WSC(k1.x, w1); q1.y = WSC(k1.y, w1); q1.z = WSC(k1.z, w1); q1.w = WSC(k1.w, w1);
#undef WSC
        __syncthreads();
        *(ATT_LAS u32x4*)(lds + KI + vst0) = q0; *(ATT_LAS u32x4*)(lds + KI + vst1) = q1;
        *(ATT_LAS bf16x8*)(lds + VI + vst0) = v0; *(ATT_LAS bf16x8*)(lds + VI + vst1) = v1; *(ATT_LAS bf16x8*)(lds + VI + SHM_T + vst0) = v2; *(ATT_LAS bf16x8*)(lds + VI + SHM_T + vst1) = v3;
        __syncthreads();
#define TRR(dst, base, off) asm volatile("ds_read_b64_tr_b16 %0, %1 offset:%2" : "=&v"(dst) : "v"(base), "i"(off) : "memory")
#define KS_STEP(ks) do { s16x4 vl, vh, kl0, kh0, kl1, kh1, kl2, kh2, kl3, kh3; \
        TRR(vl, vbw, (ks) * 4096); TRR(vh, vbw, (ks) * 4096 + 2048); \
        TRR(kl0, kb, 0 * 512 + (ks) * 4096); TRR(kh0, kb, 0 * 512 + (ks) * 4096 + 2048); TRR(kl1, kb, 1 * 512 + (ks) * 4096); TRR(kh1, kb, 1 * 512 + (ks) * 4096 + 2048); \
        TRR(kl2, kb, 2 * 512 + (ks) * 4096); TRR(kh2, kb, 2 * 512 + (ks) * 4096 + 2048); TRR(kl3, kb, 3 * 512 + (ks) * 4096); TRR(kh3, kb, 3 * 512 + (ks) * 4096 + 2048); \
        asm volatile("s_waitcnt lgkmcnt(0)" ::: "memory"); SBAR(); \
        const bf16x8 vf = (bf16x8){vl[0], vl[1], vl[2], vl[3], vh[0], vh[1], vh[2], vh[3]}; \
        acc[0] = __builtin_amdgcn_mfma_f32_32x32x16_bf16(vf, (bf16x8){kl0[0], kl0[1], kl0[2], kl0[3], kh0[0], kh0[1], kh0[2], kh0[3]}, acc[0], 0, 0, 0); \
        acc[1] = __builtin_amdgcn_mfma_f32_32x32x16_bf16(vf, (bf16x8){kl1[0], kl1[1], kl1[2], kl1[3], kh1[0], kh1[1], kh1[2], kh1[3]}, acc[1], 0, 0, 0); \
        acc[2] = __builtin_amdgcn_mfma_f32_32x32x16_bf16(vf, (bf16x8){kl2[0], kl2[1], kl2[2], kl2[3], kh2[0], kh2[1], kh2[2], kh2[3]}, acc[2], 0, 0, 0); \
        acc[3] = __builtin_amdgcn_mfma_f32_32x32x16_bf16(vf, (bf16x8){kl3[0], kl3[1], kl3[2], kl3[3], kh3[0], kh3[1], kh3[2], kh3[3]}, acc[3], 0, 0, 0); } while (0)
        const int vbw = vb + (wid & 3) * 512;
        KS_STEP(0); KS_STEP(1); KS_STEP(2); KS_STEP(3);
#undef KS_STEP
#undef TRR
    }
#pragma unroll
    for (int e0 = 0; e0 < 4; ++e0)
#pragma unroll
        for (int r = 0; r < 16; ++r) SL[(size_t)(32 * wid + (r & 3) + 8 * (r >> 2) + 4 * hi) * 128 + 32 * e0 + r32] = acc[e0][r];
    __syncthreads();
}
}

constexpr int DM = 2048, NBATCH = 8, SEQ = 4096, DEPTH = 4, M = NBATCH * SEQ;
constexpr int IN_W = 12358, NIN = 12544, DFF = 5632, NUG = 2 * DFF, NUQ = 1280, NUKV = 1536;
constexpr float NORM_EPS = 1e-6f;
constexpr int NWAVES = 8;
constexpr int PH = 11, NPHASE = DEPTH * PH + 1;

constexpr size_t MiB = 1u << 20;
constexpr size_t WS_CTL = 0, CTL_ZERO_BYTES = 1 * MiB;
constexpr size_t WS_T128 = 1 * MiB, WS_T64 = 3 * MiB, WS_CL = 4 * MiB, WS_RSQ = 5 * MiB, WS_RSKV = 5 * MiB + 512 * 1024, WS_FF = 6 * MiB;
constexpr size_t WS_W = 8 * MiB;
constexpr size_t WO_IN = 0, WO_UQ = WO_IN + (size_t)NIN * DM * 2, WO_UKV = WO_UQ + (size_t)NUQ * 512 * 2, WO_BF = WO_UKV + (size_t)NUKV * 256 * 2, WO_BM = WO_BF + (size_t)DM * 1024 * 2,
                 WO_BR = WO_BM + (size_t)DM * 1024 * 2, WO_OUT = WO_BR + (size_t)DM * 1024 * 2, WO_UG = WO_OUT + (size_t)DM * DM * 2, WO_DN = WO_UG + (size_t)NUG * DM * 2, WO_END = WO_DN + (size_t)DM * DFF * 2;
static_assert(WO_END == 137 * MiB, "weight region");
constexpr size_t WS_H = 146 * MiB;
constexpr size_t WS_BIG = 274 * MiB;
constexpr size_t WS_GATES = WS_BIG, WS_FQKV = WS_GATES + 384 * MiB, WS_CQ = WS_FQKV + 144 * MiB, WS_CKV = WS_CQ + 32 * MiB, WS_RQ = WS_CKV + 16 * MiB, WS_RK = WS_RQ + 32 * MiB,
                 WS_RV = WS_RK + 32 * MiB, WS_RG = WS_RV + 64 * MiB, WS_KR = WS_RG + 64 * MiB, WS_QM = WS_KR + 4 * MiB, WS_KVM = WS_QM + 72 * MiB, WS_A = WS_KVM + 96 * MiB,
                 WS_BM = WS_A + 64 * MiB, WS_C = WS_BM + 64 * MiB, WS_SLOC = WS_C + 64 * MiB, WS_SST = WS_SLOC + 64 * MiB, WS_MIX_END = WS_SST + 32 * MiB;
constexpr size_t WS_TMP = WS_FQKV;
static_assert(WS_RV - WS_FQKV == 256 * MiB, "tmp overlay");
constexpr size_t WS_U = WS_BIG, WS_GT = WS_U + 352 * MiB, WS_ACT = WS_GT + 352 * MiB, WS_FFN_END = WS_ACT + 352 * MiB;
constexpr size_t WS_UTAIL = WS_U, WS_UHEAD = WS_U + 8 * MiB, WS_GHEAD = WS_U + 16 * MiB;
constexpr size_t WS_END = WS_MIX_END > WS_FFN_END ? WS_MIX_END : WS_FFN_END;
constexpr int CW_BAR = 4096;
constexpr int CW_QUEUE = 16384;

constexpr int RING_OFF = 0, RING_BYTES = 131072;
constexpr int LDSCTL_OFF = RING_BYTES, MISC_OFF = LDSCTL_OFF + 320;
constexpr int LDS_BYTES = 147456;
static_assert(MISC_OFF + 128 <= LDS_BYTES, "LDS map");

#define LAS __attribute__((address_space(3)))
typedef unsigned short bf16;
typedef unsigned v4u __attribute__((ext_vector_type(4)));
typedef float f32x4 __attribute__((ext_vector_type(4)));
#define LDS_WAIT() asm volatile("s_waitcnt lgkmcnt(0)" ::: "memory")
__device__ __forceinline__ unsigned f2bf(float f) { unsigned u = __builtin_bit_cast(unsigned, f); return (u + 0x7fffu + ((u >> 16) & 1u)) >> 16; }
__device__ __forceinline__ unsigned pk2(float lo, float hi) { return f2bf(lo) | (f2bf(hi) << 16); }

#define XB_TMO      128
#define XB_XCNT(j)  (256  + 64 * (j))
#define XB_XSUB(j)  (1280 + 64 * (j))
#define XB_XGEN(j)  (2304 + 64 * (j))
#define XB_TOP      3328
#define XB_TOPGEN   3392
#define XCD_BAR_WORDS 3456
#define XB_SPIN_CAP (1u << 18)
__device__ __forceinline__ unsigned xb_ld(unsigned* p)              { return __hip_atomic_load(p, __ATOMIC_RELAXED, __HIP_MEMORY_SCOPE_AGENT); }
__device__ __forceinline__ unsigned xb_add(unsigned* p, unsigned v) { return __hip_atomic_fetch_add(p, v, __ATOMIC_RELAXED, __HIP_MEMORY_SCOPE_AGENT); }
__device__ __forceinline__ unsigned xb_xcc_id() { return (unsigned)__builtin_amdgcn_s_getreg((3 << 11) | 20) & 0xFu; }
#define XB_SPIN(cond, bar) do { unsigned _sp = 0; while (cond) { __builtin_amdgcn_s_sleep(1); \
    if ((++_sp & 255u) == 0u) { if (xb_ld(&(bar)[XB_TMO])) break; if (_sp > XB_SPIN_CAP) { atomicAdd(&(bar)[XB_TMO], 1u); break; } } } } while (0)
struct XcdBarrier { unsigned* bar; unsigned x; volatile LAS unsigned* st; };
__device__ __forceinline__ XcdBarrier xcd_barrier_post(unsigned* bar, volatile LAS unsigned* st) {
    XcdBarrier b; b.bar = bar; b.x = xb_xcc_id(); b.st = st;
    if (threadIdx.x == 0) (void)xb_add(&bar[XB_XCNT(b.x)], 1u);
    return b;
}
__device__ __forceinline__ void xcd_barrier_complete(unsigned* bar, unsigned x, unsigned& nloc, unsigned& nx) {
    const unsigned G = gridDim.x * gridDim.y * gridDim.z;
    unsigned sum, cnt, mine, sp = 0u;
    for (;;) {
        sum = 0u; cnt = 0u; mine = 0u;
#pragma unroll
        for (unsigned j = 0; j < 16; ++j) { const unsigned c = xb_ld(&bar[XB_XCNT(j)]); sum += c; cnt += (c > 0u) ? 1u : 0u; mine = (j == x) ? c : mine; }
        if (sum == G) break;
        __builtin_amdgcn_s_sleep(1);
        if ((++sp & 255u) == 0u) { if (xb_ld(&bar[XB_TMO])) break; if (sp > XB_SPIN_CAP) { atomicAdd(&bar[XB_TMO], 1u); break; } }
    }
    nloc = mine > 0u ? mine : 1u; nx = cnt > 0u ? cnt : 1u;
}
__device__ __forceinline__ void xcd_barrier(const XcdBarrier& b) {
    asm volatile("s_waitcnt vmcnt(0)" ::: "memory");
    __syncthreads();
    if (threadIdx.x == 0) {
        unsigned bx = b.x; size_t bz_ = 0; asm volatile("" : "+s"(bz_), "+s"(bx)); unsigned* bar = b.bar + bz_;
        __builtin_amdgcn_s_waitcnt(0);
        unsigned nloc = b.st[0], nx = b.st[1];
        if (nloc == 0u) { xcd_barrier_complete(bar, bx, nloc, nx); b.st[0] = nloc; b.st[1] = nx; }
        const unsigned old = xb_add(&bar[XB_XSUB(bx)], 1u);
        const unsigned gen = old / nloc;
        if (old + 1u == (gen + 1u) * nloc) {
            __builtin_amdgcn_fence(__ATOMIC_RELEASE, "agent");
            asm volatile("s_waitcnt vmcnt(0)" ::: "memory");
            const unsigned og = xb_add(&bar[XB_TOP], 1u);
            const unsigned tg = og / nx;
            if (og + 1u == (tg + 1u) * nx) xb_add(&bar[XB_TOPGEN], 1u);
            else XB_SPIN(xb_ld(&bar[XB_TOPGEN]) == tg, bar);
            __builtin_amdgcn_fence(__ATOMIC_ACQUIRE, "agent");
            xb_add(&bar[XB_XGEN(bx)], 1u);
            asm volatile("s_waitcnt vmcnt(0)" ::: "memory");
        } else {
            XB_SPIN(xb_ld(&bar[XB_XGEN(bx)]) == gen, bar);
            __builtin_amdgcn_fence(__ATOMIC_ACQUIRE, "agent");
            asm volatile("s_waitcnt vmcnt(0)" ::: "memory");
        }
    }
    __syncthreads();
}

__device__ __forceinline__ float wave_sum(float v, int lane) {
#pragma unroll
    for (int o = 1; o < 64; o <<= 1) v += __builtin_bit_cast(float, __builtin_amdgcn_ds_bpermute((lane ^ o) << 2, __builtin_bit_cast(int, v)));
    return v;
}
__device__ __forceinline__ double lane_up_d(double v, int lane, int o) {
    const int src = (lane >= o ? lane - o : lane) << 2; const unsigned long long u = __builtin_bit_cast(unsigned long long, v);
    const unsigned lo = (unsigned)__builtin_amdgcn_ds_bpermute(src, (int)(unsigned)u), hi = (unsigned)__builtin_amdgcn_ds_bpermute(src, (int)(unsigned)(u >> 32));
    return __builtin_bit_cast(double, ((unsigned long long)hi << 32) | lo);
}
__device__ __forceinline__ void wconv_item(const float* W, int ldw, int src, int valid, const float* kscale, bf16* dst, int K, int k0, LAS float* scr, int lane) {
    const int j = lane & 31; const bool ok = j < valid;
    float wv[32];
#pragma unroll
    for (int i = 0; i < 32; ++i) { const int kk = 2 * i + (lane >> 5); wv[i] = ok ? W[(size_t)(k0 + kk) * ldw + src + j] : 0.f; }
    if (kscale) {
#pragma unroll
        for (int i = 0; i < 32; ++i) wv[i] *= kscale[k0 + 2 * i + (lane >> 5)]; }
#pragma unroll
    for (int i = 0; i < 32; ++i) scr[(2 * i + (lane >> 5)) * 33 + j] = wv[i];
    LDS_WAIT(); asm volatile("" ::: "memory");
    const int c = lane & 7;
#pragma unroll
    for (int jj = 0; jj < 4; ++jj) { const int n = (lane >> 3) + 8 * jj; const LAS float* s = scr + (8 * c) * 33 + n;
        v4u o; o.x = pk2(s[0 * 33], s[1 * 33]); o.y = pk2(s[2 * 33], s[3 * 33]); o.z = pk2(s[4 * 33], s[5 * 33]); o.w = pk2(s[6 * 33], s[7 * 33]);
        *(v4u*)(dst + (size_t)n * K + k0 + 8 * c) = o; }
    LDS_WAIT(); asm volatile("" ::: "memory");
}
__device__ __forceinline__ void inproj_src(int g, int& src, int& valid) {
    const int n = g * 32; valid = 32;
    if (n < 2304) src = n;
    else if (n < 2816) src = 2310 + (n - 2304);
    else if (n < 3072) src = 2822 + (n - 2816);
    else if (n < 3328) { const int p = n - 3072; if (p == 0) src = 3078; else if (p == 32) { src = 2304; valid = 6; } else if (p == 128) src = 3110; else { src = 0; valid = 0; } }
    else if (n < 4352) { const int base = (n < 3840) ? 3142 : 3654; const int p = (n < 3840) ? n - 3328 : n - 3840; const int t = p >> 8, q = p & 255, bj = q >> 7, x = q & 127, hh = x >> 6, i = x & 63;
        src = base + 128 * (2 * t + hh) + 64 * bj + i; }
    else if (n < 5376) src = 4166 + (n - 4352);
    else if (n < 6400) src = 5190 + (n - 5376);
    else src = 6214 + (n - 6400);
}
__device__ __forceinline__ void uq_src(int g, int& src, int& valid) {
    const int n = g * 32; valid = 32;
    if (n < 768) { const int t = n >> 8, q = n & 255, bj = q >> 7, x = q & 127; src = 192 * (2 * t + bj) + x; }
    else { const int t4 = (n >= 1024) ? 1 : 0; const int q = n - 768 - 256 * t4, bj = q >> 7, x = q & 127, hh = (x >> 5) + 4 * t4; if (hh < 6) src = 192 * hh + 128 + 32 * bj; else { src = 0; valid = 0; } }
}

struct Args {
    const float* in[19]; float* out; unsigned char* ws;
    float invf128[64]; float invf64[32];
    int ph_lo, ph_hi;
};

static_assert(sizeof(Args) == 560, "Args layout");

#define KAS __attribute__((address_space(4)))
#define GAS1 __attribute__((address_space(1)))
__device__ __forceinline__ const KAS char* karg_base() { size_t z = 0; asm volatile("" : "+s"(z)); return (const KAS char*)__builtin_amdgcn_kernarg_segment_ptr() + z; }
__device__ __forceinline__ const float* arg_in(int i) { typedef const GAS1 float* gp; return (const float*)(*(const KAS gp*)(karg_base() + 8 * i)); }
__device__ __forceinline__ float* arg_out() { typedef GAS1 float* gp; return (float*)(*(const KAS gp*)(karg_base() + 152)); }
__device__ __forceinline__ unsigned char* arg_ws() { typedef GAS1 unsigned char* gp; return (unsigned char*)(*(const KAS gp*)(karg_base() + 160)); }
__device__ __forceinline__ float arg_invf128(int i) { return *(const KAS float*)(karg_base() + 168 + 4 * i); }
__device__ __forceinline__ float arg_invf64(int i) { return *(const KAS float*)(karg_base() + 424 + 4 * i); }
struct Ctx { int tid, lane, wave, G, vcu, gw, NGW; LAS unsigned char* lds; unsigned char* ws; };
__device__ __forceinline__ Ctx ctx_local(const Ctx& C0) { Ctx C = C0; int t_ = threadIdx.x; asm volatile("" : "+v"(t_)); C.tid = t_; C.lane = t_ & 63; size_t z_ = 0; asm volatile("" : "+s"(C.wave), "+s"(C.gw), "+s"(C.vcu), "+s"(z_)); C.ws = arg_ws() + z_; return C; }

constexpr int XPITCH = 4096;
__device__ __forceinline__ void cvt8(const v4u w, float (&v)[8]) {
    v[0] = __uint_as_float(w.x << 16); v[1] = __uint_as_float(w.x & 0xffff0000u); v[2] = __uint_as_float(w.y << 16); v[3] = __uint_as_float(w.y & 0xffff0000u);
    v[4] = __uint_as_float(w.z << 16); v[5] = __uint_as_float(w.z & 0xffff0000u); v[6] = __uint_as_float(w.w << 16); v[7] = __uint_as_float(w.w & 0xffff0000u); }
__device__ __forceinline__ void rows_rmsnorm_first(const Ctx& C0, const float* x, const float* gain, bf16* xb, bf16* out) { const Ctx C = ctx_local(C0);
    f32x4 g[8];
#pragma unroll
    for (int j = 0; j < 8; ++j) g[j] = ((const f32x4*)gain + C.lane)[64 * j];
    for (int m = C.gw; m < M; m += 2 * C.NGW) {
        const int m2 = m + C.NGW; const bool has2 = m2 < M;
        const f32x4* xa = (const f32x4*)(x + (size_t)m * DM) + C.lane; const f32x4* xq = (const f32x4*)(x + (size_t)(has2 ? m2 : m) * DM) + C.lane;
        f32x4 va[8], vb[8]; float sa = 0.f, sb = 0.f;
#pragma unroll
        for (int j = 0; j < 8; ++j) va[j] = xa[64 * j];
#pragma unroll
        for (int j = 0; j < 8; ++j) vb[j] = xq[64 * j];
#pragma unroll
        for (int j = 0; j < 8; ++j) { sa += (va[j].x * va[j].x + va[j].y * va[j].y) + (va[j].z * va[j].z + va[j].w * va[j].w); sb += (vb[j].x * vb[j].x + vb[j].y * vb[j].y) + (vb[j].z * vb[j].z + vb[j].w * vb[j].w); }
        const float ra = __builtin_amdgcn_rsqf(wave_sum(sa, C.lane) * (1.0f / DM) + NORM_EPS), rb = __builtin_amdgcn_rsqf(wave_sum(sb, C.lane) * (1.0f / DM) + NORM_EPS);
        unsigned long long* oa = (unsigned long long*)(out + (size_t)m * DM) + C.lane; unsigned long long* ya = (unsigned long long*)(xb + (size_t)m * XPITCH) + C.lane;
#pragma unroll
        for (int j = 0; j < 8; ++j) { oa[64 * j] = (unsigned long long)pk2(va[j].x * ra * g[j].x, va[j].y * ra * g[j].y) | ((unsigned long long)pk2(va[j].z * ra * g[j].z, va[j].w * ra * g[j].w) << 32);
            ya[64 * j] = (unsigned long long)pk2(va[j].x, va[j].y) | ((unsigned long long)pk2(va[j].z, va[j].w) << 32); }
        if (has2) { unsigned long long* ob = (unsigned long long*)(out + (size_t)m2 * DM) + C.lane; unsigned long long* yb = (unsigned long long*)(xb + (size_t)m2 * XPITCH) + C.lane;
#pragma unroll
            for (int j = 0; j < 8; ++j) { ob[64 * j] = (unsigned long long)pk2(vb[j].x * rb * g[j].x, vb[j].y * rb * g[j].y) | ((unsigned long long)pk2(vb[j].z * rb * g[j].z, vb[j].w * rb * g[j].w) << 32);
                yb[64 * j] = (unsigned long long)pk2(vb[j].x, vb[j].y) | ((unsigned long long)pk2(vb[j].z, vb[j].w) << 32); } }
    }
}
__device__ __forceinline__ void rows_rmsnorm_bf16(const Ctx& C0, const bf16* xb, const float* gain, bf16* out) { const Ctx C = ctx_local(C0);
    f32x4 g[4][2];
#pragma unroll
    for (int j = 0; j < 4; ++j) { g[j][0] = *(const f32x4*)(gain + 8 * (C.lane + 64 * j)); g[j][1] = *(const f32x4*)(gain + 8 * (C.lane + 64 * j) + 4); }
    for (int m0 = C.gw; m0 < M; m0 += 4 * C.NGW) {
        v4u w[4][4];
#pragma unroll
        for (int q = 0; q < 4; ++q) { const int m = m0 + q * C.NGW; const v4u* xr = (const v4u*)(xb + (size_t)(m < M ? m : m0) * XPITCH) + C.lane;
#pragma unroll
            for (int j = 0; j < 4; ++j) w[q][j] = xr[64 * j]; }
#pragma unroll
        for (int q = 0; q < 4; ++q) { const int m = m0 + q * C.NGW; float s = 0.f;
#pragma unroll
            for (int j = 0; j < 4; ++j) { float v[8]; cvt8(w[q][j], v);
#pragma unroll
                for (int e = 0; e < 8; ++e) s += v[e] * v[e]; }
            const float r = __builtin_amdgcn_rsqf(wave_sum(s, C.lane) * (1.0f / DM) + NORM_EPS);
            if (m < M) { v4u* orow = (v4u*)(out + (size_t)m * DM) + C.lane;
#pragma unroll
                for (int j = 0; j < 4; ++j) { float v[8]; cvt8(w[q][j], v);
                    v4u o; o.x = pk2(v[0] * r * g[j][0][0], v[1] * r * g[j][0][1]); o.y = pk2(v[2] * r * g[j][0][2], v[3] * r * g[j][0][3]); o.z = pk2(v[4] * r * g[j][1][0], v[5] * r * g[j][1][1]); o.w = pk2(v[6] * r * g[j][1][2], v[7] * r * g[j][1][3]);
                    orow[64 * j] = o; } } }
    }
}
__device__ __forceinline__ void rows_rmsnorm_final(const Ctx& C0, float* outp, const float* gain) { const Ctx C = ctx_local(C0);
    f32x4 g[4][2];
#pragma unroll
    for (int j = 0; j < 4; ++j) { g[j][0] = *(const f32x4*)(gain + 8 * (C.lane + 64 * j)); g[j][1] = *(const f32x4*)(gain + 8 * (C.lane + 64 * j) + 4); }
    for (int m0 = C.gw; m0 < M; m0 += 4 * C.NGW) {
        v4u w[4][4];
#pragma unroll
        for (int q = 0; q < 4; ++q) { const int m = m0 + q * C.NGW; const v4u* xr = (const v4u*)((const bf16*)outp + (size_t)(m < M ? m : m0) * XPITCH) + C.lane;
#pragma unroll
            for (int j = 0; j < 4; ++j) w[q][j] = xr[64 * j]; }
        asm volatile("s_waitcnt vmcnt(0)" ::: "memory");
#pragma unroll
        for (int q = 0; q < 4; ++q) { const int m = m0 + q * C.NGW; float s = 0.f;
#pragma unroll
            for (int j = 0; j < 4; ++j) { float v[8]; cvt8(w[q][j], v);
#pragma unroll
                for (int e = 0; e < 8; ++e) s += v[e] * v[e]; }
            const float r = __builtin_amdgcn_rsqf(wave_sum(s, C.lane) * (1.0f / DM) + NORM_EPS);
            if (m < M) { float* orow = outp + (size_t)m * DM + 8 * C.lane;
#pragma unroll
                for (int j = 0; j < 4; ++j) { float v[8]; cvt8(w[q][j], v);
                    *(f32x4*)(orow + 512 * j) = (f32x4){v[0] * r * g[j][0][0], v[1] * r * g[j][0][1], v[2] * r * g[j][0][2], v[3] * r * g[j][0][3]};
                    *(f32x4*)(orow + 512 * j + 4) = (f32x4){v[4] * r * g[j][1][0], v[5] * r * g[j][1][1], v[6] * r * g[j][1][2], v[7] * r * g[j][1][3]}; } } }
    }
}
__device__ __forceinline__ void sincos_d(float angf, float& co, float& si) {
    const double a = (double)angf; const double k = __builtin_rint(a * 0.15915494309189535); double r = a - k * 6.283185307179586477;
    const double q = __builtin_rint(r * 0.63661977236758134308); const double y = r - q * 1.57079632679489661923; const double y2 = y * y;
    const double sy = y * (1.0 + y2 * (-1.0 / 6 + y2 * (1.0 / 120 + y2 * (-1.0 / 5040 + y2 * (1.0 / 362880 + y2 * (-1.0 / 39916800 + y2 * (1.0 / 6227020800.0)))))));
    const double cy = 1.0 + y2 * (-0.5 + y2 * (1.0 / 24 + y2 * (-1.0 / 720 + y2 * (1.0 / 40320 + y2 * (-1.0 / 3628800 + y2 * (1.0 / 479001600 + y2 * (-1.0 / 87178291200.0)))))));
    const int qi = ((int)q) & 3;
    const double s = (qi == 0) ? sy : (qi == 1) ? cy : (qi == 2) ? -sy : -cy;
    const double c = (qi == 0) ? cy : (qi == 1) ? -sy : (qi == 2) ? -cy : sy;
    co = (float)c; si = (float)s;
}
__device__ __forceinline__ void rope_tables(const Ctx& C0, const Args& A) { const Ctx C = ctx_local(C0);
    float* T128 = (float*)(C.ws + WS_T128); float* T64 = (float*)(C.ws + WS_T64);
    const int gt = (C.vcu * NWAVES + C.wave) * 64 + C.lane, NGT = C.NGW * 64;
    for (int e = gt; e < SEQ * 64; e += NGT) { const int pos = e >> 6, i = e & 63; float c, s; sincos_d((float)pos * arg_invf128(i), c, s); T128[2 * e] = c; T128[2 * e + 1] = s; }
    for (int e = gt; e < SEQ * 32; e += NGT) { const int pos = e >> 5, i = e & 31; float c, s; sincos_d((float)pos * arg_invf64(i), c, s); T64[2 * e] = c; T64[2 * e + 1] = s; }
}
__device__ __forceinline__ void p0_phase(const Ctx& C0, const Args& A, int layer) { const Ctx C = ctx_local(C0);
    LAS float* scr = (LAS float*)(C.lds + RING_OFF + C.wave * 16384);
    const float* w_in = arg_in(2) + (size_t)layer * DM * IN_W;
    const float* w_uq = arg_in(5) + (size_t)layer * 512 * 1152; const float* w_ukv = arg_in(6) + (size_t)layer * 256 * 1536;
    const float* qg = arg_in(3) + (size_t)layer * 512; const float* kvg = arg_in(4) + (size_t)layer * 256;
    const float* w_bf = arg_in(8) + (size_t)layer * 768 * DM; const float* w_bm = arg_in(9) + (size_t)layer * 768 * DM; const float* w_br = arg_in(10) + (size_t)layer * 1024 * DM;
    const float* w_out = arg_in(11) + (size_t)layer * DM * DM;
    const float* w_up = arg_in(13) + (size_t)layer * DM * DFF; const float* w_gate = arg_in(14) + (size_t)layer * DM * DFF; const float* w_dn = arg_in(17) + (size_t)layer * DFF * DM;
    bf16* Wb = (bf16*)(C.ws + WS_W);
    constexpr int I_IN = (NIN / 32) * (DM / 64), I_UQ = (NUQ / 32) * (512 / 64), I_UKV = (NUKV / 32) * (256 / 64), I_BF = (DM / 32) * (768 / 64), I_BR = (DM / 32) * (1024 / 64),
                  I_OUT = (DM / 32) * (DM / 64), I_UG = (NUG / 32) * (DM / 64), I_DN = (DM / 32) * (DFF / 64);
    constexpr int NITEMS = I_IN + I_UQ + I_UKV + 2 * I_BF + I_BR + I_OUT;
    for (int it = C.gw; it < NITEMS; it += C.NGW) {
        int r = it, src, valid;
        if (r < I_IN) { const int g = r / (DM / 64), kb = r % (DM / 64); inproj_src(g, src, valid); wconv_item(w_in, IN_W, src, valid, nullptr, (bf16*)((char*)Wb + WO_IN) + (size_t)g * 32 * DM, DM, kb * 64, scr, C.lane); continue; } r -= I_IN;
        if (r < I_UQ) { const int g = r / 8, kb = r % 8; uq_src(g, src, valid); wconv_item(w_uq, 1152, src, valid, qg, (bf16*)((char*)Wb + WO_UQ) + (size_t)g * 32 * 512, 512, kb * 64, scr, C.lane); continue; } r -= I_UQ;
        if (r < I_UKV) { const int g = r / 4, kb = r % 4; wconv_item(w_ukv, 1536, g * 32, 32, kvg, (bf16*)((char*)Wb + WO_UKV) + (size_t)g * 32 * 256, 256, kb * 64, scr, C.lane); continue; } r -= I_UKV;
        if (r < I_BF) { const int g = r / 12, kb = r % 12; wconv_item(w_bf, DM, g * 32, 32, nullptr, (bf16*)((char*)Wb + WO_BF) + (size_t)g * 32 * 1024, 1024, kb * 64, scr, C.lane); continue; } r -= I_BF;
        if (r < I_BF) { const int g = r / 12, kb = r % 12; wconv_item(w_bm, DM, g * 32, 32, nullptr, (bf16*)((char*)Wb + WO_BM) + (size_t)g * 32 * 1024, 1024, kb * 64, scr, C.lane); continue; } r -= I_BF;
        if (r < I_BR) { const int g = r / 16, kb = r % 16; wconv_item(w_br, DM, g * 32, 32, nullptr, (bf16*)((char*)Wb + WO_BR) + (size_t)g * 32 * 1024, 1024, kb * 64, scr, C.lane); continue; } r -= I_BR;
        if (r < I_OUT) { const int g = r / 32, kb = r % 32; wconv_item(w_out, DM, g * 32, 32, nullptr, (bf16*)((char*)Wb + WO_OUT) + (size_t)g * 32 * DM, DM, kb * 64, scr, C.lane); }
    }
    if (layer == 0) rows_rmsnorm_first(C, arg_in(0), arg_in(1), (bf16*)arg_out(), (bf16*)(C.ws + WS_H));
    else rows_rmsnorm_bf16(C, (const bf16*)arg_out(), arg_in(1) + (size_t)layer * DM, (bf16*)(C.ws + WS_H));
}
__device__ __forceinline__ void wconv_ffn(const Ctx& C0, int layer, int first, int nblk) { const Ctx C = ctx_local(C0);
    LAS float* scr = (LAS float*)(C.lds + RING_OFF + C.wave * 16384);
    const float* w_up = arg_in(13) + (size_t)layer * DM * DFF; const float* w_gate = arg_in(14) + (size_t)layer * DM * DFF; const float* w_dn = arg_in(17) + (size_t)layer * DFF * DM;
    bf16* Wb = (bf16*)(C.ws + WS_W);
    constexpr int I_UG = (NUG / 32) * (DM / 64), I_DN = (DM / 32) * (DFF / 64);
    for (int it = first * NWAVES + C.wave; it < I_UG + I_DN; it += nblk * NWAVES) {
        int r = it;
        if (r < I_UG) { const int g = r / 32, kb = r % 32; const int n = g * 32, t = n >> 8, bj = (n >> 7) & 1, x = n & 127;
            wconv_item(bj ? w_gate : w_up, DFF, 128 * t + x, 32, nullptr, (bf16*)((char*)Wb + WO_UG) + (size_t)g * 32 * DM, DM, kb * 64, scr, C.lane); continue; } r -= I_UG;
        { const int g = r / 88, kb = r % 88; wconv_item(w_dn, DM, g * 32, 32, nullptr, (bf16*)((char*)Wb + WO_DN) + (size_t)g * 32 * DFF, DFF, kb * 64, scr, C.lane); }
    }
}
__device__ __forceinline__ void p2_phase(const Ctx& C0, const Args& A, int layer) { const Ctx C = ctx_local(C0);
    const float* ff = (const float*)(C.ws + WS_FF); float* cL = (float*)(C.ws + WS_CL);
    LAS double* red = (LAS double*)(C.lds + RING_OFF);
    for (int sq = C.vcu; sq < NBATCH * 6; sq += C.G) {
        const int b = sq / 6, h = sq % 6; const float bias = arg_in(7)[layer * 6 + h];
        double v[8]; double run = 0.0;
#pragma unroll
        for (int j = 0; j < 8; ++j) { const float xf = ff[((size_t)b * SEQ + C.tid * 8 + j) * 8 + h] + bias;
            const float ls = fminf(xf, 0.f) - 0.6931471805599453f * __builtin_amdgcn_logf(1.0f + __builtin_amdgcn_exp2f(-1.4426950408889634f * fabsf(xf)));
            run += (double)ls; v[j] = run; }
        double incl = run;
#pragma unroll
        for (int o = 1; o < 64; o <<= 1) { const double t = lane_up_d(incl, C.lane, o); if (C.lane >= o) incl += t; }
        __syncthreads();
        if (C.lane == 63) red[C.wave] = incl;
        __syncthreads();
        double base = incl - run;
        for (int w = 0; w < C.wave; ++w) base += red[w];
        float* dst = cL + (size_t)sq * SEQ + C.tid * 8;
#pragma unroll
        for (int j = 0; j < 8; ++j) dst[j] = (float)((base + v[j]) * 1.4426950408889634);
    }
    const bf16* cq = (const bf16*)(C.ws + WS_CQ); const bf16* ckv = (const bf16*)(C.ws + WS_CKV); float* rq = (float*)(C.ws + WS_RSQ); float* rkv = (float*)(C.ws + WS_RSKV);
    for (int m0 = C.gw; m0 < M; m0 += 4 * C.NGW) {
        v4u a[4], c[4];
#pragma unroll
        for (int q = 0; q < 4; ++q) { const int m = m0 + q * C.NGW; const int mm = m < M ? m : m0; a[q] = *((const v4u*)(cq + (size_t)mm * 512) + C.lane); c[q] = *((const v4u*)(ckv + (size_t)mm * 256) + (C.lane & 31)); }
#pragma unroll
        for (int q = 0; q < 4; ++q) { const int m = m0 + q * C.NGW;
            float s = 0.f, s2 = 0.f; const unsigned w[4] = {a[q].x, a[q].y, a[q].z, a[q].w}, w2[4] = {c[q].x, c[q].y, c[q].z, c[q].w};
#pragma unroll
            for (int j = 0; j < 4; ++j) { const float lo = __uint_as_float(w[j] << 16), hi = __uint_as_float(w[j] & 0xffff0000u); s += lo * lo + hi * hi;
                const float lo2 = __uint_as_float(w2[j] << 16), hi2 = __uint_as_float(w2[j] & 0xffff0000u); if (C.lane < 32) s2 += lo2 * lo2 + hi2 * hi2; }
            s = wave_sum(s, C.lane); s2 = wave_sum(s2, C.lane);
            if (C.lane == 0 && m < M) { rq[m] = __builtin_amdgcn_rsqf(s * (1.0f / 512.0f) + NORM_EPS); rkv[m] = __builtin_amdgcn_rsqf(s2 * (1.0f / 256.0f) + NORM_EPS); } }
    }
    { const bf16* rk = (const bf16*)(C.ws + WS_RK); const bf16* rv = (const bf16*)(C.ws + WS_RV); float* sloc = (float*)(C.ws + WS_SLOC);
      for (int u = C.vcu; u < NBATCH * 4 * 16; u += C.G) { const int k = u & 15, h = (u >> 4) & 3, b = u >> 6; const size_t row0 = (size_t)b * SEQ + 256 * k;
          att::ret_state_unit(rk + row0 * 512 + 128 * h, 512, rv + row0 * 1024 + 256 * h, 1024, __builtin_amdgcn_logf(1.0f - __builtin_amdgcn_exp2f(-5.0f - (float)h)), sloc + (size_t)u * 32768, (LAS char*)(C.lds + RING_OFF)); } }
}
__device__ __forceinline__ void ret_scan(const Ctx& C0) { const Ctx C = ctx_local(C0);
    const float* sloc = (const float*)(C.ws + WS_SLOC); bf16* sst = (bf16*)(C.ws + WS_SST);
    for (int it = C.gw * 64 + C.lane; it < NBATCH * 4 * 8192; it += C.NGW * 64) {
        const int bh = it >> 13, e4 = (it & 8191) * 4, h = bh & 3;
        const float g256 = __builtin_amdgcn_exp2f(256.0f * __builtin_amdgcn_logf(1.0f - __builtin_amdgcn_exp2f(-5.0f - (float)h)));
        f32x4 s = {0.f, 0.f, 0.f, 0.f};
        f32x4 l[16];
#pragma unroll
        for (int k = 0; k < 15; ++k) l[k] = *(const f32x4*)(sloc + ((size_t)bh * 16 + k) * 32768 + e4);
#pragma unroll
        for (int k = 0; k < 16; ++k) { const size_t o = ((size_t)bh * 16 + k) * 32768 + e4;
            *(unsigned long long*)(sst + o) = (unsigned long long)pk2(s[0], s[1]) | ((unsigned long long)pk2(s[2], s[3]) << 32);
            if (k < 15) s = s * g256 + l[k]; }
    }
}
__device__ __forceinline__ void p9_phase(const Ctx& C0, const Args& A, int layer) { const Ctx C = ctx_local(C0);
    const float* utail = (const float*)(C.ws + WS_UTAIL); const float* uhead = (const float*)(C.ws + WS_UHEAD); const float* ghead = (const float*)(C.ws + WS_GHEAD); bf16* act = (bf16*)(C.ws + WS_ACT);
    const float* cw = arg_in(15) + (size_t)layer * 3 * DFF; const float* cb = arg_in(16) + (size_t)layer * DFF;
    constexpr int NCH = DFF / 8, NITEM = (M / 256) * 2 * NCH;
    for (int it = C.gw * 64 + C.lane; it < NITEM; it += C.NGW * 64) {
        const int ch = it % NCH, rr = (it / NCH) & 1, pm = it / (2 * NCH), f0 = ch * 8;
        if ((pm & 15) == 0) continue;
        const float* p2 = rr ? utail + ((size_t)(pm - 1) * 2 + 1) * DFF : utail + ((size_t)(pm - 1) * 2) * DFF;
        const float* p1 = rr ? uhead + ((size_t)pm * 2) * DFF : utail + ((size_t)(pm - 1) * 2 + 1) * DFF;
        const float* p0 = uhead + ((size_t)pm * 2 + rr) * DFF; const float* pg = ghead + ((size_t)pm * 2 + rr) * DFF;
        unsigned o[4];
#pragma unroll
        for (int h = 0; h < 2; ++h) { const f32x4 x2 = *(const f32x4*)(p2 + f0 + 4 * h), x1 = *(const f32x4*)(p1 + f0 + 4 * h), x0 = *(const f32x4*)(p0 + f0 + 4 * h), g = *(const f32x4*)(pg + f0 + 4 * h);
            const f32x4 a = *(const f32x4*)(cw + f0 + 4 * h), b = *(const f32x4*)(cw + DFF + f0 + 4 * h), c = *(const f32x4*)(cw + 2 * DFF + f0 + 4 * h), d = *(const f32x4*)(cb + f0 + 4 * h);
            float r[4];
#pragma unroll
            for (int j = 0; j < 4; ++j) r[j] = pg8::gelu_gate(d[j] + a[j] * x2[j] + b[j] * x1[j] + c[j] * x0[j], g[j]);
            o[2 * h] = pg8::cvt_pk_bf16(r[0], r[1]); o[2 * h + 1] = pg8::cvt_pk_bf16(r[2], r[3]); }
        *(v4u*)(act + (size_t)(pm * 256 + rr) * DFF + f0) = (v4u){o[0], o[1], o[2], o[3]};
    }
}
#ifndef PROBE_SKIP_EPI
#define PROBE_SKIP_EPI 0
#endif
#ifndef KIND_MASK
#define KIND_MASK 7
#endif

__device__ __forceinline__ int queue_next(unsigned* head, volatile LAS unsigned* slot) {
    __syncthreads();
    if (threadIdx.x == 0) *slot = __hip_atomic_fetch_add(head, 1u, __ATOMIC_RELAXED, __HIP_MEMORY_SCOPE_AGENT);
    __syncthreads();
    return (int)*slot;
}
__device__ __forceinline__ void p4_phase(const Ctx& C0, const Args& A, int layer, volatile LAS unsigned* slot, int rep) { const Ctx C = ctx_local(C0);
    unsigned* qh = (unsigned*)(C.ws + WS_CTL) + CW_QUEUE + 64 * 3 * layer + 64 * 12 * rep;
    const bool k0 = rep == 0 || (KIND_MASK & 1), k1 = rep == 0 || (KIND_MASK & 2), k2 = rep == 0 || (KIND_MASK & 4);
    LAS char* lds = (LAS char*)(C.lds + RING_OFF);
    const bf16* fqkv = (const bf16*)(C.ws + WS_FQKV); const float* cL = (const float*)(C.ws + WS_CL);
    const bf16* qm = (const bf16*)(C.ws + WS_QM); const bf16* kvm = (const bf16*)(C.ws + WS_KVM); const bf16* kr = (const bf16*)(C.ws + WS_KR);
    const bf16* rq = (const bf16*)(C.ws + WS_RQ); const bf16* rk = (const bf16*)(C.ws + WS_RK); const bf16* rv = (const bf16*)(C.ws + WS_RV); const bf16* rg = (const bf16*)(C.ws + WS_RG);
    bf16* oa = (bf16*)(C.ws + WS_A); bf16* ob = (bf16*)(C.ws + WS_BM); bf16* oc = (bf16*)(C.ws + WS_C);
    if (k2) for (;;) { const int i = queue_next(qh + 128, slot); if (i >= 1024) break;
        const int qb = 31 - i / 32, bh = i % 32, b = bh >> 2, h = bh & 3; const size_t row0 = (size_t)b * SEQ + 128 * qb, seq0 = (size_t)b * SEQ;
        att::UnitPtrs U; U.Q = rq + row0 * 512 + 128 * h; U.ldq = 512; U.K = rk + seq0 * 512 + 128 * h; U.ldk = 512; U.V = rv + seq0 * 1024 + 256 * h; U.ldv = 1024; U.KR = nullptr; U.bias = nullptr;
        U.G = rg + row0 * 1024 + 256 * h; U.O = oc + row0 * 1024 + 256 * h; U.ldo = 1024; U.P0 = 128 * qb; U.T0 = 256 * (qb >> 1);
        U.ST = (qb >> 1) ? (const bf16*)(C.ws + WS_SST) + ((size_t)bh * 16 + (qb >> 1)) * 32768 : nullptr; U.c2 = __builtin_amdgcn_logf(1.0f - __builtin_amdgcn_exp2f(-5.0f - (float)h));
        att::mixer_unit<2>(U, lds); }
    if (k1) for (;;) { const int i = queue_next(qh + 64, slot); if (i >= 768) break;
        const int qb = 15 - i / 48, bh = i % 48, b = bh / 6, h = bh % 6; const size_t row0 = (size_t)b * SEQ + 256 * qb, seq0 = (size_t)b * SEQ;
        att::UnitPtrs U; U.Q = qm + row0 * 1152 + 192 * h; U.ldq = 1152; U.K = kvm + seq0 * 1536 + 256 * h; U.ldk = 1536; U.V = U.K + 128; U.ldv = 1536; U.KR = kr + seq0 * 64; U.bias = nullptr; U.G = nullptr; U.ST = nullptr; U.T0 = 0;
        U.O = ob + row0 * 1024 + 128 * h; U.ldo = 1024; U.P0 = 256 * qb; U.c2 = 0.07216878364870322f * 1.4426950408889634f;
        att::mixer_unit<1>(U, lds); }
    if (k0) for (;;) { const int i = queue_next(qh, slot); if (i >= 768) break;
        const int qb = 15 - i / 48, bh = i % 48, b = bh / 6, h = bh % 6; const size_t row0 = (size_t)b * SEQ + 256 * qb, seq0 = (size_t)b * SEQ;
        att::UnitPtrs U; U.Q = fqkv + row0 * 2304 + 128 * h; U.ldq = 2304; U.K = fqkv + seq0 * 2304 + 768 + 128 * h; U.ldk = 2304; U.V = U.K + 768; U.ldv = 2304; U.KR = nullptr; U.G = nullptr; U.ST = nullptr; U.T0 = 0;
        U.bias = cL + (size_t)bh * SEQ; U.O = oa + row0 * 1024 + 128 * h; U.ldo = 1024; U.P0 = 256 * qb; U.c2 = 0.08838834764831845f * 1.4426950408889634f;
        att::mixer_unit<0>(U, lds); }
}

__global__ void __launch_bounds__(NWAVES * 64, 2) hyb_fwd(Args args) {
    extern __shared__ __attribute__((aligned(16))) unsigned char lds_raw[];
    Ctx C;
    C.lds = (LAS unsigned char*)lds_raw;
    volatile LAS unsigned* MISC = (volatile LAS unsigned*)(C.lds + MISC_OFF);
    C.tid = 0; C.lane = 0; C.wave = __builtin_amdgcn_readfirstlane((int)threadIdx.x >> 6);
    C.G = gridDim.x; { const int bx = blockIdx.x; C.vcu = (C.G % 8 == 0) ? (bx % 8) * (C.G / 8) + bx / 8 : bx; }
    C.gw = C.vcu * NWAVES + C.wave; C.NGW = C.G * NWAVES; C.ws = arg_ws();
    unsigned* ctl = (unsigned*)(C.ws + WS_CTL);
    for (int u = threadIdx.x; u < (LDS_BYTES - LDSCTL_OFF) / 4; u += NWAVES * 64) ((LAS unsigned*)(C.lds + LDSCTL_OFF))[u] = 0u;
    __syncthreads();
#if MK_PER_PHASE
    XcdBarrier bar; bar.bar = ctl + CW_BAR; bar.x = 0; bar.st = nullptr; (void)bar;
#define GRID_BAR() do { } while (0)
#else
    XcdBarrier bar = xcd_barrier_post(ctl + CW_BAR, MISC + 8);
#define GRID_BAR() xcd_barrier(bar)
#endif
    const int lo = args.ph_lo, hi = args.ph_hi;
#define IN(k) (lo <= (k) && (k) < hi)
#ifndef PHASE_MASK
#define PHASE_MASK 0xFFFF
#endif
#define PHM(k) (((PHASE_MASK) >> (k)) & 1)
#ifndef SUB_MASK
#define SUB_MASK 0xFF
#endif
#define SUBM(k) (((SUB_MASK) >> (k)) & 1)
#ifndef REPEAT_MASK
#define REPEAT_MASK 0
#endif
#define REPS(k) (1 + (((REPEAT_MASK) >> (k)) & 1))

#define SEAM(k) do { if (IN(k) && IN((k) + 1)) GRID_BAR(); } while (0)
    PG8_LAS unsigned char* ring = (PG8_LAS unsigned char*)(C.lds + RING_OFF);
    const int bid = (int)blockIdx.x;
    if (PHM(0) && IN(0)) rope_tables(C, args);
    for (int layer = 0; layer < DEPTH; ++layer) {
        const int p = layer * PH;
        _Pragma("unroll") for (int rep = 0; rep < REPS(0); ++rep) if (PHM(0) && IN(p + 0)) { p0_phase(C, args, layer); if (rep + 1 < REPS(0)) GRID_BAR(); else SEAM(p + 0); }
        _Pragma("unroll") for (int rep = 0; rep < REPS(1); ++rep) if (PHM(1) && IN(p + 1)) { size_t wz_ = 0; asm volatile("" : "+s"(wz_)); unsigned char* wsl = arg_ws() + wz_; pg8::bf16_t* Wb = (pg8::bf16_t*)(wsl + WS_W); pg8::bf16_t* Hb = (pg8::bf16_t*)(wsl + WS_H);
            pg8::Gemm g{Hb, (const pg8::bf16_t*)((char*)Wb + WO_IN), M, NIN, DM}; pg8::StaticOrder S; S.init(M, NIN, C.G, bid);
            pg8::EpiInProj E{wsl, WS_FQKV, WS_CQ, WS_CKV, WS_KR, WS_RQ, WS_RK, WS_RV, WS_RG, WS_GATES, WS_FF, WS_T128, WS_T64, (rep + 1 < REPS(1)) ? PROBE_SKIP_EPI : 0};
            pg8::gemm_phase<pg8::EpiInProj, pg8::StaticOrder, true, true>(ring, g, S, E);
            { const int nfull = (M / 256) * (NIN / 256) % C.G; if (rep + 1 == REPS(1)) { if (nfull == 0) wconv_ffn(C, layer, bid, C.G); else if (bid >= nfull) wconv_ffn(C, layer, bid - nfull, C.G - nfull); } }
            if (rep + 1 < REPS(1)) GRID_BAR(); else SEAM(p + 1); }
        _Pragma("unroll") for (int rep = 0; rep < REPS(2); ++rep) if (PHM(2) && IN(p + 2)) { p2_phase(C, args, layer); if (rep + 1 < REPS(2)) GRID_BAR(); else SEAM(p + 2); }
        _Pragma("unroll") for (int rep = 0; rep < REPS(3); ++rep) if (PHM(3) && IN(p + 3)) { size_t wz_ = 0; asm volatile("" : "+s"(wz_)); unsigned char* wsl = arg_ws() + wz_; pg8::bf16_t* Wb = (pg8::bf16_t*)(wsl + WS_W); pg8::bf16_t* Hb = (pg8::bf16_t*)(wsl + WS_H);
            if (SUBM(0)) { pg8::Gemm g{(const pg8::bf16_t*)(wsl + WS_CQ), (const pg8::bf16_t*)((char*)Wb + WO_UQ), M, NUQ, 512}; pg8::StaticOrder S; S.init(M, NUQ, C.G, bid);
              pg8::EpiUq E{(pg8::bf16_t*)(wsl + WS_QM), (const float*)(wsl + WS_RSQ), (const float*)(wsl + WS_T64)};
              pg8::gemm_phase<pg8::EpiUq, pg8::StaticOrder, true, true>(ring, g, S, E); }
            if (SUBM(1)) { pg8::Gemm g{(const pg8::bf16_t*)(wsl + WS_CKV), (const pg8::bf16_t*)((char*)Wb + WO_UKV), M, NUKV, 256}; pg8::StaticOrder S; S.init(M, NUKV, C.G, bid);
              pg8::EpiUkv E{(pg8::bf16_t*)(wsl + WS_KVM), (const float*)(wsl + WS_RSKV)};
              pg8::gemm_phase<pg8::EpiUkv, pg8::StaticOrder, true, true>(ring, g, S, E); }
            ret_scan(C);
            if (rep + 1 < REPS(3)) GRID_BAR(); else SEAM(p + 3); }
        _Pragma("unroll") for (int rep = 0; rep < REPS(4); ++rep) if (PHM(4) && IN(p + 4)) { p4_phase(C, args, layer, MISC + 16, rep); if (rep + 1 < REPS(4)) GRID_BAR(); else SEAM(p + 4); }
        _Pragma("unroll") for (int rep = 0; rep < REPS(5); ++rep) if (PHM(5) && IN(p + 5)) { size_t wz_ = 0; asm volatile("" : "+s"(wz_)); unsigned char* wsl = arg_ws() + wz_; pg8::bf16_t* Wb = (pg8::bf16_t*)(wsl + WS_W); pg8::bf16_t* Hb = (pg8::bf16_t*)(wsl + WS_H);
            { static_assert(WS_BM - WS_A == WS_C - WS_BM && WO_BM - WO_BF == WO_BR - WO_BM, "equally spaced sub-GEMM operands");
              pg8::GemmM g{(const pg8::bf16_t*)(wsl + WS_A), (const pg8::bf16_t*)((char*)Wb + WO_BF), (WS_BM - WS_A) / 2, (WO_BM - WO_BF) / 2, 12, 4, 1024, 1024};
              pg8::StaticOrder3 S; S.init(M, DM, C.G, bid);
              pg8::EpiMergeM E{(const pg8::bf16_t*)(wsl + WS_GATES), Hb};
              pg8::gemm_phase_m<pg8::EpiMergeM, pg8::StaticOrder3, true, true>(ring, g, S, E); }
            if (rep + 1 < REPS(5)) GRID_BAR(); else SEAM(p + 5); }
        _Pragma("unroll") for (int rep = 0; rep < REPS(6); ++rep) if (PHM(6) && IN(p + 6)) { size_t wz_ = 0; asm volatile("" : "+s"(wz_)); unsigned char* wsl = arg_ws() + wz_; pg8::bf16_t* Wb = (pg8::bf16_t*)(wsl + WS_W); pg8::bf16_t* Hb = (pg8::bf16_t*)(wsl + WS_H);
            pg8::Gemm g{Hb, (const pg8::bf16_t*)((char*)Wb + WO_OUT), M, DM, DM}; pg8::StaticOrder S; S.init(M, DM, C.G, bid);
            pg8::EpiResid E{(rep + 1 < REPS(6)) ? (pg8::bf16_t*)(wsl + WS_GATES) : (pg8::bf16_t*)arg_out()}; pg8::gemm_phase<pg8::EpiResid, pg8::StaticOrder, true, true>(ring, g, S, E);
            if (rep + 1 < REPS(6)) GRID_BAR(); else SEAM(p + 6); }
        _Pragma("unroll") for (int rep = 0; rep < REPS(7); ++rep) if (PHM(7) && IN(p + 7)) { rows_rmsnorm_bf16(C, (const bf16*)arg_out(), arg_in(12) + (size_t)layer * DM, (bf16*)(C.ws + WS_H)); if (rep + 1 < REPS(7)) GRID_BAR(); else SEAM(p + 7); }
        _Pragma("unroll") for (int rep = 0; rep < REPS(8); ++rep) if (PHM(8) && IN(p + 8)) { size_t wz_ = 0; asm volatile("" : "+s"(wz_)); unsigned char* wsl = arg_ws() + wz_; pg8::bf16_t* Wb = (pg8::bf16_t*)(wsl + WS_W); pg8::bf16_t* Hb = (pg8::bf16_t*)(wsl + WS_H);
            pg8::Gemm g{Hb, (const pg8::bf16_t*)((char*)Wb + WO_UG), M, NUG, DM}; pg8::StaticOrder S; S.init(M, NUG, C.G, bid);
            pg8::EpiConvAct E{(pg8::bf16_t*)(wsl + WS_ACT), (float*)(wsl + WS_UTAIL), (float*)(wsl + WS_UHEAD), (float*)(wsl + WS_GHEAD), arg_in(15) + (size_t)layer * 3 * DFF, arg_in(16) + (size_t)layer * DFF, (PG8_LAS float*)(C.lds + LDSCTL_OFF + 1024)};
            pg8::gemm_phase<pg8::EpiConvAct, pg8::StaticOrder, true, true>(ring, g, S, E);
            if (rep + 1 < REPS(8)) GRID_BAR(); else SEAM(p + 8); }
        _Pragma("unroll") for (int rep = 0; rep < REPS(9); ++rep) if (PHM(9) && IN(p + 9)) { p9_phase(C, args, layer); if (rep + 1 < REPS(9)) GRID_BAR(); else SEAM(p + 9); }
        _Pragma("unroll") for (int rep = 0; rep < REPS(10); ++rep) if (PHM(10) && IN(p + 10)) { size_t wz_ = 0; asm volatile("" : "+s"(wz_)); unsigned char* wsl = arg_ws() + wz_; pg8::bf16_t* Wb = (pg8::bf16_t*)(wsl + WS_W); pg8::bf16_t* Hb = (pg8::bf16_t*)(wsl + WS_H);
            pg8::Gemm g{(const pg8::bf16_t*)(wsl + WS_ACT), (const pg8::bf16_t*)((char*)Wb + WO_DN), M, DM, DFF}; pg8::StaticOrder S; S.init(M, DM, C.G, bid);
            pg8::EpiResid E{(rep + 1 < REPS(10)) ? (pg8::bf16_t*)(wsl + WS_GATES) : (pg8::bf16_t*)arg_out()}; pg8::gemm_phase<pg8::EpiResid, pg8::StaticOrder, true, true>(ring, g, S, E);
            if (rep + 1 < REPS(10)) GRID_BAR(); else SEAM(p + 10); }
    }
    if (IN(DEPTH * PH)) rows_rmsnorm_final(C, arg_out(), arg_in(18));
#if defined(PROBE_EXTRA_BARRIERS) && !MK_PER_PHASE
    for (int i = 0; i < PROBE_EXTRA_BARRIERS; ++i) GRID_BAR();
#endif
#undef IN
#undef SEAM
#undef GRID_BAR
}

extern "C" void kernel_launch(void* const* d_in, const int* in_sizes, int n_in, void* d_out, int out_size, void* d_ws, size_t ws_size, hipStream_t stream) {
    static int grid = 0;
    if (grid == 0) {
        if (n_in != 19 || out_size != M * DM || ws_size < WS_END) { fprintf(stderr, "kernel_launch: unexpected problem (n_in %d, out %d, ws %zu < %zu); nothing launched\n", n_in, out_size, ws_size, (size_t)WS_END); grid = -1; return; }
        int dev = 0, cus = 0, per_cu = 0;
        if (hipGetDevice(&dev) != hipSuccess || hipDeviceGetAttribute(&cus, hipDeviceAttributeMultiprocessorCount, dev) != hipSuccess) { grid = -1; return; }
        if (hipFuncSetAttribute((const void*)hyb_fwd, hipFuncAttributeMaxDynamicSharedMemorySize, LDS_BYTES) != hipSuccess) { fprintf(stderr, "kernel_launch: hipFuncSetAttribute failed\n"); grid = -1; return; }
        if (hipOccupancyMaxActiveBlocksPerMultiprocessor(&per_cu, (const void*)hyb_fwd, NWAVES * 64, LDS_BYTES) != hipSuccess || per_cu < 1) { fprintf(stderr, "kernel_launch: occupancy query says %d\n", per_cu); }
        (void)hipGetLastError();
        grid = cus;
    }
    if (grid < 0) return;
    (void)in_sizes;
    if (hipMemsetAsync((char*)d_ws + WS_CTL, 0, CTL_ZERO_BYTES, stream) != hipSuccess) return;
    Args a; memset(&a, 0, sizeof(a));
    for (int i = 0; i < 19; ++i) a.in[i] = (const float*)d_in[i];
    a.out = (float*)d_out; a.ws = (unsigned char*)d_ws;
    for (int i = 0; i < 64; ++i) a.invf128[i] = (float)pow(10000.0, -(double)(2 * i) / 128.0);
    for (int i = 0; i < 32; ++i) a.invf64[i] = (float)pow(10000.0, -(double)(2 * i) / 64.0);
#if MK_PER_PHASE
    for (int ph = 0; ph < NPHASE; ++ph) { a.ph_lo = ph; a.ph_hi = ph + 1; hipLaunchKernelGGL(hyb_fwd, dim3(grid), dim3(NWAVES * 64), LDS_BYTES, stream, a); }
#else
    a.ph_lo = 0; a.ph_hi = NPHASE; hipLaunchKernelGGL(hyb_fwd, dim3(grid), dim3(NWAVES * 64), LDS_BYTES, stream, a);
#endif
    const hipError_t le = hipPeekAtLastError();
    if (le != hipSuccess) fprintf(stderr, "kernel_launch: launch failed: %s\n", hipGetErrorName(le));
}
```

```cpp
#include <hip/hip_runtime.h>
#include <cstdio>
#include <cstdint>
#include <cmath>
#ifndef MK_PER_PHASE
#define MK_PER_PHASE 0
#endif
#include <cstring>
namespace pg8 {
#define PG8_LAS __attribute__((address_space(3)))
typedef unsigned short bf16_t;
typedef short bf16x8 __attribute__((ext_vector_type(8)));
typedef float f32x4 __attribute__((ext_vector_type(4)));
typedef unsigned u32x4 __attribute__((ext_vector_type(4)));
constexpr int BM = 256, BK = 64, HALF = 128, HTB = HALF * BK * 2  , STAGE_BYTES = 8 * HTB, NXCD = 8, WGM = 8;

__host__ __device__ __forceinline__ int lds_byte(int r, int c) { const int st = (r >> 4) * 2 + (c >> 5), rr = r & 15, cc = c & 31, ob = rr * 64 + cc * 2; return st * 1024 + (ob ^ (((ob >> 9) & 1) << 5)); }
__host__ __device__ __forceinline__ void stage_rc(int b, int& R, int& C) { const int st = b / 1024, sb = b % 1024, swz = sb ^ (((sb >> 9) & 1) << 5); R = (st >> 1) * 16 + swz / 64; C = (st & 1) * 32 + (swz % 64) / 2; }
__host__ __device__ __forceinline__ int perm32(int rho) { const int n = rho >> 4, i = rho & 15; return 8 * (i >> 2) + 4 * n + (i & 3); }

struct Unit { int pm, pn; };
struct Gemm { const bf16_t* A; const bf16_t* Bt; int M, N, K; };

struct StaticOrder {
    int nM, nN, nwg, G, c;
    __host__ __device__ void init(int M, int N, int G_, int c_) { nM = M / BM; nN = N / BM; nwg = nM * nN; G = G_; c = c_; }
    __host__ __device__ bool next(int i, Unit& u) const {
        const long L = (long)i * G + c; if (L >= nwg) return false;
        int wgid = (int)L; { const int q = nwg / NXCD, r = nwg % NXCD, xcd = wgid % NXCD, off = wgid / NXCD; wgid = (xcd < r ? xcd * (q + 1) : r * (q + 1) + (xcd - r) * q) + off; }
        const int nig = WGM * nN, gid = wgid / nig, fm = gid * WGM, gsz = (nM - fm) < WGM ? (nM - fm) : WGM;
        u.pm = fm + ((wgid % nig) % gsz); u.pn = (wgid % nig) / gsz; return true;
    }
    __device__ __forceinline__ void a_ready(const Unit&) const {}
    __device__ __forceinline__ void done(const Unit&) const {}
};

template <class Epi, class Sched, bool ALIGN_EPI = false, bool SP2 = false>
__device__ __forceinline__ void gemm_phase(PG8_LAS unsigned char* lds, const Gemm g, const Sched& S, const Epi& E) {
    int tid_ = threadIdx.x; asm volatile("" : "+v"(tid_));
    const int tid = tid_, wid = __builtin_amdgcn_readfirstlane(tid >> 6), lane = tid & 63, wr = wid >> 2, wc = wid & 3, fr = lane & 15, fq = lane >> 4;
    int K_ = g.K; asm volatile("" : "+s"(K_)); const int K = K_, nt = K / BK;
    unsigned voffA[2], voffB[2];
#pragma unroll
    for (int i = 0; i < 2; ++i) { int R, C; stage_rc(tid * 16 + i * 8192, R, C); const int Rb = Epi::PERM ? ((R & ~31) + perm32(R & 31)) : R;
        voffA[i] = (unsigned)(R * K + C) * 2u; voffB[i] = (unsigned)(Rb * K + C) * 2u; }
    const size_t kstep = (size_t)(BK * 2);
    const size_t hstep = (size_t)HALF * K * 2;
    const size_t tstep = 2 * hstep;
    const unsigned ldsw = (unsigned)wid * 1024u;
    const int aoff = lds_byte(wr * 64 + fr, fq * 8), boff = lds_byte(wc * 32 + fr, fq * 8);
#define PG8_SA(b, h) (((b) * 2 + (h)) * HTB)
#define PG8_SB(b, h) ((4 + (b) * 2 + (h)) * HTB)
#define PG8_STAGE(bufoff, gbase, voff) do { _Pragma("unroll") for (int _i = 0; _i < 2; ++_i) \
        __builtin_amdgcn_global_load_lds((const unsigned*)((const char*)(gbase) + (voff)[_i]), (PG8_LAS unsigned*)(lds + (bufoff) + ldsw + _i * 8192), 16, 0, 0); } while (0)
#define PG8_LDA(dst, b, h) do { _Pragma("unroll") for (int m = 0; m < 4; ++m) _Pragma("unroll") for (int k = 0; k < 2; ++k) dst[m][k] = *(const PG8_LAS bf16x8*)(lds + PG8_SA(b, h) + aoff + m * 2048 + k * 1024); } while (0)
#define PG8_LDB(dst, b, h) do { _Pragma("unroll") for (int n = 0; n < 2; ++n) _Pragma("unroll") for (int k = 0; k < 2; ++k) dst[n][k] = *(const PG8_LAS bf16x8*)(lds + PG8_SB(b, h) + boff + n * 2048 + k * 1024); } while (0)
#define PG8_MMA(ai, bj, At, Bt) do { __builtin_amdgcn_s_setprio(1); _Pragma("unroll") for (int m = 0; m < 4; ++m) _Pragma("unroll") for (int n = 0; n < 2; ++n) _Pragma("unroll") for (int k = 0; k < 2; ++k) \
        acc[ai][bj][m][n] = __builtin_amdgcn_mfma_f32_16x16x32_bf16(Bt[n][k], At[m][k], acc[ai][bj][m][n], 0, 0, 0); __builtin_amdgcn_s_setprio(0); } while (0)
#define PG8_WAIT_V(n) asm volatile("s_waitcnt vmcnt(" #n ")" ::: "memory")
#define PG8_WAIT_L(n) asm volatile("s_waitcnt lgkmcnt(" #n ")" ::: "memory")
#define PG8_BAR __builtin_amdgcn_s_barrier()
#define PG8_SCHED __builtin_amdgcn_sched_barrier(0)
    Unit cur, nxt; int ui = 0;
    if (!S.next(0, cur)) return;
    f32x4 acc[2][2][4][2];
#pragma unroll
    for (int a = 0; a < 2; ++a)
#pragma unroll
        for (int b = 0; b < 2; ++b)
#pragma unroll
            for (int m = 0; m < 4; ++m)
#pragma unroll
                for (int n = 0; n < 2; ++n) acc[a][b][m][n] = (f32x4){0.f, 0.f, 0.f, 0.f};
    bf16x8 At[4][2], B0[2][2], B1[2][2];
    const char* cA = (const char*)g.A + (size_t)cur.pm * tstep; const char* cB = (const char*)g.Bt + (size_t)cur.pn * tstep;
    S.a_ready(cur);
    if constexpr (SP2) {
        PG8_STAGE(PG8_SB(0, 0), cB, voffB); PG8_STAGE(PG8_SB(0, 1), cB + hstep, voffB); PG8_STAGE(PG8_SA(0, 0), cA, voffA); PG8_STAGE(PG8_SA(0, 1), cA + hstep, voffA);
        if (wr == 1) PG8_BAR;
        PG8_WAIT_V(2); PG8_BAR;
        PG8_STAGE(PG8_SB(1, 0), cB + kstep, voffB); PG8_STAGE(PG8_SA(1, 0), cA + kstep, voffA); PG8_STAGE(PG8_SB(1, 1), cB + hstep + kstep, voffB);
        PG8_WAIT_V(6); PG8_BAR;
    } else {
        PG8_STAGE(PG8_SB(0, 0), cB, voffB); PG8_STAGE(PG8_SA(0, 0), cA, voffA); PG8_STAGE(PG8_SB(0, 1), cB + hstep, voffB); PG8_STAGE(PG8_SA(0, 1), cA + hstep, voffA);
        if (wr == 1) PG8_BAR;
        PG8_WAIT_V(4); PG8_BAR;
        PG8_STAGE(PG8_SB(1, 0), cB + kstep, voffB); PG8_STAGE(PG8_SA(1, 0), cA + kstep, voffA); PG8_STAGE(PG8_SB(1, 1), cB + hstep + kstep, voffB);
        PG8_WAIT_V(6); PG8_BAR;
    }
    for (;;) {
        const bool has_next = S.next(ui + 1, nxt);
        const char* nA = has_next ? (const char*)g.A + (size_t)nxt.pm * tstep : cA; const char* nB = has_next ? (const char*)g.Bt + (size_t)nxt.pn * tstep : cB;
        for (int t = 0; t < nt; t += 2) {
            const bool last = (t == nt - 2);
            const char* a1 = cA + (size_t)(t + 1) * kstep;
            const char* a2 = last ? nA : cA + (size_t)(t + 2) * kstep; const char* b2 = last ? nB : cB + (size_t)(t + 2) * kstep;
            const char* a3 = a2 + kstep; const char* b3 = b2 + kstep;
            if (last && has_next) S.a_ready(nxt);
            if constexpr (SP2) {
            PG8_LDB(B0, 0, 0); PG8_LDB(B1, 0, 1); PG8_SCHED; PG8_LDA(At, 0, 0); PG8_STAGE(PG8_SA(1, 1), a1 + hstep, voffA);
            PG8_WAIT_V(8); PG8_WAIT_L(0); PG8_BAR; PG8_MMA(0, 0, At, B0); PG8_MMA(0, 1, At, B1); PG8_BAR; PG8_SCHED;
            PG8_LDA(At, 0, 1); PG8_STAGE(PG8_SB(0, 0), b2, voffB); PG8_STAGE(PG8_SB(0, 1), b2 + hstep, voffB); PG8_STAGE(PG8_SA(0, 0), a2, voffA);
            PG8_WAIT_V(8); PG8_WAIT_L(0); PG8_BAR; PG8_MMA(1, 0, At, B0); PG8_MMA(1, 1, At, B1); PG8_BAR; PG8_SCHED;
            PG8_LDB(B0, 1, 0); PG8_LDB(B1, 1, 1); PG8_SCHED; PG8_LDA(At, 1, 0); PG8_STAGE(PG8_SA(0, 1), a2 + hstep, voffA);
            PG8_WAIT_V(8); PG8_WAIT_L(0); PG8_BAR; PG8_MMA(0, 0, At, B0); PG8_MMA(0, 1, At, B1); PG8_BAR; PG8_SCHED;
            PG8_LDA(At, 1, 1); PG8_STAGE(PG8_SB(1, 0), b3, voffB); PG8_STAGE(PG8_SB(1, 1), b3 + hstep, voffB); PG8_STAGE(PG8_SA(1, 0), a3, voffA);
            PG8_WAIT_V(8); PG8_WAIT_L(0); PG8_BAR; PG8_MMA(1, 0, At, B0); PG8_MMA(1, 1, At, B1); PG8_BAR; PG8_SCHED;
            } else {
            PG8_LDB(B0, 0, 0); PG8_SCHED; PG8_LDA(At, 0, 0); PG8_STAGE(PG8_SA(1, 1), a1 + hstep, voffA);
            PG8_WAIT_L(8); PG8_BAR; PG8_WAIT_L(0); PG8_MMA(0, 0, At, B0); PG8_BAR; PG8_SCHED;
            PG8_LDB(B1, 0, 1); PG8_STAGE(PG8_SB(0, 0), b2, voffB);
            PG8_BAR; PG8_WAIT_L(0); PG8_MMA(0, 1, At, B1); PG8_BAR;
            PG8_LDA(At, 0, 1); PG8_STAGE(PG8_SA(0, 0), a2, voffA);
            PG8_BAR; PG8_WAIT_L(0); PG8_MMA(1, 0, At, B0); PG8_BAR; PG8_SCHED;
            PG8_STAGE(PG8_SB(0, 1), b2 + hstep, voffB);
            PG8_WAIT_V(6); PG8_BAR; PG8_MMA(1, 1, At, B1); PG8_BAR;
            PG8_LDB(B0, 1, 0); PG8_SCHED; PG8_LDA(At, 1, 0); PG8_STAGE(PG8_SA(0, 1), a2 + hstep, voffA);
            PG8_WAIT_L(8); PG8_BAR; PG8_WAIT_L(0); PG8_MMA(0, 0, At, B0); PG8_BAR; PG8_SCHED;
            PG8_LDB(B1, 1, 1); PG8_STAGE(PG8_SB(1, 0), b3, voffB);
            PG8_BAR; PG8_WAIT_L(0); PG8_MMA(0, 1, At, B1); PG8_BAR;
            PG8_LDA(At, 1, 1); PG8_STAGE(PG8_SA(1, 0), a3, voffA);
            PG8_BAR; PG8_WAIT_L(0); PG8_MMA(1, 0, At, B0); PG8_BAR; PG8_SCHED;
            PG8_STAGE(PG8_SB(1, 1), b3 + hstep, voffB);
            PG8_WAIT_V(6); PG8_BAR; PG8_MMA(1, 1, At, B1); PG8_BAR;
            }
        }
        if constexpr (ALIGN_EPI) { if (wr == 0) PG8_BAR; }
        if constexpr (!Epi::AFTER_DRAIN) { E(acc, cur, wr, wc, fr, fq); S.done(cur); }
        if (!has_next) break;
#pragma unroll
        for (int a = 0; a < 2; ++a)
#pragma unroll
            for (int b = 0; b < 2; ++b)
#pragma unroll
                for (int m = 0; m < 4; ++m)
#pragma unroll
                    for (int n = 0; n < 2; ++n) acc[a][b][m][n] = (f32x4){0.f, 0.f, 0.f, 0.f};
        cur = nxt; cA = nA; cB = nB; ++ui;
        if constexpr (ALIGN_EPI) { if (wr == 1) PG8_BAR; }
    }
    PG8_WAIT_V(0);
    if constexpr (!ALIGN_EPI) { if (wr == 0) PG8_BAR; }
    PG8_BAR;
    if constexpr (Epi::AFTER_DRAIN) { E.fused(acc, cur, wr, wc, fr, fq, lds, wid, lane); S.done(cur); }
#undef PG8_SA
#undef PG8_SB
#undef PG8_STAGE
#undef PG8_LDA
#undef PG8_LDB
#undef PG8_MMA
#undef PG8_WAIT_V
#undef PG8_WAIT_L
#undef PG8_BAR
#undef PG8_SCHED
}

struct UnitM { int pm, pn, sub; };
struct GemmM { const bf16_t* A0; const bf16_t* B0; size_t strideA, strideB; int nt0, dnt2; int lda, ldb;
    __device__ __forceinline__ const bf16_t* a(int s) const { return A0 + (size_t)s * strideA; }
    __device__ __forceinline__ const bf16_t* b(int s) const { return B0 + (size_t)s * strideB; }
    __device__ __forceinline__ int nt(int s) const { return nt0 + (s >> 1) * dnt2; } };
struct StaticOrder3 {
    StaticOrder S;
    __device__ void init(int M, int N, int G_, int c_) { S.init(M, N, G_, c_); }
    __device__ bool next(int i, UnitM& u) const { Unit t; if (!S.next(i / 3, t)) return false; u.pm = t.pm; u.pn = t.pn; u.sub = i - 3 * (i / 3); return true; }
    __device__ __forceinline__ void a_ready(const UnitM&) const {}
    __device__ __forceinline__ void done(const UnitM&) const {}
};
template <class Epi, class Sched, bool ALIGN_EPI = false, bool SP2 = false>
__device__ __forceinline__ void gemm_phase_m(PG8_LAS unsigned char* lds, const GemmM g, const Sched& S, const Epi& E) {
    int tid_ = threadIdx.x; asm volatile("" : "+v"(tid_));
    const int tid = tid_, wid = __builtin_amdgcn_readfirstlane(tid >> 6), lane = tid & 63, wr = wid >> 2, wc = wid & 3, fr = lane & 15, fq = lane >> 4;
    int lda_ = g.lda, ldb_ = g.ldb; asm volatile("" : "+s"(lda_), "+s"(ldb_)); const int lda = lda_, ldb = ldb_; int nt;
    unsigned voffA[2], voffB[2];
#pragma unroll
    for (int i = 0; i < 2; ++i) { int R, C; stage_rc(tid * 16 + i * 8192, R, C); const int Rb = Epi::PERM ? ((R & ~31) + perm32(R & 31)) : R;
        voffA[i] = (unsigned)(R * lda + C) * 2u; voffB[i] = (unsigned)(Rb * ldb + C) * 2u; }
    const size_t kstep = (size_t)(BK * 2);
    const size_t hstepA = (size_t)HALF * lda * 2, hstepB = (size_t)HALF * ldb * 2;
    const size_t tstepA = 2 * hstepA, tstepB = 2 * hstepB;
    const unsigned ldsw = (unsigned)wid * 1024u;
    const int aoff = lds_byte(wr * 64 + fr, fq * 8), boff = lds_byte(wc * 32 + fr, fq * 8);
#define PG8_SA(b, h) (((b) * 2 + (h)) * HTB)
#define PG8_SB(b, h) ((4 + (b) * 2 + (h)) * HTB)
#define PG8_STAGE(bufoff, gbase, voff) do { _Pragma("unroll") for (int _i = 0; _i < 2; ++_i) \
        __builtin_amdgcn_global_load_lds((const unsigned*)((const char*)(gbase) + (voff)[_i]), (PG8_LAS unsigned*)(lds + (bufoff) + ldsw + _i * 8192), 16, 0, 0); } while (0)
#define PG8_LDA(dst, b, h) do { _Pragma("unroll") for (int m = 0; m < 4; ++m) _Pragma("unroll") for (int k = 0; k < 2; ++k) dst[m][k] = *(const PG8_LAS bf16x8*)(lds + PG8_SA(b, h) + aoff + m * 2048 + k * 1024); } while (0)
#define PG8_LDB(dst, b, h) do { _Pragma("unroll") for (int n = 0; n < 2; ++n) _Pragma("unroll") for (int k = 0; k < 2; ++k) dst[n][k] = *(const PG8_LAS bf16x8*)(lds + PG8_SB(b, h) + boff + n * 2048 + k * 1024); } while (0)
#define PG8_MMA(ai, bj, At, Bt) do { __builtin_amdgcn_s_setprio(1); _Pragma("unroll") for (int m = 0; m < 4; ++m) _Pragma("unroll") for (int n = 0; n < 2; ++n) _Pragma("unroll") for (int k = 0; k < 2; ++k) \
        acc[ai][bj][m][n] = __builtin_amdgcn_mfma_f32_16x16x32_bf16(Bt[n][k], At[m][k], acc[ai][bj][m][n], 0, 0, 0); __builtin_amdgcn_s_setprio(0); } while (0)
#define PG8_WAIT_V(n) asm volatile("s_waitcnt vmcnt(" #n ")" ::: "memory")
#define PG8_WAIT_L(n) asm volatile("s_waitcnt lgkmcnt(" #n ")" ::: "memory")
#define PG8_BAR __builtin_amdgcn_s_barrier()
#define PG8_SCHED __builtin_amdgcn_sched_barrier(0)
    UnitM cur, nxt; int ui = 0;
    if (!S.next(0, cur)) return;
    f32x4 acc[2][2][4][2];
#pragma unroll
    for (int a = 0; a < 2; ++a)
#pragma unroll
        for (int b = 0; b < 2; ++b)
#pragma unroll
            for (int m = 0; m < 4; ++m)
#pragma unroll
                for (int n = 0; n < 2; ++n) acc[a][b][m][n] = (f32x4){0.f, 0.f, 0.f, 0.f};
    bf16x8 At[4][2], B0[2][2], B1[2][2];
    const char* cA = (const char*)g.a(cur.sub) + (size_t)cur.pm * tstepA; const char* cB = (const char*)g.b(cur.sub) + (size_t)cur.pn * tstepB; nt = g.nt(cur.sub);
    S.a_ready(cur);
    if constexpr (SP2) {
        PG8_STAGE(PG8_SB(0, 0), cB, voffB); PG8_STAGE(PG8_SB(0, 1), cB + hstepB, voffB); PG8_STAGE(PG8_SA(0, 0), cA, voffA); PG8_STAGE(PG8_SA(0, 1), cA + hstepA, voffA);
        if (wr == 1) PG8_BAR;
        PG8_WAIT_V(2); PG8_BAR;
        PG8_STAGE(PG8_SB(1, 0), cB + kstep, voffB); PG8_STAGE(PG8_SA(1, 0), cA + kstep, voffA); PG8_STAGE(PG8_SB(1, 1), cB + hstepB + kstep, voffB);
        PG8_WAIT_V(6); PG8_BAR;
    } else {
        PG8_STAGE(PG8_SB(0, 0), cB, voffB); PG8_STAGE(PG8_SA(0, 0), cA, voffA); PG8_STAGE(PG8_SB(0, 1), cB + hstepB, voffB); PG8_STAGE(PG8_SA(0, 1), cA + hstepA, voffA);
        if (wr == 1) PG8_BAR;
        PG8_WAIT_V(4); PG8_BAR;
        PG8_STAGE(PG8_SB(1, 0), cB + kstep, voffB); PG8_STAGE(PG8_SA(1, 0), cA + kstep, voffA); PG8_STAGE(PG8_SB(1, 1), cB + hstepB + kstep, voffB);
        PG8_WAIT_V(6); PG8_BAR;
    }
    for (;;) {
        const bool has_next = S.next(ui + 1, nxt);
        const char* nA = has_next ? (const char*)g.a(nxt.sub) + (size_t)nxt.pm * tstepA : cA; const char* nB = has_next ? (const char*)g.b(nxt.sub) + (size_t)nxt.pn * tstepB : cB;
        for (int t = 0; t < nt; t += 2) {
            const bool last = (t == nt - 2);
            const char* a1 = cA + (size_t)(t + 1) * kstep;
            const char* a2 = last ? nA : cA + (size_t)(t + 2) * kstep; const char* b2 = last ? nB : cB + (size_t)(t + 2) * kstep;
            const char* a3 = a2 + kstep; const char* b3 = b2 + kstep;
            if (last && has_next) S.a_ready(nxt);
            if constexpr (SP2) {
            PG8_LDB(B0, 0, 0); PG8_LDB(B1, 0, 1); PG8_SCHED; PG8_LDA(At, 0, 0); PG8_STAGE(PG8_SA(1, 1), a1 + hstepA, voffA);
            PG8_WAIT_V(8); PG8_WAIT_L(0); PG8_BAR; PG8_MMA(0, 0, At, B0); PG8_MMA(0, 1, At, B1); PG8_BAR; PG8_SCHED;
            PG8_LDA(At, 0, 1); PG8_STAGE(PG8_SB(0, 0), b2, voffB); PG8_STAGE(PG8_SB(0, 1), b2 + hstepB, voffB); PG8_STAGE(PG8_SA(0, 0), a2, voffA);
            PG8_WAIT_V(8); PG8_WAIT_L(0); PG8_BAR; PG8_MMA(1, 0, At, B0); PG8_MMA(1, 1, At, B1); PG8_BAR; PG8_SCHED;
            PG8_LDB(B0, 1, 0); PG8_LDB(B1, 1, 1); PG8_SCHED; PG8_LDA(At, 1, 0); PG8_STAGE(PG8_SA(0, 1), a2 + hstepA, voffA);
            PG8_WAIT_V(8); PG8_WAIT_L(0); PG8_BAR; PG8_MMA(0, 0, At, B0); PG8_MMA(0, 1, At, B1); PG8_BAR; PG8_SCHED;
            PG8_LDA(At, 1, 1); PG8_STAGE(PG8_SB(1, 0), b3, voffB); PG8_STAGE(PG8_SB(1, 1), b3 + hstepB, voffB); PG8_STAGE(PG8_SA(1, 0), a3, voffA);
            PG8_WAIT_V(8); PG8_WAIT_L(0); PG8_BAR; PG8_MMA(1, 0, At, B0); PG8_MMA(1, 1, At, B1); PG8_BAR; PG8_SCHED;
            } else {
            PG8_LDB(B0, 0, 0); PG8_SCHED; PG8_LDA(At, 0, 0); PG8_STAGE(PG8_SA(1, 1), a1 + hstepA, voffA);
            PG8_WAIT_L(8); PG8_BAR; PG8_WAIT_L(0); PG8_MMA(0, 0, At, B0); PG8_BAR; PG8_SCHED;
            PG8_LDB(B1, 0, 1); PG8_STAGE(PG8_SB(0, 0), b2, voffB);
            PG8_BAR; PG8_WAIT_L(0); PG8_MMA(0, 1, At, B1); PG8_BAR;
            PG8_LDA(At, 0, 1); PG8_STAGE(PG8_SA(0, 0), a2, voffA);
            PG8_BAR; PG8_WAIT_L(0); PG8_MMA(1, 0, At, B0); PG8_BAR; PG8_SCHED;
            PG8_STAGE(PG8_SB(0, 1), b2 + hstepB, voffB);
            PG8_WAIT_V(6); PG8_BAR; PG8_MMA(1, 1, At, B1); PG8_BAR;
            PG8_LDB(B0, 1, 0); PG8_SCHED; PG8_LDA(At, 1, 0); PG8_STAGE(PG8_SA(0, 1), a2 + hstepA, voffA);
            PG8_WAIT_L(8); PG8_BAR; PG8_WAIT_L(0); PG8_MMA(0, 0, At, B0); PG8_BAR; PG8_SCHED;
            PG8_LDB(B1, 1, 1); PG8_STAGE(PG8_SB(1, 0), b3, voffB);
            PG8_BAR; PG8_WAIT_L(0); PG8_MMA(0, 1, At, B1); PG8_BAR;
            PG8_LDA(At, 1, 1); PG8_STAGE(PG8_SA(1, 0), a3, voffA);
            PG8_BAR; PG8_WAIT_L(0); PG8_MMA(1, 0, At, B0); PG8_BAR; PG8_SCHED;
            PG8_STAGE(PG8_SB(1, 1), b3 + hstepB, voffB);
            PG8_WAIT_V(6); PG8_BAR; PG8_MMA(1, 1, At, B1); PG8_BAR;
            }
        }
        if constexpr (ALIGN_EPI) { if (wr == 0) PG8_BAR; }
        if constexpr (!Epi::AFTER_DRAIN) { E(acc, cur, wr, wc, fr, fq); S.done(cur); }
        if (!has_next) break;
        if (nxt.sub == 0) {
#pragma unroll
        for (int a = 0; a < 2; ++a)
#pragma unroll
            for (int b = 0; b < 2; ++b)
#pragma unroll
                for (int m = 0; m < 4; ++m)
#pragma unroll
                    for (int n = 0; n < 2; ++n) acc[a][b][m][n] = (f32x4){0.f, 0.f, 0.f, 0.f}; }
        cur = nxt; cA = nA; cB = nB; ++ui; nt = g.nt(cur.sub);
        if constexpr (ALIGN_EPI) { if (wr == 1) PG8_BAR; }
    }
    PG8_WAIT_V(0);
    if constexpr (!ALIGN_EPI) { if (wr == 0) PG8_BAR; }
    PG8_BAR;
    if constexpr (Epi::AFTER_DRAIN) { E.fused(acc, cur, wr, wc, fr, fq, lds, wid, lane); S.done(cur); }
#undef PG8_SA
#undef PG8_SB
#undef PG8_STAGE
#undef PG8_LDA
#undef PG8_LDB
#undef PG8_MMA
#undef PG8_WAIT_V
#undef PG8_WAIT_L
#undef PG8_BAR
#undef PG8_SCHED
}
}

namespace pg8 {
typedef float f32x2 __attribute__((ext_vector_type(2)));
__device__ __forceinline__ unsigned cvt_pk_bf16(float lo, float hi) { unsigned r; asm volatile("v_cvt_pk_bf16_f32 %0, %1, %2" : "=v"(r) : "v"(lo), "v"(hi)); return r; }
__device__ __forceinline__ void store8(bf16_t* p, const f32x4 v0, const f32x4 v1) {
    u32x4 w; w.x = cvt_pk_bf16(v0[0], v0[1]); w.y = cvt_pk_bf16(v0[2], v0[3]); w.z = cvt_pk_bf16(v1[0], v1[1]); w.w = cvt_pk_bf16(v1[2], v1[3]); *(u32x4*)p = w; }
__device__ __forceinline__ float fsigmoid(float x) { return __builtin_amdgcn_rcpf(1.0f + __builtin_amdgcn_exp2f(-1.4426950408889634f * x)); }
__device__ __forceinline__ f32x4 act4(const f32x4 v, const int ACT) {
    if (ACT == 0) return v;
    f32x4 o;
#pragma unroll
    for (int j = 0; j < 4; ++j) { const float s = fsigmoid(v[j]); o[j] = (ACT == 1) ? v[j] * s : s; }
    return o; }
__device__ __forceinline__ void bf8_to_f32(const u32x4 w, f32x4& a, f32x4& b) {
    a[0] = __uint_as_float(w.x << 16); a[1] = __uint_as_float(w.x & 0xffff0000u); a[2] = __uint_as_float(w.y << 16); a[3] = __uint_as_float(w.y & 0xffff0000u);
    b[0] = __uint_as_float(w.z << 16); b[1] = __uint_as_float(w.z & 0xffff0000u); b[2] = __uint_as_float(w.w << 16); b[3] = __uint_as_float(w.w & 0xffff0000u); }

constexpr int SEQ_MASK = 4095;
__device__ __forceinline__ void rope4(const float* tab, const f32x4 a, const f32x4 b, float sc, bf16_t* p1, bf16_t* p2) {
    typedef unsigned u32x2 __attribute__((ext_vector_type(2)));
    const f32x4 t0 = *(const f32x4*)(tab), t1 = *(const f32x4*)(tab + 4);
    const float o10 = (a[0] * t0[0] - b[0] * t0[1]) * sc, o20 = (b[0] * t0[0] + a[0] * t0[1]) * sc;
    const float o11 = (a[1] * t0[2] - b[1] * t0[3]) * sc, o21 = (b[1] * t0[2] + a[1] * t0[3]) * sc;
    const float o12 = (a[2] * t1[0] - b[2] * t1[1]) * sc, o22 = (b[2] * t1[0] + a[2] * t1[1]) * sc;
    const float o13 = (a[3] * t1[2] - b[3] * t1[3]) * sc, o23 = (b[3] * t1[2] + a[3] * t1[3]) * sc;
    u32x2 w1, w2; w1.x = cvt_pk_bf16(o10, o11); w1.y = cvt_pk_bf16(o12, o13); w2.x = cvt_pk_bf16(o20, o21); w2.y = cvt_pk_bf16(o22, o23);
    *(u32x2*)p1 = w1; *(u32x2*)p2 = w2;
}
#define EPI_FENCE() asm volatile("" ::: "memory")

struct EpiInProj {
    static constexpr bool PERM = true, AFTER_DRAIN = false;
    unsigned char* ws; size_t o_fqkv, o_cq, o_ckv, o_kr, o_rq, o_rk, o_rv, o_rg, o_gates, o_ff, o_t128, o_t64; int skip;
    __device__ __forceinline__ void plain(const f32x4 (&acc)[2][2][4][2], bf16_t* dst, int ld, int colbase, int act, int row0, int wc, int fq) const {
        const int col0 = colbase + wc * 32 + 8 * fq;
#pragma unroll
        for (int ai = 0; ai < 2; ++ai)
#pragma unroll
            for (int m = 0; m < 4; ++m) { bf16_t* rowp = dst + (size_t)(row0 + ai * HALF + m * 16) * ld + col0;
#pragma unroll
                for (int bj = 0; bj < 2; ++bj) { f32x4 v0 = acc[ai][bj][m][0], v1 = acc[ai][bj][m][1];
                    if (act) {
#pragma unroll
                        for (int j = 0; j < 4; ++j) { const float s0 = fsigmoid(v0[j]), s1 = fsigmoid(v1[j]); v0[j] = (act == 1) ? v0[j] * s0 : s0; v1[j] = (act == 1) ? v1[j] * s1 : s1; } }
                    if (skip == 2) { u32x4 w; w.x = cvt_pk_bf16(v0[0], v0[1]); w.y = cvt_pk_bf16(v0[2], v0[3]); w.z = cvt_pk_bf16(v1[0], v1[1]); w.w = cvt_pk_bf16(v1[2], v1[3]); asm volatile("" :: "v"(w)); }
                    else store8(rowp + bj * HALF, v0, v1); }
                EPI_FENCE(); }
    }
    __device__ __forceinline__ void rope128(const f32x4 (&acc)[2][2][4][2], bf16_t* dst, int t, float sc, int row0, int wc, int fq) const {
        const int x = 32 * wc + 8 * fq, hh = x >> 6, i0 = x & 63, head = 2 * t + hh; const float* T128 = (const float*)(ws + o_t128);
#pragma unroll
        for (int ai = 0; ai < 2; ++ai)
#pragma unroll
            for (int m = 0; m < 4; ++m) { const int row = row0 + ai * HALF + m * 16, pos = row & SEQ_MASK;
                const float* tp = T128 + ((size_t)pos * 64 + i0) * 2; bf16_t* p = dst + (size_t)row * 512 + 128 * head + i0;
                rope4(tp, acc[ai][0][m][0], acc[ai][1][m][0], sc, p, p + 64); rope4(tp + 8, acc[ai][0][m][1], acc[ai][1][m][1], sc, p + 4, p + 68);
                EPI_FENCE(); }
    }
    __device__ __forceinline__ void misc(const f32x4 (&acc)[2][2][4][2], int row0, int wc, int fq) const {
        if (wc == 0) { const int i0 = 8 * fq; const float* T64 = (const float*)(ws + o_t64); bf16_t* kr = (bf16_t*)(ws + o_kr);
#pragma unroll
            for (int ai = 0; ai < 2; ++ai)
#pragma unroll
                for (int m = 0; m < 4; ++m) { const int row = row0 + ai * HALF + m * 16, pos = row & SEQ_MASK;
                    const float* tp = T64 + ((size_t)pos * 32 + i0) * 2; bf16_t* p = kr + (size_t)row * 64 + i0;
                    rope4(tp, acc[ai][0][m][0], acc[ai][1][m][0], 1.0f, p, p + 32); rope4(tp + 8, acc[ai][0][m][1], acc[ai][1][m][1], 1.0f, p + 4, p + 36);
                    EPI_FENCE(); }
        } else if (wc == 1) { if (fq == 0) { float* ff = (float*)(ws + o_ff);
#pragma unroll
            for (int ai = 0; ai < 2; ++ai)
#pragma unroll
                for (int m = 0; m < 4; ++m) { const int row = row0 + ai * HALF + m * 16; float* p = ff + (size_t)row * 8; *(f32x4*)p = acc[ai][0][m][0]; *(f32x4*)(p + 4) = acc[ai][0][m][1]; } } }
    }
    __device__ __forceinline__ void operator()(const f32x4 (&acc)[2][2][4][2], const Unit& u, int wr, int wc, int fr, int fq) const {
        const int pn = u.pn, row0 = u.pm * BM + wr * 64 + fr;
        if (skip == 1) {
#pragma unroll
            for (int ai = 0; ai < 2; ++ai)
#pragma unroll
                for (int bj = 0; bj < 2; ++bj)
#pragma unroll
                    for (int m = 0; m < 4; ++m) asm volatile("" :: "v"(acc[ai][bj][m][0]), "v"(acc[ai][bj][m][1]));
            return; }
        if (pn == 12) misc(acc, row0, wc, fq);
        else if (pn >= 13 && pn < 17) { const bool isk = pn >= 15; rope128(acc, (bf16_t*)(ws + (isk ? o_rk : o_rq)), isk ? pn - 15 : pn - 13, isk ? 0.08838834764831845f : 1.0f, row0, wc, fq); }
        else { size_t off; int ld, cb, act = 0;
            if (pn < 9) { off = o_fqkv; ld = 2304; cb = 256 * pn; }
            else if (pn < 11) { off = o_cq; ld = 512; cb = 256 * (pn - 9); }
            else if (pn == 11) { off = o_ckv; ld = 256; cb = 0; }
            else if (pn < 21) { off = o_rv; ld = 1024; cb = 256 * (pn - 17); }
            else if (pn < 25) { off = o_rg; ld = 1024; cb = 256 * (pn - 21); act = 1; }
            else { off = o_gates; ld = 6144; cb = 256 * (pn - 25); act = 2; }
            plain(acc, (bf16_t*)(ws + off), ld, cb, act, row0, wc, fq); }
    }
};

struct EpiUq {
    static constexpr bool PERM = true, AFTER_DRAIN = false;
    bf16_t* qm; const float* rstd; const float* T64;
    __device__ __forceinline__ void operator()(const f32x4 (&acc)[2][2][4][2], const Unit& u, int wr, int wc, int fr, int fq) const {
        const int pn = u.pn, row0 = u.pm * BM + wr * 64 + fr;
        float rsv[2][4];
#pragma unroll
        for (int ai = 0; ai < 2; ++ai)
#pragma unroll
            for (int m = 0; m < 4; ++m) rsv[ai][m] = rstd[row0 + ai * HALF + m * 16];
        if (pn < 3) {
#pragma unroll
            for (int ai = 0; ai < 2; ++ai)
#pragma unroll
                for (int m = 0; m < 4; ++m) { const int row = row0 + ai * HALF + m * 16; const float rs = rsv[ai][m];
#pragma unroll
                    for (int bj = 0; bj < 2; ++bj) store8(qm + (size_t)row * 1152 + 192 * (2 * pn + bj) + 32 * wc + 8 * fq, acc[ai][bj][m][0] * rs, acc[ai][bj][m][1] * rs);
                    EPI_FENCE(); }
        } else { const int head = (pn == 3) ? wc : 4 + wc; if (head < 6) { const int i0 = 8 * fq;
#pragma unroll
            for (int ai = 0; ai < 2; ++ai)
#pragma unroll
                for (int m = 0; m < 4; ++m) { const int row = row0 + ai * HALF + m * 16, pos = row & SEQ_MASK; const float rs = rsv[ai][m];
                    const float* tp = T64 + ((size_t)pos * 32 + i0) * 2; bf16_t* p = qm + (size_t)row * 1152 + 192 * head + 128 + i0;
                    rope4(tp, acc[ai][0][m][0], acc[ai][1][m][0], rs, p, p + 32); rope4(tp + 8, acc[ai][0][m][1], acc[ai][1][m][1], rs, p + 4, p + 36);
                    EPI_FENCE(); } } }
    }
};
struct EpiUkv {
    static constexpr bool PERM = true, AFTER_DRAIN = false;
    bf16_t* kvm; const float* rstd;
    __device__ __forceinline__ void operator()(const f32x4 (&acc)[2][2][4][2], const Unit& u, int wr, int wc, int fr, int fq) const {
        const int row0 = u.pm * BM + wr * 64 + fr, col0 = u.pn * BM + wc * 32 + 8 * fq;
        float rsv[2][4];
#pragma unroll
        for (int ai = 0; ai < 2; ++ai)
#pragma unroll
            for (int m = 0; m < 4; ++m) rsv[ai][m] = rstd[row0 + ai * HALF + m * 16];
#pragma unroll
        for (int ai = 0; ai < 2; ++ai)
#pragma unroll
            for (int m = 0; m < 4; ++m) { const int row = row0 + ai * HALF + m * 16; const float rs = rsv[ai][m];
#pragma unroll
                for (int bj = 0; bj < 2; ++bj) store8(kvm + (size_t)row * 1536 + col0 + bj * HALF, acc[ai][bj][m][0] * rs, acc[ai][bj][m][1] * rs);
                EPI_FENCE(); }
    }
};
template <int PASS> struct EpiMerge {
    static constexpr bool PERM = true, AFTER_DRAIN = false;
    const bf16_t* gates; float* tmp; bf16_t* out;
    __device__ __forceinline__ void operator()(const f32x4 (&acc)[2][2][4][2], const Unit& u, int wr, int wc, int fr, int fq) const {
        const int row0 = u.pm * BM + wr * 64 + fr, col0 = u.pn * BM + wc * 32 + 8 * fq;
#pragma unroll
        for (int ai = 0; ai < 2; ++ai)
#pragma unroll
            for (int m = 0; m < 4; ++m) { const int row = row0 + ai * HALF + m * 16;
#pragma unroll
                for (int bj = 0; bj < 2; ++bj) { const int col = col0 + bj * HALF;
                    f32x4 g0, g1; bf8_to_f32(*(const u32x4*)(gates + (size_t)row * 6144 + 2048 * PASS + col), g0, g1);
                    f32x4 v0 = g0 * acc[ai][bj][m][0], v1 = g1 * acc[ai][bj][m][1];
                    float* tp = tmp + (size_t)row * 2048 + col;
                    if (PASS > 0) { v0 += *(const f32x4*)tp; v1 += *(const f32x4*)(tp + 4); }
                    if (PASS < 2) { *(f32x4*)tp = v0; *(f32x4*)(tp + 4) = v1; }
                    else store8(out + (size_t)row * 2048 + col, v0, v1);
                    EPI_FENCE(); } }
    }
};
struct EpiMergeM {
    static constexpr bool PERM = true, AFTER_DRAIN = false;
    const bf16_t* gates; bf16_t* out;
    __device__ __forceinline__ void operator()(f32x4 (&acc)[2][2][4][2], const UnitM& u, int wr, int wc, int fr, int fq) const {
        int t_ = threadIdx.x; asm volatile("" : "+v"(t_)); (void)fr; (void)fq; const int lrow0 = wr * 64 + (t_ & 15), lcol0 = wc * 32 + 8 * ((t_ >> 4) & 3);
        const int sub = u.sub;
#pragma unroll
        for (int ai = 0; ai < 2; ++ai) {
            u32x4 ga[4][2], gb[4][2];
#pragma unroll
            for (int m = 0; m < 4; ++m)
#pragma unroll
                for (int bj = 0; bj < 2; ++bj) { const bf16_t* gp = gates + ((size_t)u.pm * BM + lrow0 + ai * HALF + m * 16) * 6144 + 2048 * sub + u.pn * BM + lcol0 + bj * HALF;
                    ga[m][bj] = *(const u32x4*)gp; if (sub < 2) gb[m][bj] = *(const u32x4*)(gp + 2048); }
#pragma unroll
            for (int m = 0; m < 4; ++m)
#pragma unroll
                for (int bj = 0; bj < 2; ++bj) { f32x4 a0, a1; bf8_to_f32(ga[m][bj], a0, a1);
#pragma unroll
                    for (int j = 0; j < 4; ++j) { a0[j] = fmaxf(a0[j], 1e-30f); a1[j] = fmaxf(a1[j], 1e-30f); }
                    if (sub < 2) { f32x4 b0, b1; bf8_to_f32(gb[m][bj], b0, b1);
#pragma unroll
                        for (int j = 0; j < 4; ++j) { a0[j] *= __builtin_amdgcn_rcpf(fmaxf(b0[j], 1e-30f)); a1[j] *= __builtin_amdgcn_rcpf(fmaxf(b1[j], 1e-30f)); }
                        acc[ai][bj][m][0] *= a0; acc[ai][bj][m][1] *= a1; }
                    else store8(out + ((size_t)u.pm * BM + lrow0 + ai * HALF + m * 16) * 2048 + u.pn * BM + lcol0 + bj * HALF, acc[ai][bj][m][0] * a0, acc[ai][bj][m][1] * a1); }
            EPI_FENCE(); }
    }
};
struct EpiResid {
    static constexpr bool PERM = true, AFTER_DRAIN = false;
    bf16_t* xb;
    __device__ __forceinline__ void operator()(const f32x4 (&acc)[2][2][4][2], const Unit& u, int wr, int wc, int fr, int fq) const {
        int t_ = threadIdx.x; asm volatile("" : "+v"(t_)); (void)fr; (void)fq;
        const int row0 = u.pm * BM + wr * 64 + (t_ & 15), col0 = u.pn * BM + wc * 32 + 8 * ((t_ >> 4) & 3);
#pragma unroll
        for (int ai = 0; ai < 2; ++ai) {
            u32x4 b[4][2];
#pragma unroll
            for (int m = 0; m < 4; ++m)
#pragma unroll
                for (int bj = 0; bj < 2; ++bj) b[m][bj] = *(const u32x4*)(xb + (size_t)(row0 + ai * HALF + m * 16) * 4096 + col0 + bj * HALF);
#pragma unroll
            for (int m = 0; m < 4; ++m)
#pragma unroll
                for (int bj = 0; bj < 2; ++bj) { f32x4 x0, x1; bf8_to_f32(b[m][bj], x0, x1);
                    store8(xb + (size_t)(row0 + ai * HALF + m * 16) * 4096 + col0 + bj * HALF, x0 + acc[ai][bj][m][0], x1 + acc[ai][bj][m][1]); }
            EPI_FENCE(); }
    }
};
__device__ __forceinline__ float gelu_gate(float xc, float g) {
    const float z = xc * __builtin_fmaf(0.044715f * xc, xc, 1.0f);
    return xc * __builtin_amdgcn_rcpf(1.0f + __builtin_amdgcn_exp2f(-2.3022081985378545f * z)) * g;
}
template <int CTRL> __device__ __forceinline__ float dpp_f(float old, float src) {
    return __builtin_bit_cast(float, __builtin_amdgcn_update_dpp(__builtin_bit_cast(int, old), __builtin_bit_cast(int, src), CTRL, 0xf, 0xf, false)); }
struct EpiConvAct {
    static constexpr bool PERM = true, AFTER_DRAIN = false;
    bf16_t* act; float* utail; float* uhead; float* ghead; const float* cw; const float* cb; PG8_LAS float* xbuf;
    __device__ __forceinline__ void operator()(const f32x4 (&acc)[2][2][4][2], const Unit& u, int wr_, int wc_, int fr_, int fq_) const {
        int t_ = threadIdx.x; asm volatile("" : "+v"(t_)); const int fr = t_ & 15, fq = (t_ >> 4) & 3, wr = wr_, wc = wc_; (void)fr_; (void)fq_;
        const int lc = 32 * wc + 8 * fq, f0 = u.pn * HALF + lc;
        if (fr >= 14) {
#pragma unroll
            for (int ai = 0; ai < 2; ++ai) { PG8_LAS float* xp = xbuf + ((2 * ai + wr) * 2 + (fr - 14)) * 128 + lc; *(PG8_LAS f32x4*)xp = acc[ai][0][3][0]; *(PG8_LAS f32x4*)(xp + 4) = acc[ai][0][3][1]; }
            if (wr == 1) { float* tp = utail + ((size_t)u.pm * 2 + (fr - 14)) * 5632 + f0; *(f32x4*)tp = acc[1][0][3][0]; *(f32x4*)(tp + 4) = acc[1][0][3][1]; } }
        if (fr < 2 && wr == 0) { const size_t o = ((size_t)u.pm * 2 + fr) * 5632 + f0;
            *(f32x4*)(uhead + o) = acc[0][0][0][0]; *(f32x4*)(uhead + o + 4) = acc[0][0][0][1]; *(f32x4*)(ghead + o) = acc[0][1][0][0]; *(f32x4*)(ghead + o + 4) = acc[0][1][0][1]; }
        asm volatile("s_waitcnt lgkmcnt(0)" ::: "memory"); __builtin_amdgcn_s_barrier(); asm volatile("" ::: "memory");
        float w0[8], w1[8], w2[8], bb[8];
#pragma unroll
        for (int h = 0; h < 2; ++h) { const f32x4 a = *(const f32x4*)(cw + f0 + 4 * h), b = *(const f32x4*)(cw + 5632 + f0 + 4 * h), c = *(const f32x4*)(cw + 2 * 5632 + f0 + 4 * h), d = *(const f32x4*)(cb + f0 + 4 * h);
#pragma unroll
            for (int j = 0; j < 4; ++j) { w0[4 * h + j] = a[j]; w1[4 * h + j] = b[j]; w2[4 * h + j] = c[j]; bb[4 * h + j] = d[j]; } }
        const int row0 = u.pm * BM + wr * 64 + fr;
#pragma unroll
        for (int ai = 0; ai < 2; ++ai) {
            f32x4 t0a = {0.f, 0.f, 0.f, 0.f}, t0b = t0a, t1a = t0a, t1b = t0a;
            if (2 * ai + wr > 0) { const PG8_LAS float* xp = xbuf + ((2 * ai + wr - 1) * 2) * 128 + lc; t0a = *(const PG8_LAS f32x4*)xp; t0b = *(const PG8_LAS f32x4*)(xp + 4); t1a = *(const PG8_LAS f32x4*)(xp + 128); t1b = *(const PG8_LAS f32x4*)(xp + 132); }
#pragma unroll
            for (int m = 0; m < 4; ++m) { f32x4 o0, o1;
#pragma unroll
                for (int n = 0; n < 2; ++n)
#pragma unroll
                    for (int j = 0; j < 4; ++j) { const int k = 4 * n + j; const float cur = acc[ai][0][m][n][j];
                        float a1, a2;
                        if (m == 0) { const float T0 = n ? t0b[j] : t0a[j], T1 = n ? t1b[j] : t1a[j]; a1 = T1; a2 = (fr == 0) ? T0 : T1; }
                        else { const float pv = acc[ai][0][m - 1][n][j]; a1 = dpp_f<0x10F>(pv, pv); a2 = dpp_f<0x10E>(pv, pv); }
                        const float s1 = dpp_f<0x111>(a1, cur), s2 = dpp_f<0x112>(a2, cur);
                        const float xc = __builtin_fmaf(w2[k], cur, __builtin_fmaf(w1[k], s1, __builtin_fmaf(w0[k], s2, bb[k])));
                        const float r = gelu_gate(xc, acc[ai][1][m][n][j]);
                        if (n == 0) o0[j] = r; else o1[j] = r; }
                store8(act + (size_t)(row0 + ai * HALF + m * 16) * 5632 + f0, o0, o1);
                EPI_FENCE(); } }
    }
};
}

namespace att {
#define ATT_LAS __attribute__((address_space(3)))
typedef unsigned short bf16_t;
typedef short bf16x8 __attribute__((ext_vector_type(8)));
typedef short s16x4 __attribute__((ext_vector_type(4)));
typedef float f32x16 __attribute__((ext_vector_type(16)));
typedef float f32x4 __attribute__((ext_vector_type(4)));
typedef unsigned u32x4 __attribute__((ext_vector_type(4)));
typedef unsigned u32x2 __attribute__((ext_vector_type(2)));
constexpr int SHM_T = 16384;
#define KSWZ(row, colB) ((row) * 256 + ((colB) ^ (((row) & 15) << 4)))
#define KSWZ64(row, colB) ((row) * 128 + ((colB) ^ ((((row) >> 1) & 7) << 4)))
#define SBAR() __builtin_amdgcn_sched_barrier(0)
__device__ __forceinline__ int v_st(int k, int c) { const int kk = (k & ~0xC) | ((k & 4) << 1) | ((k & 8) >> 1); return ((kk >> 3) * 4 + (c >> 5)) * 512 + ((kk & 7) * 32 + (c & 31)) * 2; }
__device__ __forceinline__ int v_rd_base(int lane) { return ((lane & 3) << 3) | (((lane >> 2) & 3) << 6) | (((lane >> 4) & 1) << 5) | (((lane >> 5) & 1) << 8); }
constexpr int v_rd_off(int d0, int ks, int half) { return d0 * 512 + ks * 4096 + half * 2048; }
__device__ __forceinline__ unsigned cvtpk(float lo, float hi) { unsigned r; asm volatile("v_cvt_pk_bf16_f32 %0, %1, %2" : "=v"(r) : "v"(lo), "v"(hi)); return r; }

template <bool ROPE>
__device__ __forceinline__ void qkt(f32x16& p0, f32x16& p1, const ATT_LAS char* Kt, const ATT_LAS char* Kr, int r32, int hi, const bf16x8* qr) {
    p0 = f32x16{}; p1 = f32x16{};
#pragma unroll
    for (int d0 = 0; d0 < 8; ++d0) { const ATT_LAS char* a = Kt + KSWZ(r32, (d0 * 16 + hi * 8) * 2);
        const bf16x8 b0 = *(const ATT_LAS bf16x8*)a, b1 = *(const ATT_LAS bf16x8*)(a + 32 * 256);
        p0 = __builtin_amdgcn_mfma_f32_32x32x16_bf16(b0, qr[d0], p0, 0, 0, 0);
        p1 = __builtin_amdgcn_mfma_f32_32x32x16_bf16(b1, qr[d0], p1, 0, 0, 0); }
    if (ROPE) {
#pragma unroll
        for (int d0 = 0; d0 < 4; ++d0) { const ATT_LAS char* a = Kr + KSWZ64(r32, (d0 * 16 + hi * 8) * 2);
            const bf16x8 b0 = *(const ATT_LAS bf16x8*)a, b1 = *(const ATT_LAS bf16x8*)(a + 32 * 128);
            p0 = __builtin_amdgcn_mfma_f32_32x32x16_bf16(b0, qr[8 + d0], p0, 0, 0, 0);
            p1 = __builtin_amdgcn_mfma_f32_32x32x16_bf16(b1, qr[8 + d0], p1, 0, 0, 0); } }
}
__device__ __forceinline__ void pv_tile_T(f32x16* o, int vb, bf16x8 pa0, bf16x8 pa1, bf16x8 pa2, bf16x8 pa3) {
#define TRRD(dst, off) asm volatile("ds_read_b64_tr_b16 %0, %1 offset:%2" : "=&v"(dst) : "v"(vb), "i"(off) : "memory")
#define PV_D0(d0) do { s16x4 l0, l1, l2, l3, h0, h1, h2, h3; constexpr int b_ = v_rd_off(d0, 0, 0); \
        TRRD(l0, b_); TRRD(h0, b_ + 2048); TRRD(l1, b_ + 4096); TRRD(h1, b_ + 6144); TRRD(l2, b_ + 8192); TRRD(h2, b_ + 10240); TRRD(l3, b_ + 12288); TRRD(h3, b_ + 14336); \
        asm volatile("s_waitcnt lgkmcnt(0)" ::: "memory"); SBAR(); \
        o[d0] = __builtin_amdgcn_mfma_f32_32x32x16_bf16((bf16x8){l0[0], l0[1], l0[2], l0[3], h0[0], h0[1], h0[2], h0[3]}, pa0, o[d0], 0, 0, 0); \
        o[d0] = __builtin_amdgcn_mfma_f32_32x32x16_bf16((bf16x8){l1[0], l1[1], l1[2], l1[3], h1[0], h1[1], h1[2], h1[3]}, pa1, o[d0], 0, 0, 0); \
        o[d0] = __builtin_amdgcn_mfma_f32_32x32x16_bf16((bf16x8){l2[0], l2[1], l2[2], l2[3], h2[0], h2[1], h2[2], h2[3]}, pa2, o[d0], 0, 0, 0); \
        o[d0] = __builtin_amdgcn_mfma_f32_32x32x16_bf16((bf16x8){l3[0], l3[1], l3[2], l3[3], h3[0], h3[1], h3[2], h3[3]}, pa3, o[d0], 0, 0, 0); } while (0)
    PV_D0(0); PV_D0(1); PV_D0(2); PV_D0(3);
#undef PV_D0
#undef TRRD
}
__device__ __forceinline__ void pack_p(const f32x16& p0, const f32x16& p1, bf16x8& pa0, bf16x8& pa1, bf16x8& pa2, bf16x8& pa3) {
#define PK4(P, B_, OUT) do { unsigned a0 = cvtpk(P[B_+0], P[B_+1]), a1 = cvtpk(P[B_+2], P[B_+3]); \
        unsigned b0 = cvtpk(P[B_+4], P[B_+5]), b1 = cvtpk(P[B_+6], P[B_+7]); \
        auto r0 = __builtin_amdgcn_permlane32_swap(a0, b0, false, false); auto r1 = __builtin_amdgcn_permlane32_swap(a1, b1, false, false); \
        u32x4 w = {r0[0], r1[0], r0[1], r1[1]}; OUT = *reinterpret_cast<bf16x8*>(&w); } while (0)
    PK4(p0, 0, pa0); PK4(p0, 8, pa1); PK4(p1, 0, pa2); PK4(p1, 8, pa3);
#undef PK4
}
__device__ __forceinline__ float swap_max(float v) { auto rr = __builtin_amdgcn_permlane32_swap(__float_as_uint(v), __float_as_uint(v), false, false); return fmaxf(__uint_as_float(rr[0]), __uint_as_float(rr[1])); }
__device__ __forceinline__ float swap_sum(float v) { auto rr = __builtin_amdgcn_permlane32_swap(__float_as_uint(v), __float_as_uint(v), false, false); return __uint_as_float(rr[0]) + __uint_as_float(rr[1]); }

__device__ __forceinline__ void store_pair16(bf16_t* row_pair_base  , u32x2 a, u32x2 b) {
    auto rx = __builtin_amdgcn_permlane32_swap(a.x, b.x, false, false); auto ry = __builtin_amdgcn_permlane32_swap(a.y, b.y, false, false);
    const u32x4 w = {rx[0], ry[0], rx[1], ry[1]}; *(u32x4*)row_pair_base = w; }
struct UnitPtrs {
    const bf16_t* Q; int ldq;
    const bf16_t* K; int ldk;
    const bf16_t* V; int ldv;
    const bf16_t* KR;
    const float* bias;
    const bf16_t* G;
    bf16_t* O; int ldo;
    int P0;
    float c2;
    const bf16_t* ST;
    int T0;
};
template <int MODE>
__device__ __forceinline__ void mixer_unit(const UnitPtrs& U, ATT_LAS char* lds, unsigned* qhead, volatile ATT_LAS unsigned* slot) {
    constexpr bool ROPE = (MODE == 1);
    constexpr int NQ = ROPE ? 12 : 8;
    constexpr int K_OFF = 0, KR_OFF = 32768, V_OFF = (MODE == 1) ? 49152 : 32768, V_SZ = (MODE == 2) ? 32768 : 16384, BIAS_OFF = 65536, SCR_OFF = 98304;
    int tid_ = threadIdx.x; asm volatile("" : "+v"(tid_));
    const int tid = tid_, wid = __builtin_amdgcn_readfirstlane(tid >> 6), lane = tid & 63, r32 = lane & 31, hi = lane >> 5;
    const int rg = (MODE == 2) ? (wid >> 1) : wid;
    const int vhalf = (MODE == 2) ? (wid & 1) : 0;
    const int qlo = U.P0 + 32 * rg;
    const int tbase = (MODE == 2) ? (U.T0 >> 6) : 0;
    const int NT = (U.P0 + ((MODE == 2) ? 128 : 256)) / 64 - tbase;
    const int tlast = (qlo >> 6) - tbase;
    bf16x8 qr[NQ];
    { const bf16_t* qp = U.Q + (size_t)(32 * rg + r32) * U.ldq + hi * 8;
#pragma unroll
      for (int d0 = 0; d0 < NQ; ++d0) qr[d0] = *(const bf16x8*)(qp + d0 * 16); }
    const int sr = tid >> 4, sc = (tid & 15) * 8;
    const int kws = KSWZ(sr, sc * 2), vst0 = v_st(sr, sc), vst1 = v_st(32 + sr, sc);
    const int rr = tid >> 3, rc = (tid & 7) * 8, krs = KSWZ64(rr, rc * 2);
    const int vbase = (int)(unsigned)(uintptr_t)(lds + V_OFF) + v_rd_base(lane) + vhalf * SHM_T;
    bf16x8 st_k0, st_k1, st_v0, st_v1, st_v2, st_v3, st_r;
#define ST_LOAD(kb_) do { const bf16_t* kp_ = U.K + (size_t)((kb_) + sr) * U.ldk + sc; st_k0 = *(const bf16x8*)kp_; st_k1 = *(const bf16x8*)(kp_ + (size_t)32 * U.ldk); \
        const bf16_t* vp_ = U.V + (size_t)((kb_) + sr) * U.ldv + sc; st_v0 = *(const bf16x8*)vp_; st_v1 = *(const bf16x8*)(vp_ + (size_t)32 * U.ldv); \
        if (MODE == 2) { st_v2 = *(const bf16x8*)(vp_ + 128); st_v3 = *(const bf16x8*)(vp_ + (size_t)32 * U.ldv + 128); } \
        if (MODE == 1) { st_r = *(const bf16x8*)(U.KR + (size_t)((kb_) + rr) * 64 + rc); } } while (0)
#define ST_WRITE(bf) do { ATT_LAS char* kd_ = lds + K_OFF + (bf) * SHM_T; *(ATT_LAS bf16x8*)(kd_ + kws) = st_k0; *(ATT_LAS bf16x8*)(kd_ + kws + 32 * 256) = st_k1; \
        ATT_LAS char* vd_ = lds + V_OFF + (bf) * V_SZ; *(ATT_LAS bf16x8*)(vd_ + vst0) = st_v0; *(ATT_LAS bf16x8*)(vd_ + vst1) = st_v1; \
        if (MODE == 2) { *(ATT_LAS bf16x8*)(vd_ + SHM_T + vst0) = st_v2; *(ATT_LAS bf16x8*)(vd_ + SHM_T + vst1) = st_v3; } \
        if (MODE == 1) { *(ATT_LAS bf16x8*)(lds + KR_OFF + (bf) * 8192 + krs) = st_r; } } while (0)
    float m_reg = -1e30f, l_reg = 0.f; f32x16 o[4] = {};
    float colf[(MODE == 2) ? 32 : 1];
    if (MODE == 2) {
#pragma unroll
        for (int r = 0; r < 16; ++r) { const int c = (r & 3) + 8 * (r >> 2); colf[r] = __builtin_amdgcn_exp2f(-U.c2 * (float)c); colf[16 + r] = __builtin_amdgcn_exp2f(-U.c2 * (float)(c + 32)); } }
    const int qpos = qlo + r32;
#define TIDX(t) ((MODE == 0) ? (NT - 1 - (t)) : (t))
    ST_LOAD((tbase + TIDX(0)) * 64);
    if (MODE == 0) { const int nk = U.P0 + 256; ATT_LAS float* bl = (ATT_LAS float*)(lds + BIAS_OFF); for (int i = tid; i < nk; i += 512) bl[i] = -U.bias[i]; }
    ST_WRITE(0);
    __syncthreads();
    if (MODE == 2) { if (U.ST) {
        const bf16_t* sp = U.ST + (size_t)(vhalf * 128 + r32) * 128 + hi * 8;
        bf16x8 sa[4][8];
#pragma unroll
        for (int d0 = 0; d0 < 4; ++d0)
#pragma unroll
            for (int ks = 0; ks < 8; ++ks) sa[d0][ks] = *(const bf16x8*)(sp + (size_t)d0 * 32 * 128 + ks * 16);
#pragma unroll
        for (int d0 = 0; d0 < 4; ++d0)
#pragma unroll
            for (int ks = 0; ks < 8; ++ks) o[d0] = __builtin_amdgcn_mfma_f32_32x32x16_bf16(sa[d0][ks], qr[ks], o[d0], 0, 0, 0);
        const float rf = __builtin_amdgcn_exp2f(U.c2 * (float)(qpos - U.T0 + 1));
#pragma unroll
        for (int d0 = 0; d0 < 4; ++d0)
#pragma unroll
            for (int r = 0; r < 16; ++r) o[d0][r] *= rf; } }
#define STEP(t, B) do { const int t_ = TIDX(t); const bool more_ = ((t) + 1 < NT); \
        if (more_) ST_LOAD((tbase + TIDX((t) + 1)) * 64); \
        if (t_ <= tlast) { f32x16 p0, p1; bf16x8 pa0, pa1, pa2, pa3; \
            qkt<ROPE>(p0, p1, lds + K_OFF + (B) * SHM_T, lds + KR_OFF + (B) * 8192, r32, hi, qr); \
            const int dq = qpos - (tbase + t_) * 64 - 4 * hi; \
            if (MODE == 2) { \
                if (t_ < tlast) { const float rowf = __builtin_amdgcn_exp2f(U.c2 * (float)dq);     \
                    _Pragma("unroll") for (int r = 0; r < 16; ++r) { p0[r] *= rowf * colf[r]; p1[r] *= rowf * colf[16 + r]; } \
                } else { \
                    _Pragma("unroll") for (int r = 0; r < 16; ++r) { const int c = (r & 3) + 8 * (r >> 2); \
                        p0[r] *= __builtin_amdgcn_exp2f(U.c2 * fabsf((float)(dq - c))); p1[r] *= __builtin_amdgcn_exp2f(U.c2 * fabsf((float)(dq - c - 32))); } } \
            } else { \
                if (MODE == 0) { const ATT_LAS float* bl = (const ATT_LAS float*)(lds + BIAS_OFF) + t_ * 64 + 4 * hi; \
                    _Pragma("unroll") for (int g = 0; g < 4; ++g) { const f32x4 b0 = *(const ATT_LAS f32x4*)(bl + 8 * g), b1 = *(const ATT_LAS f32x4*)(bl + 32 + 8 * g); \
                        _Pragma("unroll") for (int j = 0; j < 4; ++j) { p0[4 * g + j] = fmaf(p0[4 * g + j], U.c2, b0[j]); p1[4 * g + j] = fmaf(p1[4 * g + j], U.c2, b1[j]); } } \
                    if (t_ == tlast) { const float NEG = -__builtin_inff(); \
                        _Pragma("unroll") for (int r = 0; r < 16; ++r) { const int c = (r & 3) + 8 * (r >> 2); if (dq - c < 0) p0[r] = NEG; if (dq - c - 32 < 0) p1[r] = NEG; } } \
                } else { _Pragma("unroll") for (int r = 0; r < 16; ++r) { p0[r] *= U.c2; p1[r] *= U.c2; } } \
                float pmax = p0[0]; \
                _Pragma("unroll") for (int r = 1; r < 16; ++r) pmax = fmaxf(pmax, p0[r]); \
                _Pragma("unroll") for (int r = 0; r < 16; ++r) pmax = fmaxf(pmax, p1[r]); \
                pmax = swap_max(pmax); \
                if (__any(pmax > m_reg + ((MODE == 1) ? 8.0f : 0.0f))) { const float mn = fmaxf(m_reg, pmax), alpha = __builtin_amdgcn_exp2f(m_reg - mn); m_reg = mn; l_reg *= alpha; \
                    _Pragma("unroll") for (int d_ = 0; d_ < 4; ++d_) _Pragma("unroll") for (int r = 0; r < 16; ++r) o[d_][r] *= alpha; } \
                float ps = 0.f; \
                _Pragma("unroll") for (int r = 0; r < 16; ++r) { p0[r] = __builtin_amdgcn_exp2f(p0[r] - m_reg); p1[r] = __builtin_amdgcn_exp2f(p1[r] - m_reg); ps += p0[r] + p1[r]; } \
                ps = swap_sum(ps); l_reg += ps; \
            } \
            pack_p(p0, p1, pa0, pa1, pa2, pa3); \
            pv_tile_T(o, vbase + (B) * V_SZ, pa0, pa1, pa2, pa3); } \
        if (more_) ST_WRITE((B) ^ 1); \
        __syncthreads(); } while (0)
    for (int t = 0; t < NT; t += 2) { STEP(t, 0); STEP(t + 1, 1); }
#undef STEP
#undef TIDX
#undef ST_LOAD
#undef ST_WRITE
    unsigned tk = 0u; if (tid == 0) tk = __hip_atomic_fetch_add(qhead, 1u, __ATOMIC_RELAXED, __HIP_MEMORY_SCOPE_AGENT);
    bf16_t* orow = U.O + (size_t)(32 * rg + r32) * U.ldo + vhalf * 128 + 8 * hi;
    if (MODE == 2) {
        float ss = 0.f;
#pragma unroll
        for (int d0 = 0; d0 < 4; ++d0)
#pragma unroll
            for (int r = 0; r < 16; ++r) ss += o[d0][r] * o[d0][r];
        ss = swap_sum(ss);
        ATT_LAS float* scr = (ATT_LAS float*)(lds + SCR_OFF);
        if (hi == 0) scr[wid * 32 + r32] = ss;
        __syncthreads();
        const float tot = ss + scr[(wid ^ 1) * 32 + r32];
        const float rstd = __builtin_amdgcn_rsqf(tot * (1.0f / 256.0f) + 1e-6f);
        const bf16_t* grow = U.G + (size_t)(32 * rg + r32) * 1024 + vhalf * 128 + 4 * hi;
#pragma unroll
        for (int d0 = 0; d0 < 4; ++d0)
#pragma unroll
            for (int gp = 0; gp < 4; gp += 2) { u32x2 w[2];
#pragma unroll
                for (int e = 0; e < 2; ++e) { const int g = gp + e; const u32x2 gw = *(const u32x2*)(grow + 32 * d0 + 8 * g);
                    const float g0 = __uint_as_float(gw.x << 16), g1 = __uint_as_float(gw.x & 0xffff0000u), g2 = __uint_as_float(gw.y << 16), g3 = __uint_as_float(gw.y & 0xffff0000u);
                    w[e].x = cvtpk(o[d0][4 * g] * rstd * g0, o[d0][4 * g + 1] * rstd * g1); w[e].y = cvtpk(o[d0][4 * g + 2] * rstd * g2, o[d0][4 * g + 3] * rstd * g3); }
                store_pair16(orow + 32 * d0 + 8 * gp, w[0], w[1]); }
        __syncthreads();
    } else {
        const float inv = 1.0f / l_reg;
#pragma unroll
        for (int d0 = 0; d0 < 4; ++d0)
#pragma unroll
            for (int gp = 0; gp < 4; gp += 2) { u32x2 w[2];
#pragma unroll
                for (int e = 0; e < 2; ++e) { const int g = gp + e; w[e].x = cvtpk(o[d0][4 * g] * inv, o[d0][4 * g + 1] * inv); w[e].y = cvtpk(o[d0][4 * g + 2] * inv, o[d0][4 * g + 3] * inv); }
                store_pair16(orow + 32 * d0 + 8 * gp, w[0], w[1]); }
    }
    if (tid == 0) *slot = tk;
}

__device__ __forceinline__ void ret_state_unit(const bf16_t* K, int ldk, const bf16_t* V, int ldv, float c2, float* SL, ATT_LAS char* lds) {
    int tid_ = threadIdx.x; asm volatile("" : "+v"(tid_));
    const int tid = tid_, wid = __builtin_amdgcn_readfirstlane(tid >> 6), lane = tid & 63, r32 = lane & 31, hi = lane >> 5;
    const int sr = tid >> 4, sc = (tid & 15) * 8, vst0 = v_st(sr, sc), vst1 = v_st(32 + sr, sc);
    constexpr int KI = 0, VI = 16384;
    const int kb = (int)(unsigned)(uintptr_t)(lds + KI) + v_rd_base(lane), vb = (int)(unsigned)(uintptr_t)(lds + VI) + v_rd_base(lane) + (wid >> 2) * SHM_T;
    f32x16 acc[4] = {};
    for (int t = 0; t < 4; ++t) {
        const bf16_t* kp = K + (size_t)(t * 64 + sr) * ldk + sc; const bf16_t* vp = V + (size_t)(t * 64 + sr) * ldv + sc;
        const u32x4 k0 = *(const u32x4*)kp, k1 = *(const u32x4*)(kp + (size_t)32 * ldk);
        const bf16x8 v0 = *(const bf16x8*)vp, v1 = *(const bf16x8*)(vp + (size_t)32 * ldv), v2 = *(const bf16x8*)(vp + 128), v3 = *(const bf16x8*)(vp + (size_t)32 * ldv + 128);
        const float w0 = __builtin_amdgcn_exp2f(c2 * (float)(255 - (t * 64 + sr))), w1 = __builtin_amdgcn_exp2f(c2 * (float)(255 - (t * 64 + 32 + sr)));
        u32x4 q0, q1;
#define WSC(w, s) cvtpk(__uint_as_float((w) << 16) * (s), __uint_as_float((w) & 0xffff0000u) * (s))
        q0.x = WSC(k0.x, w0); q0.y = WSC(k0.y, w0); q0.z = WSC(k0.z, w0); q0.w = WSC(k0.w, w0); q1.x = WSC(k1.x, w1); q1.y = WSC(k1.y, w1); q1.z = WSC(k1.z, w1); q1.w = WSC(k1.w, w1);
#undef WSC
        __syncthreads();
        *(ATT_LAS u32x4*)(lds + KI + vst0) = q0; *(ATT_LAS u32x4*)(lds + KI + vst1) = q1;
        *(ATT_LAS bf16x8*)(lds + VI + vst0) = v0; *(ATT_LAS bf16x8*)(lds + VI + vst1) = v1; *(ATT_LAS bf16x8*)(lds + VI + SHM_T + vst0) = v2; *(ATT_LAS bf16x8*)(lds + VI + SHM_T + vst1) = v3;
        __syncthreads();
#define TRR(dst, base, off) asm volatile("ds_read_b64_tr_b16 %0, %1 offset:%2" : "=&v"(dst) : "v"(base), "i"(off) : "memory")
#define KS_STEP(ks) do { s16x4 vl, vh, kl0, kh0, kl1, kh1, kl2, kh2, kl3, kh3; \
        TRR(vl, vbw, (ks) * 4096); TRR(vh, vbw, (ks) * 4096 + 2048); \
        TRR(kl0, kb, 0 * 512 + (ks) * 4096); TRR(kh0, kb, 0 * 512 + (ks) * 4096 + 2048); TRR(kl1, kb, 1 * 512 + (ks) * 4096); TRR(kh1, kb, 1 * 512 + (ks) * 4096 + 2048); \
        TRR(kl2, kb, 2 * 512 + (ks) * 4096); TRR(kh2, kb, 2 * 512 + (ks) * 4096 + 2048); TRR(kl3, kb, 3 * 512 + (ks) * 4096); TRR(kh3, kb, 3 * 512 + (ks) * 4096 + 2048); \
        asm volatile("s_waitcnt lgkmcnt(0)" ::: "memory"); SBAR(); \
        const bf16x8 vf = (bf16x8){vl[0], vl[1], vl[2], vl[3], vh[0], vh[1], vh[2], vh[3]}; \
        acc[0] = __builtin_amdgcn_mfma_f32_32x32x16_bf16(vf, (bf16x8){kl0[0], kl0[1], kl0[2], kl0[3], kh0[0], kh0[1], kh0[2], kh0[3]}, acc[0], 0, 0, 0); \
        acc[1] = __builtin_amdgcn_mfma_f32_32x32x16_bf16(vf, (bf16x8){kl1[0], kl1[1], kl1[2], kl1[3], kh1[0], kh1[1], kh1[2], kh1[3]}, acc[1], 0, 0, 0); \
        acc[2] = __builtin_amdgcn_mfma_f32_32x32x16_bf16(vf, (bf16x8){kl2[0], kl2[1], kl2[2], kl2[3], kh2[0], kh2[1], kh2[2], kh2[3]}, acc[2], 0, 0, 0); \
        acc[3] = __builtin_amdgcn_mfma_f32_32x32x16_bf16(vf, (bf16x8){kl3[0], kl3[1], kl3[2], kl3[3], kh3[0], kh3[1], kh3[2], kh3[3]}, acc[3], 0, 0, 0); } while (0)
        const int vbw = vb + (wid & 3) * 512;
        KS_STEP(0); KS_STEP(1); KS_STEP(2); KS_STEP(3);
#undef KS_STEP
#undef TRR
    }
#pragma unroll
    for (int e0 = 0; e0 < 4; ++e0)
#pragma unroll
        for (int r = 0; r < 16; ++r) SL[(size_t)(32 * wid + (r & 3) + 8 * (r >> 2) + 4 * hi) * 128 + 32 * e0 + r32] = acc[e0][r];
    __syncthreads();
}
}

constexpr int DM = 2048, NBATCH = 8, SEQ = 4096, DEPTH = 4, M = NBATCH * SEQ;
constexpr int IN_W = 12358, NIN = 12544, DFF = 5632, NUG = 2 * DFF, NUQ = 1280, NUKV = 1536;
constexpr float NORM_EPS = 1e-6f;
constexpr int NWAVES = 8;
constexpr int PH = 11, NPHASE = DEPTH * PH + 1;

constexpr size_t MiB = 1u << 20;
constexpr size_t WS_CTL = 0, CTL_ZERO_BYTES = 1 * MiB;
constexpr size_t WS_T128 = 1 * MiB, WS_T64 = 3 * MiB, WS_CL = 4 * MiB, WS_RSQ = 5 * MiB, WS_RSKV = 5 * MiB + 512 * 1024, WS_FF = 6 * MiB;
constexpr size_t WS_W = 8 * MiB;
constexpr size_t WO_IN = 0, WO_UQ = WO_IN + (size_t)NIN * DM * 2, WO_UKV = WO_UQ + (size_t)NUQ * 512 * 2, WO_BF = WO_UKV + (size_t)NUKV * 256 * 2, WO_BM = WO_BF + (size_t)DM * 1024 * 2,
                 WO_BR = WO_BM + (size_t)DM * 1024 * 2, WO_OUT = WO_BR + (size_t)DM * 1024 * 2, WO_UG = WO_OUT + (size_t)DM * DM * 2, WO_DN = WO_UG + (size_t)NUG * DM * 2, WO_END = WO_DN + (size_t)DM * DFF * 2;
static_assert(WO_END == 137 * MiB, "weight region");
constexpr size_t WS_H = 146 * MiB;
constexpr size_t WS_BIG = 274 * MiB;
constexpr size_t WS_GATES = WS_BIG, WS_FQKV = WS_GATES + 384 * MiB, WS_CQ = WS_FQKV + 144 * MiB, WS_CKV = WS_CQ + 32 * MiB, WS_RQ = WS_CKV + 16 * MiB, WS_RK = WS_RQ + 32 * MiB,
                 WS_RV = WS_RK + 32 * MiB, WS_RG = WS_RV + 64 * MiB, WS_KR = WS_RG + 64 * MiB, WS_QM = WS_KR + 4 * MiB, WS_KVM = WS_QM + 72 * MiB, WS_A = WS_KVM + 96 * MiB,
                 WS_BM = WS_A + 64 * MiB, WS_C = WS_BM + 64 * MiB, WS_SLOC = WS_C + 64 * MiB, WS_SST = WS_SLOC + 64 * MiB, WS_MIX_END = WS_SST + 32 * MiB;
constexpr size_t WS_TMP = WS_FQKV;
static_assert(WS_RV - WS_FQKV == 256 * MiB, "tmp overlay");
constexpr size_t WS_U = WS_BIG, WS_GT = WS_U + 352 * MiB, WS_ACT = WS_GT + 352 * MiB, WS_FFN_END = WS_ACT + 352 * MiB;
constexpr size_t WS_UTAIL = WS_U, WS_UHEAD = WS_U + 8 * MiB, WS_GHEAD = WS_U + 16 * MiB;
constexpr size_t WS_END = WS_MIX_END > WS_FFN_END ? WS_MIX_END : WS_FFN_END;
constexpr int CW_BAR = 4096;
constexpr int CW_QUEUE = 16384;

constexpr int RING_OFF = 0, RING_BYTES = 131072;
constexpr int LDSCTL_OFF = RING_BYTES, MISC_OFF = LDSCTL_OFF + 320;
constexpr int LDS_BYTES = 147456;
static_assert(MISC_OFF + 128 <= LDS_BYTES, "LDS map");

#define LAS __attribute__((address_space(3)))
typedef unsigned short bf16;
typedef unsigned v4u __attribute__((ext_vector_type(4)));
typedef float f32x4 __attribute__((ext_vector_type(4)));
#define LDS_WAIT() asm volatile("s_waitcnt lgkmcnt(0)" ::: "memory")
__device__ __forceinline__ unsigned f2bf(float f) { unsigned u = __builtin_bit_cast(unsigned, f); return (u + 0x7fffu + ((u >> 16) & 1u)) >> 16; }
__device__ __forceinline__ unsigned pk2(float lo, float hi) { return f2bf(lo) | (f2bf(hi) << 16); }

#define XB_TMO      128
#define XB_XCNT(j)  (256  + 64 * (j))
#define XB_XSUB(j)  (1280 + 64 * (j))
#define XB_XGEN(j)  (2304 + 64 * (j))
#define XB_TOP      3328
#define XB_TOPGEN   3392
#define XCD_BAR_WORDS 3456
#define XB_SPIN_CAP (1u << 18)
__device__ __forceinline__ unsigned xb_ld(unsigned* p)              { return __hip_atomic_load(p, __ATOMIC_RELAXED, __HIP_MEMORY_SCOPE_AGENT); }
__device__ __forceinline__ unsigned xb_add(unsigned* p, unsigned v) { return __hip_atomic_fetch_add(p, v, __ATOMIC_RELAXED, __HIP_MEMORY_SCOPE_AGENT); }
__device__ __forceinline__ unsigned xb_xcc_id() { return (unsigned)__builtin_amdgcn_s_getreg((3 << 11) | 20) & 0xFu; }
#define XB_SPIN(cond, bar) do { unsigned _sp = 0; while (cond) { __builtin_amdgcn_s_sleep(1); \
    if ((++_sp & 255u) == 0u) { if (xb_ld(&(bar)[XB_TMO])) break; if (_sp > XB_SPIN_CAP) { atomicAdd(&(bar)[XB_TMO], 1u); break; } } } } while (0)
struct XcdBarrier { unsigned* bar; unsigned x; volatile LAS unsigned* st; };
__device__ __forceinline__ XcdBarrier xcd_barrier_post(unsigned* bar, volatile LAS unsigned* st) {
    XcdBarrier b; b.bar = bar; b.x = xb_xcc_id(); b.st = st;
    if (threadIdx.x == 0) (void)xb_add(&bar[XB_XCNT(b.x)], 1u);
    return b;
}
__device__ __forceinline__ void xcd_barrier_complete(unsigned* bar, unsigned x, unsigned& nloc, unsigned& nx) {
    const unsigned G = gridDim.x * gridDim.y * gridDim.z;
    unsigned sum, cnt, mine, sp = 0u;
    for (;;) {
        sum = 0u; cnt = 0u; mine = 0u;
#pragma unroll
        for (unsigned j = 0; j < 16; ++j) { const unsigned c = xb_ld(&bar[XB_XCNT(j)]); sum += c; cnt += (c > 0u) ? 1u : 0u; mine = (j == x) ? c : mine; }
        if (sum == G) break;
        __builtin_amdgcn_s_sleep(1);
        if ((++sp & 255u) == 0u) { if (xb_ld(&bar[XB_TMO])) break; if (sp > XB_SPIN_CAP) { atomicAdd(&bar[XB_TMO], 1u); break; } }
    }
    nloc = mine > 0u ? mine : 1u; nx = cnt > 0u ? cnt : 1u;
}
__device__ __forceinline__ void xcd_barrier(const XcdBarrier& b) {
    asm volatile("s_waitcnt vmcnt(0)" ::: "memory");
    __syncthreads();
    if (threadIdx.x == 0) {
        unsigned bx = b.x; size_t bz_ = 0; asm volatile("" : "+s"(bz_), "+s"(bx)); unsigned* bar = b.bar + bz_;
        __builtin_amdgcn_s_waitcnt(0);
        unsigned nloc = b.st[0], nx = b.st[1];
        if (nloc == 0u) { xcd_barrier_complete(bar, bx, nloc, nx); b.st[0] = nloc; b.st[1] = nx; }
        const unsigned old = xb_add(&bar[XB_XSUB(bx)], 1u);
        const unsigned gen = old / nloc;
        if (old + 1u == (gen + 1u) * nloc) {
            __builtin_amdgcn_fence(__ATOMIC_RELEASE, "agent");
            asm volatile("s_waitcnt vmcnt(0)" ::: "memory");
            const unsigned og = xb_add(&bar[XB_TOP], 1u);
            const unsigned tg = og / nx;
            if (og + 1u == (tg + 1u) * nx) xb_add(&bar[XB_TOPGEN], 1u);
            else XB_SPIN(xb_ld(&bar[XB_TOPGEN]) == tg, bar);
            __builtin_amdgcn_fence(__ATOMIC_ACQUIRE, "agent");
            xb_add(&bar[XB_XGEN(bx)], 1u);
            asm volatile("s_waitcnt vmcnt(0)" ::: "memory");
        } else {
            XB_SPIN(xb_ld(&bar[XB_XGEN(bx)]) == gen, bar);
            __builtin_amdgcn_fence(__ATOMIC_ACQUIRE, "agent");
            asm volatile("s_waitcnt vmcnt(0)" ::: "memory");
        }
    }
    __syncthreads();
}

__device__ __forceinline__ float wave_sum(float v, int lane) {
#pragma unroll
    for (int o = 1; o < 64; o <<= 1) v += __builtin_bit_cast(float, __builtin_amdgcn_ds_bpermute((lane ^ o) << 2, __builtin_bit_cast(int, v)));
    return v;
}
__device__ __forceinline__ double lane_up_d(double v, int lane, int o) {
    const int src = (lane >= o ? lane - o : lane) << 2; const unsigned long long u = __builtin_bit_cast(unsigned long long, v);
    const unsigned lo = (unsigned)__builtin_amdgcn_ds_bpermute(src, (int)(unsigned)u), hi = (unsigned)__builtin_amdgcn_ds_bpermute(src, (int)(unsigned)(u >> 32));
    return __builtin_bit_cast(double, ((unsigned long long)hi << 32) | lo);
}
__device__ __forceinline__ void wconv_item(const float* W, int ldw, int src, int valid, const float* kscale, bf16* dst, int K, int k0, LAS float* scr, int lane) {
    const int j = lane & 31; const bool ok = j < valid;
    float wv[32];
#pragma unroll
    for (int i = 0; i < 32; ++i) { const int kk = 2 * i + (lane >> 5); wv[i] = ok ? W[(size_t)(k0 + kk) * ldw + src + j] : 0.f; }
    if (kscale) {
#pragma unroll
        for (int i = 0; i < 32; ++i) wv[i] *= kscale[k0 + 2 * i + (lane >> 5)]; }
#pragma unroll
    for (int i = 0; i < 32; ++i) scr[(2 * i + (lane >> 5)) * 33 + j] = wv[i];
    LDS_WAIT(); asm volatile("" ::: "memory");
    const int c = lane & 7;
#pragma unroll
    for (int jj = 0; jj < 4; ++jj) { const int n = (lane >> 3) + 8 * jj; const LAS float* s = scr + (8 * c) * 33 + n;
        v4u o; o.x = pk2(s[0 * 33], s[1 * 33]); o.y = pk2(s[2 * 33], s[3 * 33]); o.z = pk2(s[4 * 33], s[5 * 33]); o.w = pk2(s[6 * 33], s[7 * 33]);
        *(v4u*)(dst + (size_t)n * K + k0 + 8 * c) = o; }
    LDS_WAIT(); asm volatile("" ::: "memory");
}
__device__ __forceinline__ void inproj_src(int g, int& src, int& valid) {
    const int n = g * 32; valid = 32;
    if (n < 2304) src = n;
    else if (n < 2816) src = 2310 + (n - 2304);
    else if (n < 3072) src = 2822 + (n - 2816);
    else if (n < 3328) { const int p = n - 3072; if (p == 0) src = 3078; else if (p == 32) { src = 2304; valid = 6; } else if (p == 128) src = 3110; else { src = 0; valid = 0; } }
    else if (n < 4352) { const int base = (n < 3840) ? 3142 : 3654; const int p = (n < 3840) ? n - 3328 : n - 3840; const int t = p >> 8, q = p & 255, bj = q >> 7, x = q & 127, hh = x >> 6, i = x & 63;
        src = base + 128 * (2 * t + hh) + 64 * bj + i; }
    else if (n < 5376) src = 4166 + (n - 4352);
    else if (n < 6400) src = 5190 + (n - 5376);
    else src = 6214 + (n - 6400);
}
__device__ __forceinline__ void uq_src(int g, int& src, int& valid) {
    const int n = g * 32; valid = 32;
    if (n < 768) { const int t = n >> 8, q = n & 255, bj = q >> 7, x = q & 127; src = 192 * (2 * t + bj) + x; }
    else { const int t4 = (n >= 1024) ? 1 : 0; const int q = n - 768 - 256 * t4, bj = q >> 7, x = q & 127, hh = (x >> 5) + 4 * t4; if (hh < 6) src = 192 * hh + 128 + 32 * bj; else { src = 0; valid = 0; } }
}

struct Args {
    const float* in[19]; float* out; unsigned char* ws;
    float invf128[64]; float invf64[32];
    int ph_lo, ph_hi;
};

static_assert(sizeof(Args) == 560, "Args layout");

#define KAS __attribute__((address_space(4)))
#define GAS1 __attribute__((address_space(1)))
__device__ __forceinline__ const KAS char* karg_base() { size_t z = 0; asm volatile("" : "+s"(z)); return (const KAS char*)__builtin_amdgcn_kernarg_segment_ptr() + z; }
__device__ __forceinline__ const float* arg_in(int i) { typedef const GAS1 float* gp; return (const float*)(*(const KAS gp*)(karg_base() + 8 * i)); }
__device__ __forceinline__ float* arg_out() { typedef GAS1 float* gp; return (float*)(*(const KAS gp*)(karg_base() + 152)); }
__device__ __forceinline__ unsigned char* arg_ws() { typedef GAS1 unsigned char* gp; return (unsigned char*)(*(const KAS gp*)(karg_base() + 160)); }
__device__ __forceinline__ float arg_invf128(int i) { return *(const KAS float*)(karg_base() + 168 + 4 * i); }
__device__ __forceinline__ float arg_invf64(int i) { return *(const KAS float*)(karg_base() + 424 + 4 * i); }
struct Ctx { int tid, lane, wave, G, vcu, gw, NGW; LAS unsigned char* lds; unsigned char* ws; };
__device__ __forceinline__ Ctx ctx_local(const Ctx& C0) { Ctx C = C0; int t_ = threadIdx.x; asm volatile("" : "+v"(t_)); C.tid = t_; C.lane = t_ & 63; size_t z_ = 0; asm volatile("" : "+s"(C.wave), "+s"(C.gw), "+s"(C.vcu), "+s"(z_)); C.ws = arg_ws() + z_; return C; }

constexpr int XPITCH = 4096;
__device__ __forceinline__ void cvt8(const v4u w, float (&v)[8]) {
    v[0] = __uint_as_float(w.x << 16); v[1] = __uint_as_float(w.x & 0xffff0000u); v[2] = __uint_as_float(w.y << 16); v[3] = __uint_as_float(w.y & 0xffff0000u);
    v[4] = __uint_as_float(w.z << 16); v[5] = __uint_as_float(w.z & 0xffff0000u); v[6] = __uint_as_float(w.w << 16); v[7] = __uint_as_float(w.w & 0xffff0000u); }
__device__ __forceinline__ void rows_rmsnorm_first(const Ctx& C0, const float* x, const float* gain, bf16* xb, bf16* out) { const Ctx C = ctx_local(C0);
    f32x4 g[8];
#pragma unroll
    for (int j = 0; j < 8; ++j) g[j] = ((const f32x4*)gain + C.lane)[64 * j];
    for (int m = C.gw; m < M; m += 2 * C.NGW) {
        const int m2 = m + C.NGW; const bool has2 = m2 < M;
        const f32x4* xa = (const f32x4*)(x + (size_t)m * DM) + C.lane; const f32x4* xq = (const f32x4*)(x + (size_t)(has2 ? m2 : m) * DM) + C.lane;
        f32x4 va[8], vb[8]; float sa = 0.f, sb = 0.f;
#pragma unroll
        for (int j = 0; j < 8; ++j) va[j] = xa[64 * j];
#pragma unroll
        for (int j = 0; j < 8; ++j) vb[j] = xq[64 * j];
#pragma unroll
        for (int j = 0; j < 8; ++j) { sa += (va[j].x * va[j].x + va[j].y * va[j].y) + (va[j].z * va[j].z + va[j].w * va[j].w); sb += (vb[j].x * vb[j].x + vb[j].y * vb[j].y) + (vb[j].z * vb[j].z + vb[j].w * vb[j].w); }
        const float ra = __builtin_amdgcn_rsqf(wave_sum(sa, C.lane) * (1.0f / DM) + NORM_EPS), rb = __builtin_amdgcn_rsqf(wave_sum(sb, C.lane) * (1.0f / DM) + NORM_EPS);
        unsigned long long* oa = (unsigned long long*)(out + (size_t)m * DM) + C.lane; unsigned long long* ya = (unsigned long long*)(xb + (size_t)m * XPITCH) + C.lane;
#pragma unroll
        for (int j = 0; j < 8; ++j) { oa[64 * j] = (unsigned long long)pk2(va[j].x * ra * g[j].x, va[j].y * ra * g[j].y) | ((unsigned long long)pk2(va[j].z * ra * g[j].z, va[j].w * ra * g[j].w) << 32);
            ya[64 * j] = (unsigned long long)pk2(va[j].x, va[j].y) | ((unsigned long long)pk2(va[j].z, va[j].w) << 32); }
        if (has2) { unsigned long long* ob = (unsigned long long*)(out + (size_t)m2 * DM) + C.lane; unsigned long long* yb = (unsigned long long*)(xb + (size_t)m2 * XPITCH) + C.lane;
#pragma unroll
            for (int j = 0; j < 8; ++j) { ob[64 * j] = (unsigned long long)pk2(vb[j].x * rb * g[j].x, vb[j].y * rb * g[j].y) | ((unsigned long long)pk2(vb[j].z * rb * g[j].z, vb[j].w * rb * g[j].w) << 32);
                yb[64 * j] = (unsigned long long)pk2(vb[j].x, vb[j].y) | ((unsigned long long)pk2(vb[j].z, vb[j].w) << 32); } }
    }
}
__device__ __forceinline__ void rows_rmsnorm_bf16(const Ctx& C0, const bf16* xb, const float* gain, bf16* out) { const Ctx C = ctx_local(C0);
    f32x4 g[4][2];
#pragma unroll
    for (int j = 0; j < 4; ++j) { g[j][0] = *(const f32x4*)(gain + 8 * (C.lane + 64 * j)); g[j][1] = *(const f32x4*)(gain + 8 * (C.lane + 64 * j) + 4); }
    for (int m0 = C.gw; m0 < M; m0 += 4 * C.NGW) {
        v4u w[4][4];
#pragma unroll
        for (int q = 0; q < 4; ++q) { const int m = m0 + q * C.NGW; const v4u* xr = (const v4u*)(xb + (size_t)(m < M ? m : m0) * XPITCH) + C.lane;
#pragma unroll
            for (int j = 0; j < 4; ++j) w[q][j] = xr[64 * j]; }
#pragma unroll
        for (int q = 0; q < 4; ++q) { const int m = m0 + q * C.NGW; float s = 0.f;
#pragma unroll
            for (int j = 0; j < 4; ++j) { float v[8]; cvt8(w[q][j], v);
#pragma unroll
                for (int e = 0; e < 8; ++e) s += v[e] * v[e]; }
            const float r = __builtin_amdgcn_rsqf(wave_sum(s, C.lane) * (1.0f / DM) + NORM_EPS);
            if (m < M) { v4u* orow = (v4u*)(out + (size_t)m * DM) + C.lane;
#pragma unroll
                for (int j = 0; j < 4; ++j) { float v[8]; cvt8(w[q][j], v);
                    v4u o; o.x = pk2(v[0] * r * g[j][0][0], v[1] * r * g[j][0][1]); o.y = pk2(v[2] * r * g[j][0][2], v[3] * r * g[j][0][3]); o.z = pk2(v[4] * r * g[j][1][0], v[5] * r * g[j][1][1]); o.w = pk2(v[6] * r * g[j][1][2], v[7] * r * g[j][1][3]);
                    orow[64 * j] = o; } } }
    }
}
__device__ __forceinline__ void rows_rmsnorm_final(const Ctx& C0, float* outp, const float* gain) { const Ctx C = ctx_local(C0);
    f32x4 g[4][2];
#pragma unroll
    for (int j = 0; j < 4; ++j) { g[j][0] = *(const f32x4*)(gain + 8 * (C.lane + 64 * j)); g[j][1] = *(const f32x4*)(gain + 8 * (C.lane + 64 * j) + 4); }
    for (int m0 = C.gw; m0 < M; m0 += 4 * C.NGW) {
        v4u w[4][4];
#pragma unroll
        for (int q = 0; q < 4; ++q) { const int m = m0 + q * C.NGW; const v4u* xr = (const v4u*)((const bf16*)outp + (size_t)(m < M ? m : m0) * XPITCH) + C.lane;
#pragma unroll
            for (int j = 0; j < 4; ++j) w[q][j] = xr[64 * j]; }
        asm volatile("s_waitcnt vmcnt(0)" ::: "memory");
#pragma unroll
        for (int q = 0; q < 4; ++q) { const int m = m0 + q * C.NGW; float s = 0.f;
#pragma unroll
            for (int j = 0; j < 4; ++j) { float v[8]; cvt8(w[q][j], v);
#pragma unroll
                for (int e = 0; e < 8; ++e) s += v[e] * v[e]; }
            const float r = __builtin_amdgcn_rsqf(wave_sum(s, C.lane) * (1.0f / DM) + NORM_EPS);
            if (m < M) { float* orow = outp + (size_t)m * DM + 8 * C.lane;
#pragma unroll
                for (int j = 0; j < 4; ++j) { float v[8]; cvt8(w[q][j], v);
                    *(f32x4*)(orow + 512 * j) = (f32x4){v[0] * r * g[j][0][0], v[1] * r * g[j][0][1], v[2] * r * g[j][0][2], v[3] * r * g[j][0][3]};
                    *(f32x4*)(orow + 512 * j + 4) = (f32x4){v[4] * r * g[j][1][0], v[5] * r * g[j][1][1], v[6] * r * g[j][1][2], v[7] * r * g[j][1][3]}; } } }
    }
}
__device__ __forceinline__ void sincos_d(float angf, float& co, float& si) {
    const double a = (double)angf; const double k = __builtin_rint(a * 0.15915494309189535); double r = a - k * 6.283185307179586477;
    const double q = __builtin_rint(r * 0.63661977236758134308); const double y = r - q * 1.57079632679489661923; const double y2 = y * y;
    const double sy = y * (1.0 + y2 * (-1.0 / 6 + y2 * (1.0 / 120 + y2 * (-1.0 / 5040 + y2 * (1.0 / 362880 + y2 * (-1.0 / 39916800 + y2 * (1.0 / 6227020800.0)))))));
    const double cy = 1.0 + y2 * (-0.5 + y2 * (1.0 / 24 + y2 * (-1.0 / 720 + y2 * (1.0 / 40320 + y2 * (-1.0 / 3628800 + y2 * (1.0 / 479001600 + y2 * (-1.0 / 87178291200.0)))))));
    const int qi = ((int)q) & 3;
    const double s = (qi == 0) ? sy : (qi == 1) ? cy : (qi == 2) ? -sy : -cy;
    const double c = (qi == 0) ? cy : (qi == 1) ? -sy : (qi == 2) ? -cy : sy;
    co = (float)c; si = (float)s;
}
__device__ __forceinline__ void rope_tables(const Ctx& C0, const Args& A) { const Ctx C = ctx_local(C0);
    float* T128 = (float*)(C.ws + WS_T128); float* T64 = (float*)(C.ws + WS_T64);
    const int gt = (C.vcu * NWAVES + C.wave) * 64 + C.lane, NGT = C.NGW * 64;
    for (int e = gt; e < SEQ * 64; e += NGT) { const int pos = e >> 6, i = e & 63; float c, s; sincos_d((float)pos * arg_invf128(i), c, s); T128[2 * e] = c; T128[2 * e + 1] = s; }
    for (int e = gt; e < SEQ * 32; e += NGT) { const int pos = e >> 5, i = e & 31; float c, s; sincos_d((float)pos * arg_invf64(i), c, s); T64[2 * e] = c; T64[2 * e + 1] = s; }
}
__device__ __forceinline__ void p0_phase(const Ctx& C0, const Args& A, int layer) { const Ctx C = ctx_local(C0);
    LAS float* scr = (LAS float*)(C.lds + RING_OFF + C.wave * 16384);
    const float* w_in = arg_in(2) + (size_t)layer * DM * IN_W;
    const float* w_uq = arg_in(5) + (size_t)layer * 512 * 1152; const float* w_ukv = arg_in(6) + (size_t)layer * 256 * 1536;
    const float* qg = arg_in(3) + (size_t)layer * 512; const float* kvg = arg_in(4) + (size_t)layer * 256;
    const float* w_bf = arg_in(8) + (size_t)layer * 768 * DM; const float* w_bm = arg_in(9) + (size_t)layer * 768 * DM; const float* w_br = arg_in(10) + (size_t)layer * 1024 * DM;
    const float* w_out = arg_in(11) + (size_t)layer * DM * DM;
    const float* w_up = arg_in(13) + (size_t)layer * DM * DFF; const float* w_gate = arg_in(14) + (size_t)layer * DM * DFF; const float* w_dn = arg_in(17) + (size_t)layer * DFF * DM;
    bf16* Wb = (bf16*)(C.ws + WS_W);
    constexpr int I_IN = (NIN / 32) * (DM / 64), I_UQ = (NUQ / 32) * (512 / 64), I_UKV = (NUKV / 32) * (256 / 64), I_BF = (DM / 32) * (768 / 64), I_BR = (DM / 32) * (1024 / 64),
                  I_OUT = (DM / 32) * (DM / 64), I_UG = (NUG / 32) * (DM / 64), I_DN = (DM / 32) * (DFF / 64);
    constexpr int NITEMS = I_IN + I_UQ + I_UKV + 2 * I_BF + I_BR + I_OUT;
    for (int it = C.gw; it < NITEMS; it += C.NGW) {
        int r = it, src, valid;
        if (r < I_IN) { const int g = r / (DM / 64), kb = r % (DM / 64); inproj_src(g, src, valid); wconv_item(w_in, IN_W, src, valid, nullptr, (bf16*)((char*)Wb + WO_IN) + (size_t)g * 32 * DM, DM, kb * 64, scr, C.lane); continue; } r -= I_IN;
        if (r < I_UQ) { const int g = r / 8, kb = r % 8; uq_src(g, src, valid); wconv_item(w_uq, 1152, src, valid, qg, (bf16*)((char*)Wb + WO_UQ) + (size_t)g * 32 * 512, 512, kb * 64, scr, C.lane); continue; } r -= I_UQ;
        if (r < I_UKV) { const int g = r / 4, kb = r % 4; wconv_item(w_ukv, 1536, g * 32, 32, kvg, (bf16*)((char*)Wb + WO_UKV) + (size_t)g * 32 * 256, 256, kb * 64, scr, C.lane); continue; } r -= I_UKV;
        if (r < I_BF) { const int g = r / 12, kb = r % 12; wconv_item(w_bf, DM, g * 32, 32, nullptr, (bf16*)((char*)Wb + WO_BF) + (size_t)g * 32 * 1024, 1024, kb * 64, scr, C.lane); continue; } r -= I_BF;
        if (r < I_BF) { const int g = r / 12, kb = r % 12; wconv_item(w_bm, DM, g * 32, 32, nullptr, (bf16*)((char*)Wb + WO_BM) + (size_t)g * 32 * 1024, 1024, kb * 64, scr, C.lane); continue; } r -= I_BF;
        if (r < I_BR) { const int g = r / 16, kb = r % 16; wconv_item(w_br, DM, g * 32, 32, nullptr, (bf16*)((char*)Wb + WO_BR) + (size_t)g * 32 * 1024, 1024, kb * 64, scr, C.lane); continue; } r -= I_BR;
        if (r < I_OUT) { const int g = r / 32, kb = r % 32; wconv_item(w_out, DM, g * 32, 32, nullptr, (bf16*)((char*)Wb + WO_OUT) + (size_t)g * 32 * DM, DM, kb * 64, scr, C.lane); }
    }
    if (layer == 0) rows_rmsnorm_first(C, arg_in(0), arg_in(1), (bf16*)arg_out(), (bf16*)(C.ws + WS_H));
    else rows_rmsnorm_bf16(C, (const bf16*)arg_out(), arg_in(1) + (size_t)layer * DM, (bf16*)(C.ws + WS_H));
}
__device__ __forceinline__ void wconv_ffn(const Ctx& C0, int layer, int first, int nblk) { const Ctx C = ctx_local(C0);
    LAS float* scr = (LAS float*)(C.lds + RING_OFF + C.wave * 16384);
    const float* w_up = arg_in(13) + (size_t)layer * DM * DFF; const float* w_gate = arg_in(14) + (size_t)layer * DM * DFF; const float* w_dn = arg_in(17) + (size_t)layer * DFF * DM;
    bf16* Wb = (bf16*)(C.ws + WS_W);
    constexpr int I_UG = (NUG / 32) * (DM / 64), I_DN = (DM / 32) * (DFF / 64);
    for (int it = first * NWAVES + C.wave; it < I_UG + I_DN; it += nblk * NWAVES) {
        int r = it;
        if (r < I_UG) { const int g = r / 32, kb = r % 32; const int n = g * 32, t = n >> 8, bj = (n >> 7) & 1, x = n & 127;
            wconv_item(bj ? w_gate : w_up, DFF, 128 * t + x, 32, nullptr, (bf16*)((char*)Wb + WO_UG) + (size_t)g * 32 * DM, DM, kb * 64, scr, C.lane); continue; } r -= I_UG;
        { const int g = r / 88, kb = r % 88; wconv_item(w_dn, DM, g * 32, 32, nullptr, (bf16*)((char*)Wb + WO_DN) + (size_t)g * 32 * DFF, DFF, kb * 64, scr, C.lane); }
    }
}
__device__ __forceinline__ void p2_phase(const Ctx& C0, const Args& A, int layer) { const Ctx C = ctx_local(C0);
    const float* ff = (const float*)(C.ws + WS_FF); float* cL = (float*)(C.ws + WS_CL);
    LAS double* red = (LAS double*)(C.lds + RING_OFF);
    for (int sq = C.vcu; sq < NBATCH * 6; sq += C.G) {
        const int b = sq / 6, h = sq % 6; const float bias = arg_in(7)[layer * 6 + h];
        double v[8]; double run = 0.0;
#pragma unroll
        for (int j = 0; j < 8; ++j) { const float xf = ff[((size_t)b * SEQ + C.tid * 8 + j) * 8 + h] + bias;
            const float ls = fminf(xf, 0.f) - 0.6931471805599453f * __builtin_amdgcn_logf(1.0f + __builtin_amdgcn_exp2f(-1.4426950408889634f * fabsf(xf)));
            run += (double)ls; v[j] = run; }
        double incl = run;
#pragma unroll
        for (int o = 1; o < 64; o <<= 1) { const double t = lane_up_d(incl, C.lane, o); if (C.lane >= o) incl += t; }
        __syncthreads();
        if (C.lane == 63) red[C.wave] = incl;
        __syncthreads();
        double base = incl - run;
        for (int w = 0; w < C.wave; ++w) base += red[w];
        float* dst = cL + (size_t)sq * SEQ + C.tid * 8;
#pragma unroll
        for (int j = 0; j < 8; ++j) dst[j] = (float)((base + v[j]) * 1.4426950408889634);
    }
    const bf16* cq = (const bf16*)(C.ws + WS_CQ); const bf16* ckv = (const bf16*)(C.ws + WS_CKV); float* rq = (float*)(C.ws + WS_RSQ); float* rkv = (float*)(C.ws + WS_RSKV);
    for (int m0 = C.gw; m0 < M; m0 += 4 * C.NGW) {
        v4u a[4], c[4];
#pragma unroll
        for (int q = 0; q < 4; ++q) { const int m = m0 + q * C.NGW; const int mm = m < M ? m : m0; a[q] = *((const v4u*)(cq + (size_t)mm * 512) + C.lane); c[q] = *((const v4u*)(ckv + (size_t)mm * 256) + (C.lane & 31)); }
#pragma unroll
        for (int q = 0; q < 4; ++q) { const int m = m0 + q * C.NGW;
            float s = 0.f, s2 = 0.f; const unsigned w[4] = {a[q].x, a[q].y, a[q].z, a[q].w}, w2[4] = {c[q].x, c[q].y, c[q].z, c[q].w};
#pragma unroll
            for (int j = 0; j < 4; ++j) { const float lo = __uint_as_float(w[j] << 16), hi = __uint_as_float(w[j] & 0xffff0000u); s += lo * lo + hi * hi;
                const float lo2 = __uint_as_float(w2[j] << 16), hi2 = __uint_as_float(w2[j] & 0xffff0000u); if (C.lane < 32) s2 += lo2 * lo2 + hi2 * hi2; }
            s = wave_sum(s, C.lane); s2 = wave_sum(s2, C.lane);
            if (C.lane == 0 && m < M) { rq[m] = __builtin_amdgcn_rsqf(s * (1.0f / 512.0f) + NORM_EPS); rkv[m] = __builtin_amdgcn_rsqf(s2 * (1.0f / 256.0f) + NORM_EPS); } }
    }
    { const bf16* rk = (const bf16*)(C.ws + WS_RK); const bf16* rv = (const bf16*)(C.ws + WS_RV); float* sloc = (float*)(C.ws + WS_SLOC);
      for (int u = C.vcu; u < NBATCH * 4 * 16; u += C.G) { const int k = u & 15, h = (u >> 4) & 3, b = u >> 6; const size_t row0 = (size_t)b * SEQ + 256 * k;
          att::ret_state_unit(rk + row0 * 512 + 128 * h, 512, rv + row0 * 1024 + 256 * h, 1024, __builtin_amdgcn_logf(1.0f - __builtin_amdgcn_exp2f(-5.0f - (float)h)), sloc + (size_t)u * 32768, (LAS char*)(C.lds + RING_OFF)); } }
}
__device__ __forceinline__ void ret_scan(const Ctx& C0) { const Ctx C = ctx_local(C0);
    const float* sloc = (const float*)(C.ws + WS_SLOC); bf16* sst = (bf16*)(C.ws + WS_SST);
    for (int it = C.gw * 64 + C.lane; it < NBATCH * 4 * 8192; it += C.NGW * 64) {
        const int bh = it >> 13, e4 = (it & 8191) * 4, h = bh & 3;
        const float g256 = __builtin_amdgcn_exp2f(256.0f * __builtin_amdgcn_logf(1.0f - __builtin_amdgcn_exp2f(-5.0f - (float)h)));
        float z_ = 0.f; asm volatile("" : "+v"(z_));
        f32x4 s = {z_, z_, z_, z_};
        f32x4 l[16];
#pragma unroll
        for (int k = 0; k < 15; ++k) l[k] = *(const f32x4*)(sloc + ((size_t)bh * 16 + k) * 32768 + e4);
#pragma unroll
        for (int k = 0; k < 16; ++k) { const size_t o = ((size_t)bh * 16 + k) * 32768 + e4;
            *(unsigned long long*)(sst + o) = (unsigned long long)pk2(s[0], s[1]) | ((unsigned long long)pk2(s[2], s[3]) << 32);
            if (k < 15) s = s * g256 + l[k]; }
    }
}
__device__ __forceinline__ void p9_phase(const Ctx& C0, const Args& A, int layer) { const Ctx C = ctx_local(C0);
    const float* utail = (const float*)(C.ws + WS_UTAIL); const float* uhead = (const float*)(C.ws + WS_UHEAD); const float* ghead = (const float*)(C.ws + WS_GHEAD); bf16* act = (bf16*)(C.ws + WS_ACT);
    const float* cw = arg_in(15) + (size_t)layer * 3 * DFF; const float* cb = arg_in(16) + (size_t)layer * DFF;
    constexpr int NCH = DFF / 8, NITEM = (M / 256) * 2 * NCH;
    for (int it = C.gw * 64 + C.lane; it < NITEM; it += C.NGW * 64) {
        const int ch = it % NCH, rr = (it / NCH) & 1, pm = it / (2 * NCH), f0 = ch * 8;
        if ((pm & 15) == 0) continue;
        const float* p2 = rr ? utail + ((size_t)(pm - 1) * 2 + 1) * DFF : utail + ((size_t)(pm - 1) * 2) * DFF;
        const float* p1 = rr ? uhead + ((size_t)pm * 2) * DFF : utail + ((size_t)(pm - 1) * 2 + 1) * DFF;
        const float* p0 = uhead + ((size_t)pm * 2 + rr) * DFF; const float* pg = ghead + ((size_t)pm * 2 + rr) * DFF;
        unsigned o[4];
#pragma unroll
        for (int h = 0; h < 2; ++h) { const f32x4 x2 = *(const f32x4*)(p2 + f0 + 4 * h), x1 = *(const f32x4*)(p1 + f0 + 4 * h), x0 = *(const f32x4*)(p0 + f0 + 4 * h), g = *(const f32x4*)(pg + f0 + 4 * h);
            const f32x4 a = *(const f32x4*)(cw + f0 + 4 * h), b = *(const f32x4*)(cw + DFF + f0 + 4 * h), c = *(const f32x4*)(cw + 2 * DFF + f0 + 4 * h), d = *(const f32x4*)(cb + f0 + 4 * h);
            float r[4];
#pragma unroll
            for (int j = 0; j < 4; ++j) r[j] = pg8::gelu_gate(d[j] + a[j] * x2[j] + b[j] * x1[j] + c[j] * x0[j], g[j]);
            o[2 * h] = pg8::cvt_pk_bf16(r[0], r[1]); o[2 * h + 1] = pg8::cvt_pk_bf16(r[2], r[3]); }
        *(v4u*)(act + (size_t)(pm * 256 + rr) * DFF + f0) = (v4u){o[0], o[1], o[2], o[3]};
    }
}
#ifndef PROBE_SKIP_EPI
#define PROBE_SKIP_EPI 0
#endif
#ifndef KIND_MASK
#define KIND_MASK 7
#endif

__device__ __forceinline__ int queue_next(unsigned* head, volatile LAS unsigned* slot) {
    __syncthreads();
    if (threadIdx.x == 0) *slot = __hip_atomic_fetch_add(head, 1u, __ATOMIC_RELAXED, __HIP_MEMORY_SCOPE_AGENT);
    __syncthreads();
    return (int)*slot;
}
__device__ __forceinline__ int queue_after(volatile LAS unsigned* slot) { __syncthreads(); return (int)*slot; }
__device__ __forceinline__ void p4_phase(const Ctx& C0, const Args& A, int layer, volatile LAS unsigned* slot, int rep) { const Ctx C = ctx_local(C0);
    unsigned* qh = (unsigned*)(C.ws + WS_CTL) + CW_QUEUE + 64 * 3 * layer + 64 * 12 * rep;
    const bool k0 = rep == 0 || (KIND_MASK & 1), k1 = rep == 0 || (KIND_MASK & 2), k2 = rep == 0 || (KIND_MASK & 4);
    LAS char* lds = (LAS char*)(C.lds + RING_OFF);
    const bf16* fqkv = (const bf16*)(C.ws + WS_FQKV); const float* cL = (const float*)(C.ws + WS_CL);
    const bf16* qm = (const bf16*)(C.ws + WS_QM); const bf16* kvm = (const bf16*)(C.ws + WS_KVM); const bf16* kr = (const bf16*)(C.ws + WS_KR);
    const bf16* rq = (const bf16*)(C.ws + WS_RQ); const bf16* rk = (const bf16*)(C.ws + WS_RK); const bf16* rv = (const bf16*)(C.ws + WS_RV); const bf16* rg = (const bf16*)(C.ws + WS_RG);
    bf16* oa = (bf16*)(C.ws + WS_A); bf16* ob = (bf16*)(C.ws + WS_BM); bf16* oc = (bf16*)(C.ws + WS_C);
    if (k2) for (int i = queue_next(qh + 128, slot); i < 1024; i = queue_after(slot)) {
        const int qb = 31 - i / 32, bh = i % 32, b = bh >> 2, h = bh & 3; const size_t row0 = (size_t)b * SEQ + 128 * qb, seq0 = (size_t)b * SEQ;
        att::UnitPtrs U; U.Q = rq + row0 * 512 + 128 * h; U.ldq = 512; U.K = rk + seq0 * 512 + 128 * h; U.ldk = 512; U.V = rv + seq0 * 1024 + 256 * h; U.ldv = 1024; U.KR = nullptr; U.bias = nullptr;
        U.G = rg + row0 * 1024 + 256 * h; U.O = oc + row0 * 1024 + 256 * h; U.ldo = 1024; U.P0 = 128 * qb; U.T0 = 256 * (qb >> 1);
        U.ST = (qb >> 1) ? (const bf16*)(C.ws + WS_SST) + ((size_t)bh * 16 + (qb >> 1)) * 32768 : nullptr; U.c2 = __builtin_amdgcn_logf(1.0f - __builtin_amdgcn_exp2f(-5.0f - (float)h));
        att::mixer_unit<2>(U, lds, qh + 128, slot); }
    if (k1) for (int i = queue_next(qh + 64, slot); i < 768; i = queue_after(slot)) {
        const int qb = 15 - i / 48, bh = i % 48, b = bh / 6, h = bh % 6; const size_t row0 = (size_t)b * SEQ + 256 * qb, seq0 = (size_t)b * SEQ;
        att::UnitPtrs U; U.Q = qm + row0 * 1152 + 192 * h; U.ldq = 1152; U.K = kvm + seq0 * 1536 + 256 * h; U.ldk = 1536; U.V = U.K + 128; U.ldv = 1536; U.KR = kr + seq0 * 64; U.bias = nullptr; U.G = nullptr; U.ST = nullptr; U.T0 = 0;
        U.O = ob + row0 * 1024 + 128 * h; U.ldo = 1024; U.P0 = 256 * qb; U.c2 = 0.07216878364870322f * 1.4426950408889634f;
        att::mixer_unit<1>(U, lds, qh + 64, slot); }
    if (k0) for (int i = queue_next(qh, slot); i < 768; i = queue_after(slot)) {
        const int qb = 15 - i / 48, bh = i % 48, b = bh / 6, h = bh % 6; const size_t row0 = (size_t)b * SEQ + 256 * qb, seq0 = (size_t)b * SEQ;
        att::UnitPtrs U; U.Q = fqkv + row0 * 2304 + 128 * h; U.ldq = 2304; U.K = fqkv + seq0 * 2304 + 768 + 128 * h; U.ldk = 2304; U.V = U.K + 768; U.ldv = 2304; U.KR = nullptr; U.G = nullptr; U.ST = nullptr; U.T0 = 0;
        U.bias = cL + (size_t)bh * SEQ; U.O = oa + row0 * 1024 + 128 * h; U.ldo = 1024; U.P0 = 256 * qb; U.c2 = 0.08838834764831845f * 1.4426950408889634f;
        att::mixer_unit<0>(U, lds, qh, slot); }
}

__global__ void __launch_bounds__(NWAVES * 64, 2) hyb_fwd(Args args) {
    extern __shared__ __attribute__((aligned(16))) unsigned char lds_raw[];
    Ctx C;
    C.lds = (LAS unsigned char*)lds_raw;
    volatile LAS unsigned* MISC = (volatile LAS unsigned*)(C.lds + MISC_OFF);
    C.tid = 0; C.lane = 0; C.wave = __builtin_amdgcn_readfirstlane((int)threadIdx.x >> 6);
    C.G = gridDim.x; { const int bx = blockIdx.x; C.vcu = (C.G % 8 == 0) ? (bx % 8) * (C.G / 8) + bx / 8 : bx; }
    C.gw = C.vcu * NWAVES + C.wave; C.NGW = C.G * NWAVES; C.ws = arg_ws();
    unsigned* ctl = (unsigned*)(C.ws + WS_CTL);
    for (int u = threadIdx.x; u < (LDS_BYTES - LDSCTL_OFF) / 4; u += NWAVES * 64) ((LAS unsigned*)(C.lds + LDSCTL_OFF))[u] = 0u;
    __syncthreads();
#if MK_PER_PHASE
    XcdBarrier bar; bar.bar = ctl + CW_BAR; bar.x = 0; bar.st = nullptr; (void)bar;
#define GRID_BAR() do { } while (0)
#else
    XcdBarrier bar = xcd_barrier_post(ctl + CW_BAR, MISC + 8);
#define GRID_BAR() xcd_barrier(bar)
#endif
    const int lo = args.ph_lo, hi = args.ph_hi;
#define IN(k) (lo <= (k) && (k) < hi)
#ifndef PHASE_MASK
#define PHASE_MASK 0xFFFF
#endif
#define PHM(k) (((PHASE_MASK) >> (k)) & 1)
#ifndef SUB_MASK
#define SUB_MASK 0xFF
#endif
#define SUBM(k) (((SUB_MASK) >> (k)) & 1)
#ifndef REPEAT_MASK
#define REPEAT_MASK 0
#endif
#define REPS(k) (1 + (((REPEAT_MASK) >> (k)) & 1))

#define SEAM(k) do { if (IN(k) && IN((k) + 1)) GRID_BAR(); } while (0)
    PG8_LAS unsigned char* ring = (PG8_LAS unsigned char*)(C.lds + RING_OFF);
    const int bid = (int)blockIdx.x;
    if (PHM(0) && IN(0)) rope_tables(C, args);
    for (int layer = 0; layer < DEPTH; ++layer) {
        const int p = layer * PH;
        _Pragma("unroll") for (int rep = 0; rep < REPS(0); ++rep) if (PHM(0) && IN(p + 0)) { p0_phase(C, args, layer); if (rep + 1 < REPS(0)) GRID_BAR(); else SEAM(p + 0); }
        _Pragma("unroll") for (int rep = 0; rep < REPS(1); ++rep) if (PHM(1) && IN(p + 1)) { size_t wz_ = 0; asm volatile("" : "+s"(wz_)); unsigned char* wsl = arg_ws() + wz_; pg8::bf16_t* Wb = (pg8::bf16_t*)(wsl + WS_W); pg8::bf16_t* Hb = (pg8::bf16_t*)(wsl + WS_H);
            pg8::Gemm g{Hb, (const pg8::bf16_t*)((char*)Wb + WO_IN), M, NIN, DM}; pg8::StaticOrder S; S.init(M, NIN, C.G, bid);
            pg8::EpiInProj E{wsl, WS_FQKV, WS_CQ, WS_CKV, WS_KR, WS_RQ, WS_RK, WS_RV, WS_RG, WS_GATES, WS_FF, WS_T128, WS_T64, (rep + 1 < REPS(1)) ? PROBE_SKIP_EPI : 0};
            pg8::gemm_phase<pg8::EpiInProj, pg8::StaticOrder, true, true>(ring, g, S, E);
            { const int nfull = (M / 256) * (NIN / 256) % C.G; if (rep + 1 == REPS(1)) { if (nfull == 0) wconv_ffn(C, layer, bid, C.G); else if (bid >= nfull) wconv_ffn(C, layer, bid - nfull, C.G - nfull); } }
            if (rep + 1 < REPS(1)) GRID_BAR(); else SEAM(p + 1); }
        _Pragma("unroll") for (int rep = 0; rep < REPS(2); ++rep) if (PHM(2) && IN(p + 2)) { p2_phase(C, args, layer); if (rep + 1 < REPS(2)) GRID_BAR(); else SEAM(p + 2); }
        _Pragma("unroll") for (int rep = 0; rep < REPS(3); ++rep) if (PHM(3) && IN(p + 3)) { size_t wz_ = 0; asm volatile("" : "+s"(wz_)); unsigned char* wsl = arg_ws() + wz_; pg8::bf16_t* Wb = (pg8::bf16_t*)(wsl + WS_W); pg8::bf16_t* Hb = (pg8::bf16_t*)(wsl + WS_H);
            if (SUBM(0)) { pg8::Gemm g{(const pg8::bf16_t*)(wsl + WS_CQ), (const pg8::bf16_t*)((char*)Wb + WO_UQ), M, NUQ, 512}; pg8::StaticOrder S; S.init(M, NUQ, C.G, bid);
              pg8::EpiUq E{(pg8::bf16_t*)(wsl + WS_QM), (const float*)(wsl + WS_RSQ), (const float*)(wsl + WS_T64)};
              pg8::gemm_phase<pg8::EpiUq, pg8::StaticOrder, true, true>(ring, g, S, E); }
            if (SUBM(1)) { pg8::Gemm g{(const pg8::bf16_t*)(wsl + WS_CKV), (const pg8::bf16_t*)((char*)Wb + WO_UKV), M, NUKV, 256}; pg8::StaticOrder S; S.init(M, NUKV, C.G, bid);
              pg8::EpiUkv E{(pg8::bf16_t*)(wsl + WS_KVM), (const float*)(wsl + WS_RSKV)};
              pg8::gemm_phase<pg8::EpiUkv, pg8::StaticOrder, true, true>(ring, g, S, E); }
            ret_scan(C);
            if (rep + 1 < REPS(3)) GRID_BAR(); else SEAM(p + 3); }
        _Pragma("unroll") for (int rep = 0; rep < REPS(4); ++rep) if (PHM(4) && IN(p + 4)) { p4_phase(C, args, layer, MISC + 16, rep); if (rep + 1 < REPS(4)) GRID_BAR(); else SEAM(p + 4); }
        _Pragma("unroll") for (int rep = 0; rep < REPS(5); ++rep) if (PHM(5) && IN(p + 5)) { size_t wz_ = 0; asm volatile("" : "+s"(wz_)); unsigned char* wsl = arg_ws() + wz_; pg8::bf16_t* Wb = (pg8::bf16_t*)(wsl + WS_W); pg8::bf16_t* Hb = (pg8::bf16_t*)(wsl + WS_H);
            { static_assert(WS_BM - WS_A == WS_C - WS_BM && WO_BM - WO_BF == WO_BR - WO_BM, "equally spaced sub-GEMM operands");
              pg8::GemmM g{(const pg8::bf16_t*)(wsl + WS_A), (const pg8::bf16_t*)((char*)Wb + WO_BF), (WS_BM - WS_A) / 2, (WO_BM - WO_BF) / 2, 12, 4, 1024, 1024};
              pg8::StaticOrder3 S; S.init(M, DM, C.G, bid);
              pg8::EpiMergeM E{(const pg8::bf16_t*)(wsl + WS_GATES), Hb};
              pg8::gemm_phase_m<pg8::EpiMergeM, pg8::StaticOrder3, true, true>(ring, g, S, E); }
            if (rep + 1 < REPS(5)) GRID_BAR(); else SEAM(p + 5); }
        _Pragma("unroll") for (int rep = 0; rep < REPS(6); ++rep) if (PHM(6) && IN(p + 6)) { size_t wz_ = 0; asm volatile("" : "+s"(wz_)); unsigned char* wsl = arg_ws() + wz_; pg8::bf16_t* Wb = (pg8::bf16_t*)(wsl + WS_W); pg8::bf16_t* Hb = (pg8::bf16_t*)(wsl + WS_H);
            pg8::Gemm g{Hb, (const pg8::bf16_t*)((char*)Wb + WO_OUT), M, DM, DM}; pg8::StaticOrder S; S.init(M, DM, C.G, bid);
            pg8::EpiResid E{(rep + 1 < REPS(6)) ? (pg8::bf16_t*)(wsl + WS_GATES) : (pg8::bf16_t*)arg_out()}; pg8::gemm_phase<pg8::EpiResid, pg8::StaticOrder, true, true>(ring, g, S, E);
            if (rep + 1 < REPS(6)) GRID_BAR(); else SEAM(p + 6); }
        _Pragma("unroll") for (int rep = 0; rep < REPS(7); ++rep) if (PHM(7) && IN(p + 7)) { rows_rmsnorm_bf16(C, (const bf16*)arg_out(), arg_in(12) + (size_t)layer * DM, (bf16*)(C.ws + WS_H)); if (rep + 1 < REPS(7)) GRID_BAR(); else SEAM(p + 7); }
        _Pragma("unroll") for (int rep = 0; rep < REPS(8); ++rep) if (PHM(8) && IN(p + 8)) { size_t wz_ = 0; asm volatile("" : "+s"(wz_)); unsigned char* wsl = arg_ws() + wz_; pg8::bf16_t* Wb = (pg8::bf16_t*)(wsl + WS_W); pg8::bf16_t* Hb = (pg8::bf16_t*)(wsl + WS_H);
            pg8::Gemm g{Hb, (const pg8::bf16_t*)((char*)Wb + WO_UG), M, NUG, DM}; pg8::StaticOrder S; S.init(M, NUG, C.G, bid);
            pg8::EpiConvAct E{(pg8::bf16_t*)(wsl + WS_ACT), (float*)(wsl + WS_UTAIL), (float*)(wsl + WS_UHEAD), (float*)(wsl + WS_GHEAD), arg_in(15) + (size_t)layer * 3 * DFF, arg_in(16) + (size_t)layer * DFF, (PG8_LAS float*)(C.lds + LDSCTL_OFF + 1024)};
            pg8::gemm_phase<pg8::EpiConvAct, pg8::StaticOrder, true, true>(ring, g, S, E);
            if (rep + 1 < REPS(8)) GRID_BAR(); else SEAM(p + 8); }
        _Pragma("unroll") for (int rep = 0; rep < REPS(9); ++rep) if (PHM(9) && IN(p + 9)) { p9_phase(C, args, layer); if (rep + 1 < REPS(9)) GRID_BAR(); else SEAM(p + 9); }
        _Pragma("unroll") for (int rep = 0; rep < REPS(10); ++rep) if (PHM(10) && IN(p + 10)) { size_t wz_ = 0; asm volatile("" : "+s"(wz_)); unsigned char* wsl = arg_ws() + wz_; pg8::bf16_t* Wb = (pg8::bf16_t*)(wsl + WS_W); pg8::bf16_t* Hb = (pg8::bf16_t*)(wsl + WS_H);
            pg8::Gemm g{(const pg8::bf16_t*)(wsl + WS_ACT), (const pg8::bf16_t*)((char*)Wb + WO_DN), M, DM, DFF}; pg8::StaticOrder S; S.init(M, DM, C.G, bid);
            pg8::EpiResid E{(rep + 1 < REPS(10)) ? (pg8::bf16_t*)(wsl + WS_GATES) : (pg8::bf16_t*)arg_out()}; pg8::gemm_phase<pg8::EpiResid, pg8::StaticOrder, true, true>(ring, g, S, E);
            if (rep + 1 < REPS(10)) GRID_BAR(); else SEAM(p + 10); }
    }
    if (IN(DEPTH * PH)) rows_rmsnorm_final(C, arg_out(), arg_in(18));
#if defined(PROBE_EXTRA_BARRIERS) && !MK_PER_PHASE
    for (int i = 0; i < PROBE_EXTRA_BARRIERS; ++i) GRID_BAR();
#endif
#undef IN
#undef SEAM
#undef GRID_BAR
}

extern "C" void kernel_launch(void* const* d_in, const int* in_sizes, int n_in, void* d_out, int out_size, void* d_ws, size_t ws_size, hipStream_t stream) {
    static int grid = 0;
    if (grid == 0) {
        if (n_in != 19 || out_size != M * DM || ws_size < WS_END) { fprintf(stderr, "kernel_launch: unexpected problem (n_in %d, out %d, ws %zu < %zu); nothing launched\n", n_in, out_size, ws_size, (size_t)WS_END); grid = -1; return; }
        int dev = 0, cus = 0, per_cu = 0;
        if (hipGetDevice(&dev) != hipSuccess || hipDeviceGetAttribute(&cus, hipDeviceAttributeMultiprocessorCount, dev) != hipSuccess) { grid = -1; return; }
        if (hipFuncSetAttribute((const void*)hyb_fwd, hipFuncAttributeMaxDynamicSharedMemorySize, LDS_BYTES) != hipSuccess) { fprintf(stderr, "kernel_launch: hipFuncSetAttribute failed\n"); grid = -1; return; }
        if (hipOccupancyMaxActiveBlocksPerMultiprocessor(&per_cu, (const void*)hyb_fwd, NWAVES * 64, LDS_BYTES) != hipSuccess || per_cu < 1) { fprintf(stderr, "kernel_launch: occupancy query says %d\n", per_cu); }
        (void)hipGetLastError();
        grid = cus;
    }
    if (grid < 0) return;
    (void)in_sizes;
    if (hipMemsetAsync((char*)d_ws + WS_CTL, 0, CTL_ZERO_BYTES, stream) != hipSuccess) return;
    Args a; memset(&a, 0, sizeof(a));
    for (int i = 0; i < 19; ++i) a.in[i] = (const float*)d_in[i];
    a.out = (float*)d_out; a.ws = (unsigned char*)d_ws;
    for (int i = 0; i < 64; ++i) a.invf128[i] = (float)pow(10000.0, -(double)(2 * i) / 128.0);
    for (int i = 0; i < 32; ++i) a.invf64[i] = (float)pow(10000.0, -(double)(2 * i) / 64.0);
#if MK_PER_PHASE
    for (int ph = 0; ph < NPHASE; ++ph) { a.ph_lo = ph; a.ph_hi = ph + 1; hipLaunchKernelGGL(hyb_fwd, dim3(grid), dim3(NWAVES * 64), LDS_BYTES, stream, a); }
#else
    a.ph_lo = 0; a.ph_hi = NPHASE; hipLaunchKernelGGL(hyb_fwd, dim3(grid), dim3(NWAVES * 64), LDS_BYTES, stream, a);
#endif
    const hipError_t le = hipPeekAtLastError();
    if (le != hipSuccess) fprintf(stderr, "kernel_launch: launch failed: %s\n", hipGetErrorName(le));
}
```

```cpp
#include <hip/hip_runtime.h>
#include <cstdio>
#include <cstdint>
#include <cmath>
#ifndef MK_PER_PHASE
#define MK_PER_PHASE 0
#endif
#include <cstring>
namespace pg8 {
#define PG8_LAS __attribute__((address_space(3)))
typedef unsigned short bf16_t;
typedef short bf16x8 __attribute__((ext_vector_type(8)));
typedef float f32x4 __attribute__((ext_vector_type(4)));
typedef unsigned u32x4 __attribute__((ext_vector_type(4)));
constexpr int BM = 256, BK = 64, HALF = 128, HTB = HALF * BK * 2  , STAGE_BYTES = 8 * HTB, NXCD = 8, WGM = 8;

__host__ __device__ __forceinline__ int lds_byte(int r, int c) { const int st = (r >> 4) * 2 + (c >> 5), rr = r & 15, cc = c & 31, ob = rr * 64 + cc * 2; return st * 1024 + (ob ^ (((ob >> 9) & 1) << 5)); }
__host__ __device__ __forceinline__ void stage_rc(int b, int& R, int& C) { const int st = b / 1024, sb = b % 1024, swz = sb ^ (((sb >> 9) & 1) << 5); R = (st >> 1) * 16 + swz / 64; C = (st & 1) * 32 + (swz % 64) / 2; }
__host__ __device__ __forceinline__ int perm32(int rho) { const int n = rho >> 4, i = rho & 15; return 8 * (i >> 2) + 4 * n + (i & 3); }

struct Unit { int pm, pn; };
struct Gemm { const bf16_t* A; const bf16_t* Bt; int M, N, K; };

struct StaticOrder {
    int nM, nN, nwg, G, c;
    __host__ __device__ void init(int M, int N, int G_, int c_) { nM = M / BM; nN = N / BM; nwg = nM * nN; G = G_; c = c_; }
    __host__ __device__ bool next(int i, Unit& u) const {
        const long L = (long)i * G + c; if (L >= nwg) return false;
        int wgid = (int)L; { const int q = nwg / NXCD, r = nwg % NXCD, xcd = wgid % NXCD, off = wgid / NXCD; wgid = (xcd < r ? xcd * (q + 1) : r * (q + 1) + (xcd - r) * q) + off; }
        const int nig = WGM * nN, gid = wgid / nig, fm = gid * WGM, gsz = (nM - fm) < WGM ? (nM - fm) : WGM;
        u.pm = fm + ((wgid % nig) % gsz); u.pn = (wgid % nig) / gsz; return true;
    }
    __device__ __forceinline__ void a_ready(const Unit&) const {}
    __device__ __forceinline__ void done(const Unit&) const {}
};

template <class Epi, class Sched, bool ALIGN_EPI = false, bool SP2 = false>
__device__ __forceinline__ void gemm_phase(PG8_LAS unsigned char* lds, const Gemm g, const Sched& S, const Epi& E) {
    int tid_ = threadIdx.x; asm volatile("" : "+v"(tid_));
    const int tid = tid_, wid = __builtin_amdgcn_readfirstlane(tid >> 6), lane = tid & 63, wr = wid >> 2, wc = wid & 3, fr = lane & 15, fq = lane >> 4;
    int K_ = g.K; asm volatile("" : "+s"(K_)); const int K = K_, nt = K / BK;
    unsigned voffA[2], voffB[2];
#pragma unroll
    for (int i = 0; i < 2; ++i) { int R, C; stage_rc(tid * 16 + i * 8192, R, C); const int Rb = Epi::PERM ? ((R & ~31) + perm32(R & 31)) : R;
        voffA[i] = (unsigned)(R * K + C) * 2u; voffB[i] = (unsigned)(Rb * K + C) * 2u; }
    const size_t kstep = (size_t)(BK * 2);
    const size_t hstep = (size_t)HALF * K * 2;
    const size_t tstep = 2 * hstep;
    const unsigned ldsw = (unsigned)wid * 1024u;
    const int aoff = lds_byte(wr * 64 + fr, fq * 8), boff = lds_byte(wc * 32 + fr, fq * 8);
#define PG8_SA(b, h) (((b) * 2 + (h)) * HTB)
#define PG8_SB(b, h) ((4 + (b) * 2 + (h)) * HTB)
#define PG8_STAGE(bufoff, gbase, voff) do { _Pragma("unroll") for (int _i = 0; _i < 2; ++_i) \
        __builtin_amdgcn_global_load_lds((const unsigned*)((const char*)(gbase) + (voff)[_i]), (PG8_LAS unsigned*)(lds + (bufoff) + ldsw + _i * 8192), 16, 0, 0); } while (0)
#define PG8_LDA(dst, b, h) do { _Pragma("unroll") for (int m = 0; m < 4; ++m) _Pragma("unroll") for (int k = 0; k < 2; ++k) dst[m][k] = *(const PG8_LAS bf16x8*)(lds + PG8_SA(b, h) + aoff + m * 2048 + k * 1024); } while (0)
#define PG8_LDB(dst, b, h) do { _Pragma("unroll") for (int n = 0; n < 2; ++n) _Pragma("unroll") for (int k = 0; k < 2; ++k) dst[n][k] = *(const PG8_LAS bf16x8*)(lds + PG8_SB(b, h) + boff + n * 2048 + k * 1024); } while (0)
#define PG8_MMA(ai, bj, At, Bt) do { __builtin_amdgcn_s_setprio(1); _Pragma("unroll") for (int m = 0; m < 4; ++m) _Pragma("unroll") for (int n = 0; n < 2; ++n) _Pragma("unroll") for (int k = 0; k < 2; ++k) \
        acc[ai][bj][m][n] = __builtin_amdgcn_mfma_f32_16x16x32_bf16(Bt[n][k], At[m][k], acc[ai][bj][m][n], 0, 0, 0); __builtin_amdgcn_s_setprio(0); } while (0)
#define PG8_WAIT_V(n) asm volatile("s_waitcnt vmcnt(" #n ")" ::: "memory")
#define PG8_WAIT_L(n) asm volatile("s_waitcnt lgkmcnt(" #n ")" ::: "memory")
#define PG8_BAR __builtin_amdgcn_s_barrier()
#define PG8_SCHED __builtin_amdgcn_sched_barrier(0)
    Unit cur, nxt; int ui = 0;
    if (!S.next(0, cur)) return;
    f32x4 acc[2][2][4][2];
#pragma unroll
    for (int a = 0; a < 2; ++a)
#pragma unroll
        for (int b = 0; b < 2; ++b)
#pragma unroll
            for (int m = 0; m < 4; ++m)
#pragma unroll
                for (int n = 0; n < 2; ++n) acc[a][b][m][n] = (f32x4){0.f, 0.f, 0.f, 0.f};
    bf16x8 At[4][2], B0[2][2], B1[2][2];
    const char* cA = (const char*)g.A + (size_t)cur.pm * tstep; const char* cB = (const char*)g.Bt + (size_t)cur.pn * tstep;
    S.a_ready(cur);
    if constexpr (SP2) {
        PG8_STAGE(PG8_SB(0, 0), cB, voffB); PG8_STAGE(PG8_SB(0, 1), cB + hstep, voffB); PG8_STAGE(PG8_SA(0, 0), cA, voffA); PG8_STAGE(PG8_SA(0, 1), cA + hstep, voffA);
        if (wr == 1) PG8_BAR;
        PG8_WAIT_V(2); PG8_BAR;
        PG8_STAGE(PG8_SB(1, 0), cB + kstep, voffB); PG8_STAGE(PG8_SA(1, 0), cA + kstep, voffA); PG8_STAGE(PG8_SB(1, 1), cB + hstep + kstep, voffB);
        PG8_WAIT_V(6); PG8_BAR;
    } else {
        PG8_STAGE(PG8_SB(0, 0), cB, voffB); PG8_STAGE(PG8_SA(0, 0), cA, voffA); PG8_STAGE(PG8_SB(0, 1), cB + hstep, voffB); PG8_STAGE(PG8_SA(0, 1), cA + hstep, voffA);
        if (wr == 1) PG8_BAR;
        PG8_WAIT_V(4); PG8_BAR;
        PG8_STAGE(PG8_SB(1, 0), cB + kstep, voffB); PG8_STAGE(PG8_SA(1, 0), cA + kstep, voffA); PG8_STAGE(PG8_SB(1, 1), cB + hstep + kstep, voffB);
        PG8_WAIT_V(6); PG8_BAR;
    }
    for (;;) {
        const bool has_next = S.next(ui + 1, nxt);
        const char* nA = has_next ? (const char*)g.A + (size_t)nxt.pm * tstep : cA; const char* nB = has_next ? (const char*)g.Bt + (size_t)nxt.pn * tstep : cB;
        for (int t = 0; t < nt; t += 2) {
            const bool last = (t == nt - 2);
            const char* a1 = cA + (size_t)(t + 1) * kstep;
            const char* a2 = last ? nA : cA + (size_t)(t + 2) * kstep; const char* b2 = last ? nB : cB + (size_t)(t + 2) * kstep;
            const char* a3 = a2 + kstep; const char* b3 = b2 + kstep;
            if (last && has_next) S.a_ready(nxt);
            if constexpr (SP2) {
            PG8_LDB(B0, 0, 0); PG8_LDB(B1, 0, 1); PG8_SCHED; PG8_LDA(At, 0, 0); PG8_STAGE(PG8_SA(1, 1), a1 + hstep, voffA);
            PG8_WAIT_V(8); PG8_WAIT_L(0); PG8_BAR; PG8_MMA(0, 0, At, B0); PG8_MMA(0, 1, At, B1); PG8_BAR; PG8_SCHED;
            PG8_LDA(At, 0, 1); PG8_STAGE(PG8_SB(0, 0), b2, voffB); PG8_STAGE(PG8_SB(0, 1), b2 + hstep, voffB); PG8_STAGE(PG8_SA(0, 0), a2, voffA);
            PG8_WAIT_V(8); PG8_WAIT_L(0); PG8_BAR; PG8_MMA(1, 0, At, B0); PG8_MMA(1, 1, At, B1); PG8_BAR; PG8_SCHED;
            PG8_LDB(B0, 1, 0); PG8_LDB(B1, 1, 1); PG8_SCHED; PG8_LDA(At, 1, 0); PG8_STAGE(PG8_SA(0, 1), a2 + hstep, voffA);
            PG8_WAIT_V(8); PG8_WAIT_L(0); PG8_BAR; PG8_MMA(0, 0, At, B0); PG8_MMA(0, 1, At, B1); PG8_BAR; PG8_SCHED;
            PG8_LDA(At, 1, 1); PG8_STAGE(PG8_SB(1, 0), b3, voffB); PG8_STAGE(PG8_SB(1, 1), b3 + hstep, voffB); PG8_STAGE(PG8_SA(1, 0), a3, voffA);
            PG8_WAIT_V(8); PG8_WAIT_L(0); PG8_BAR; PG8_MMA(1, 0, At, B0); PG8_MMA(1, 1, At, B1); PG8_BAR; PG8_SCHED;
            } else {
            PG8_LDB(B0, 0, 0); PG8_SCHED; PG8_LDA(At, 0, 0); PG8_STAGE(PG8_SA(1, 1), a1 + hstep, voffA);
            PG8_WAIT_L(8); PG8_BAR; PG8_WAIT_L(0); PG8_MMA(0, 0, At, B0); PG8_BAR; PG8_SCHED;
            PG8_LDB(B1, 0, 1); PG8_STAGE(PG8_SB(0, 0), b2, voffB);
            PG8_BAR; PG8_WAIT_L(0); PG8_MMA(0, 1, At, B1); PG8_BAR;
            PG8_LDA(At, 0, 1); PG8_STAGE(PG8_SA(0, 0), a2, voffA);
            PG8_BAR; PG8_WAIT_L(0); PG8_MMA(1, 0, At, B0); PG8_BAR; PG8_SCHED;
            PG8_STAGE(PG8_SB(0, 1), b2 + hstep, voffB);
            PG8_WAIT_V(6); PG8_BAR; PG8_MMA(1, 1, At, B1); PG8_BAR;
            PG8_LDB(B0, 1, 0); PG8_SCHED; PG8_LDA(At, 1, 0); PG8_STAGE(PG8_SA(0, 1), a2 + hstep, voffA);
            PG8_WAIT_L(8); PG8_BAR; PG8_WAIT_L(0); PG8_MMA(0, 0, At, B0); PG8_BAR; PG8_SCHED;
            PG8_LDB(B1, 1, 1); PG8_STAGE(PG8_SB(1, 0), b3, voffB);
            PG8_BAR; PG8_WAIT_L(0); PG8_MMA(0, 1, At, B1); PG8_BAR;
            PG8_LDA(At, 1, 1); PG8_STAGE(PG8_SA(1, 0), a3, voffA);
            PG8_BAR; PG8_WAIT_L(0); PG8_MMA(1, 0, At, B0); PG8_BAR; PG8_SCHED;
            PG8_STAGE(PG8_SB(1, 1), b3 + hstep, voffB);
            PG8_WAIT_V(6); PG8_BAR; PG8_MMA(1, 1, At, B1); PG8_BAR;
            }
        }
        if constexpr (ALIGN_EPI) { if (wr == 0) PG8_BAR; }
        if constexpr (!Epi::AFTER_DRAIN) { E(acc, cur, wr, wc, fr, fq); S.done(cur); }
        if (!has_next) break;
#pragma unroll
        for (int a = 0; a < 2; ++a)
#pragma unroll
            for (int b = 0; b < 2; ++b)
#pragma unroll
                for (int m = 0; m < 4; ++m)
#pragma unroll
                    for (int n = 0; n < 2; ++n) acc[a][b][m][n] = (f32x4){0.f, 0.f, 0.f, 0.f};
        cur = nxt; cA = nA; cB = nB; ++ui;
        if constexpr (ALIGN_EPI) { if (wr == 1) PG8_BAR; }
    }
    PG8_WAIT_V(0);
    if constexpr (!ALIGN_EPI) { if (wr == 0) PG8_BAR; }
    PG8_BAR;
    if constexpr (Epi::AFTER_DRAIN) { E.fused(acc, cur, wr, wc, fr, fq, lds, wid, lane); S.done(cur); }
#undef PG8_SA
#undef PG8_SB
#undef PG8_STAGE
#undef PG8_LDA
#undef PG8_LDB
#undef PG8_MMA
#undef PG8_WAIT_V
#undef PG8_WAIT_L
#undef PG8_BAR
#undef PG8_SCHED
}

struct UnitM { int pm, pn, sub; };
struct GemmM { const bf16_t* A0; const bf16_t* B0; size_t strideA, strideB; int nt0, dnt2; int lda, ldb;
    __device__ __forceinline__ const bf16_t* a(int s) const { return A0 + (size_t)s * strideA; }
    __device__ __forceinline__ const bf16_t* b(int s) const { return B0 + (size_t)s * strideB; }
    __device__ __forceinline__ int nt(int s) const { return nt0 + (s >> 1) * dnt2; } };
struct StaticOrder3 {
    StaticOrder S;
    __device__ void init(int M, int N, int G_, int c_) { S.init(M, N, G_, c_); }
    __device__ bool next(int i, UnitM& u) const { Unit t; if (!S.next(i / 3, t)) return false; u.pm = t.pm; u.pn = t.pn; u.sub = i - 3 * (i / 3); return true; }
    __device__ __forceinline__ void a_ready(const UnitM&) const {}
    __device__ __forceinline__ void done(const UnitM&) const {}
};
template <class Epi, class Sched, bool ALIGN_EPI = false, bool SP2 = false>
__device__ __forceinline__ void gemm_phase_m(PG8_LAS unsigned char* lds, const GemmM g, const Sched& S, const Epi& E) {
    int tid_ = threadIdx.x; asm volatile("" : "+v"(tid_));
    const int tid = tid_, wid = __builtin_amdgcn_readfirstlane(tid >> 6), lane = tid & 63, wr = wid >> 2, wc = wid & 3, fr = lane & 15, fq = lane >> 4;
    int lda_ = g.lda, ldb_ = g.ldb; asm volatile("" : "+s"(lda_), "+s"(ldb_)); const int lda = lda_, ldb = ldb_; int nt;
    unsigned voffA[2], voffB[2];
#pragma unroll
    for (int i = 0; i < 2; ++i) { int R, C; stage_rc(tid * 16 + i * 8192, R, C); const int Rb = Epi::PERM ? ((R & ~31) + perm32(R & 31)) : R;
        voffA[i] = (unsigned)(R * lda + C) * 2u; voffB[i] = (unsigned)(Rb * ldb + C) * 2u; }
    const size_t kstep = (size_t)(BK * 2);
    const size_t hstepA = (size_t)HALF * lda * 2, hstepB = (size_t)HALF * ldb * 2;
    const size_t tstepA = 2 * hstepA, tstepB = 2 * hstepB;
    const unsigned ldsw = (unsigned)wid * 1024u;
    const int aoff = lds_byte(wr * 64 + fr, fq * 8), boff = lds_byte(wc * 32 + fr, fq * 8);
#define PG8_SA(b, h) (((b) * 2 + (h)) * HTB)
#define PG8_SB(b, h) ((4 + (b) * 2 + (h)) * HTB)
#define PG8_STAGE(bufoff, gbase, voff) do { _Pragma("unroll") for (int _i = 0; _i < 2; ++_i) \
        __builtin_amdgcn_global_load_lds((const unsigned*)((const char*)(gbase) + (voff)[_i]), (PG8_LAS unsigned*)(lds + (bufoff) + ldsw + _i * 8192), 16, 0, 0); } while (0)
#define PG8_LDA(dst, b, h) do { _Pragma("unroll") for (int m = 0; m < 4; ++m) _Pragma("unroll") for (int k = 0; k < 2; ++k) dst[m][k] = *(const PG8_LAS bf16x8*)(lds + PG8_SA(b, h) + aoff + m * 2048 + k * 1024); } while (0)
#define PG8_LDB(dst, b, h) do { _Pragma("unroll") for (int n = 0; n < 2; ++n) _Pragma("unroll") for (int k = 0; k < 2; ++k) dst[n][k] = *(const PG8_LAS bf16x8*)(lds + PG8_SB(b, h) + boff + n * 2048 + k * 1024); } while (0)
#define PG8_MMA(ai, bj, At, Bt) do { __builtin_amdgcn_s_setprio(1); _Pragma("unroll") for (int m = 0; m < 4; ++m) _Pragma("unroll") for (int n = 0; n < 2; ++n) _Pragma("unroll") for (int k = 0; k < 2; ++k) \
        acc[ai][bj][m][n] = __builtin_amdgcn_mfma_f32_16x16x32_bf16(Bt[n][k], At[m][k], acc[ai][bj][m][n], 0, 0, 0); __builtin_amdgcn_s_setprio(0); } while (0)
#define PG8_WAIT_V(n) asm volatile("s_waitcnt vmcnt(" #n ")" ::: "memory")
#define PG8_WAIT_L(n) asm volatile("s_waitcnt lgkmcnt(" #n ")" ::: "memory")
#define PG8_BAR __builtin_amdgcn_s_barrier()
#define PG8_SCHED __builtin_amdgcn_sched_barrier(0)
    UnitM cur, nxt; int ui = 0;
    if (!S.next(0, cur)) return;
    f32x4 acc[2][2][4][2];
#pragma unroll
    for (int a = 0; a < 2; ++a)
#pragma unroll
        for (int b = 0; b < 2; ++b)
#pragma unroll
            for (int m = 0; m < 4; ++m)
#pragma unroll
                for (int n = 0; n < 2; ++n) acc[a][b][m][n] = (f32x4){0.f, 0.f, 0.f, 0.f};
    bf16x8 At[4][2], B0[2][2], B1[2][2];
    const char* cA = (const char*)g.a(cur.sub) + (size_t)cur.pm * tstepA; const char* cB = (const char*)g.b(cur.sub) + (size_t)cur.pn * tstepB; nt = g.nt(cur.sub);
    S.a_ready(cur);
    if constexpr (SP2) {
        PG8_STAGE(PG8_SB(0, 0), cB, voffB); PG8_STAGE(PG8_SB(0, 1), cB + hstepB, voffB); PG8_STAGE(PG8_SA(0, 0), cA, voffA); PG8_STAGE(PG8_SA(0, 1), cA + hstepA, voffA);
        if (wr == 1) PG8_BAR;
        PG8_WAIT_V(2); PG8_BAR;
        PG8_STAGE(PG8_SB(1, 0), cB + kstep, voffB); PG8_STAGE(PG8_SA(1, 0), cA + kstep, voffA); PG8_STAGE(PG8_SB(1, 1), cB + hstepB + kstep, voffB);
        PG8_WAIT_V(6); PG8_BAR;
    } else {
        PG8_STAGE(PG8_SB(0, 0), cB, voffB); PG8_STAGE(PG8_SA(0, 0), cA, voffA); PG8_STAGE(PG8_SB(0, 1), cB + hstepB, voffB); PG8_STAGE(PG8_SA(0, 1), cA + hstepA, voffA);
        if (wr == 1) PG8_BAR;
        PG8_WAIT_V(4); PG8_BAR;
        PG8_STAGE(PG8_SB(1, 0), cB + kstep, voffB); PG8_STAGE(PG8_SA(1, 0), cA + kstep, voffA); PG8_STAGE(PG8_SB(1, 1), cB + hstepB + kstep, voffB);
        PG8_WAIT_V(6); PG8_BAR;
    }
    for (;;) {
        const bool has_next = S.next(ui + 1, nxt);
        const char* nA = has_next ? (const char*)g.a(nxt.sub) + (size_t)nxt.pm * tstepA : cA; const char* nB = has_next ? (const char*)g.b(nxt.sub) + (size_t)nxt.pn * tstepB : cB;
        for (int t = 0; t < nt; t += 2) {
            const bool last = (t == nt - 2);
            const char* a1 = cA + (size_t)(t + 1) * kstep;
            const char* a2 = last ? nA : cA + (size_t)(t + 2) * kstep; const char* b2 = last ? nB : cB + (size_t)(t + 2) * kstep;
            const char* a3 = a2 + kstep; const char* b3 = b2 + kstep;
            if (last && has_next) S.a_ready(nxt);
            if constexpr (SP2) {
            PG8_LDB(B0, 0, 0); PG8_LDB(B1, 0, 1); PG8_SCHED; PG8_LDA(At, 0, 0); PG8_STAGE(PG8_SA(1, 1), a1 + hstepA, voffA);
            PG8_WAIT_V(8); PG8_WAIT_L(0); PG8_BAR; PG8_MMA(0, 0, At, B0); PG8_MMA(0, 1, At, B1); PG8_BAR; PG8_SCHED;
            PG8_LDA(At, 0, 1); PG8_STAGE(PG8_SB(0, 0), b2, voffB); PG8_STAGE(PG8_SB(0, 1), b2 + hstepB, voffB); PG8_STAGE(PG8_SA(0, 0), a2, voffA);
            PG8_WAIT_V(8); PG8_WAIT_L(0); PG8_BAR; PG8_MMA(1, 0, At, B0); PG8_MMA(1, 1, At, B1); PG8_BAR; PG8_SCHED;
            PG8_LDB(B0, 1, 0); PG8_LDB(B1, 1, 1); PG8_SCHED; PG8_LDA(At, 1, 0); PG8_STAGE(PG8_SA(0, 1), a2 + hstepA, voffA);
            PG8_WAIT_V(8); PG8_WAIT_L(0); PG8_BAR; PG8_MMA(0, 0, At, B0); PG8_MMA(0, 1, At, B1); PG8_BAR; PG8_SCHED;
            PG8_LDA(At, 1, 1); PG8_STAGE(PG8_SB(1, 0), b3, voffB); PG8_STAGE(PG8_SB(1, 1), b3 + hstepB, voffB); PG8_STAGE(PG8_SA(1, 0), a3, voffA);
            PG8_WAIT_V(8); PG8_WAIT_L(0); PG8_BAR; PG8_MMA(1, 0, At, B0); PG8_MMA(1, 1, At, B1); PG8_BAR; PG8_SCHED;
            } else {
            PG8_LDB(B0, 0, 0); PG8_SCHED; PG8_LDA(At, 0, 0); PG8_STAGE(PG8_SA(1, 1), a1 + hstepA, voffA);
            PG8_WAIT_L(8); PG8_BAR; PG8_WAIT_L(0); PG8_MMA(0, 0, At, B0); PG8_BAR; PG8_SCHED;
            PG8_LDB(B1, 0, 1); PG8_STAGE(PG8_SB(0, 0), b2, voffB);
            PG8_BAR; PG8_WAIT_L(0); PG8_MMA(0, 1, At, B1); PG8_BAR;
            PG8_LDA(At, 0, 1); PG8_STAGE(PG8_SA(0, 0), a2, voffA);
            PG8_BAR; PG8_WAIT_L(0); PG8_MMA(1, 0, At, B0); PG8_BAR; PG8_SCHED;
            PG8_STAGE(PG8_SB(0, 1), b2 + hstepB, voffB);
            PG8_WAIT_V(6); PG8_BAR; PG8_MMA(1, 1, At, B1); PG8_BAR;
            PG8_LDB(B0, 1, 0); PG8_SCHED; PG8_LDA(At, 1, 0); PG8_STAGE(PG8_SA(0, 1), a2 + hstepA, voffA);
            PG8_WAIT_L(8); PG8_BAR; PG8_WAIT_L(0); PG8_MMA(0, 0, At, B0); PG8_BAR; PG8_SCHED;
            PG8_LDB(B1, 1, 1); PG8_STAGE(PG8_SB(1, 0), b3, voffB);
            PG8_BAR; PG8_WAIT_L(0); PG8_MMA(0, 1, At, B1); PG8_BAR;
            PG8_LDA(At, 1, 1); PG8_STAGE(PG8_SA(1, 0), a3, voffA);
            PG8_BAR; PG8_WAIT_L(0); PG8_MMA(1, 0, At, B0); PG8_BAR; PG8_SCHED;
            PG8_STAGE(PG8_SB(1, 1), b3 + hstepB, voffB);
            PG8_WAIT_V(6); PG8_BAR; PG8_MMA(1, 1, At, B1); PG8_BAR;
            }
        }
        if constexpr (ALIGN_EPI) { if (wr == 0) PG8_BAR; }
        if constexpr (!Epi::AFTER_DRAIN) { E(acc, cur, wr, wc, fr, fq); S.done(cur); }
        if (!has_next) break;
        if (nxt.sub == 0) {
#pragma unroll
        for (int a = 0; a < 2; ++a)
#pragma unroll
            for (int b = 0; b < 2; ++b)
#pragma unroll
                for (int m = 0; m < 4; ++m)
#pragma unroll
                    for (int n = 0; n < 2; ++n) acc[a][b][m][n] = (f32x4){0.f, 0.f, 0.f, 0.f}; }
        cur = nxt; cA = nA; cB = nB; ++ui; nt = g.nt(cur.sub);
        if constexpr (ALIGN_EPI) { if (wr == 1) PG8_BAR; }
    }
    PG8_WAIT_V(0);
    if constexpr (!ALIGN_EPI) { if (wr == 0) PG8_BAR; }
    PG8_BAR;
    if constexpr (Epi::AFTER_DRAIN) { E.fused(acc, cur, wr, wc, fr, fq, lds, wid, lane); S.done(cur); }
#undef PG8_SA
#undef PG8_SB
#undef PG8_STAGE
#undef PG8_LDA
#undef PG8_LDB
#undef PG8_MMA
#undef PG8_WAIT_V
#undef PG8_WAIT_L
#undef PG8_BAR
#undef PG8_SCHED
}
}

namespace pg8 {
typedef float f32x2 __attribute__((ext_vector_type(2)));
__device__ __forceinline__ unsigned cvt_pk_bf16(float lo, float hi) { unsigned r; asm volatile("v_cvt_pk_bf16_f32 %0, %1, %2" : "=v"(r) : "v"(lo), "v"(hi)); return r; }
__device__ __forceinline__ void store8(bf16_t* p, const f32x4 v0, const f32x4 v1) {
    u32x4 w; w.x = cvt_pk_bf16(v0[0], v0[1]); w.y = cvt_pk_bf16(v0[2], v0[3]); w.z = cvt_pk_bf16(v1[0], v1[1]); w.w = cvt_pk_bf16(v1[2], v1[3]); *(u32x4*)p = w; }
__device__ __forceinline__ float fsigmoid(float x) { return __builtin_amdgcn_rcpf(1.0f + __builtin_amdgcn_exp2f(-1.4426950408889634f * x)); }
__device__ __forceinline__ f32x4 act4(const f32x4 v, const int ACT) {
    if (ACT == 0) return v;
    f32x4 o;
#pragma unroll
    for (int j = 0; j < 4; ++j) { const float s = fsigmoid(v[j]); o[j] = (ACT == 1) ? v[j] * s : s; }
    return o; }
__device__ __forceinline__ void bf8_to_f32(const u32x4 w, f32x4& a, f32x4& b) {
    a[0] = __uint_as_float(w.x << 16); a[1] = __uint_as_float(w.x & 0xffff0000u); a[2] = __uint_as_float(w.y << 16); a[3] = __uint_as_float(w.y & 0xffff0000u);
    b[0] = __uint_as_float(w.z << 16); b[1] = __uint_as_float(w.z & 0xffff0000u); b[2] = __uint_as_float(w.w << 16); b[3] = __uint_as_float(w.w & 0xffff0000u); }

constexpr int SEQ_MASK = 4095;
constexpr float MLA_QSCALE = 0.07216878364870322f * 1.4426950408889634f;
__device__ __forceinline__ void rope4(const float* tab, const f32x4 a, const f32x4 b, float sc, bf16_t* p1, bf16_t* p2) {
    typedef unsigned u32x2 __attribute__((ext_vector_type(2)));
    const f32x4 t0 = *(const f32x4*)(tab), t1 = *(const f32x4*)(tab + 4);
    const float o10 = (a[0] * t0[0] - b[0] * t0[1]) * sc, o20 = (b[0] * t0[0] + a[0] * t0[1]) * sc;
    const float o11 = (a[1] * t0[2] - b[1] * t0[3]) * sc, o21 = (b[1] * t0[2] + a[1] * t0[3]) * sc;
    const float o12 = (a[2] * t1[0] - b[2] * t1[1]) * sc, o22 = (b[2] * t1[0] + a[2] * t1[1]) * sc;
    const float o13 = (a[3] * t1[2] - b[3] * t1[3]) * sc, o23 = (b[3] * t1[2] + a[3] * t1[3]) * sc;
    u32x2 w1, w2; w1.x = cvt_pk_bf16(o10, o11); w1.y = cvt_pk_bf16(o12, o13); w2.x = cvt_pk_bf16(o20, o21); w2.y = cvt_pk_bf16(o22, o23);
    *(u32x2*)p1 = w1; *(u32x2*)p2 = w2;
}
#define EPI_FENCE() asm volatile("" ::: "memory")

struct EpiInProj {
    static constexpr bool PERM = true, AFTER_DRAIN = false;
    unsigned char* ws; size_t o_fqkv, o_cq, o_ckv, o_kr, o_rq, o_rk, o_rv, o_rg, o_gates, o_ff, o_t128, o_t64; int skip;
    __device__ __forceinline__ void plain(const f32x4 (&acc)[2][2][4][2], bf16_t* dst, int ld, int colbase, int act, int row0, int wc, int fq) const {
        const int col0 = colbase + wc * 32 + 8 * fq;
#pragma unroll
        for (int ai = 0; ai < 2; ++ai)
#pragma unroll
            for (int m = 0; m < 4; ++m) { bf16_t* rowp = dst + (size_t)(row0 + ai * HALF + m * 16) * ld + col0;
#pragma unroll
                for (int bj = 0; bj < 2; ++bj) { f32x4 v0 = acc[ai][bj][m][0], v1 = acc[ai][bj][m][1];
                    if (act) {
#pragma unroll
                        for (int j = 0; j < 4; ++j) { const float s0 = fsigmoid(v0[j]), s1 = fsigmoid(v1[j]); v0[j] = (act == 1) ? v0[j] * s0 : s0; v1[j] = (act == 1) ? v1[j] * s1 : s1; } }
                    if (skip == 2) { u32x4 w; w.x = cvt_pk_bf16(v0[0], v0[1]); w.y = cvt_pk_bf16(v0[2], v0[3]); w.z = cvt_pk_bf16(v1[0], v1[1]); w.w = cvt_pk_bf16(v1[2], v1[3]); asm volatile("" :: "v"(w)); }
                    else store8(rowp + bj * HALF, v0, v1); }
                EPI_FENCE(); }
    }
    __device__ __forceinline__ void gate_pair(const f32x4 (&acc)[2][2][4][2], bf16_t* dst, int j, int row0, int wc, int fq) const {
        const int col0 = 128 * j + wc * 32 + 8 * fq;
#pragma unroll
        for (int ai = 0; ai < 2; ++ai)
#pragma unroll
            for (int m = 0; m < 4; ++m) { bf16_t* rowp = dst + (size_t)(row0 + ai * HALF + m * 16) * 6144 + col0;
                f32x4 r[2], g[2];
#pragma unroll
                for (int n = 0; n < 2; ++n)
#pragma unroll
                    for (int e = 0; e < 4; ++e) { const float g0 = fmaxf(fsigmoid(acc[ai][0][m][n][e]), 1e-30f), g1 = fmaxf(fsigmoid(acc[ai][1][m][n][e]), 1e-30f);
                        const float g1r = __uint_as_float(cvt_pk_bf16(g1, g1) << 16);
                        g[n][e] = g1r; r[n][e] = g0 * __builtin_amdgcn_rcpf(g1r); }
                store8(rowp, r[0], r[1]); store8(rowp + 2048, g[0], g[1]);
                EPI_FENCE(); }
    }
    __device__ __forceinline__ void rope128(const f32x4 (&acc)[2][2][4][2], bf16_t* dst, int t, float sc, int row0, int wc, int fq) const {
        const int x = 32 * wc + 8 * fq, hh = x >> 6, i0 = x & 63, head = 2 * t + hh; const float* T128 = (const float*)(ws + o_t128);
#pragma unroll
        for (int ai = 0; ai < 2; ++ai)
#pragma unroll
            for (int m = 0; m < 4; ++m) { const int row = row0 + ai * HALF + m * 16, pos = row & SEQ_MASK;
                const float* tp = T128 + ((size_t)pos * 64 + i0) * 2; bf16_t* p = dst + (size_t)row * 512 + 128 * head + i0;
                rope4(tp, acc[ai][0][m][0], acc[ai][1][m][0], sc, p, p + 64); rope4(tp + 8, acc[ai][0][m][1], acc[ai][1][m][1], sc, p + 4, p + 68);
                EPI_FENCE(); }
    }
    __device__ __forceinline__ void misc(const f32x4 (&acc)[2][2][4][2], int row0, int wc, int fq) const {
        if (wc == 0) { const int i0 = 8 * fq; const float* T64 = (const float*)(ws + o_t64); bf16_t* kr = (bf16_t*)(ws + o_kr);
#pragma unroll
            for (int ai = 0; ai < 2; ++ai)
#pragma unroll
                for (int m = 0; m < 4; ++m) { const int row = row0 + ai * HALF + m * 16, pos = row & SEQ_MASK;
                    const float* tp = T64 + ((size_t)pos * 32 + i0) * 2; bf16_t* p = kr + (size_t)row * 64 + i0;
                    rope4(tp, acc[ai][0][m][0], acc[ai][1][m][0], 1.0f, p, p + 32); rope4(tp + 8, acc[ai][0][m][1], acc[ai][1][m][1], 1.0f, p + 4, p + 36);
                    EPI_FENCE(); }
        } else if (wc == 1) { if (fq == 0) { float* ff = (float*)(ws + o_ff);
#pragma unroll
            for (int ai = 0; ai < 2; ++ai)
#pragma unroll
                for (int m = 0; m < 4; ++m) { const int row = row0 + ai * HALF + m * 16; float* p = ff + (size_t)row * 8; *(f32x4*)p = acc[ai][0][m][0]; *(f32x4*)(p + 4) = acc[ai][0][m][1]; } } }
    }
    __device__ __forceinline__ void operator()(const f32x4 (&acc)[2][2][4][2], const Unit& u, int wr, int wc, int fr, int fq) const {
        const int pn = u.pn, row0 = u.pm * BM + wr * 64 + fr;
        if (skip == 1) {
#pragma unroll
            for (int ai = 0; ai < 2; ++ai)
#pragma unroll
                for (int bj = 0; bj < 2; ++bj)
#pragma unroll
                    for (int m = 0; m < 4; ++m) asm volatile("" :: "v"(acc[ai][bj][m][0]), "v"(acc[ai][bj][m][1]));
            return; }
        if (pn >= 25 && pn < 41) gate_pair(acc, (bf16_t*)(ws + o_gates), pn - 25, row0, wc, fq);
        else if (pn == 12) misc(acc, row0, wc, fq);
        else if (pn >= 13 && pn < 17) { const bool isk = pn >= 15; rope128(acc, (bf16_t*)(ws + (isk ? o_rk : o_rq)), isk ? pn - 15 : pn - 13, isk ? 0.08838834764831845f : 1.0f, row0, wc, fq); }
        else { size_t off; int ld, cb, act = 0;
            if (pn < 9) { off = o_fqkv; ld = 2304; cb = 256 * pn; }
            else if (pn < 11) { off = o_cq; ld = 512; cb = 256 * (pn - 9); }
            else if (pn == 11) { off = o_ckv; ld = 256; cb = 0; }
            else if (pn < 21) { off = o_rv; ld = 1024; cb = 256 * (pn - 17); }
            else if (pn < 25) { off = o_rg; ld = 1024; cb = 256 * (pn - 21); act = 1; }
            else { off = o_gates; ld = 6144; cb = 256 * (pn - 25); act = 2; }
            plain(acc, (bf16_t*)(ws + off), ld, cb, act, row0, wc, fq); }
    }
};

struct EpiUq {
    static constexpr bool PERM = true, AFTER_DRAIN = false;
    bf16_t* qm; const float* rstd; const float* T64;
    __device__ __forceinline__ void operator()(const f32x4 (&acc)[2][2][4][2], const Unit& u, int wr, int wc, int fr, int fq) const {
        const int pn = u.pn, row0 = u.pm * BM + wr * 64 + fr;
        float rsv[2][4];
#pragma unroll
        for (int ai = 0; ai < 2; ++ai)
#pragma unroll
            for (int m = 0; m < 4; ++m) rsv[ai][m] = rstd[row0 + ai * HALF + m * 16] * MLA_QSCALE;
        if (pn < 3) {
#pragma unroll
            for (int ai = 0; ai < 2; ++ai)
#pragma unroll
                for (int m = 0; m < 4; ++m) { const int row = row0 + ai * HALF + m * 16; const float rs = rsv[ai][m];
#pragma unroll
                    for (int bj = 0; bj < 2; ++bj) store8(qm + (size_t)row * 1152 + 192 * (2 * pn + bj) + 32 * wc + 8 * fq, acc[ai][bj][m][0] * rs, acc[ai][bj][m][1] * rs);
                    EPI_FENCE(); }
        } else { const int head = (pn == 3) ? wc : 4 + wc; if (head < 6) { const int i0 = 8 * fq;
#pragma unroll
            for (int ai = 0; ai < 2; ++ai)
#pragma unroll
                for (int m = 0; m < 4; ++m) { const int row = row0 + ai * HALF + m * 16, pos = row & SEQ_MASK; const float rs = rsv[ai][m];
                    const float* tp = T64 + ((size_t)pos * 32 + i0) * 2; bf16_t* p = qm + (size_t)row * 1152 + 192 * head + 128 + i0;
                    rope4(tp, acc[ai][0][m][0], acc[ai][1][m][0], rs, p, p + 32); rope4(tp + 8, acc[ai][0][m][1], acc[ai][1][m][1], rs, p + 4, p + 36);
                    EPI_FENCE(); } } }
    }
};
struct EpiUkv {
    static constexpr bool PERM = true, AFTER_DRAIN = false;
    bf16_t* kvm; const float* rstd;
    __device__ __forceinline__ void operator()(const f32x4 (&acc)[2][2][4][2], const Unit& u, int wr, int wc, int fr, int fq) const {
        const int row0 = u.pm * BM + wr * 64 + fr, col0 = u.pn * BM + wc * 32 + 8 * fq;
        float rsv[2][4];
#pragma unroll
        for (int ai = 0; ai < 2; ++ai)
#pragma unroll
            for (int m = 0; m < 4; ++m) rsv[ai][m] = rstd[row0 + ai * HALF + m * 16];
#pragma unroll
        for (int ai = 0; ai < 2; ++ai)
#pragma unroll
            for (int m = 0; m < 4; ++m) { const int row = row0 + ai * HALF + m * 16; const float rs = rsv[ai][m];
#pragma unroll
                for (int bj = 0; bj < 2; ++bj) store8(kvm + (size_t)row * 1536 + col0 + bj * HALF, acc[ai][bj][m][0] * rs, acc[ai][bj][m][1] * rs);
                EPI_FENCE(); }
    }
};
template <int PASS> struct EpiMerge {
    static constexpr bool PERM = true, AFTER_DRAIN = false;
    const bf16_t* gates; float* tmp; bf16_t* out;
    __device__ __forceinline__ void operator()(const f32x4 (&acc)[2][2][4][2], const Unit& u, int wr, int wc, int fr, int fq) const {
        const int row0 = u.pm * BM + wr * 64 + fr, col0 = u.pn * BM + wc * 32 + 8 * fq;
#pragma unroll
        for (int ai = 0; ai < 2; ++ai)
#pragma unroll
            for (int m = 0; m < 4; ++m) { const int row = row0 + ai * HALF + m * 16;
#pragma unroll
                for (int bj = 0; bj < 2; ++bj) { const int col = col0 + bj * HALF;
                    f32x4 g0, g1; bf8_to_f32(*(const u32x4*)(gates + (size_t)row * 6144 + 2048 * PASS + col), g0, g1);
                    f32x4 v0 = g0 * acc[ai][bj][m][0], v1 = g1 * acc[ai][bj][m][1];
                    float* tp = tmp + (size_t)row * 2048 + col;
                    if (PASS > 0) { v0 += *(const f32x4*)tp; v1 += *(const f32x4*)(tp + 4); }
                    if (PASS < 2) { *(f32x4*)tp = v0; *(f32x4*)(tp + 4) = v1; }
                    else store8(out + (size_t)row * 2048 + col, v0, v1);
                    EPI_FENCE(); } }
    }
};
struct EpiMergeM {
    static constexpr bool PERM = true, AFTER_DRAIN = false;
    const bf16_t* gates; bf16_t* out;
    __device__ __forceinline__ void operator()(f32x4 (&acc)[2][2][4][2], const UnitM& u, int wr, int wc, int fr, int fq) const {
        int t_ = threadIdx.x; asm volatile("" : "+v"(t_)); (void)fr; (void)fq; const int lrow0 = wr * 64 + (t_ & 15), lcol0 = wc * 32 + 8 * ((t_ >> 4) & 3);
        const int sub = u.sub;
#pragma unroll
        for (int ai = 0; ai < 2; ++ai) {
            u32x4 ga[4][2], gb[4][2];
#pragma unroll
            for (int m = 0; m < 4; ++m)
#pragma unroll
                for (int bj = 0; bj < 2; ++bj) { const bf16_t* gp = gates + ((size_t)u.pm * BM + lrow0 + ai * HALF + m * 16) * 6144 + 2048 * sub + u.pn * BM + lcol0 + bj * HALF;
                    ga[m][bj] = *(const u32x4*)gp; if (sub == 1) gb[m][bj] = *(const u32x4*)(gp + 2048); }
#pragma unroll
            for (int m = 0; m < 4; ++m)
#pragma unroll
                for (int bj = 0; bj < 2; ++bj) { f32x4 a0, a1; bf8_to_f32(ga[m][bj], a0, a1);
                    if (sub == 0) { acc[ai][bj][m][0] *= a0; acc[ai][bj][m][1] *= a1; continue; }
#pragma unroll
                    for (int j = 0; j < 4; ++j) { a0[j] = fmaxf(a0[j], 1e-30f); a1[j] = fmaxf(a1[j], 1e-30f); }
                    if (sub < 2) { f32x4 b0, b1; bf8_to_f32(gb[m][bj], b0, b1);
#pragma unroll
                        for (int j = 0; j < 4; ++j) { a0[j] *= __builtin_amdgcn_rcpf(fmaxf(b0[j], 1e-30f)); a1[j] *= __builtin_amdgcn_rcpf(fmaxf(b1[j], 1e-30f)); }
                        acc[ai][bj][m][0] *= a0; acc[ai][bj][m][1] *= a1; }
                    else store8(out + ((size_t)u.pm * BM + lrow0 + ai * HALF + m * 16) * 2048 + u.pn * BM + lcol0 + bj * HALF, acc[ai][bj][m][0] * a0, acc[ai][bj][m][1] * a1); }
            EPI_FENCE(); }
    }
};
struct EpiResid {
    static constexpr bool PERM = true, AFTER_DRAIN = false;
    bf16_t* xb;
    __device__ __forceinline__ void operator()(const f32x4 (&acc)[2][2][4][2], const Unit& u, int wr, int wc, int fr, int fq) const {
        int t_ = threadIdx.x; asm volatile("" : "+v"(t_)); (void)fr; (void)fq;
        const int row0 = u.pm * BM + wr * 64 + (t_ & 15), col0 = u.pn * BM + wc * 32 + 8 * ((t_ >> 4) & 3);
#pragma unroll
        for (int ai = 0; ai < 2; ++ai) {
            u32x4 b[4][2];
#pragma unroll
            for (int m = 0; m < 4; ++m)
#pragma unroll
                for (int bj = 0; bj < 2; ++bj) b[m][bj] = *(const u32x4*)(xb + (size_t)(row0 + ai * HALF + m * 16) * 4096 + col0 + bj * HALF);
#pragma unroll
            for (int m = 0; m < 4; ++m)
#pragma unroll
                for (int bj = 0; bj < 2; ++bj) { f32x4 x0, x1; bf8_to_f32(b[m][bj], x0, x1);
                    store8(xb + (size_t)(row0 + ai * HALF + m * 16) * 4096 + col0 + bj * HALF, x0 + acc[ai][bj][m][0], x1 + acc[ai][bj][m][1]); }
            EPI_FENCE(); }
    }
};
__device__ __forceinline__ float gelu_gate(float xc, float g) {
    const float z = xc * __builtin_fmaf(0.044715f * xc, xc, 1.0f);
    return xc * __builtin_amdgcn_rcpf(1.0f + __builtin_amdgcn_exp2f(-2.3022081985378545f * z)) * g;
}
template <int CTRL> __device__ __forceinline__ float dpp_f(float old, float src) {
    return __builtin_bit_cast(float, __builtin_amdgcn_update_dpp(__builtin_bit_cast(int, old), __builtin_bit_cast(int, src), CTRL, 0xf, 0xf, false)); }
struct EpiConvAct {
    static constexpr bool PERM = true, AFTER_DRAIN = false;
    bf16_t* act; float* utail; float* uhead; float* ghead; const float* cw; const float* cb; PG8_LAS float* xbuf;
    __device__ __forceinline__ void operator()(const f32x4 (&acc)[2][2][4][2], const Unit& u, int wr_, int wc_, int fr_, int fq_) const {
        int t_ = threadIdx.x; asm volatile("" : "+v"(t_)); const int fr = t_ & 15, fq = (t_ >> 4) & 3, wr = wr_, wc = wc_; (void)fr_; (void)fq_;
        const int lc = 32 * wc + 8 * fq, f0 = u.pn * HALF + lc;
        if (fr >= 14) {
#pragma unroll
            for (int ai = 0; ai < 2; ++ai) { PG8_LAS float* xp = xbuf + ((2 * ai + wr) * 2 + (fr - 14)) * 128 + lc; *(PG8_LAS f32x4*)xp = acc[ai][0][3][0]; *(PG8_LAS f32x4*)(xp + 4) = acc[ai][0][3][1]; }
            if (wr == 1) { float* tp = utail + ((size_t)u.pm * 2 + (fr - 14)) * 5632 + f0; *(f32x4*)tp = acc[1][0][3][0]; *(f32x4*)(tp + 4) = acc[1][0][3][1]; } }
        if (fr < 2 && wr == 0) { const size_t o = ((size_t)u.pm * 2 + fr) * 5632 + f0;
            *(f32x4*)(uhead + o) = acc[0][0][0][0]; *(f32x4*)(uhead + o + 4) = acc[0][0][0][1]; *(f32x4*)(ghead + o) = acc[0][1][0][0]; *(f32x4*)(ghead + o + 4) = acc[0][1][0][1]; }
        asm volatile("s_waitcnt lgkmcnt(0)" ::: "memory"); __builtin_amdgcn_s_barrier(); asm volatile("" ::: "memory");
        float w0[8], w1[8], w2[8], bb[8];
#pragma unroll
        for (int h = 0; h < 2; ++h) { const f32x4 a = *(const f32x4*)(cw + f0 + 4 * h), b = *(const f32x4*)(cw + 5632 + f0 + 4 * h), c = *(const f32x4*)(cw + 2 * 5632 + f0 + 4 * h), d = *(const f32x4*)(cb + f0 + 4 * h);
#pragma unroll
            for (int j = 0; j < 4; ++j) { w0[4 * h + j] = a[j]; w1[4 * h + j] = b[j]; w2[4 * h + j] = c[j]; bb[4 * h + j] = d[j]; } }
        const int row0 = u.pm * BM + wr * 64 + fr;
#pragma unroll
        for (int ai = 0; ai < 2; ++ai) {
            f32x4 t0a = {0.f, 0.f, 0.f, 0.f}, t0b = t0a, t1a = t0a, t1b = t0a;
            if (2 * ai + wr > 0) { const PG8_LAS float* xp = xbuf + ((2 * ai + wr - 1) * 2) * 128 + lc; t0a = *(const PG8_LAS f32x4*)xp; t0b = *(const PG8_LAS f32x4*)(xp + 4); t1a = *(const PG8_LAS f32x4*)(xp + 128); t1b = *(const PG8_LAS f32x4*)(xp + 132); }
#pragma unroll
            for (int m = 0; m < 4; ++m) { f32x4 o0, o1;
#pragma unroll
                for (int n = 0; n < 2; ++n)
#pragma unroll
                    for (int j = 0; j < 4; ++j) { const int k = 4 * n + j; const float cur = acc[ai][0][m][n][j];
                        float a1, a2;
                        if (m == 0) { const float T0 = n ? t0b[j] : t0a[j], T1 = n ? t1b[j] : t1a[j]; a1 = T1; a2 = (fr == 0) ? T0 : T1; }
                        else { const float pv = acc[ai][0][m - 1][n][j]; a1 = dpp_f<0x10F>(pv, pv); a2 = dpp_f<0x10E>(pv, pv); }
                        const float s1 = dpp_f<0x111>(a1, cur), s2 = dpp_f<0x112>(a2, cur);
                        const float xc = __builtin_fmaf(w2[k], cur, __builtin_fmaf(w1[k], s1, __builtin_fmaf(w0[k], s2, bb[k])));
                        const float r = gelu_gate(xc, acc[ai][1][m][n][j]);
                        if (n == 0) o0[j] = r; else o1[j] = r; }
                store8(act + (size_t)(row0 + ai * HALF + m * 16) * 5632 + f0, o0, o1);
                EPI_FENCE(); } }
    }
};
}

namespace att {
#define ATT_LAS __attribute__((address_space(3)))
typedef unsigned short bf16_t;
typedef short bf16x8 __attribute__((ext_vector_type(8)));
typedef short s16x4 __attribute__((ext_vector_type(4)));
typedef float f32x16 __attribute__((ext_vector_type(16)));
typedef float f32x4 __attribute__((ext_vector_type(4)));
typedef unsigned u32x4 __attribute__((ext_vector_type(4)));
typedef unsigned u32x2 __attribute__((ext_vector_type(2)));
constexpr int SHM_T = 16384;
#define KSWZ(row, colB) ((row) * 256 + ((colB) ^ (((row) & 15) << 4)))
#define KSWZ64(row, colB) ((row) * 128 + ((colB) ^ ((((row) >> 1) & 7) << 4)))
#define SBAR() __builtin_amdgcn_sched_barrier(0)
__device__ __forceinline__ int v_st(int k, int c) { const int kk = (k & ~0xC) | ((k & 4) << 1) | ((k & 8) >> 1); return ((kk >> 3) * 4 + (c >> 5)) * 512 + ((kk & 7) * 32 + (c & 31)) * 2; }
__device__ __forceinline__ int v_rd_base(int lane) { return ((lane & 3) << 3) | (((lane >> 2) & 3) << 6) | (((lane >> 4) & 1) << 5) | (((lane >> 5) & 1) << 8); }
constexpr int v_rd_off(int d0, int ks, int half) { return d0 * 512 + ks * 4096 + half * 2048; }
__device__ __forceinline__ unsigned cvtpk(float lo, float hi) { unsigned r; asm volatile("v_cvt_pk_bf16_f32 %0, %1, %2" : "=v"(r) : "v"(lo), "v"(hi)); return r; }

template <bool ROPE>
__device__ __forceinline__ void qkt(f32x16& p0, f32x16& p1, const ATT_LAS char* Kt, const ATT_LAS char* Kr, int r32, int hi, const bf16x8* qr) {
    p0 = f32x16{}; p1 = f32x16{};
#pragma unroll
    for (int d0 = 0; d0 < 8; ++d0) { const ATT_LAS char* a = Kt + KSWZ(r32, (d0 * 16 + hi * 8) * 2);
        const bf16x8 b0 = *(const ATT_LAS bf16x8*)a, b1 = *(const ATT_LAS bf16x8*)(a + 32 * 256);
        p0 = __builtin_amdgcn_mfma_f32_32x32x16_bf16(b0, qr[d0], p0, 0, 0, 0);
        p1 = __builtin_amdgcn_mfma_f32_32x32x16_bf16(b1, qr[d0], p1, 0, 0, 0); }
    if (ROPE) {
#pragma unroll
        for (int d0 = 0; d0 < 4; ++d0) { const ATT_LAS char* a = Kr + KSWZ64(r32, (d0 * 16 + hi * 8) * 2);
            const bf16x8 b0 = *(const ATT_LAS bf16x8*)a, b1 = *(const ATT_LAS bf16x8*)(a + 32 * 128);
            p0 = __builtin_amdgcn_mfma_f32_32x32x16_bf16(b0, qr[8 + d0], p0, 0, 0, 0);
            p1 = __builtin_amdgcn_mfma_f32_32x32x16_bf16(b1, qr[8 + d0], p1, 0, 0, 0); } }
}
__device__ __forceinline__ void pv_tile_T(f32x16* o, int vb, bf16x8 pa0, bf16x8 pa1, bf16x8 pa2, bf16x8 pa3) {
#define TRRD(dst, off) asm volatile("ds_read_b64_tr_b16 %0, %1 offset:%2" : "=&v"(dst) : "v"(vb), "i"(off) : "memory")
#define PV_D0(d0) do { s16x4 l0, l1, l2, l3, h0, h1, h2, h3; constexpr int b_ = v_rd_off(d0, 0, 0); \
        TRRD(l0, b_); TRRD(h0, b_ + 2048); TRRD(l1, b_ + 4096); TRRD(h1, b_ + 6144); TRRD(l2, b_ + 8192); TRRD(h2, b_ + 10240); TRRD(l3, b_ + 12288); TRRD(h3, b_ + 14336); \
        asm volatile("s_waitcnt lgkmcnt(0)" ::: "memory"); SBAR(); \
        o[d0] = __builtin_amdgcn_mfma_f32_32x32x16_bf16((bf16x8){l0[0], l0[1], l0[2], l0[3], h0[0], h0[1], h0[2], h0[3]}, pa0, o[d0], 0, 0, 0); \
        o[d0] = __builtin_amdgcn_mfma_f32_32x32x16_bf16((bf16x8){l1[0], l1[1], l1[2], l1[3], h1[0], h1[1], h1[2], h1[3]}, pa1, o[d0], 0, 0, 0); \
        o[d0] = __builtin_amdgcn_mfma_f32_32x32x16_bf16((bf16x8){l2[0], l2[1], l2[2], l2[3], h2[0], h2[1], h2[2], h2[3]}, pa2, o[d0], 0, 0, 0); \
        o[d0] = __builtin_amdgcn_mfma_f32_32x32x16_bf16((bf16x8){l3[0], l3[1], l3[2], l3[3], h3[0], h3[1], h3[2], h3[3]}, pa3, o[d0], 0, 0, 0); } while (0)
    PV_D0(0); PV_D0(1); PV_D0(2); PV_D0(3);
#undef PV_D0
#undef TRRD
}
__device__ __forceinline__ void pack_p(const f32x16& p0, const f32x16& p1, bf16x8& pa0, bf16x8& pa1, bf16x8& pa2, bf16x8& pa3) {
#define PK4(P, B_, OUT) do { unsigned a0 = cvtpk(P[B_+0], P[B_+1]), a1 = cvtpk(P[B_+2], P[B_+3]); \
        unsigned b0 = cvtpk(P[B_+4], P[B_+5]), b1 = cvtpk(P[B_+6], P[B_+7]); \
        auto r0 = __builtin_amdgcn_permlane32_swap(a0, b0, false, false); auto r1 = __builtin_amdgcn_permlane32_swap(a1, b1, false, false); \
        u32x4 w = {r0[0], r1[0], r0[1], r1[1]}; OUT = *reinterpret_cast<bf16x8*>(&w); } while (0)
    PK4(p0, 0, pa0); PK4(p0, 8, pa1); PK4(p1, 0, pa2); PK4(p1, 8, pa3);
#undef PK4
}
__device__ __forceinline__ float swap_max(float v) { auto rr = __builtin_amdgcn_permlane32_swap(__float_as_uint(v), __float_as_uint(v), false, false); return fmaxf(__uint_as_float(rr[0]), __uint_as_float(rr[1])); }
__device__ __forceinline__ float swap_sum(float v) { auto rr = __builtin_amdgcn_permlane32_swap(__float_as_uint(v), __float_as_uint(v), false, false); return __uint_as_float(rr[0]) + __uint_as_float(rr[1]); }

__device__ __forceinline__ void store_pair16(bf16_t* row_pair_base  , u32x2 a, u32x2 b) {
    auto rx = __builtin_amdgcn_permlane32_swap(a.x, b.x, false, false); auto ry = __builtin_amdgcn_permlane32_swap(a.y, b.y, false, false);
    const u32x4 w = {rx[0], ry[0], rx[1], ry[1]}; *(u32x4*)row_pair_base = w; }
struct UnitPtrs {
    const bf16_t* Q; int ldq;
    const bf16_t* K; int ldk;
    const bf16_t* V; int ldv;
    const bf16_t* KR;
    const float* bias;
    const bf16_t* G;
    bf16_t* O; int ldo;
    int P0;
    float c2;
    const bf16_t* ST;
    int T0;
};
template <int MODE>
__device__ __forceinline__ void mixer_unit(const UnitPtrs& U, ATT_LAS char* lds, unsigned* qhead, volatile ATT_LAS unsigned* slot) {
    constexpr bool ROPE = (MODE == 1);
    constexpr int NQ = ROPE ? 12 : 8;
    constexpr int K_OFF = 0, KR_OFF = 32768, V_OFF = (MODE == 1) ? 49152 : 32768, V_SZ = (MODE == 2) ? 32768 : 16384, BIAS_OFF = 65536, SCR_OFF = 98304;
    int tid_ = threadIdx.x; asm volatile("" : "+v"(tid_));
    const int tid = tid_, wid = __builtin_amdgcn_readfirstlane(tid >> 6), lane = tid & 63, r32 = lane & 31, hi = lane >> 5;
    const int rg = (MODE == 2) ? (wid >> 1) : wid;
    const int vhalf = (MODE == 2) ? (wid & 1) : 0;
    const int qlo = U.P0 + 32 * rg;
    const int tbase = (MODE == 2) ? (U.T0 >> 6) : 0;
    const int NT = (U.P0 + ((MODE == 2) ? 128 : 256)) / 64 - tbase;
    const int tlast = (qlo >> 6) - tbase;
    bf16x8 qr[NQ];
    { const bf16_t* qp = U.Q + (size_t)(32 * rg + r32) * U.ldq + hi * 8;
#pragma unroll
      for (int d0 = 0; d0 < NQ; ++d0) qr[d0] = *(const bf16x8*)(qp + d0 * 16); }
    const int sr = tid >> 4, sc = (tid & 15) * 8;
    const int kws = KSWZ(sr, sc * 2), vst0 = v_st(sr, sc), vst1 = v_st(32 + sr, sc);
    const int rr = tid >> 3, rc = (tid & 7) * 8, krs = KSWZ64(rr, rc * 2);
    const int vbase = (int)(unsigned)(uintptr_t)(lds + V_OFF) + v_rd_base(lane) + vhalf * SHM_T;
    bf16x8 st_k0, st_k1, st_v0, st_v1, st_v2, st_v3, st_r;
#define ST_LOAD(kb_) do { const bf16_t* kp_ = U.K + (size_t)((kb_) + sr) * U.ldk + sc; st_k0 = *(const bf16x8*)kp_; st_k1 = *(const bf16x8*)(kp_ + (size_t)32 * U.ldk); \
        const bf16_t* vp_ = U.V + (size_t)((kb_) + sr) * U.ldv + sc; st_v0 = *(const bf16x8*)vp_; st_v1 = *(const bf16x8*)(vp_ + (size_t)32 * U.ldv); \
        if (MODE == 2) { st_v2 = *(const bf16x8*)(vp_ + 128); st_v3 = *(const bf16x8*)(vp_ + (size_t)32 * U.ldv + 128); } \
        if (MODE == 1) { st_r = *(const bf16x8*)(U.KR + (size_t)((kb_) + rr) * 64 + rc); } } while (0)
#define ST_WRITE(bf) do { ATT_LAS char* kd_ = lds + K_OFF + (bf) * SHM_T; *(ATT_LAS bf16x8*)(kd_ + kws) = st_k0; *(ATT_LAS bf16x8*)(kd_ + kws + 32 * 256) = st_k1; \
        ATT_LAS char* vd_ = lds + V_OFF + (bf) * V_SZ; *(ATT_LAS bf16x8*)(vd_ + vst0) = st_v0; *(ATT_LAS bf16x8*)(vd_ + vst1) = st_v1; \
        if (MODE == 2) { *(ATT_LAS bf16x8*)(vd_ + SHM_T + vst0) = st_v2; *(ATT_LAS bf16x8*)(vd_ + SHM_T + vst1) = st_v3; } \
        if (MODE == 1) { *(ATT_LAS bf16x8*)(lds + KR_OFF + (bf) * 8192 + krs) = st_r; } } while (0)
    float m_reg = -1e30f, l_reg = 0.f; f32x16 o[4] = {};
    float colf[(MODE == 2) ? 32 : 1];
    if (MODE == 2) {
#pragma unroll
        for (int r = 0; r < 16; ++r) { const int c = (r & 3) + 8 * (r >> 2); colf[r] = __builtin_amdgcn_exp2f(-U.c2 * (float)c); colf[16 + r] = __builtin_amdgcn_exp2f(-U.c2 * (float)(c + 32)); } }
    const int qpos = qlo + r32;
#define TIDX(t) ((MODE == 0) ? (NT - 1 - (t)) : (t))
    ST_LOAD((tbase + TIDX(0)) * 64);
    if (MODE == 0) { const int nk = U.P0 + 256; ATT_LAS float* bl = (ATT_LAS float*)(lds + BIAS_OFF); float bv[8];
#pragma unroll
        for (int j = 0; j < 8; ++j) { const int i = tid + 512 * j; bv[j] = (i < nk) ? U.bias[i] : 0.f; }
#pragma unroll
        for (int j = 0; j < 8; ++j) { const int i = tid + 512 * j; if (i < nk) bl[i] = -bv[j]; } }
    ST_WRITE(0);
    __syncthreads();
    if (MODE == 2) { if (U.ST) {
        const bf16_t* sp = U.ST + (size_t)(vhalf * 128 + r32) * 128 + hi * 8;
        bf16x8 sa[4][8];
#pragma unroll
        for (int d0 = 0; d0 < 4; ++d0)
#pragma unroll
            for (int ks = 0; ks < 8; ++ks) sa[d0][ks] = *(const bf16x8*)(sp + (size_t)d0 * 32 * 128 + ks * 16);
#pragma unroll
        for (int d0 = 0; d0 < 4; ++d0)
#pragma unroll
            for (int ks = 0; ks < 8; ++ks) o[d0] = __builtin_amdgcn_mfma_f32_32x32x16_bf16(sa[d0][ks], qr[ks], o[d0], 0, 0, 0);
        const float rf = __builtin_amdgcn_exp2f(U.c2 * (float)(qpos - U.T0 + 1));
#pragma unroll
        for (int d0 = 0; d0 < 4; ++d0)
#pragma unroll
            for (int r = 0; r < 16; ++r) o[d0][r] *= rf; } }
#define STEP(t, B) do { const int t_ = TIDX(t); const bool more_ = ((t) + 1 < NT); \
        if (more_) ST_LOAD((tbase + TIDX((t) + 1)) * 64); \
        if (t_ <= tlast) { f32x16 p0, p1; bf16x8 pa0, pa1, pa2, pa3; \
            qkt<ROPE>(p0, p1, lds + K_OFF + (B) * SHM_T, lds + KR_OFF + (B) * 8192, r32, hi, qr); \
            const int dq = qpos - (tbase + t_) * 64 - 4 * hi; \
            if (MODE == 2) { \
                if (t_ < tlast) { const float rowf = __builtin_amdgcn_exp2f(U.c2 * (float)dq);     \
                    _Pragma("unroll") for (int r = 0; r < 16; ++r) { p0[r] *= rowf * colf[r]; p1[r] *= rowf * colf[16 + r]; } \
                } else { \
                    _Pragma("unroll") for (int r = 0; r < 16; ++r) { const int c = (r & 3) + 8 * (r >> 2); \
                        p0[r] *= __builtin_amdgcn_exp2f(U.c2 * fabsf((float)(dq - c))); p1[r] *= __builtin_amdgcn_exp2f(U.c2 * fabsf((float)(dq - c - 32))); } } \
            } else { \
                if (MODE == 0) { const ATT_LAS float* bl = (const ATT_LAS float*)(lds + BIAS_OFF) + t_ * 64 + 4 * hi; \
                    _Pragma("unroll") for (int g = 0; g < 4; ++g) { const f32x4 b0 = *(const ATT_LAS f32x4*)(bl + 8 * g), b1 = *(const ATT_LAS f32x4*)(bl + 32 + 8 * g); \
                        _Pragma("unroll") for (int j = 0; j < 4; ++j) { p0[4 * g + j] = fmaf(p0[4 * g + j], U.c2, b0[j]); p1[4 * g + j] = fmaf(p1[4 * g + j], U.c2, b1[j]); } } \
                    if (t_ == tlast) { const float NEG = -__builtin_inff(); \
                        _Pragma("unroll") for (int r = 0; r < 16; ++r) { const int c = (r & 3) + 8 * (r >> 2); if (dq - c < 0) p0[r] = NEG; if (dq - c - 32 < 0) p1[r] = NEG; } } \
                }                                                         \
                float pmax = p0[0]; \
                _Pragma("unroll") for (int r = 1; r < 16; ++r) pmax = fmaxf(pmax, p0[r]); \
                _Pragma("unroll") for (int r = 0; r < 16; ++r) pmax = fmaxf(pmax, p1[r]); \
                pmax = swap_max(pmax); \
                if (__any(pmax > m_reg + ((MODE == 1) ? 8.0f : 0.0f))) { const float mn = fmaxf(m_reg, pmax), alpha = __builtin_amdgcn_exp2f(m_reg - mn); m_reg = mn; l_reg *= alpha; \
                    _Pragma("unroll") for (int d_ = 0; d_ < 4; ++d_) _Pragma("unroll") for (int r = 0; r < 16; ++r) o[d_][r] *= alpha; } \
                float ps = 0.f; \
                _Pragma("unroll") for (int r = 0; r < 16; ++r) { p0[r] = __builtin_amdgcn_exp2f(p0[r] - m_reg); p1[r] = __builtin_amdgcn_exp2f(p1[r] - m_reg); ps += p0[r] + p1[r]; } \
                ps = swap_sum(ps); l_reg += ps; \
            } \
            pack_p(p0, p1, pa0, pa1, pa2, pa3); \
            pv_tile_T(o, vbase + (B) * V_SZ, pa0, pa1, pa2, pa3); } \
        if (more_) ST_WRITE((B) ^ 1); \
        __syncthreads(); } while (0)
    for (int t = 0; t < NT; t += 2) { STEP(t, 0); STEP(t + 1, 1); }
#undef STEP
#undef TIDX
#undef ST_LOAD
#undef ST_WRITE
    unsigned tk = 0u; if (tid == 0) tk = __hip_atomic_fetch_add(qhead, 1u, __ATOMIC_RELAXED, __HIP_MEMORY_SCOPE_AGENT);
    bf16_t* orow = U.O + (size_t)(32 * rg + r32) * U.ldo + vhalf * 128 + 8 * hi;
    if (MODE == 2) {
        float ss = 0.f;
#pragma unroll
        for (int d0 = 0; d0 < 4; ++d0)
#pragma unroll
            for (int r = 0; r < 16; ++r) ss += o[d0][r] * o[d0][r];
        ss = swap_sum(ss);
        ATT_LAS float* scr = (ATT_LAS float*)(lds + SCR_OFF);
        if (hi == 0) scr[wid * 32 + r32] = ss;
        __syncthreads();
        const float tot = ss + scr[(wid ^ 1) * 32 + r32];
        const float rstd = __builtin_amdgcn_rsqf(tot * (1.0f / 256.0f) + 1e-6f);
        const bf16_t* grow = U.G + (size_t)(32 * rg + r32) * 1024 + vhalf * 128 + 4 * hi;
#pragma unroll
        for (int d0 = 0; d0 < 4; ++d0)
#pragma unroll
            for (int gp = 0; gp < 4; gp += 2) { u32x2 w[2];
#pragma unroll
                for (int e = 0; e < 2; ++e) { const int g = gp + e; const u32x2 gw = *(const u32x2*)(grow + 32 * d0 + 8 * g);
                    const float g0 = __uint_as_float(gw.x << 16), g1 = __uint_as_float(gw.x & 0xffff0000u), g2 = __uint_as_float(gw.y << 16), g3 = __uint_as_float(gw.y & 0xffff0000u);
                    w[e].x = cvtpk(o[d0][4 * g] * rstd * g0, o[d0][4 * g + 1] * rstd * g1); w[e].y = cvtpk(o[d0][4 * g + 2] * rstd * g2, o[d0][4 * g + 3] * rstd * g3); }
                store_pair16(orow + 32 * d0 + 8 * gp, w[0], w[1]); }
        __syncthreads();
    } else {
        const float inv = 1.0f / l_reg;
#pragma unroll
        for (int d0 = 0; d0 < 4; ++d0)
#pragma unroll
            for (int gp = 0; gp < 4; gp += 2) { u32x2 w[2];
#pragma unroll
                for (int e = 0; e < 2; ++e) { const int g = gp + e; w[e].x = cvtpk(o[d0][4 * g] * inv, o[d0][4 * g + 1] * inv); w[e].y = cvtpk(o[d0][4 * g + 2] * inv, o[d0][4 * g + 3] * inv); }
                store_pair16(orow + 32 * d0 + 8 * gp, w[0], w[1]); }
    }
    if (tid == 0) *slot = tk;
}

__device__ __forceinline__ void ret_state_unit(const bf16_t* K, int ldk, const bf16_t* V, int ldv, float c2, float* SL, ATT_LAS char* lds) {
    int tid_ = threadIdx.x; asm volatile("" : "+v"(tid_));
    const int tid = tid_, wid = __builtin_amdgcn_readfirstlane(tid >> 6), lane = tid & 63, r32 = lane & 31, hi = lane >> 5;
    const int sr = tid >> 4, sc = (tid & 15) * 8, vst0 = v_st(sr, sc), vst1 = v_st(32 + sr, sc);
    constexpr int KI = 0, VI = 16384;
    const int kb = (int)(unsigned)(uintptr_t)(lds + KI) + v_rd_base(lane), vb = (int)(unsigned)(uintptr_t)(lds + VI) + v_rd_base(lane) + (wid >> 2) * SHM_T;
    f32x16 acc[4] = {};
    for (int t = 0; t < 4; ++t) {
        const bf16_t* kp = K + (size_t)(t * 64 + sr) * ldk + sc; const bf16_t* vp = V + (size_t)(t * 64 + sr) * ldv + sc;
        const u32x4 k0 = *(const u32x4*)kp, k1 = *(const u32x4*)(kp + (size_t)32 * ldk);
        const bf16x8 v0 = *(const bf16x8*)vp, v1 = *(const bf16x8*)(vp + (size_t)32 * ldv), v2 = *(const bf16x8*)(vp + 128), v3 = *(const bf16x8*)(vp + (size_t)32 * ldv + 128);
        const float w0 = __builtin_amdgcn_exp2f(c2 * (float)(255 - (t * 64 + sr))), w1 = __builtin_amdgcn_exp2f(c2 * (float)(255 - (t * 64 + 32 + sr)));
        u32x4 q0, q1;
#define WSC(w, s) cvtpk(__uint_as_float((w) << 16) * (s), __uint_as_float((w) & 0xffff0000u) * (s))
        q0.x = WSC(k0.x, w0); q0.y = WSC(k0.y, w0); q0.z = WSC(k0.z, w0); q0.w = WSC(k0.w, w0); q1.x = WSC(k1.x, w1); q1.y = WSC(k1.y, w1); q1.z = WSC(k1.z, w1); q1.w = WSC(k1.w, w1);
#undef WSC
        __syncthreads();
        *(ATT_LAS u32x4*)(lds + KI + vst0) = q0; *(ATT_LAS u32x4*)(lds + KI + vst1) = q1;
        *(ATT_LAS bf16x8*)(lds + VI + vst0) = v0; *(ATT_LAS bf16x8*)(lds + VI + vst1) = v1; *(ATT_LAS bf16x8*)(lds + VI + SHM_T + vst0) = v2; *(ATT_LAS bf16x8*)(lds + VI + SHM_T + vst1) = v3;
        __syncthreads();
#define TRR(dst, base, off) asm volatile("ds_read_b64_tr_b16 %0, %1 offset:%2" : "=&v"(dst) : "v"(base), "i"(off) : "memory")
#define KS_STEP(ks) do { s16x4 vl, vh, kl0, kh0, kl1, kh1, kl2, kh2, kl3, kh3; \
        TRR(vl, vbw, (ks) * 4096); TRR(vh, vbw, (ks) * 4096 + 2048); \
        TRR(kl0, kb, 0 * 512 + (ks) * 4096); TRR(kh0, kb, 0 * 512 + (ks) * 4096 + 2048); TRR(kl1, kb, 1 * 512 + (ks) * 4096); TRR(kh1, kb, 1 * 512 + (ks) * 4096 + 2048); \
        TRR(kl2, kb, 2 * 512 + (ks) * 4096); TRR(kh2, kb, 2 * 512 + (ks) * 4096 + 2048); TRR(kl3, kb, 3 * 512 + (ks) * 4096); TRR(kh3, kb, 3 * 512 + (ks) * 4096 + 2048); \
        asm volatile("s_waitcnt lgkmcnt(0)" ::: "memory"); SBAR(); \
        const bf16x8 vf = (bf16x8){vl[0], vl[1], vl[2], vl[3], vh[0], vh[1], vh[2], vh[3]}; \
        acc[0] = __builtin_amdgcn_mfma_f32_32x32x16_bf16(vf, (bf16x8){kl0[0], kl0[1], kl0[2], kl0[3], kh0[0], kh0[1], kh0[2], kh0[3]}, acc[0], 0, 0, 0); \
        acc[1] = __builtin_amdgcn_mfma_f32_32x32x16_bf16(vf, (bf16x8){kl1[0], kl1[1], kl1[2], kl1[3], kh1[0], kh1[1], kh1[2], kh1[3]}, acc[1], 0, 0, 0); \
        acc[2] = __builtin_amdgcn_mfma_f32_32x32x16_bf16(vf, (bf16x8){kl2[0], kl2[1], kl2[2], kl2[3], kh2[0], kh2[1], kh2[2], kh2[3]}, acc[2], 0, 0, 0); \
        acc[3] = __builtin_amdgcn_mfma_f32_32x32x16_bf16(vf, (bf16x8){kl3[0], kl3[1], kl3[2], kl3[3], kh3[0], kh3[1], kh3[2], kh3[3]}, acc[3], 0, 0, 0); } while (0)
        const int vbw = vb + (wid & 3) * 512;
        KS_STEP(0); KS_STEP(1); KS_STEP(2); KS_STEP(3);
#undef KS_STEP
#undef TRR
    }
#pragma unroll
    for (int e0 = 0; e0 < 4; ++e0)
#pragma unroll
        for (int r = 0; r < 16; ++r) SL[(size_t)(32 * wid + (r & 3) + 8 * (r >> 2) + 4 * hi) * 128 + 32 * e0 + r32] = acc[e0][r];
    __syncthreads();
}
}

constexpr int DM = 2048, NBATCH = 8, SEQ = 4096, DEPTH = 4, M = NBATCH * SEQ;
constexpr int IN_W = 12358, NIN = 12544, DFF = 5632, NUG = 2 * DFF, NUQ = 1280, NUKV = 1536;
constexpr float NORM_EPS = 1e-6f;
constexpr int NWAVES = 8;
constexpr int PH = 11, NPHASE = DEPTH * PH + 1;

constexpr size_t MiB = 1u << 20;
constexpr size_t WS_CTL = 0, CTL_ZERO_BYTES = 1 * MiB;
constexpr size_t WS_T128 = 1 * MiB, WS_T64 = 3 * MiB, WS_CL = 4 * MiB, WS_RSQ = 5 * MiB, WS_RSKV = 5 * MiB + 512 * 1024, WS_FF = 6 * MiB;
constexpr size_t WS_W = 8 * MiB;
constexpr size_t WO_IN = 0, WO_UQ = WO_IN + (size_t)NIN * DM * 2, WO_UKV = WO_UQ + (size_t)NUQ * 512 * 2, WO_BF = WO_UKV + (size_t)NUKV * 256 * 2, WO_BM = WO_BF + (size_t)DM * 1024 * 2,
                 WO_BR = WO_BM + (size_t)DM * 1024 * 2, WO_OUT = WO_BR + (size_t)DM * 1024 * 2, WO_UG = WO_OUT + (size_t)DM * DM * 2, WO_DN = WO_UG + (size_t)NUG * DM * 2, WO_END = WO_DN + (size_t)DM * DFF * 2;
static_assert(WO_END == 137 * MiB, "weight region");
constexpr size_t WS_H = 146 * MiB;
constexpr size_t WS_BIG = 274 * MiB;
constexpr size_t WS_GATES = WS_BIG, WS_FQKV = WS_GATES + 384 * MiB, WS_CQ = WS_FQKV + 144 * MiB, WS_CKV = WS_CQ + 32 * MiB, WS_RQ = WS_CKV + 16 * MiB, WS_RK = WS_RQ + 32 * MiB,
                 WS_RV = WS_RK + 32 * MiB, WS_RG = WS_RV + 64 * MiB, WS_KR = WS_RG + 64 * MiB, WS_QM = WS_KR + 4 * MiB, WS_KVM = WS_QM + 72 * MiB, WS_A = WS_KVM + 96 * MiB,
                 WS_BM = WS_A + 64 * MiB, WS_C = WS_BM + 64 * MiB, WS_SLOC = WS_C + 64 * MiB, WS_SST = WS_SLOC + 64 * MiB, WS_MIX_END = WS_SST + 32 * MiB;
constexpr size_t WS_TMP = WS_FQKV;
static_assert(WS_RV - WS_FQKV == 256 * MiB, "tmp overlay");
constexpr size_t WS_U = WS_BIG, WS_GT = WS_U + 352 * MiB, WS_ACT = WS_GT + 352 * MiB, WS_FFN_END = WS_ACT + 352 * MiB;
constexpr size_t WS_UTAIL = WS_U, WS_UHEAD = WS_U + 8 * MiB, WS_GHEAD = WS_U + 16 * MiB;
constexpr size_t WS_END = WS_MIX_END > WS_FFN_END ? WS_MIX_END : WS_FFN_END;
constexpr int CW_BAR = 4096;
constexpr int CW_QUEUE = 16384;

constexpr int RING_OFF = 0, RING_BYTES = 131072;
constexpr int LDSCTL_OFF = RING_BYTES, MISC_OFF = LDSCTL_OFF + 320;
constexpr int LDS_BYTES = 147456;
static_assert(MISC_OFF + 128 <= LDS_BYTES, "LDS map");

#define LAS __attribute__((address_space(3)))
typedef unsigned short bf16;
typedef unsigned v4u __attribute__((ext_vector_type(4)));
typedef float f32x4 __attribute__((ext_vector_type(4)));
#define LDS_WAIT() asm volatile("s_waitcnt lgkmcnt(0)" ::: "memory")
__device__ __forceinline__ unsigned f2bf(float f) { unsigned u = __builtin_bit_cast(unsigned, f); return (u + 0x7fffu + ((u >> 16) & 1u)) >> 16; }
__device__ __forceinline__ unsigned pk2(float lo, float hi) { return f2bf(lo) | (f2bf(hi) << 16); }

#define XB_TMO      128
#define XB_XCNT(j)  (256  + 64 * (j))
#define XB_XSUB(j)  (1280 + 64 * (j))
#define XB_XGEN(j)  (2304 + 64 * (j))
#define XB_TOP      3328
#define XB_TOPGEN   3392
#define XCD_BAR_WORDS 3456
#define XB_SPIN_CAP (1u << 18)
__device__ __forceinline__ unsigned xb_ld(unsigned* p)              { return __hip_atomic_load(p, __ATOMIC_RELAXED, __HIP_MEMORY_SCOPE_AGENT); }
__device__ __forceinline__ unsigned xb_add(unsigned* p, unsigned v) { return __hip_atomic_fetch_add(p, v, __ATOMIC_RELAXED, __HIP_MEMORY_SCOPE_AGENT); }
__device__ __forceinline__ unsigned xb_xcc_id() { return (unsigned)__builtin_amdgcn_s_getreg((3 << 11) | 20) & 0xFu; }
#define XB_SPIN(cond, bar) do { unsigned _sp = 0; while (cond) { __builtin_amdgcn_s_sleep(1); \
    if ((++_sp & 255u) == 0u) { if (xb_ld(&(bar)[XB_TMO])) break; if (_sp > XB_SPIN_CAP) { atomicAdd(&(bar)[XB_TMO], 1u); break; } } } } while (0)
struct XcdBarrier { unsigned* bar; unsigned x; volatile LAS unsigned* st; };
__device__ __forceinline__ XcdBarrier xcd_barrier_post(unsigned* bar, volatile LAS unsigned* st) {
    XcdBarrier b; b.bar = bar; b.x = xb_xcc_id(); b.st = st;
    if (threadIdx.x == 0) (void)xb_add(&bar[XB_XCNT(b.x)], 1u);
    return b;
}
__device__ __forceinline__ void xcd_barrier_complete(unsigned* bar, unsigned x, unsigned& nloc, unsigned& nx) {
    const unsigned G = gridDim.x * gridDim.y * gridDim.z;
    unsigned sum, cnt, mine, sp = 0u;
    for (;;) {
        sum = 0u; cnt = 0u; mine = 0u;
#pragma unroll
        for (unsigned j = 0; j < 16; ++j) { const unsigned c = xb_ld(&bar[XB_XCNT(j)]); sum += c; cnt += (c > 0u) ? 1u : 0u; mine = (j == x) ? c : mine; }
        if (sum == G) break;
        __builtin_amdgcn_s_sleep(1);
        if ((++sp & 255u) == 0u) { if (xb_ld(&bar[XB_TMO])) break; if (sp > XB_SPIN_CAP) { atomicAdd(&bar[XB_TMO], 1u); break; } }
    }
    nloc = mine > 0u ? mine : 1u; nx = cnt > 0u ? cnt : 1u;
}
__device__ __forceinline__ void xcd_barrier(const XcdBarrier& b) {
    asm volatile("s_waitcnt vmcnt(0)" ::: "memory");
    __syncthreads();
    if (threadIdx.x == 0) {
        unsigned bx = b.x; size_t bz_ = 0; asm volatile("" : "+s"(bz_), "+s"(bx)); unsigned* bar = b.bar + bz_;
        __builtin_amdgcn_s_waitcnt(0);
        unsigned nloc = b.st[0], nx = b.st[1];
        if (nloc == 0u) { xcd_barrier_complete(bar, bx, nloc, nx); b.st[0] = nloc; b.st[1] = nx; }
        const unsigned old = xb_add(&bar[XB_XSUB(bx)], 1u);
        const unsigned gen = old / nloc;
        if (old + 1u == (gen + 1u) * nloc) {
            __builtin_amdgcn_fence(__ATOMIC_RELEASE, "agent");
            asm volatile("s_waitcnt vmcnt(0)" ::: "memory");
            const unsigned og = xb_add(&bar[XB_TOP], 1u);
            const unsigned tg = og / nx;
            if (og + 1u == (tg + 1u) * nx) xb_add(&bar[XB_TOPGEN], 1u);
            else XB_SPIN(xb_ld(&bar[XB_TOPGEN]) == tg, bar);
            __builtin_amdgcn_fence(__ATOMIC_ACQUIRE, "agent");
            xb_add(&bar[XB_XGEN(bx)], 1u);
            asm volatile("s_waitcnt vmcnt(0)" ::: "memory");
        } else {
            XB_SPIN(xb_ld(&bar[XB_XGEN(bx)]) == gen, bar);
            __builtin_amdgcn_fence(__ATOMIC_ACQUIRE, "agent");
            asm volatile("s_waitcnt vmcnt(0)" ::: "memory");
        }
    }
    __syncthreads();
}

__device__ __forceinline__ float wave_sum(float v, int lane) {
#pragma unroll
    for (int o = 1; o < 64; o <<= 1) v += __builtin_bit_cast(float, __builtin_amdgcn_ds_bpermute((lane ^ o) << 2, __builtin_bit_cast(int, v)));
    return v;
}
__device__ __forceinline__ double lane_up_d(double v, int lane, int o) {
    const int src = (lane >= o ? lane - o : lane) << 2; const unsigned long long u = __builtin_bit_cast(unsigned long long, v);
    const unsigned lo = (unsigned)__builtin_amdgcn_ds_bpermute(src, (int)(unsigned)u), hi = (unsigned)__builtin_amdgcn_ds_bpermute(src, (int)(unsigned)(u >> 32));
    return __builtin_bit_cast(double, ((unsigned long long)hi << 32) | lo);
}
__device__ __forceinline__ void wconv_item(const float* W, int ldw, int src, int valid, const float* kscale, bf16* dst, int K, int k0, LAS float* scr, int lane) {
    const int j = lane & 31; const bool ok = j < valid;
    float wv[32];
#pragma unroll
    for (int i = 0; i < 32; ++i) { const int kk = 2 * i + (lane >> 5); wv[i] = ok ? W[(size_t)(k0 + kk) * ldw + src + j] : 0.f; }
    if (kscale) {
#pragma unroll
        for (int i = 0; i < 32; ++i) wv[i] *= kscale[k0 + 2 * i + (lane >> 5)]; }
#pragma unroll
    for (int i = 0; i < 32; ++i) scr[(2 * i + (lane >> 5)) * 33 + j] = wv[i];
    LDS_WAIT(); asm volatile("" ::: "memory");
    const int c = lane & 7;
#pragma unroll
    for (int jj = 0; jj < 4; ++jj) { const int n = (lane >> 3) + 8 * jj; const LAS float* s = scr + (8 * c) * 33 + n;
        v4u o; o.x = pk2(s[0 * 33], s[1 * 33]); o.y = pk2(s[2 * 33], s[3 * 33]); o.z = pk2(s[4 * 33], s[5 * 33]); o.w = pk2(s[6 * 33], s[7 * 33]);
        *(v4u*)(dst + (size_t)n * K + k0 + 8 * c) = o; }
    LDS_WAIT(); asm volatile("" ::: "memory");
}
__device__ __forceinline__ void inproj_src(int g, int& src, int& valid) {
    const int n = g * 32; valid = 32;
    if (n < 2304) src = n;
    else if (n < 2816) src = 2310 + (n - 2304);
    else if (n < 3072) src = 2822 + (n - 2816);
    else if (n < 3328) { const int p = n - 3072; if (p == 0) src = 3078; else if (p == 32) { src = 2304; valid = 6; } else if (p == 128) src = 3110; else { src = 0; valid = 0; } }
    else if (n < 4352) { const int base = (n < 3840) ? 3142 : 3654; const int p = (n < 3840) ? n - 3328 : n - 3840; const int t = p >> 8, q = p & 255, bj = q >> 7, x = q & 127, hh = x >> 6, i = x & 63;
        src = base + 128 * (2 * t + hh) + 64 * bj + i; }
    else if (n < 5376) src = 4166 + (n - 4352);
    else if (n < 6400) src = 5190 + (n - 5376);
    else if (n < 10496) { const int q = n - 6400, j = q >> 8, bj = (q >> 7) & 1, x = q & 127; src = 6214 + 2048 * bj + 128 * j + x; }
    else src = 6214 + (n - 6400);
}
__device__ __forceinline__ void uq_src(int g, int& src, int& valid) {
    const int n = g * 32; valid = 32;
    if (n < 768) { const int t = n >> 8, q = n & 255, bj = q >> 7, x = q & 127; src = 192 * (2 * t + bj) + x; }
    else { const int t4 = (n >= 1024) ? 1 : 0; const int q = n - 768 - 256 * t4, bj = q >> 7, x = q & 127, hh = (x >> 5) + 4 * t4; if (hh < 6) src = 192 * hh + 128 + 32 * bj; else { src = 0; valid = 0; } }
}

struct Args {
    const float* in[19]; float* out; unsigned char* ws;
    float invf128[64]; float invf64[32];
    int ph_lo, ph_hi;
};

static_assert(sizeof(Args) == 560, "Args layout");

#define KAS __attribute__((address_space(4)))
#define GAS1 __attribute__((address_space(1)))
__device__ __forceinline__ const KAS char* karg_base() { size_t z = 0; asm volatile("" : "+s"(z)); return (const KAS char*)__builtin_amdgcn_kernarg_segment_ptr() + z; }
__device__ __forceinline__ const float* arg_in(int i) { typedef const GAS1 float* gp; return (const float*)(*(const KAS gp*)(karg_base() + 8 * i)); }
__device__ __forceinline__ float* arg_out() { typedef GAS1 float* gp; return (float*)(*(const KAS gp*)(karg_base() + 152)); }
__device__ __forceinline__ unsigned char* arg_ws() { typedef GAS1 unsigned char* gp; return (unsigned char*)(*(const KAS gp*)(karg_base() + 160)); }
__device__ __forceinline__ float arg_invf128(int i) { return *(const KAS float*)(karg_base() + 168 + 4 * i); }
__device__ __forceinline__ float arg_invf64(int i) { return *(const KAS float*)(karg_base() + 424 + 4 * i); }
struct Ctx { int tid, lane, wave, G, vcu, gw, NGW; LAS unsigned char* lds; unsigned char* ws; };
__device__ __forceinline__ Ctx ctx_local(const Ctx& C0) { Ctx C = C0; int t_ = threadIdx.x; asm volatile("" : "+v"(t_)); C.tid = t_; C.lane = t_ & 63; size_t z_ = 0; asm volatile("" : "+s"(C.wave), "+s"(C.gw), "+s"(C.vcu), "+s"(z_)); C.ws = arg_ws() + z_; return C; }

constexpr int XPITCH = 4096;
__device__ __forceinline__ void cvt8(const v4u w, float (&v)[8]) {
    v[0] = __uint_as_float(w.x << 16); v[1] = __uint_as_float(w.x & 0xffff0000u); v[2] = __uint_as_float(w.y << 16); v[3] = __uint_as_float(w.y & 0xffff0000u);
    v[4] = __uint_as_float(w.z << 16); v[5] = __uint_as_float(w.z & 0xffff0000u); v[6] = __uint_as_float(w.w << 16); v[7] = __uint_as_float(w.w & 0xffff0000u); }
__device__ __forceinline__ void rows_rmsnorm_first(const Ctx& C0, const float* x, const float* gain, bf16* xb, bf16* out) { const Ctx C = ctx_local(C0);
    f32x4 g[8];
#pragma unroll
    for (int j = 0; j < 8; ++j) g[j] = ((const f32x4*)gain + C.lane)[64 * j];
    for (int m = C.gw; m < M; m += 2 * C.NGW) {
        const int m2 = m + C.NGW; const bool has2 = m2 < M;
        const f32x4* xa = (const f32x4*)(x + (size_t)m * DM) + C.lane; const f32x4* xq = (const f32x4*)(x + (size_t)(has2 ? m2 : m) * DM) + C.lane;
        f32x4 va[8], vb[8]; float sa = 0.f, sb = 0.f;
#pragma unroll
        for (int j = 0; j < 8; ++j) va[j] = xa[64 * j];
#pragma unroll
        for (int j = 0; j < 8; ++j) vb[j] = xq[64 * j];
#pragma unroll
        for (int j = 0; j < 8; ++j) { sa += (va[j].x * va[j].x + va[j].y * va[j].y) + (va[j].z * va[j].z + va[j].w * va[j].w); sb += (vb[j].x * vb[j].x + vb[j].y * vb[j].y) + (vb[j].z * vb[j].z + vb[j].w * vb[j].w); }
        const float ra = __builtin_amdgcn_rsqf(wave_sum(sa, C.lane) * (1.0f / DM) + NORM_EPS), rb = __builtin_amdgcn_rsqf(wave_sum(sb, C.lane) * (1.0f / DM) + NORM_EPS);
        unsigned long long* oa = (unsigned long long*)(out + (size_t)m * DM) + C.lane; unsigned long long* ya = (unsigned long long*)(xb + (size_t)m * XPITCH) + C.lane;
#pragma unroll
        for (int j = 0; j < 8; ++j) { oa[64 * j] = (unsigned long long)pk2(va[j].x * ra * g[j].x, va[j].y * ra * g[j].y) | ((unsigned long long)pk2(va[j].z * ra * g[j].z, va[j].w * ra * g[j].w) << 32);
            ya[64 * j] = (unsigned long long)pk2(va[j].x, va[j].y) | ((unsigned long long)pk2(va[j].z, va[j].w) << 32); }
        if (has2) { unsigned long long* ob = (unsigned long long*)(out + (size_t)m2 * DM) + C.lane; unsigned long long* yb = (unsigned long long*)(xb + (size_t)m2 * XPITCH) + C.lane;
#pragma unroll
            for (int j = 0; j < 8; ++j) { ob[64 * j] = (unsigned long long)pk2(vb[j].x * rb * g[j].x, vb[j].y * rb * g[j].y) | ((unsigned long long)pk2(vb[j].z * rb * g[j].z, vb[j].w * rb * g[j].w) << 32);
                yb[64 * j] = (unsigned long long)pk2(vb[j].x, vb[j].y) | ((unsigned long long)pk2(vb[j].z, vb[j].w) << 32); } }
    }
}
__device__ __forceinline__ void rows_rmsnorm_bf16(const Ctx& C0, const bf16* xb, const float* gain, bf16* out) { const Ctx C = ctx_local(C0);
    f32x4 g[4][2];
#pragma unroll
    for (int j = 0; j < 4; ++j) { g[j][0] = *(const f32x4*)(gain + 8 * (C.lane + 64 * j)); g[j][1] = *(const f32x4*)(gain + 8 * (C.lane + 64 * j) + 4); }
    for (int m0 = C.gw; m0 < M; m0 += 4 * C.NGW) {
        v4u w[4][4];
#pragma unroll
        for (int q = 0; q < 4; ++q) { const int m = m0 + q * C.NGW; const v4u* xr = (const v4u*)(xb + (size_t)(m < M ? m : m0) * XPITCH) + C.lane;
#pragma unroll
            for (int j = 0; j < 4; ++j) w[q][j] = xr[64 * j]; }
#pragma unroll
        for (int q = 0; q < 4; ++q) { const int m = m0 + q * C.NGW; float s = 0.f;
#pragma unroll
            for (int j = 0; j < 4; ++j) { float v[8]; cvt8(w[q][j], v);
#pragma unroll
                for (int e = 0; e < 8; ++e) s += v[e] * v[e]; }
            const float r = __builtin_amdgcn_rsqf(wave_sum(s, C.lane) * (1.0f / DM) + NORM_EPS);
            if (m < M) { v4u* orow = (v4u*)(out + (size_t)m * DM) + C.lane;
#pragma unroll
                for (int j = 0; j < 4; ++j) { float v[8]; cvt8(w[q][j], v);
                    v4u o; o.x = pk2(v[0] * r * g[j][0][0], v[1] * r * g[j][0][1]); o.y = pk2(v[2] * r * g[j][0][2], v[3] * r * g[j][0][3]); o.z = pk2(v[4] * r * g[j][1][0], v[5] * r * g[j][1][1]); o.w = pk2(v[6] * r * g[j][1][2], v[7] * r * g[j][1][3]);
                    orow[64 * j] = o; } } }
    }
}
__device__ __forceinline__ void rows_rmsnorm_final(const Ctx& C0, float* outp, const float* gain) { const Ctx C = ctx_local(C0);
    f32x4 g[4][2];
#pragma unroll
    for (int j = 0; j < 4; ++j) { g[j][0] = *(const f32x4*)(gain + 8 * (C.lane + 64 * j)); g[j][1] = *(const f32x4*)(gain + 8 * (C.lane + 64 * j) + 4); }
    for (int m0 = C.gw; m0 < M; m0 += 4 * C.NGW) {
        v4u w[4][4];
#pragma unroll
        for (int q = 0; q < 4; ++q) { const int m = m0 + q * C.NGW; const v4u* xr = (const v4u*)((const bf16*)outp + (size_t)(m < M ? m : m0) * XPITCH) + C.lane;
#pragma unroll
            for (int j = 0; j < 4; ++j) w[q][j] = xr[64 * j]; }
        asm volatile("s_waitcnt vmcnt(0)" ::: "memory");
#pragma unroll
        for (int q = 0; q < 4; ++q) { const int m = m0 + q * C.NGW; float s = 0.f;
#pragma unroll
            for (int j = 0; j < 4; ++j) { float v[8]; cvt8(w[q][j], v);
#pragma unroll
                for (int e = 0; e < 8; ++e) s += v[e] * v[e]; }
            const float r = __builtin_amdgcn_rsqf(wave_sum(s, C.lane) * (1.0f / DM) + NORM_EPS);
            if (m < M) { float* orow = outp + (size_t)m * DM + 8 * C.lane;
#pragma unroll
                for (int j = 0; j < 4; ++j) { float v[8]; cvt8(w[q][j], v);
                    *(f32x4*)(orow + 512 * j) = (f32x4){v[0] * r * g[j][0][0], v[1] * r * g[j][0][1], v[2] * r * g[j][0][2], v[3] * r * g[j][0][3]};
                    *(f32x4*)(orow + 512 * j + 4) = (f32x4){v[4] * r * g[j][1][0], v[5] * r * g[j][1][1], v[6] * r * g[j][1][2], v[7] * r * g[j][1][3]}; } } }
    }
}
__device__ __forceinline__ void sincos_d(float angf, float& co, float& si) {
    const double a = (double)angf; const double k = __builtin_rint(a * 0.15915494309189535); double r = a - k * 6.283185307179586477;
    const double q = __builtin_rint(r * 0.63661977236758134308); const double y = r - q * 1.57079632679489661923; const double y2 = y * y;
    const double sy = y * (1.0 + y2 * (-1.0 / 6 + y2 * (1.0 / 120 + y2 * (-1.0 / 5040 + y2 * (1.0 / 362880 + y2 * (-1.0 / 39916800 + y2 * (1.0 / 6227020800.0)))))));
    const double cy = 1.0 + y2 * (-0.5 + y2 * (1.0 / 24 + y2 * (-1.0 / 720 + y2 * (1.0 / 40320 + y2 * (-1.0 / 3628800 + y2 * (1.0 / 479001600 + y2 * (-1.0 / 87178291200.0)))))));
    const int qi = ((int)q) & 3;
    const double s = (qi == 0) ? sy : (qi == 1) ? cy : (qi == 2) ? -sy : -cy;
    const double c = (qi == 0) ? cy : (qi == 1) ? -sy : (qi == 2) ? -cy : sy;
    co = (float)c; si = (float)s;
}
__device__ __forceinline__ void rope_tables(const Ctx& C0, const Args& A) { const Ctx C = ctx_local(C0);
    float* T128 = (float*)(C.ws + WS_T128); float* T64 = (float*)(C.ws + WS_T64);
    const int gt = (C.vcu * NWAVES + C.wave) * 64 + C.lane, NGT = C.NGW * 64;
    for (int e = gt; e < SEQ * 64; e += NGT) { const int pos = e >> 6, i = e & 63; float c, s; sincos_d((float)pos * arg_invf128(i), c, s); T128[2 * e] = c; T128[2 * e + 1] = s; }
    for (int e = gt; e < SEQ * 32; e += NGT) { const int pos = e >> 5, i = e & 31; float c, s; sincos_d((float)pos * arg_invf64(i), c, s); T64[2 * e] = c; T64[2 * e + 1] = s; }
}
__device__ __forceinline__ void p0_phase(const Ctx& C0, const Args& A, int layer) { const Ctx C = ctx_local(C0);
    LAS float* scr = (LAS float*)(C.lds + RING_OFF + C.wave * 16384);
    const float* w_in = arg_in(2) + (size_t)layer * DM * IN_W;
    const float* w_uq = arg_in(5) + (size_t)layer * 512 * 1152; const float* w_ukv = arg_in(6) + (size_t)layer * 256 * 1536;
    const float* qg = arg_in(3) + (size_t)layer * 512; const float* kvg = arg_in(4) + (size_t)layer * 256;
    const float* w_bf = arg_in(8) + (size_t)layer * 768 * DM; const float* w_bm = arg_in(9) + (size_t)layer * 768 * DM; const float* w_br = arg_in(10) + (size_t)layer * 1024 * DM;
    const float* w_out = arg_in(11) + (size_t)layer * DM * DM;
    const float* w_up = arg_in(13) + (size_t)layer * DM * DFF; const float* w_gate = arg_in(14) + (size_t)layer * DM * DFF; const float* w_dn = arg_in(17) + (size_t)layer * DFF * DM;
    bf16* Wb = (bf16*)(C.ws + WS_W);
    constexpr int I_IN = (NIN / 32) * (DM / 64), I_UQ = (NUQ / 32) * (512 / 64), I_UKV = (NUKV / 32) * (256 / 64), I_BF = (DM / 32) * (768 / 64), I_BR = (DM / 32) * (1024 / 64),
                  I_OUT = (DM / 32) * (DM / 64), I_UG = (NUG / 32) * (DM / 64), I_DN = (DM / 32) * (DFF / 64);
    constexpr int NITEMS = I_IN + I_UQ + I_UKV + 2 * I_BF + I_BR + I_OUT;
    for (int it = C.gw; it < NITEMS; it += C.NGW) {
        int r = it, src, valid;
        if (r < I_IN) { const int g = r / (DM / 64), kb = r % (DM / 64); inproj_src(g, src, valid); wconv_item(w_in, IN_W, src, valid, nullptr, (bf16*)((char*)Wb + WO_IN) + (size_t)g * 32 * DM, DM, kb * 64, scr, C.lane); continue; } r -= I_IN;
        if (r < I_UQ) { const int g = r / 8, kb = r % 8; uq_src(g, src, valid); wconv_item(w_uq, 1152, src, valid, qg, (bf16*)((char*)Wb + WO_UQ) + (size_t)g * 32 * 512, 512, kb * 64, scr, C.lane); continue; } r -= I_UQ;
        if (r < I_UKV) { const int g = r / 4, kb = r % 4; wconv_item(w_ukv, 1536, g * 32, 32, kvg, (bf16*)((char*)Wb + WO_UKV) + (size_t)g * 32 * 256, 256, kb * 64, scr, C.lane); continue; } r -= I_UKV;
        if (r < I_BF) { const int g = r / 12, kb = r % 12; wconv_item(w_bf, DM, g * 32, 32, nullptr, (bf16*)((char*)Wb + WO_BF) + (size_t)g * 32 * 1024, 1024, kb * 64, scr, C.lane); continue; } r -= I_BF;
        if (r < I_BF) { const int g = r / 12, kb = r % 12; wconv_item(w_bm, DM, g * 32, 32, nullptr, (bf16*)((char*)Wb + WO_BM) + (size_t)g * 32 * 1024, 1024, kb * 64, scr, C.lane); continue; } r -= I_BF;
        if (r < I_BR) { const int g = r / 16, kb = r % 16; wconv_item(w_br, DM, g * 32, 32, nullptr, (bf16*)((char*)Wb + WO_BR) + (size_t)g * 32 * 1024, 1024, kb * 64, scr, C.lane); continue; } r -= I_BR;
        if (r < I_OUT) { const int g = r / 32, kb = r % 32; wconv_item(w_out, DM, g * 32, 32, nullptr, (bf16*)((char*)Wb + WO_OUT) + (size_t)g * 32 * DM, DM, kb * 64, scr, C.lane); }
    }
    if (layer == 0) rows_rmsnorm_first(C, arg_in(0), arg_in(1), (bf16*)arg_out(), (bf16*)(C.ws + WS_H));
    else rows_rmsnorm_bf16(C, (const bf16*)arg_out(), arg_in(1) + (size_t)layer * DM, (bf16*)(C.ws + WS_H));
}
__device__ __forceinline__ void wconv_ffn(const Ctx& C0, int layer, int first, int nblk) { const Ctx C = ctx_local(C0);
    LAS float* scr = (LAS float*)(C.lds + RING_OFF + C.wave * 16384);
    const float* w_up = arg_in(13) + (size_t)layer * DM * DFF; const float* w_gate = arg_in(14) + (size_t)layer * DM * DFF; const float* w_dn = arg_in(17) + (size_t)layer * DFF * DM;
    bf16* Wb = (bf16*)(C.ws + WS_W);
    constexpr int I_UG = (NUG / 32) * (DM / 64), I_DN = (DM / 32) * (DFF / 64);
    for (int it = first * NWAVES + C.wave; it < I_UG + I_DN; it += nblk * NWAVES) {
        int r = it;
        if (r < I_UG) { const int g = r / 32, kb = r % 32; const int n = g * 32, t = n >> 8, bj = (n >> 7) & 1, x = n & 127;
            wconv_item(bj ? w_gate : w_up, DFF, 128 * t + x, 32, nullptr, (bf16*)((char*)Wb + WO_UG) + (size_t)g * 32 * DM, DM, kb * 64, scr, C.lane); continue; } r -= I_UG;
        { const int g = r / 88, kb = r % 88; wconv_item(w_dn, DM, g * 32, 32, nullptr, (bf16*)((char*)Wb + WO_DN) + (size_t)g * 32 * DFF, DFF, kb * 64, scr, C.lane); }
    }
}
__device__ __forceinline__ void p2_phase(const Ctx& C0, const Args& A, int layer) { const Ctx C = ctx_local(C0);
    const float* ff = (const float*)(C.ws + WS_FF); float* cL = (float*)(C.ws + WS_CL);
    LAS double* red = (LAS double*)(C.lds + RING_OFF);
    for (int sq = C.vcu; sq < NBATCH * 6; sq += C.G) {
        const int b = sq / 6, h = sq % 6; const float bias = arg_in(7)[layer * 6 + h];
        double v[8]; double run = 0.0;
#pragma unroll
        for (int j = 0; j < 8; ++j) { const float xf = ff[((size_t)b * SEQ + C.tid * 8 + j) * 8 + h] + bias;
            const float ls = fminf(xf, 0.f) - 0.6931471805599453f * __builtin_amdgcn_logf(1.0f + __builtin_amdgcn_exp2f(-1.4426950408889634f * fabsf(xf)));
            run += (double)ls; v[j] = run; }
        double incl = run;
#pragma unroll
        for (int o = 1; o < 64; o <<= 1) { const double t = lane_up_d(incl, C.lane, o); if (C.lane >= o) incl += t; }
        __syncthreads();
        if (C.lane == 63) red[C.wave] = incl;
        __syncthreads();
        double base = incl - run;
        for (int w = 0; w < C.wave; ++w) base += red[w];
        float* dst = cL + (size_t)sq * SEQ + C.tid * 8;
#pragma unroll
        for (int j = 0; j < 8; ++j) dst[j] = (float)((base + v[j]) * 1.4426950408889634);
    }
    const bf16* cq = (const bf16*)(C.ws + WS_CQ); const bf16* ckv = (const bf16*)(C.ws + WS_CKV); float* rq = (float*)(C.ws + WS_RSQ); float* rkv = (float*)(C.ws + WS_RSKV);
    for (int m0 = C.gw; m0 < M; m0 += 4 * C.NGW) {
        v4u a[4], c[4];
#pragma unroll
        for (int q = 0; q < 4; ++q) { const int m = m0 + q * C.NGW; const int mm = m < M ? m : m0; a[q] = *((const v4u*)(cq + (size_t)mm * 512) + C.lane); c[q] = *((const v4u*)(ckv + (size_t)mm * 256) + (C.lane & 31)); }
#pragma unroll
        for (int q = 0; q < 4; ++q) { const int m = m0 + q * C.NGW;
            float s = 0.f, s2 = 0.f; const unsigned w[4] = {a[q].x, a[q].y, a[q].z, a[q].w}, w2[4] = {c[q].x, c[q].y, c[q].z, c[q].w};
#pragma unroll
            for (int j = 0; j < 4; ++j) { const float lo = __uint_as_float(w[j] << 16), hi = __uint_as_float(w[j] & 0xffff0000u); s += lo * lo + hi * hi;
                const float lo2 = __uint_as_float(w2[j] << 16), hi2 = __uint_as_float(w2[j] & 0xffff0000u); if (C.lane < 32) s2 += lo2 * lo2 + hi2 * hi2; }
            s = wave_sum(s, C.lane); s2 = wave_sum(s2, C.lane);
            if (C.lane == 0 && m < M) { rq[m] = __builtin_amdgcn_rsqf(s * (1.0f / 512.0f) + NORM_EPS); rkv[m] = __builtin_amdgcn_rsqf(s2 * (1.0f / 256.0f) + NORM_EPS); } }
    }
    { const bf16* rk = (const bf16*)(C.ws + WS_RK); const bf16* rv = (const bf16*)(C.ws + WS_RV); float* sloc = (float*)(C.ws + WS_SLOC);
      for (int u = C.vcu; u < NBATCH * 4 * 16; u += C.G) { const int k = u & 15, h = (u >> 4) & 3, b = u >> 6; const size_t row0 = (size_t)b * SEQ + 256 * k;
          att::ret_state_unit(rk + row0 * 512 + 128 * h, 512, rv + row0 * 1024 + 256 * h, 1024, __builtin_amdgcn_logf(1.0f - __builtin_amdgcn_exp2f(-5.0f - (float)h)), sloc + (size_t)u * 32768, (LAS char*)(C.lds + RING_OFF)); } }
}
__device__ __forceinline__ void ret_scan(const Ctx& C0) { const Ctx C = ctx_local(C0);
    const float* sloc = (const float*)(C.ws + WS_SLOC); bf16* sst = (bf16*)(C.ws + WS_SST);
    for (int it = C.gw * 64 + C.lane; it < NBATCH * 4 * 8192; it += C.NGW * 64) {
        const int bh = it >> 13, e4 = (it & 8191) * 4, h = bh & 3;
        const float g256 = __builtin_amdgcn_exp2f(256.0f * __builtin_amdgcn_logf(1.0f - __builtin_amdgcn_exp2f(-5.0f - (float)h)));
        float z_ = 0.f; asm volatile("" : "+v"(z_));
        f32x4 s = {z_, z_, z_, z_};
        f32x4 l[16];
#pragma unroll
        for (int k = 0; k < 15; ++k) l[k] = *(const f32x4*)(sloc + ((size_t)bh * 16 + k) * 32768 + e4);
#pragma unroll
        for (int k = 0; k < 16; ++k) { const size_t o = ((size_t)bh * 16 + k) * 32768 + e4;
            *(unsigned long long*)(sst + o) = (unsigned long long)pk2(s[0], s[1]) | ((unsigned long long)pk2(s[2], s[3]) << 32);
            if (k < 15) s = s * g256 + l[k]; }
    }
}
__device__ __forceinline__ void p9_phase(const Ctx& C0, const Args& A, int layer) { const Ctx C = ctx_local(C0);
    const float* utail = (const float*)(C.ws + WS_UTAIL); const float* uhead = (const float*)(C.ws + WS_UHEAD); const float* ghead = (const float*)(C.ws + WS_GHEAD); bf16* act = (bf16*)(C.ws + WS_ACT);
    const float* cw = arg_in(15) + (size_t)layer * 3 * DFF; const float* cb = arg_in(16) + (size_t)layer * DFF;
    constexpr int NCH = DFF / 8, NITEM = (M / 256) * 2 * NCH;
    for (int it = C.gw * 64 + C.lane; it < NITEM; it += C.NGW * 64) {
        const int ch = it % NCH, rr = (it / NCH) & 1, pm = it / (2 * NCH), f0 = ch * 8;
        if ((pm & 15) == 0) continue;
        const float* p2 = rr ? utail + ((size_t)(pm - 1) * 2 + 1) * DFF : utail + ((size_t)(pm - 1) * 2) * DFF;
        const float* p1 = rr ? uhead + ((size_t)pm * 2) * DFF : utail + ((size_t)(pm - 1) * 2 + 1) * DFF;
        const float* p0 = uhead + ((size_t)pm * 2 + rr) * DFF; const float* pg = ghead + ((size_t)pm * 2 + rr) * DFF;
        unsigned o[4];
#pragma unroll
        for (int h = 0; h < 2; ++h) { const f32x4 x2 = *(const f32x4*)(p2 + f0 + 4 * h), x1 = *(const f32x4*)(p1 + f0 + 4 * h), x0 = *(const f32x4*)(p0 + f0 + 4 * h), g = *(const f32x4*)(pg + f0 + 4 * h);
            const f32x4 a = *(const f32x4*)(cw + f0 + 4 * h), b = *(const f32x4*)(cw + DFF + f0 + 4 * h), c = *(const f32x4*)(cw + 2 * DFF + f0 + 4 * h), d = *(const f32x4*)(cb + f0 + 4 * h);
            float r[4];
#pragma unroll
            for (int j = 0; j < 4; ++j) r[j] = pg8::gelu_gate(d[j] + a[j] * x2[j] + b[j] * x1[j] + c[j] * x0[j], g[j]);
            o[2 * h] = pg8::cvt_pk_bf16(r[0], r[1]); o[2 * h + 1] = pg8::cvt_pk_bf16(r[2], r[3]); }
        *(v4u*)(act + (size_t)(pm * 256 + rr) * DFF + f0) = (v4u){o[0], o[1], o[2], o[3]};
    }
}
#ifndef PROBE_SKIP_EPI
#define PROBE_SKIP_EPI 0
#endif
#ifndef KIND_MASK
#define KIND_MASK 7
#endif

__device__ __forceinline__ int queue_next(unsigned* head, volatile LAS unsigned* slot) {
    __syncthreads();
    if (threadIdx.x == 0) *slot = __hip_atomic_fetch_add(head, 1u, __ATOMIC_RELAXED, __HIP_MEMORY_SCOPE_AGENT);
    __syncthreads();
    return (int)*slot;
}
__device__ __forceinline__ int queue_after(volatile LAS unsigned* slot) { __syncthreads(); return (int)*slot; }
__device__ __forceinline__ void p4_phase(const Ctx& C0, const Args& A, int layer, volatile LAS unsigned* slot, int rep) { const Ctx C = ctx_local(C0);
    unsigned* qh = (unsigned*)(C.ws + WS_CTL) + CW_QUEUE + 64 * 3 * layer + 64 * 12 * rep;
    const bool k0 = rep == 0 || (KIND_MASK & 1), k1 = rep == 0 || (KIND_MASK & 2), k2 = rep == 0 || (KIND_MASK & 4);
    LAS char* lds = (LAS char*)(C.lds + RING_OFF);
    const bf16* fqkv = (const bf16*)(C.ws + WS_FQKV); const float* cL = (const float*)(C.ws + WS_CL);
    const bf16* qm = (const bf16*)(C.ws + WS_QM); const bf16* kvm = (const bf16*)(C.ws + WS_KVM); const bf16* kr = (const bf16*)(C.ws + WS_KR);
    const bf16* rq = (const bf16*)(C.ws + WS_RQ); const bf16* rk = (const bf16*)(C.ws + WS_RK); const bf16* rv = (const bf16*)(C.ws + WS_RV); const bf16* rg = (const bf16*)(C.ws + WS_RG);
    bf16* oa = (bf16*)(C.ws + WS_A); bf16* ob = (bf16*)(C.ws + WS_BM); bf16* oc = (bf16*)(C.ws + WS_C);
    if (k2) for (int i = queue_next(qh + 128, slot); i < 1024; i = queue_after(slot)) {
        const int qb = 31 - i / 32, bh = i % 32, b = bh >> 2, h = bh & 3; const size_t row0 = (size_t)b * SEQ + 128 * qb, seq0 = (size_t)b * SEQ;
        att::UnitPtrs U; U.Q = rq + row0 * 512 + 128 * h; U.ldq = 512; U.K = rk + seq0 * 512 + 128 * h; U.ldk = 512; U.V = rv + seq0 * 1024 + 256 * h; U.ldv = 1024; U.KR = nullptr; U.bias = nullptr;
        U.G = rg + row0 * 1024 + 256 * h; U.O = oc + row0 * 1024 + 256 * h; U.ldo = 1024; U.P0 = 128 * qb; U.T0 = 256 * (qb >> 1);
        U.ST = (qb >> 1) ? (const bf16*)(C.ws + WS_SST) + ((size_t)bh * 16 + (qb >> 1)) * 32768 : nullptr; U.c2 = __builtin_amdgcn_logf(1.0f - __builtin_amdgcn_exp2f(-5.0f - (float)h));
        att::mixer_unit<2>(U, lds, qh + 128, slot); }
    if (k1) for (int i = queue_next(qh + 64, slot); i < 768; i = queue_after(slot)) {
        const int qb = 15 - i / 48, bh = i % 48, b = bh / 6, h = bh % 6; const size_t row0 = (size_t)b * SEQ + 256 * qb, seq0 = (size_t)b * SEQ;
        att::UnitPtrs U; U.Q = qm + row0 * 1152 + 192 * h; U.ldq = 1152; U.K = kvm + seq0 * 1536 + 256 * h; U.ldk = 1536; U.V = U.K + 128; U.ldv = 1536; U.KR = kr + seq0 * 64; U.bias = nullptr; U.G = nullptr; U.ST = nullptr; U.T0 = 0;
        U.O = ob + row0 * 1024 + 128 * h; U.ldo = 1024; U.P0 = 256 * qb; U.c2 = 0.07216878364870322f * 1.4426950408889634f;
        att::mixer_unit<1>(U, lds, qh + 64, slot); }
    if (k0) for (int i = queue_next(qh, slot); i < 768; i = queue_after(slot)) {
        const int qb = 15 - i / 48, bh = i % 48, b = bh / 6, h = bh % 6; const size_t row0 = (size_t)b * SEQ + 256 * qb, seq0 = (size_t)b * SEQ;
        att::UnitPtrs U; U.Q = fqkv + row0 * 2304 + 128 * h; U.ldq = 2304; U.K = fqkv + seq0 * 2304 + 768 + 128 * h; U.ldk = 2304; U.V = U.K + 768; U.ldv = 2304; U.KR = nullptr; U.G = nullptr; U.ST = nullptr; U.T0 = 0;
        U.bias = cL + (size_t)bh * SEQ; U.O = oa + row0 * 1024 + 128 * h; U.ldo = 1024; U.P0 = 256 * qb; U.c2 = 0.08838834764831845f * 1.4426950408889634f;
        att::mixer_unit<0>(U, lds, qh, slot); }
}

__global__ void __launch_bounds__(NWAVES * 64, 2) hyb_fwd(Args args) {
    extern __shared__ __attribute__((aligned(16))) unsigned char lds_raw[];
    Ctx C;
    C.lds = (LAS unsigned char*)lds_raw;
    volatile LAS unsigned* MISC = (volatile LAS unsigned*)(C.lds + MISC_OFF);
    C.tid = 0; C.lane = 0; C.wave = __builtin_amdgcn_readfirstlane((int)threadIdx.x >> 6);
    C.G = gridDim.x; { const int bx = blockIdx.x; C.vcu = (C.G % 8 == 0) ? (bx % 8) * (C.G / 8) + bx / 8 : bx; }
    C.gw = C.vcu * NWAVES + C.wave; C.NGW = C.G * NWAVES; C.ws = arg_ws();
    unsigned* ctl = (unsigned*)(C.ws + WS_CTL);
    for (int u = threadIdx.x; u < (LDS_BYTES - LDSCTL_OFF) / 4; u += NWAVES * 64) ((LAS unsigned*)(C.lds + LDSCTL_OFF))[u] = 0u;
    __syncthreads();
#if MK_PER_PHASE
    XcdBarrier bar; bar.bar = ctl + CW_BAR; bar.x = 0; bar.st = nullptr; (void)bar;
#define GRID_BAR() do { } while (0)
#else
    XcdBarrier bar = xcd_barrier_post(ctl + CW_BAR, MISC + 8);
#define GRID_BAR() xcd_barrier(bar)
#endif
    const int lo = args.ph_lo, hi = args.ph_hi;
#define IN(k) (lo <= (k) && (k) < hi)
#ifndef PHASE_MASK
#define PHASE_MASK 0xFFFF
#endif
#define PHM(k) (((PHASE_MASK) >> (k)) & 1)
#ifndef SUB_MASK
#define SUB_MASK 0xFF
#endif
#define SUBM(k) (((SUB_MASK) >> (k)) & 1)
#ifndef REPEAT_MASK
#define REPEAT_MASK 0
#endif
#define REPS(k) (1 + (((REPEAT_MASK) >> (k)) & 1))

#define SEAM(k) do { if (IN(k) && IN((k) + 1)) GRID_BAR(); } while (0)
    PG8_LAS unsigned char* ring = (PG8_LAS unsigned char*)(C.lds + RING_OFF);
    const int bid = (int)blockIdx.x;
    if (PHM(0) && IN(0)) rope_tables(C, args);
    for (int layer = 0; layer < DEPTH; ++layer) {
        const int p = layer * PH;
        _Pragma("unroll") for (int rep = 0; rep < REPS(0); ++rep) if (PHM(0) && IN(p + 0)) { p0_phase(C, args, layer); if (rep + 1 < REPS(0)) GRID_BAR(); else SEAM(p + 0); }
        _Pragma("unroll") for (int rep = 0; rep < REPS(1); ++rep) if (PHM(1) && IN(p + 1)) { size_t wz_ = 0; asm volatile("" : "+s"(wz_)); unsigned char* wsl = arg_ws() + wz_; pg8::bf16_t* Wb = (pg8::bf16_t*)(wsl + WS_W); pg8::bf16_t* Hb = (pg8::bf16_t*)(wsl + WS_H);
            pg8::Gemm g{Hb, (const pg8::bf16_t*)((char*)Wb + WO_IN), M, NIN, DM}; pg8::StaticOrder S; S.init(M, NIN, C.G, bid);
            pg8::EpiInProj E{wsl, WS_FQKV, WS_CQ, WS_CKV, WS_KR, WS_RQ, WS_RK, WS_RV, WS_RG, WS_GATES, WS_FF, WS_T128, WS_T64, (rep + 1 < REPS(1)) ? PROBE_SKIP_EPI : 0};
            pg8::gemm_phase<pg8::EpiInProj, pg8::StaticOrder, true, true>(ring, g, S, E);
            { const int nfull = (M / 256) * (NIN / 256) % C.G; if (rep + 1 == REPS(1)) { if (nfull == 0) wconv_ffn(C, layer, bid, C.G); else if (bid >= nfull) wconv_ffn(C, layer, bid - nfull, C.G - nfull); } }
            if (rep + 1 < REPS(1)) GRID_BAR(); else SEAM(p + 1); }
        _Pragma("unroll") for (int rep = 0; rep < REPS(2); ++rep) if (PHM(2) && IN(p + 2)) { p2_phase(C, args, layer); if (rep + 1 < REPS(2)) GRID_BAR(); else SEAM(p + 2); }
        _Pragma("unroll") for (int rep = 0; rep < REPS(3); ++rep) if (PHM(3) && IN(p + 3)) { size_t wz_ = 0; asm volatile("" : "+s"(wz_)); unsigned char* wsl = arg_ws() + wz_; pg8::bf16_t* Wb = (pg8::bf16_t*)(wsl + WS_W); pg8::bf16_t* Hb = (pg8::bf16_t*)(wsl + WS_H);
            if (SUBM(0)) { pg8::Gemm g{(const pg8::bf16_t*)(wsl + WS_CQ), (const pg8::bf16_t*)((char*)Wb + WO_UQ), M, NUQ, 512}; pg8::StaticOrder S; S.init(M, NUQ, C.G, bid);
              pg8::EpiUq E{(pg8::bf16_t*)(wsl + WS_QM), (const float*)(wsl + WS_RSQ), (const float*)(wsl + WS_T64)};
              pg8::gemm_phase<pg8::EpiUq, pg8::StaticOrder, true, true>(ring, g, S, E); }
            if (SUBM(1)) { pg8::Gemm g{(const pg8::bf16_t*)(wsl + WS_CKV), (const pg8::bf16_t*)((char*)Wb + WO_UKV), M, NUKV, 256}; pg8::StaticOrder S; S.init(M, NUKV, C.G, bid);
              pg8::EpiUkv E{(pg8::bf16_t*)(wsl + WS_KVM), (const float*)(wsl + WS_RSKV)};
              pg8::gemm_phase<pg8::EpiUkv, pg8::StaticOrder, true, true>(ring, g, S, E); }
            ret_scan(C);
            if (rep + 1 < REPS(3)) GRID_BAR(); else SEAM(p + 3); }
        _Pragma("unroll") for (int rep = 0; rep < REPS(4); ++rep) if (PHM(4) && IN(p + 4)) { p4_phase(C, args, layer, MISC + 16, rep); if (rep + 1 < REPS(4)) GRID_BAR(); else SEAM(p + 4); }
        _Pragma("unroll") for (int rep = 0; rep < REPS(5); ++rep) if (PHM(5) && IN(p + 5)) { size_t wz_ = 0; asm volatile("" : "+s"(wz_)); unsigned char* wsl = arg_ws() + wz_; pg8::bf16_t* Wb = (pg8::bf16_t*)(wsl + WS_W); pg8::bf16_t* Hb = (pg8::bf16_t*)(wsl + WS_H);
            { static_assert(WS_BM - WS_A == WS_C - WS_BM && WO_BM - WO_BF == WO_BR - WO_BM, "equally spaced sub-GEMM operands");
              pg8::GemmM g{(const pg8::bf16_t*)(wsl + WS_A), (const pg8::bf16_t*)((char*)Wb + WO_BF), (WS_BM - WS_A) / 2, (WO_BM - WO_BF) / 2, 12, 4, 1024, 1024};
              pg8::StaticOrder3 S; S.init(M, DM, C.G, bid);
              pg8::EpiMergeM E{(const pg8::bf16_t*)(wsl + WS_GATES), Hb};
              pg8::gemm_phase_m<pg8::EpiMergeM, pg8::StaticOrder3, true, true>(ring, g, S, E); }
            if (rep + 1 < REPS(5)) GRID_BAR(); else SEAM(p + 5); }
        _Pragma("unroll") for (int rep = 0; rep < REPS(6); ++rep) if (PHM(6) && IN(p + 6)) { size_t wz_ = 0; asm volatile("" : "+s"(wz_)); unsigned char* wsl = arg_ws() + wz_; pg8::bf16_t* Wb = (pg8::bf16_t*)(wsl + WS_W); pg8::bf16_t* Hb = (pg8::bf16_t*)(wsl + WS_H);
            pg8::Gemm g{Hb, (const pg8::bf16_t*)((char*)Wb + WO_OUT), M, DM, DM}; pg8::StaticOrder S; S.init(M, DM, C.G, bid);
            pg8::EpiResid E{(rep + 1 < REPS(6)) ? (pg8::bf16_t*)(wsl + WS_GATES) : (pg8::bf16_t*)arg_out()}; pg8::gemm_phase<pg8::EpiResid, pg8::StaticOrder, true, true>(ring, g, S, E);
            if (rep + 1 < REPS(6)) GRID_BAR(); else SEAM(p + 6); }
        _Pragma("unroll") for (int rep = 0; rep < REPS(7); ++rep) if (PHM(7) && IN(p + 7)) { rows_rmsnorm_bf16(C, (const bf16*)arg_out(), arg_in(12) + (size_t)layer * DM, (bf16*)(C.ws + WS_H)); if (rep + 1 < REPS(7)) GRID_BAR(); else SEAM(p + 7); }
        _Pragma("unroll") for (int rep = 0; rep < REPS(8); ++rep) if (PHM(8) && IN(p + 8)) { size_t wz_ = 0; asm volatile("" : "+s"(wz_)); unsigned char* wsl = arg_ws() + wz_; pg8::bf16_t* Wb = (pg8::bf16_t*)(wsl + WS_W); pg8::bf16_t* Hb = (pg8::bf16_t*)(wsl + WS_H);
            pg8::Gemm g{Hb, (const pg8::bf16_t*)((char*)Wb + WO_UG), M, NUG, DM}; pg8::StaticOrder S; S.init(M, NUG, C.G, bid);
            pg8::EpiConvAct E{(pg8::bf16_t*)(wsl + WS_ACT), (float*)(wsl + WS_UTAIL), (float*)(wsl + WS_UHEAD), (float*)(wsl + WS_GHEAD), arg_in(15) + (size_t)layer * 3 * DFF, arg_in(16) + (size_t)layer * DFF, (PG8_LAS float*)(C.lds + LDSCTL_OFF + 1024)};
            pg8::gemm_phase<pg8::EpiConvAct, pg8::StaticOrder, true, true>(ring, g, S, E);
            if (rep + 1 < REPS(8)) GRID_BAR(); else SEAM(p + 8); }
        _Pragma("unroll") for (int rep = 0; rep < REPS(9); ++rep) if (PHM(9) && IN(p + 9)) { p9_phase(C, args, layer); if (rep + 1 < REPS(9)) GRID_BAR(); else SEAM(p + 9); }
        _Pragma("unroll") for (int rep = 0; rep < REPS(10); ++rep) if (PHM(10) && IN(p + 10)) { size_t wz_ = 0; asm volatile("" : "+s"(wz_)); unsigned char* wsl = arg_ws() + wz_; pg8::bf16_t* Wb = (pg8::bf16_t*)(wsl + WS_W); pg8::bf16_t* Hb = (pg8::bf16_t*)(wsl + WS_H);
            pg8::Gemm g{(const pg8::bf16_t*)(wsl + WS_ACT), (const pg8::bf16_t*)((char*)Wb + WO_DN), M, DM, DFF}; pg8::StaticOrder S; S.init(M, DM, C.G, bid);
            pg8::EpiResid E{(rep + 1 < REPS(10)) ? (pg8::bf16_t*)(wsl + WS_GATES) : (pg8::bf16_t*)arg_out()}; pg8::gemm_phase<pg8::EpiResid, pg8::StaticOrder, true, true>(ring, g, S, E);
            if (rep + 1 < REPS(10)) GRID_BAR(); else SEAM(p + 10); }
    }
    if (IN(DEPTH * PH)) rows_rmsnorm_final(C, arg_out(), arg_in(18));
#if defined(PROBE_EXTRA_BARRIERS) && !MK_PER_PHASE
    for (int i = 0; i < PROBE_EXTRA_BARRIERS; ++i) GRID_BAR();
#endif
#undef IN
#undef SEAM
#undef GRID_BAR
}

extern "C" void kernel_launch(void* const* d_in, const int* in_sizes, int n_in, void* d_out, int out_size, void* d_ws, size_t ws_size, hipStream_t stream) {
    static int grid = 0;
    if (grid == 0) {
        if (n_in != 19 || out_size != M * DM || ws_size < WS_END) { fprintf(stderr, "kernel_launch: unexpected problem (n_in %d, out %d, ws %zu < %zu); nothing launched\n", n_in, out_size, ws_size, (size_t)WS_END); grid = -1; return; }
        int dev = 0, cus = 0, per_cu = 0;
        if (hipGetDevice(&dev) != hipSuccess || hipDeviceGetAttribute(&cus, hipDeviceAttributeMultiprocessorCount, dev) != hipSuccess) { grid = -1; return; }
        if (hipFuncSetAttribute((const void*)hyb_fwd, hipFuncAttributeMaxDynamicSharedMemorySize, LDS_BYTES) != hipSuccess) { fprintf(stderr, "kernel_launch: hipFuncSetAttribute failed\n"); grid = -1; return; }
        if (hipOccupancyMaxActiveBlocksPerMultiprocessor(&per_cu, (const void*)hyb_fwd, NWAVES * 64, LDS_BYTES) != hipSuccess || per_cu < 1) { fprintf(stderr, "kernel_launch: occupancy query says %d\n", per_cu); }
        (void)hipGetLastError();
        grid = cus;
    }
    if (grid < 0) return;
    (void)in_sizes;
    if (hipMemsetAsync((char*)d_ws + WS_CTL, 0, CTL_ZERO_BYTES, stream) != hipSuccess) return;
    Args a; memset(&a, 0, sizeof(a));
    for (int i = 0; i < 19; ++i) a.in[i] = (const float*)d_in[i];
    a.out = (float*)d_out; a.ws = (unsigned char*)d_ws;
    for (int i = 0; i < 64; ++i) a.invf128[i] = (float)pow(10000.0, -(double)(2 * i) / 128.0);
    for (int i = 0; i < 32; ++i) a.invf64[i] = (float)pow(10000.0, -(double)(2 * i) / 64.0);
#if MK_PER_PHASE
    for (int ph = 0; ph < NPHASE; ++ph) { a.ph_lo = ph; a.ph_hi = ph + 1; hipLaunchKernelGGL(hyb_fwd, dim3(grid), dim3(NWAVES * 64), LDS_BYTES, stream, a); }
#else
    a.ph_lo = 0; a.ph_hi = NPHASE; hipLaunchKernelGGL(hyb_fwd, dim3(grid), dim3(NWAVES * 64), LDS_BYTES, stream, a);
#endif
    const hipError_t le = hipPeekAtLastError();
    if (le != hipSuccess) fprintf(stderr, "kernel_launch: launch failed: %s\n", hipGetErrorName(le));
}
```

```cpp
#include <hip/hip_runtime.h>
#include <cstdio>
#include <cstdint>
#include <cmath>
#ifndef MK_PER_PHASE
#define MK_PER_PHASE 0
#endif
#include <cstring>
namespace pg8 {
#define PG8_LAS __attribute__((address_space(3)))
typedef unsigned short bf16_t;
typedef short bf16x8 __attribute__((ext_vector_type(8)));
typedef float f32x4 __attribute__((ext_vector_type(4)));
typedef unsigned u32x4 __attribute__((ext_vector_type(4)));
constexpr int BM = 256, BK = 64, HALF = 128, HTB = HALF * BK * 2  , STAGE_BYTES = 8 * HTB, NXCD = 8, WGM = 8;

__host__ __device__ __forceinline__ int lds_byte(int r, int c) { const int st = (r >> 4) * 2 + (c >> 5), rr = r & 15, cc = c & 31, ob = rr * 64 + cc * 2; return st * 1024 + (ob ^ (((ob >> 9) & 1) << 5)); }
__host__ __device__ __forceinline__ void stage_rc(int b, int& R, int& C) { const int st = b / 1024, sb = b % 1024, swz = sb ^ (((sb >> 9) & 1) << 5); R = (st >> 1) * 16 + swz / 64; C = (st & 1) * 32 + (swz % 64) / 2; }
__host__ __device__ __forceinline__ int perm32(int rho) { const int n = rho >> 4, i = rho & 15; return 8 * (i >> 2) + 4 * n + (i & 3); }

struct Unit { int pm, pn; };
struct Gemm { const bf16_t* A; const bf16_t* Bt; int M, N, K; };

struct StaticOrder {
    int nM, nN, nwg, G, c;
    __host__ __device__ void init(int M, int N, int G_, int c_) { nM = M / BM; nN = N / BM; nwg = nM * nN; G = G_; c = c_; }
    __host__ __device__ bool next(int i, Unit& u) const {
        const long L = (long)i * G + c; if (L >= nwg) return false;
        int wgid = (int)L; { const int q = nwg / NXCD, r = nwg % NXCD, xcd = wgid % NXCD, off = wgid / NXCD; wgid = (xcd < r ? xcd * (q + 1) : r * (q + 1) + (xcd - r) * q) + off; }
        const int nig = WGM * nN, gid = wgid / nig, fm = gid * WGM, gsz = (nM - fm) < WGM ? (nM - fm) : WGM;
        u.pm = fm + ((wgid % nig) % gsz); u.pn = (wgid % nig) / gsz; return true;
    }
    __device__ __forceinline__ void a_ready(const Unit&) const {}
    __device__ __forceinline__ void done(const Unit&) const {}
};

template <class Epi, class Sched, bool ALIGN_EPI = false, bool SP2 = false>
__device__ __forceinline__ void gemm_phase(PG8_LAS unsigned char* lds, const Gemm g, const Sched& S, const Epi& E) {
    int tid_ = threadIdx.x; asm volatile("" : "+v"(tid_));
    const int tid = tid_, wid = __builtin_amdgcn_readfirstlane(tid >> 6), lane = tid & 63, wr = wid >> 2, wc = wid & 3, fr = lane & 15, fq = lane >> 4;
    int K_ = g.K; asm volatile("" : "+s"(K_)); const int K = K_, nt = K / BK;
    unsigned voffA[2], voffB[2];
#pragma unroll
    for (int i = 0; i < 2; ++i) { int R, C; stage_rc(tid * 16 + i * 8192, R, C); const int Rb = Epi::PERM ? ((R & ~31) + perm32(R & 31)) : R;
        voffA[i] = (unsigned)(R * K + C) * 2u; voffB[i] = (unsigned)(Rb * K + C) * 2u; }
    const size_t kstep = (size_t)(BK * 2);
    const size_t hstep = (size_t)HALF * K * 2;
    const size_t tstep = 2 * hstep;
    const unsigned ldsw = (unsigned)wid * 1024u;
    const int aoff = lds_byte(wr * 64 + fr, fq * 8), boff = lds_byte(wc * 32 + fr, fq * 8);
#define PG8_SA(b, h) (((b) * 2 + (h)) * HTB)
#define PG8_SB(b, h) ((4 + (b) * 2 + (h)) * HTB)
#define PG8_STAGE(bufoff, gbase, voff) do { _Pragma("unroll") for (int _i = 0; _i < 2; ++_i) \
        __builtin_amdgcn_global_load_lds((const unsigned*)((const char*)(gbase) + (voff)[_i]), (PG8_LAS unsigned*)(lds + (bufoff) + ldsw + _i * 8192), 16, 0, 0); } while (0)
#define PG8_LDA(dst, b, h) do { _Pragma("unroll") for (int m = 0; m < 4; ++m) _Pragma("unroll") for (int k = 0; k < 2; ++k) dst[m][k] = *(const PG8_LAS bf16x8*)(lds + PG8_SA(b, h) + aoff + m * 2048 + k * 1024); } while (0)
#define PG8_LDB(dst, b, h) do { _Pragma("unroll") for (int n = 0; n < 2; ++n) _Pragma("unroll") for (int k = 0; k < 2; ++k) dst[n][k] = *(const PG8_LAS bf16x8*)(lds + PG8_SB(b, h) + boff + n * 2048 + k * 1024); } while (0)
#define PG8_MMA(ai, bj, At, Bt) do { __builtin_amdgcn_s_setprio(1); _Pragma("unroll") for (int m = 0; m < 4; ++m) _Pragma("unroll") for (int n = 0; n < 2; ++n) _Pragma("unroll") for (int k = 0; k < 2; ++k) \
        acc[ai][bj][m][n] = __builtin_amdgcn_mfma_f32_16x16x32_bf16(Bt[n][k], At[m][k], acc[ai][bj][m][n], 0, 0, 0); __builtin_amdgcn_s_setprio(0); } while (0)
#define PG8_WAIT_V(n) asm volatile("s_waitcnt vmcnt(" #n ")" ::: "memory")
#define PG8_WAIT_L(n) asm volatile("s_waitcnt lgkmcnt(" #n ")" ::: "memory")
#define PG8_BAR __builtin_amdgcn_s_barrier()
#define PG8_SCHED __builtin_amdgcn_sched_barrier(0)
    Unit cur, nxt; int ui = 0;
    if (!S.next(0, cur)) return;
    f32x4 acc[2][2][4][2];
#pragma unroll
    for (int a = 0; a < 2; ++a)
#pragma unroll
        for (int b = 0; b < 2; ++b)
#pragma unroll
            for (int m = 0; m < 4; ++m)
#pragma unroll
                for (int n = 0; n < 2; ++n) acc[a][b][m][n] = (f32x4){0.f, 0.f, 0.f, 0.f};
    bf16x8 At[4][2], B0[2][2], B1[2][2];
    const char* cA = (const char*)g.A + (size_t)cur.pm * tstep; const char* cB = (const char*)g.Bt + (size_t)cur.pn * tstep;
    S.a_ready(cur);
    if constexpr (SP2) {
        PG8_STAGE(PG8_SB(0, 0), cB, voffB); PG8_STAGE(PG8_SB(0, 1), cB + hstep, voffB); PG8_STAGE(PG8_SA(0, 0), cA, voffA); PG8_STAGE(PG8_SA(0, 1), cA + hstep, voffA);
        if (wr == 1) PG8_BAR;
        PG8_WAIT_V(2); PG8_BAR;
        PG8_STAGE(PG8_SB(1, 0), cB + kstep, voffB); PG8_STAGE(PG8_SA(1, 0), cA + kstep, voffA); PG8_STAGE(PG8_SB(1, 1), cB + hstep + kstep, voffB);
        PG8_WAIT_V(6); PG8_BAR;
    } else {
        PG8_STAGE(PG8_SB(0, 0), cB, voffB); PG8_STAGE(PG8_SA(0, 0), cA, voffA); PG8_STAGE(PG8_SB(0, 1), cB + hstep, voffB); PG8_STAGE(PG8_SA(0, 1), cA + hstep, voffA);
        if (wr == 1) PG8_BAR;
        PG8_WAIT_V(4); PG8_BAR;
        PG8_STAGE(PG8_SB(1, 0), cB + kstep, voffB); PG8_STAGE(PG8_SA(1, 0), cA + kstep, voffA); PG8_STAGE(PG8_SB(1, 1), cB + hstep + kstep, voffB);
        PG8_WAIT_V(6); PG8_BAR;
    }
    for (;;) {
        const bool has_next = S.next(ui + 1, nxt);
        const char* nA = has_next ? (const char*)g.A + (size_t)nxt.pm * tstep : cA; const char* nB = has_next ? (const char*)g.Bt + (size_t)nxt.pn * tstep : cB;
        for (int t = 0; t < nt; t += 2) {
            const bool last = (t == nt - 2);
            const char* a1 = cA + (size_t)(t + 1) * kstep;
            const char* a2 = last ? nA : cA + (size_t)(t + 2) * kstep; const char* b2 = last ? nB : cB + (size_t)(t + 2) * kstep;
            const char* a3 = a2 + kstep; const char* b3 = b2 + kstep;
            if (last && has_next) S.a_ready(nxt);
            if constexpr (SP2) {
            PG8_LDB(B0, 0, 0); PG8_LDB(B1, 0, 1); PG8_SCHED; PG8_LDA(At, 0, 0); PG8_STAGE(PG8_SA(1, 1), a1 + hstep, voffA);
            PG8_WAIT_V(8); PG8_WAIT_L(0); PG8_BAR; PG8_MMA(0, 0, At, B0); PG8_MMA(0, 1, At, B1); PG8_BAR; PG8_SCHED;
            PG8_LDA(At, 0, 1); PG8_STAGE(PG8_SB(0, 0), b2, voffB); PG8_STAGE(PG8_SB(0, 1), b2 + hstep, voffB); PG8_STAGE(PG8_SA(0, 0), a2, voffA);
            PG8_WAIT_V(8); PG8_WAIT_L(0); PG8_BAR; PG8_MMA(1, 0, At, B0); PG8_MMA(1, 1, At, B1); PG8_BAR; PG8_SCHED;
            PG8_LDB(B0, 1, 0); PG8_LDB(B1, 1, 1); PG8_SCHED; PG8_LDA(At, 1, 0); PG8_STAGE(PG8_SA(0, 1), a2 + hstep, voffA);
            PG8_WAIT_V(8); PG8_WAIT_L(0); PG8_BAR; PG8_MMA(0, 0, At, B0); PG8_MMA(0, 1, At, B1); PG8_BAR; PG8_SCHED;
            PG8_LDA(At, 1, 1); PG8_STAGE(PG8_SB(1, 0), b3, voffB); PG8_STAGE(PG8_SB(1, 1), b3 + hstep, voffB); PG8_STAGE(PG8_SA(1, 0), a3, voffA);
            PG8_WAIT_V(8); PG8_WAIT_L(0); PG8_BAR; PG8_MMA(1, 0, At, B0); PG8_MMA(1, 1, At, B1); PG8_BAR; PG8_SCHED;
            } else {
            PG8_LDB(B0, 0, 0); PG8_SCHED; PG8_LDA(At, 0, 0); PG8_STAGE(PG8_SA(1, 1), a1 + hstep, voffA);
            PG8_WAIT_L(8); PG8_BAR; PG8_WAIT_L(0); PG8_MMA(0, 0, At, B0); PG8_BAR; PG8_SCHED;
            PG8_LDB(B1, 0, 1); PG8_STAGE(PG8_SB(0, 0), b2, voffB);
            PG8_BAR; PG8_WAIT_L(0); PG8_MMA(0, 1, At, B1); PG8_BAR;
            PG8_LDA(At, 0, 1); PG8_STAGE(PG8_SA(0, 0), a2, voffA);
            PG8_BAR; PG8_WAIT_L(0); PG8_MMA(1, 0, At, B0); PG8_BAR; PG8_SCHED;
            PG8_STAGE(PG8_SB(0, 1), b2 + hstep, voffB);
            PG8_WAIT_V(6); PG8_BAR; PG8_MMA(1, 1, At, B1); PG8_BAR;
            PG8_LDB(B0, 1, 0); PG8_SCHED; PG8_LDA(At, 1, 0); PG8_STAGE(PG8_SA(0, 1), a2 + hstep, voffA);
            PG8_WAIT_L(8); PG8_BAR; PG8_WAIT_L(0); PG8_MMA(0, 0, At, B0); PG8_BAR; PG8_SCHED;
            PG8_LDB(B1, 1, 1); PG8_STAGE(PG8_SB(1, 0), b3, voffB);
            PG8_BAR; PG8_WAIT_L(0); PG8_MMA(0, 1, At, B1); PG8_BAR;
            PG8_LDA(At, 1, 1); PG8_STAGE(PG8_SA(1, 0), a3, voffA);
            PG8_BAR; PG8_WAIT_L(0); PG8_MMA(1, 0, At, B0); PG8_BAR; PG8_SCHED;
            PG8_STAGE(PG8_SB(1, 1), b3 + hstep, voffB);
            PG8_WAIT_V(6); PG8_BAR; PG8_MMA(1, 1, At, B1); PG8_BAR;
            }
        }
        if constexpr (ALIGN_EPI) { if (wr == 0) PG8_BAR; }
        if constexpr (!Epi::AFTER_DRAIN) { E(acc, cur, wr, wc, fr, fq); S.done(cur); }
        if (!has_next) break;
#pragma unroll
        for (int a = 0; a < 2; ++a)
#pragma unroll
            for (int b = 0; b < 2; ++b)
#pragma unroll
                for (int m = 0; m < 4; ++m)
#pragma unroll
                    for (int n = 0; n < 2; ++n) acc[a][b][m][n] = (f32x4){0.f, 0.f, 0.f, 0.f};
        cur = nxt; cA = nA; cB = nB; ++ui;
        if constexpr (ALIGN_EPI) { if (wr == 1) PG8_BAR; }
    }
    PG8_WAIT_V(0);
    if constexpr (!ALIGN_EPI) { if (wr == 0) PG8_BAR; }
    PG8_BAR;
    if constexpr (Epi::AFTER_DRAIN) { E.fused(acc, cur, wr, wc, fr, fq, lds, wid, lane); S.done(cur); }
#undef PG8_SA
#undef PG8_SB
#undef PG8_STAGE
#undef PG8_LDA
#undef PG8_LDB
#undef PG8_MMA
#undef PG8_WAIT_V
#undef PG8_WAIT_L
#undef PG8_BAR
#undef PG8_SCHED
}

struct UnitM { int pm, pn, sub; };
struct GemmM { const bf16_t* A0; const bf16_t* B0; size_t strideA, strideB; int nt0, dnt2; int lda, ldb;
    __device__ __forceinline__ const bf16_t* a(int s) const { return A0 + (size_t)s * strideA; }
    __device__ __forceinline__ const bf16_t* b(int s) const { return B0 + (size_t)s * strideB; }
    __device__ __forceinline__ int nt(int s) const { return nt0 + (s >> 1) * dnt2; } };
struct StaticOrder3 {
    StaticOrder S;
    __device__ void init(int M, int N, int G_, int c_) { S.init(M, N, G_, c_); }
    __device__ bool next(int i, UnitM& u) const { Unit t; if (!S.next(i / 3, t)) return false; u.pm = t.pm; u.pn = t.pn; u.sub = i - 3 * (i / 3); return true; }
    __device__ __forceinline__ void a_ready(const UnitM&) const {}
    __device__ __forceinline__ void done(const UnitM&) const {}
};
template <class Epi, class Sched, bool ALIGN_EPI = false, bool SP2 = false>
__device__ __forceinline__ void gemm_phase_m(PG8_LAS unsigned char* lds, const GemmM g, const Sched& S, const Epi& E) {
    int tid_ = threadIdx.x; asm volatile("" : "+v"(tid_));
    const int tid = tid_, wid = __builtin_amdgcn_readfirstlane(tid >> 6), lane = tid & 63, wr = wid >> 2, wc = wid & 3, fr = lane & 15, fq = lane >> 4;
    int lda_ = g.lda, ldb_ = g.ldb; asm volatile("" : "+s"(lda_), "+s"(ldb_)); const int lda = lda_, ldb = ldb_; int nt;
    unsigned voffA[2], voffB[2];
#pragma unroll
    for (int i = 0; i < 2; ++i) { int R, C; stage_rc(tid * 16 + i * 8192, R, C); const int Rb = Epi::PERM ? ((R & ~31) + perm32(R & 31)) : R;
        voffA[i] = (unsigned)(R * lda + C) * 2u; voffB[i] = (unsigned)(Rb * ldb + C) * 2u; }
    const size_t kstep = (size_t)(BK * 2);
    const size_t hstepA = (size_t)HALF * lda * 2, hstepB = (size_t)HALF * ldb * 2;
    const size_t tstepA = 2 * hstepA, tstepB = 2 * hstepB;
    const unsigned ldsw = (unsigned)wid * 1024u;
    const int aoff = lds_byte(wr * 64 + fr, fq * 8), boff = lds_byte(wc * 32 + fr, fq * 8);
#define PG8_SA(b, h) (((b) * 2 + (h)) * HTB)
#define PG8_SB(b, h) ((4 + (b) * 2 + (h)) * HTB)
#define PG8_STAGE(bufoff, gbase, voff) do { _Pragma("unroll") for (int _i = 0; _i < 2; ++_i) \
        __builtin_amdgcn_global_load_lds((const unsigned*)((const char*)(gbase) + (voff)[_i]), (PG8_LAS unsigned*)(lds + (bufoff) + ldsw + _i * 8192), 16, 0, 0); } while (0)
#define PG8_LDA(dst, b, h) do { _Pragma("unroll") for (int m = 0; m < 4; ++m) _Pragma("unroll") for (int k = 0; k < 2; ++k) dst[m][k] = *(const PG8_LAS bf16x8*)(lds + PG8_SA(b, h) + aoff + m * 2048 + k * 1024); } while (0)
#define PG8_LDB(dst, b, h) do { _Pragma("unroll") for (int n = 0; n < 2; ++n) _Pragma("unroll") for (int k = 0; k < 2; ++k) dst[n][k] = *(const PG8_LAS bf16x8*)(lds + PG8_SB(b, h) + boff + n * 2048 + k * 1024); } while (0)
#define PG8_MMA(ai, bj, At, Bt) do { __builtin_amdgcn_s_setprio(1); _Pragma("unroll") for (int m = 0; m < 4; ++m) _Pragma("unroll") for (int n = 0; n < 2; ++n) _Pragma("unroll") for (int k = 0; k < 2; ++k) \
        acc[ai][bj][m][n] = __builtin_amdgcn_mfma_f32_16x16x32_bf16(Bt[n][k], At[m][k], acc[ai][bj][m][n], 0, 0, 0); __builtin_amdgcn_s_setprio(0); } while (0)
#define PG8_WAIT_V(n) asm volatile("s_waitcnt vmcnt(" #n ")" ::: "memory")
#define PG8_WAIT_L(n) asm volatile("s_waitcnt lgkmcnt(" #n ")" ::: "memory")
#define PG8_BAR __builtin_amdgcn_s_barrier()
#define PG8_SCHED __builtin_amdgcn_sched_barrier(0)
    UnitM cur, nxt; int ui = 0;
    if (!S.next(0, cur)) return;
    f32x4 acc[2][2][4][2];
#pragma unroll
    for (int a = 0; a < 2; ++a)
#pragma unroll
        for (int b = 0; b < 2; ++b)
#pragma unroll
            for (int m = 0; m < 4; ++m)
#pragma unroll
                for (int n = 0; n < 2; ++n) acc[a][b][m][n] = (f32x4){0.f, 0.f, 0.f, 0.f};
    bf16x8 At[4][2], B0[2][2], B1[2][2];
    const char* cA = (const char*)g.a(cur.sub) + (size_t)cur.pm * tstepA; const char* cB = (const char*)g.b(cur.sub) + (size_t)cur.pn * tstepB; nt = g.nt(cur.sub);
    S.a_ready(cur);
    if constexpr (SP2) {
        PG8_STAGE(PG8_SB(0, 0), cB, voffB); PG8_STAGE(PG8_SB(0, 1), cB + hstepB, voffB); PG8_STAGE(PG8_SA(0, 0), cA, voffA); PG8_STAGE(PG8_SA(0, 1), cA + hstepA, voffA);
        if (wr == 1) PG8_BAR;
        PG8_WAIT_V(2); PG8_BAR;
        PG8_STAGE(PG8_SB(1, 0), cB + kstep, voffB); PG8_STAGE(PG8_SA(1, 0), cA + kstep, voffA); PG8_STAGE(PG8_SB(1, 1), cB + hstepB + kstep, voffB);
        PG8_WAIT_V(6); PG8_BAR;
    } else {
        PG8_STAGE(PG8_SB(0, 0), cB, voffB); PG8_STAGE(PG8_SA(0, 0), cA, voffA); PG8_STAGE(PG8_SB(0, 1), cB + hstepB, voffB); PG8_STAGE(PG8_SA(0, 1), cA + hstepA, voffA);
        if (wr == 1) PG8_BAR;
        PG8_WAIT_V(4); PG8_BAR;
        PG8_STAGE(PG8_SB(1, 0), cB + kstep, voffB); PG8_STAGE(PG8_SA(1, 0), cA + kstep, voffA); PG8_STAGE(PG8_SB(1, 1), cB + hstepB + kstep, voffB);
        PG8_WAIT_V(6); PG8_BAR;
    }
    for (;;) {
        const bool has_next = S.next(ui + 1, nxt);
        const char* nA = has_next ? (const char*)g.a(nxt.sub) + (size_t)nxt.pm * tstepA : cA; const char* nB = has_next ? (const char*)g.b(nxt.sub) + (size_t)nxt.pn * tstepB : cB;
        for (int t = 0; t < nt; t += 2) {
            const bool last = (t == nt - 2);
            const char* a1 = cA + (size_t)(t + 1) * kstep;
            const char* a2 = last ? nA : cA + (size_t)(t + 2) * kstep; const char* b2 = last ? nB : cB + (size_t)(t + 2) * kstep;
            const char* a3 = a2 + kstep; const char* b3 = b2 + kstep;
            if (last && has_next) S.a_ready(nxt);
            if constexpr (SP2) {
            PG8_LDB(B0, 0, 0); PG8_LDB(B1, 0, 1); PG8_SCHED; PG8_LDA(At, 0, 0); PG8_STAGE(PG8_SA(1, 1), a1 + hstepA, voffA);
            PG8_WAIT_V(8); PG8_WAIT_L(0); PG8_BAR; PG8_MMA(0, 0, At, B0); PG8_MMA(0, 1, At, B1); PG8_BAR; PG8_SCHED;
            PG8_LDA(At, 0, 1); PG8_STAGE(PG8_SB(0, 0), b2, voffB); PG8_STAGE(PG8_SB(0, 1), b2 + hstepB, voffB); PG8_STAGE(PG8_SA(0, 0), a2, voffA);
            PG8_WAIT_V(8); PG8_WAIT_L(0); PG8_BAR; PG8_MMA(1, 0, At, B0); PG8_MMA(1, 1, At, B1); PG8_BAR; PG8_SCHED;
            PG8_LDB(B0, 1, 0); PG8_LDB(B1, 1, 1); PG8_SCHED; PG8_LDA(At, 1, 0); PG8_STAGE(PG8_SA(0, 1), a2 + hstepA, voffA);
            PG8_WAIT_V(8); PG8_WAIT_L(0); PG8_BAR; PG8_MMA(0, 0, At, B0); PG8_MMA(0, 1, At, B1); PG8_BAR; PG8_SCHED;
            PG8_LDA(At, 1, 1); PG8_STAGE(PG8_SB(1, 0), b3, voffB); PG8_STAGE(PG8_SB(1, 1), b3 + hstepB, voffB); PG8_STAGE(PG8_SA(1, 0), a3, voffA);
            PG8_WAIT_V(8); PG8_WAIT_L(0); PG8_BAR; PG8_MMA(1, 0, At, B0); PG8_MMA(1, 1, At, B1); PG8_BAR; PG8_SCHED;
            } else {
            PG8_LDB(B0, 0, 0); PG8_SCHED; PG8_LDA(At, 0, 0); PG8_STAGE(PG8_SA(1, 1), a1 + hstepA, voffA);
            PG8_WAIT_L(8); PG8_BAR; PG8_WAIT_L(0); PG8_MMA(0, 0, At, B0); PG8_BAR; PG8_SCHED;
            PG8_LDB(B1, 0, 1); PG8_STAGE(PG8_SB(0, 0), b2, voffB);
            PG8_BAR; PG8_WAIT_L(0); PG8_MMA(0, 1, At, B1); PG8_BAR;
            PG8_LDA(At, 0, 1); PG8_STAGE(PG8_SA(0, 0), a2, voffA);
            PG8_BAR; PG8_WAIT_L(0); PG8_MMA(1, 0, At, B0); PG8_BAR; PG8_SCHED;
            PG8_STAGE(PG8_SB(0, 1), b2 + hstepB, voffB);
            PG8_WAIT_V(6); PG8_BAR; PG8_MMA(1, 1, At, B1); PG8_BAR;
            PG8_LDB(B0, 1, 0); PG8_SCHED; PG8_LDA(At, 1, 0); PG8_STAGE(PG8_SA(0, 1), a2 + hstepA, voffA);
            PG8_WAIT_L(8); PG8_BAR; PG8_WAIT_L(0); PG8_MMA(0, 0, At, B0); PG8_BAR; PG8_SCHED;
            PG8_LDB(B1, 1, 1); PG8_STAGE(PG8_SB(1, 0), b3, voffB);
            PG8_BAR; PG8_WAIT_L(0); PG8_MMA(0, 1, At, B1); PG8_BAR;
            PG8_LDA(At, 1, 1); PG8_STAGE(PG8_SA(1, 0), a3, voffA);
            PG8_BAR; PG8_WAIT_L(0); PG8_MMA(1, 0, At, B0); PG8_BAR; PG8_SCHED;
            PG8_STAGE(PG8_SB(1, 1), b3 + hstepB, voffB);
            PG8_WAIT_V(6); PG8_BAR; PG8_MMA(1, 1, At, B1); PG8_BAR;
            }
        }
        if constexpr (ALIGN_EPI) { if (wr == 0) PG8_BAR; }
        if constexpr (!Epi::AFTER_DRAIN) { E(acc, cur, wr, wc, fr, fq); S.done(cur); }
        if (!has_next) break;
        if (nxt.sub == 0) {
#pragma unroll
        for (int a = 0; a < 2; ++a)
#pragma unroll
            for (int b = 0; b < 2; ++b)
#pragma unroll
                for (int m = 0; m < 4; ++m)
#pragma unroll
                    for (int n = 0; n < 2; ++n) acc[a][b][m][n] = (f32x4){0.f, 0.f, 0.f, 0.f}; }
        cur = nxt; cA = nA; cB = nB; ++ui; nt = g.nt(cur.sub);
        if constexpr (ALIGN_EPI) { if (wr == 1) PG8_BAR; }
    }
    PG8_WAIT_V(0);
    if constexpr (!ALIGN_EPI) { if (wr == 0) PG8_BAR; }
    PG8_BAR;
    if constexpr (Epi::AFTER_DRAIN) { E.fused(acc, cur, wr, wc, fr, fq, lds, wid, lane); S.done(cur); }
#undef PG8_SA
#undef PG8_SB
#undef PG8_STAGE
#undef PG8_LDA
#undef PG8_LDB
#undef PG8_MMA
#undef PG8_WAIT_V
#undef PG8_WAIT_L
#undef PG8_BAR
#undef PG8_SCHED
}
}

namespace pg8 {
typedef float f32x2 __attribute__((ext_vector_type(2)));
__device__ __forceinline__ unsigned cvt_pk_bf16(float lo, float hi) { unsigned r; asm volatile("v_cvt_pk_bf16_f32 %0, %1, %2" : "=v"(r) : "v"(lo), "v"(hi)); return r; }
__device__ __forceinline__ void store8(bf16_t* p, const f32x4 v0, const f32x4 v1) {
    u32x4 w; w.x = cvt_pk_bf16(v0[0], v0[1]); w.y = cvt_pk_bf16(v0[2], v0[3]); w.z = cvt_pk_bf16(v1[0], v1[1]); w.w = cvt_pk_bf16(v1[2], v1[3]); *(u32x4*)p = w; }
__device__ __forceinline__ float fsigmoid(float x) { return __builtin_amdgcn_rcpf(1.0f + __builtin_amdgcn_exp2f(-1.4426950408889634f * x)); }
__device__ __forceinline__ f32x4 act4(const f32x4 v, const int ACT) {
    if (ACT == 0) return v;
    f32x4 o;
#pragma unroll
    for (int j = 0; j < 4; ++j) { const float s = fsigmoid(v[j]); o[j] = (ACT == 1) ? v[j] * s : s; }
    return o; }
__device__ __forceinline__ void bf8_to_f32(const u32x4 w, f32x4& a, f32x4& b) {
    a[0] = __uint_as_float(w.x << 16); a[1] = __uint_as_float(w.x & 0xffff0000u); a[2] = __uint_as_float(w.y << 16); a[3] = __uint_as_float(w.y & 0xffff0000u);
    b[0] = __uint_as_float(w.z << 16); b[1] = __uint_as_float(w.z & 0xffff0000u); b[2] = __uint_as_float(w.w << 16); b[3] = __uint_as_float(w.w & 0xffff0000u); }

constexpr int SEQ_MASK = 4095;
constexpr float MLA_QSCALE = 0.07216878364870322f * 1.4426950408889634f;
__device__ __forceinline__ void rope4(const float* tab, const f32x4 a, const f32x4 b, float sc, bf16_t* p1, bf16_t* p2) {
    typedef unsigned u32x2 __attribute__((ext_vector_type(2)));
    const f32x4 t0 = *(const f32x4*)(tab), t1 = *(const f32x4*)(tab + 4);
    const float o10 = (a[0] * t0[0] - b[0] * t0[1]) * sc, o20 = (b[0] * t0[0] + a[0] * t0[1]) * sc;
    const float o11 = (a[1] * t0[2] - b[1] * t0[3]) * sc, o21 = (b[1] * t0[2] + a[1] * t0[3]) * sc;
    const float o12 = (a[2] * t1[0] - b[2] * t1[1]) * sc, o22 = (b[2] * t1[0] + a[2] * t1[1]) * sc;
    const float o13 = (a[3] * t1[2] - b[3] * t1[3]) * sc, o23 = (b[3] * t1[2] + a[3] * t1[3]) * sc;
    u32x2 w1, w2; w1.x = cvt_pk_bf16(o10, o11); w1.y = cvt_pk_bf16(o12, o13); w2.x = cvt_pk_bf16(o20, o21); w2.y = cvt_pk_bf16(o22, o23);
    *(u32x2*)p1 = w1; *(u32x2*)p2 = w2;
}
#define EPI_FENCE() asm volatile("" ::: "memory")

struct EpiInProj {
    static constexpr bool PERM = true, AFTER_DRAIN = false;
    unsigned char* ws; size_t o_fqkv, o_cq, o_ckv, o_kr, o_rq, o_rk, o_rv, o_rg, o_gates, o_ff, o_t128, o_t64; int skip;
    __device__ __forceinline__ void plain(const f32x4 (&acc)[2][2][4][2], bf16_t* dst, int ld, int colbase, int act, int row0, int wc, int fq) const {
        const int col0 = colbase + wc * 32 + 8 * fq;
#pragma unroll
        for (int ai = 0; ai < 2; ++ai)
#pragma unroll
            for (int m = 0; m < 4; ++m) { bf16_t* rowp = dst + (size_t)(row0 + ai * HALF + m * 16) * ld + col0;
#pragma unroll
                for (int bj = 0; bj < 2; ++bj) { f32x4 v0 = acc[ai][bj][m][0], v1 = acc[ai][bj][m][1];
                    if (act) {
#pragma unroll
                        for (int j = 0; j < 4; ++j) { const float s0 = fsigmoid(v0[j]), s1 = fsigmoid(v1[j]); v0[j] = (act == 1) ? v0[j] * s0 : s0; v1[j] = (act == 1) ? v1[j] * s1 : s1; } }
                    if (skip == 2) { u32x4 w; w.x = cvt_pk_bf16(v0[0], v0[1]); w.y = cvt_pk_bf16(v0[2], v0[3]); w.z = cvt_pk_bf16(v1[0], v1[1]); w.w = cvt_pk_bf16(v1[2], v1[3]); asm volatile("" :: "v"(w)); }
                    else store8(rowp + bj * HALF, v0, v1); }
                EPI_FENCE(); }
    }
    __device__ __forceinline__ void gate_pair(const f32x4 (&acc)[2][2][4][2], bf16_t* dst, int j, int row0, int wc, int fq) const {
        const int col0 = 128 * j + wc * 32 + 8 * fq;
#pragma unroll
        for (int ai = 0; ai < 2; ++ai)
#pragma unroll
            for (int m = 0; m < 4; ++m) { bf16_t* rowp = dst + (size_t)(row0 + ai * HALF + m * 16) * 6144 + col0;
                f32x4 r[2], g[2];
#pragma unroll
                for (int n = 0; n < 2; ++n)
#pragma unroll
                    for (int e = 0; e < 4; ++e) { const float g0 = fmaxf(fsigmoid(acc[ai][0][m][n][e]), 1e-30f), g1 = fmaxf(fsigmoid(acc[ai][1][m][n][e]), 1e-30f);
                        const float g1r = __uint_as_float(cvt_pk_bf16(g1, g1) << 16);
                        g[n][e] = g1r; r[n][e] = g0 * __builtin_amdgcn_rcpf(g1r); }
                store8(rowp, r[0], r[1]); store8(rowp + 2048, g[0], g[1]);
                EPI_FENCE(); }
    }
    __device__ __forceinline__ void rope128(const f32x4 (&acc)[2][2][4][2], bf16_t* dst, int t, float sc, int row0, int wc, int fq) const {
        const int x = 32 * wc + 8 * fq, hh = x >> 6, i0 = x & 63, head = 2 * t + hh; const float* T128 = (const float*)(ws + o_t128);
#pragma unroll
        for (int ai = 0; ai < 2; ++ai)
#pragma unroll
            for (int m = 0; m < 4; ++m) { const int row = row0 + ai * HALF + m * 16, pos = row & SEQ_MASK;
                const float* tp = T128 + ((size_t)pos * 64 + i0) * 2; bf16_t* p = dst + (size_t)row * 512 + 128 * head + i0;
                rope4(tp, acc[ai][0][m][0], acc[ai][1][m][0], sc, p, p + 64); rope4(tp + 8, acc[ai][0][m][1], acc[ai][1][m][1], sc, p + 4, p + 68);
                EPI_FENCE(); }
    }
    __device__ __forceinline__ void misc(const f32x4 (&acc)[2][2][4][2], int row0, int wc, int fq) const {
        if (wc == 0) { const int i0 = 8 * fq; const float* T64 = (const float*)(ws + o_t64); bf16_t* kr = (bf16_t*)(ws + o_kr);
#pragma unroll
            for (int ai = 0; ai < 2; ++ai)
#pragma unroll
                for (int m = 0; m < 4; ++m) { const int row = row0 + ai * HALF + m * 16, pos = row & SEQ_MASK;
                    const float* tp = T64 + ((size_t)pos * 32 + i0) * 2; bf16_t* p = kr + (size_t)row * 64 + i0;
                    rope4(tp, acc[ai][0][m][0], acc[ai][1][m][0], 1.0f, p, p + 32); rope4(tp + 8, acc[ai][0][m][1], acc[ai][1][m][1], 1.0f, p + 4, p + 36);
                    EPI_FENCE(); }
        } else if (wc == 1) { if (fq == 0) { float* ff = (float*)(ws + o_ff);
#pragma unroll
            for (int ai = 0; ai < 2; ++ai)
#pragma unroll
                for (int m = 0; m < 4; ++m) { const int row = row0 + ai * HALF + m * 16; float* p = ff + (size_t)row * 8; *(f32x4*)p = acc[ai][0][m][0]; *(f32x4*)(p + 4) = acc[ai][0][m][1]; } } }
    }
    __device__ __forceinline__ void operator()(const f32x4 (&acc)[2][2][4][2], const Unit& u, int wr, int wc, int fr, int fq) const {
        const int pn = u.pn, row0 = u.pm * BM + wr * 64 + fr;
        if (skip == 1) {
#pragma unroll
            for (int ai = 0; ai < 2; ++ai)
#pragma unroll
                for (int bj = 0; bj < 2; ++bj)
#pragma unroll
                    for (int m = 0; m < 4; ++m) asm volatile("" :: "v"(acc[ai][bj][m][0]), "v"(acc[ai][bj][m][1]));
            return; }
        if (pn >= 25 && pn < 41) gate_pair(acc, (bf16_t*)(ws + o_gates), pn - 25, row0, wc, fq);
        else if (pn == 12) misc(acc, row0, wc, fq);
        else if (pn >= 13 && pn < 17) { const bool isk = pn >= 15; rope128(acc, (bf16_t*)(ws + (isk ? o_rk : o_rq)), isk ? pn - 15 : pn - 13, isk ? 0.08838834764831845f : 1.0f, row0, wc, fq); }
        else { size_t off; int ld, cb, act = 0;
            if (pn < 9) { off = o_fqkv; ld = 2304; cb = 256 * pn; }
            else if (pn < 11) { off = o_cq; ld = 512; cb = 256 * (pn - 9); }
            else if (pn == 11) { off = o_ckv; ld = 256; cb = 0; }
            else if (pn < 21) { off = o_rv; ld = 1024; cb = 256 * (pn - 17); }
            else if (pn < 25) { off = o_rg; ld = 1024; cb = 256 * (pn - 21); act = 1; }
            else { off = o_gates; ld = 6144; cb = 256 * (pn - 25); act = 2; }
            plain(acc, (bf16_t*)(ws + off), ld, cb, act, row0, wc, fq); }
    }
};

struct EpiUq {
    static constexpr bool PERM = true, AFTER_DRAIN = false;
    bf16_t* qm; const float* rstd; const float* T64;
    __device__ __forceinline__ void operator()(const f32x4 (&acc)[2][2][4][2], const Unit& u, int wr, int wc, int fr, int fq) const {
        const int pn = u.pn, row0 = u.pm * BM + wr * 64 + fr;
        float rsv[2][4];
#pragma unroll
        for (int ai = 0; ai < 2; ++ai)
#pragma unroll
            for (int m = 0; m < 4; ++m) rsv[ai][m] = rstd[row0 + ai * HALF + m * 16] * MLA_QSCALE;
        if (pn < 3) {
#pragma unroll
            for (int ai = 0; ai < 2; ++ai)
#pragma unroll
                for (int m = 0; m < 4; ++m) { const int row = row0 + ai * HALF + m * 16; const float rs = rsv[ai][m];
#pragma unroll
                    for (int bj = 0; bj < 2; ++bj) store8(qm + (size_t)row * 1152 + 192 * (2 * pn + bj) + 32 * wc + 8 * fq, acc[ai][bj][m][0] * rs, acc[ai][bj][m][1] * rs);
                    EPI_FENCE(); }
        } else { const int head = (pn == 3) ? wc : 4 + wc; if (head < 6) { const int i0 = 8 * fq;
#pragma unroll
            for (int ai = 0; ai < 2; ++ai)
#pragma unroll
                for (int m = 0; m < 4; ++m) { const int row = row0 + ai * HALF + m * 16, pos = row & SEQ_MASK; const float rs = rsv[ai][m];
                    const float* tp = T64 + ((size_t)pos * 32 + i0) * 2; bf16_t* p = qm + (size_t)row * 1152 + 192 * head + 128 + i0;
                    rope4(tp, acc[ai][0][m][0], acc[ai][1][m][0], rs, p, p + 32); rope4(tp + 8, acc[ai][0][m][1], acc[ai][1][m][1], rs, p + 4, p + 36);
                    EPI_FENCE(); } } }
    }
};
struct EpiUkv {
    static constexpr bool PERM = true, AFTER_DRAIN = false;
    bf16_t* kvm; const float* rstd;
    __device__ __forceinline__ void operator()(const f32x4 (&acc)[2][2][4][2], const Unit& u, int wr, int wc, int fr, int fq) const {
        const int row0 = u.pm * BM + wr * 64 + fr, col0 = u.pn * BM + wc * 32 + 8 * fq;
        float rsv[2][4];
#pragma unroll
        for (int ai = 0; ai < 2; ++ai)
#pragma unroll
            for (int m = 0; m < 4; ++m) rsv[ai][m] = rstd[row0 + ai * HALF + m * 16];
#pragma unroll
        for (int ai = 0; ai < 2; ++ai)
#pragma unroll
            for (int m = 0; m < 4; ++m) { const int row = row0 + ai * HALF + m * 16; const float rs = rsv[ai][m];
#pragma unroll
                for (int bj = 0; bj < 2; ++bj) store8(kvm + (size_t)row * 1536 + col0 + bj * HALF, acc[ai][bj][m][0] * rs, acc[ai][bj][m][1] * rs);
                EPI_FENCE(); }
    }
};
template <int PASS> struct EpiMerge {
    static constexpr bool PERM = true, AFTER_DRAIN = false;
    const bf16_t* gates; float* tmp; bf16_t* out;
    __device__ __forceinline__ void operator()(const f32x4 (&acc)[2][2][4][2], const Unit& u, int wr, int wc, int fr, int fq) const {
        const int row0 = u.pm * BM + wr * 64 + fr, col0 = u.pn * BM + wc * 32 + 8 * fq;
#pragma unroll
        for (int ai = 0; ai < 2; ++ai)
#pragma unroll
            for (int m = 0; m < 4; ++m) { const int row = row0 + ai * HALF + m * 16;
#pragma unroll
                for (int bj = 0; bj < 2; ++bj) { const int col = col0 + bj * HALF;
                    f32x4 g0, g1; bf8_to_f32(*(const u32x4*)(gates + (size_t)row * 6144 + 2048 * PASS + col), g0, g1);
                    f32x4 v0 = g0 * acc[ai][bj][m][0], v1 = g1 * acc[ai][bj][m][1];
                    float* tp = tmp + (size_t)row * 2048 + col;
                    if (PASS > 0) { v0 += *(const f32x4*)tp; v1 += *(const f32x4*)(tp + 4); }
                    if (PASS < 2) { *(f32x4*)tp = v0; *(f32x4*)(tp + 4) = v1; }
                    else store8(out + (size_t)row * 2048 + col, v0, v1);
                    EPI_FENCE(); } }
    }
};
struct EpiMergeM {
    static constexpr bool PERM = true, AFTER_DRAIN = false;
    const bf16_t* gates; bf16_t* out;
    __device__ __forceinline__ void operator()(f32x4 (&acc)[2][2][4][2], const UnitM& u, int wr, int wc, int fr, int fq) const {
        int t_ = threadIdx.x; asm volatile("" : "+v"(t_)); (void)fr; (void)fq; const int lrow0 = wr * 64 + (t_ & 15), lcol0 = wc * 32 + 8 * ((t_ >> 4) & 3);
        const int sub = u.sub;
#pragma unroll
        for (int ai = 0; ai < 2; ++ai) {
            u32x4 ga[4][2], gb[4][2];
#pragma unroll
            for (int m = 0; m < 4; ++m)
#pragma unroll
                for (int bj = 0; bj < 2; ++bj) { const bf16_t* gp = gates + ((size_t)u.pm * BM + lrow0 + ai * HALF + m * 16) * 6144 + 2048 * sub + u.pn * BM + lcol0 + bj * HALF;
                    ga[m][bj] = *(const u32x4*)gp; if (sub == 1) gb[m][bj] = *(const u32x4*)(gp + 2048); }
#pragma unroll
            for (int m = 0; m < 4; ++m)
#pragma unroll
                for (int bj = 0; bj < 2; ++bj) { f32x4 a0, a1; bf8_to_f32(ga[m][bj], a0, a1);
                    if (sub == 0) { acc[ai][bj][m][0] *= a0; acc[ai][bj][m][1] *= a1; continue; }
#pragma unroll
                    for (int j = 0; j < 4; ++j) { a0[j] = fmaxf(a0[j], 1e-30f); a1[j] = fmaxf(a1[j], 1e-30f); }
                    if (sub < 2) { f32x4 b0, b1; bf8_to_f32(gb[m][bj], b0, b1);
#pragma unroll
                        for (int j = 0; j < 4; ++j) { a0[j] *= __builtin_amdgcn_rcpf(fmaxf(b0[j], 1e-30f)); a1[j] *= __builtin_amdgcn_rcpf(fmaxf(b1[j], 1e-30f)); }
                        acc[ai][bj][m][0] *= a0; acc[ai][bj][m][1] *= a1; }
                    else store8(out + ((size_t)u.pm * BM + lrow0 + ai * HALF + m * 16) * 2048 + u.pn * BM + lcol0 + bj * HALF, acc[ai][bj][m][0] * a0, acc[ai][bj][m][1] * a1); }
            EPI_FENCE(); }
    }
};
struct EpiResid {
    static constexpr bool PERM = true, AFTER_DRAIN = false;
    bf16_t* xb;
    __device__ __forceinline__ void operator()(const f32x4 (&acc)[2][2][4][2], const Unit& u, int wr, int wc, int fr, int fq) const {
        int t_ = threadIdx.x; asm volatile("" : "+v"(t_)); (void)fr; (void)fq;
        const int row0 = u.pm * BM + wr * 64 + (t_ & 15), col0 = u.pn * BM + wc * 32 + 8 * ((t_ >> 4) & 3);
#pragma unroll
        for (int ai = 0; ai < 2; ++ai) {
            u32x4 b[4][2];
#pragma unroll
            for (int m = 0; m < 4; ++m)
#pragma unroll
                for (int bj = 0; bj < 2; ++bj) b[m][bj] = *(const u32x4*)(xb + (size_t)(row0 + ai * HALF + m * 16) * 4096 + col0 + bj * HALF);
#pragma unroll
            for (int m = 0; m < 4; ++m)
#pragma unroll
                for (int bj = 0; bj < 2; ++bj) { f32x4 x0, x1; bf8_to_f32(b[m][bj], x0, x1);
                    store8(xb + (size_t)(row0 + ai * HALF + m * 16) * 4096 + col0 + bj * HALF, x0 + acc[ai][bj][m][0], x1 + acc[ai][bj][m][1]); }
            EPI_FENCE(); }
    }
};
__device__ __forceinline__ float gelu_gate(float xc, float g) {
    const float z = xc * __builtin_fmaf(0.044715f * xc, xc, 1.0f);
    return xc * __builtin_amdgcn_rcpf(1.0f + __builtin_amdgcn_exp2f(-2.3022081985378545f * z)) * g;
}
template <int CTRL> __device__ __forceinline__ float dpp_f(float old, float src) {
    return __builtin_bit_cast(float, __builtin_amdgcn_update_dpp(__builtin_bit_cast(int, old), __builtin_bit_cast(int, src), CTRL, 0xf, 0xf, false)); }
struct EpiConvAct {
    static constexpr bool PERM = true, AFTER_DRAIN = false;
    bf16_t* act; float* utail; float* uhead; float* ghead; const float* cw; const float* cb; PG8_LAS float* xbuf;
    __device__ __forceinline__ void operator()(const f32x4 (&acc)[2][2][4][2], const Unit& u, int wr_, int wc_, int fr_, int fq_) const {
        int t_ = threadIdx.x; asm volatile("" : "+v"(t_)); const int fr = t_ & 15, fq = (t_ >> 4) & 3, wr = wr_, wc = wc_; (void)fr_; (void)fq_;
        const int lc = 32 * wc + 8 * fq, f0 = u.pn * HALF + lc;
        if (fr >= 14) {
#pragma unroll
            for (int ai = 0; ai < 2; ++ai) { PG8_LAS float* xp = xbuf + ((2 * ai + wr) * 2 + (fr - 14)) * 128 + lc; *(PG8_LAS f32x4*)xp = acc[ai][0][3][0]; *(PG8_LAS f32x4*)(xp + 4) = acc[ai][0][3][1]; }
            if (wr == 1) { float* tp = utail + ((size_t)u.pm * 2 + (fr - 14)) * 5632 + f0; *(f32x4*)tp = acc[1][0][3][0]; *(f32x4*)(tp + 4) = acc[1][0][3][1]; } }
        if (fr < 2 && wr == 0) { const size_t o = ((size_t)u.pm * 2 + fr) * 5632 + f0;
            *(f32x4*)(uhead + o) = acc[0][0][0][0]; *(f32x4*)(uhead + o + 4) = acc[0][0][0][1]; *(f32x4*)(ghead + o) = acc[0][1][0][0]; *(f32x4*)(ghead + o + 4) = acc[0][1][0][1]; }
        asm volatile("s_waitcnt lgkmcnt(0)" ::: "memory"); __builtin_amdgcn_s_barrier(); asm volatile("" ::: "memory");
        float w0[8], w1[8], w2[8], bb[8];
#pragma unroll
        for (int h = 0; h < 2; ++h) { const f32x4 a = *(const f32x4*)(cw + f0 + 4 * h), b = *(const f32x4*)(cw + 5632 + f0 + 4 * h), c = *(const f32x4*)(cw + 2 * 5632 + f0 + 4 * h), d = *(const f32x4*)(cb + f0 + 4 * h);
#pragma unroll
            for (int j = 0; j < 4; ++j) { w0[4 * h + j] = a[j]; w1[4 * h + j] = b[j]; w2[4 * h + j] = c[j]; bb[4 * h + j] = d[j]; } }
        const int row0 = u.pm * BM + wr * 64 + fr;
#pragma unroll
        for (int ai = 0; ai < 2; ++ai) {
            f32x4 t0a = {0.f, 0.f, 0.f, 0.f}, t0b = t0a, t1a = t0a, t1b = t0a;
            if (2 * ai + wr > 0) { const PG8_LAS float* xp = xbuf + ((2 * ai + wr - 1) * 2) * 128 + lc; t0a = *(const PG8_LAS f32x4*)xp; t0b = *(const PG8_LAS f32x4*)(xp + 4); t1a = *(const PG8_LAS f32x4*)(xp + 128); t1b = *(const PG8_LAS f32x4*)(xp + 132); }
#pragma unroll
            for (int m = 0; m < 4; ++m) { f32x4 o0, o1;
#pragma unroll
                for (int n = 0; n < 2; ++n)
#pragma unroll
                    for (int j = 0; j < 4; ++j) { const int k = 4 * n + j; const float cur = acc[ai][0][m][n][j];
                        float a1, a2;
                        if (m == 0) { const float T0 = n ? t0b[j] : t0a[j], T1 = n ? t1b[j] : t1a[j]; a1 = T1; a2 = (fr == 0) ? T0 : T1; }
                        else { const float pv = acc[ai][0][m - 1][n][j]; a1 = dpp_f<0x10F>(pv, pv); a2 = dpp_f<0x10E>(pv, pv); }
                        const float s1 = dpp_f<0x111>(a1, cur), s2 = dpp_f<0x112>(a2, cur);
                        const float xc = __builtin_fmaf(w2[k], cur, __builtin_fmaf(w1[k], s1, __builtin_fmaf(w0[k], s2, bb[k])));
                        const float r = gelu_gate(xc, acc[ai][1][m][n][j]);
                        if (n == 0) o0[j] = r; else o1[j] = r; }
                store8(act + (size_t)(row0 + ai * HALF + m * 16) * 5632 + f0, o0, o1);
                EPI_FENCE(); } }
    }
};
}

namespace att {
#define ATT_LAS __attribute__((address_space(3)))
typedef unsigned short bf16_t;
typedef short bf16x8 __attribute__((ext_vector_type(8)));
typedef short s16x4 __attribute__((ext_vector_type(4)));
typedef float f32x16 __attribute__((ext_vector_type(16)));
typedef float f32x4 __attribute__((ext_vector_type(4)));
typedef unsigned u32x4 __attribute__((ext_vector_type(4)));
typedef unsigned u32x2 __attribute__((ext_vector_type(2)));
constexpr int SHM_T = 16384;
#define KSWZ(row, colB) ((row) * 256 + ((colB) ^ (((row) & 15) << 4)))
#define KSWZ64(row, colB) ((row) * 128 + ((colB) ^ ((((row) >> 1) & 7) << 4)))
#define SBAR() __builtin_amdgcn_sched_barrier(0)
__device__ __forceinline__ int v_st(int k, int c) { const int kk = (k & ~0xC) | ((k & 4) << 1) | ((k & 8) >> 1); return ((kk >> 3) * 4 + (c >> 5)) * 512 + ((kk & 7) * 32 + (c & 31)) * 2; }
__device__ __forceinline__ int v_rd_base(int lane) { return ((lane & 3) << 3) | (((lane >> 2) & 3) << 6) | (((lane >> 4) & 1) << 5) | (((lane >> 5) & 1) << 8); }
constexpr int v_rd_off(int d0, int ks, int half) { return d0 * 512 + ks * 4096 + half * 2048; }
__device__ __forceinline__ unsigned cvtpk(float lo, float hi) { unsigned r; asm volatile("v_cvt_pk_bf16_f32 %0, %1, %2" : "=v"(r) : "v"(lo), "v"(hi)); return r; }

template <bool ROPE>
__device__ __forceinline__ void qkt(f32x16& p0, f32x16& p1, const ATT_LAS char* Kt, const ATT_LAS char* Kr, int r32, int hi, const bf16x8* qr) {
    p0 = f32x16{}; p1 = f32x16{};
#pragma unroll
    for (int d0 = 0; d0 < 8; ++d0) { const ATT_LAS char* a = Kt + KSWZ(r32, (d0 * 16 + hi * 8) * 2);
        const bf16x8 b0 = *(const ATT_LAS bf16x8*)a, b1 = *(const ATT_LAS bf16x8*)(a + 32 * 256);
        p0 = __builtin_amdgcn_mfma_f32_32x32x16_bf16(b0, qr[d0], p0, 0, 0, 0);
        p1 = __builtin_amdgcn_mfma_f32_32x32x16_bf16(b1, qr[d0], p1, 0, 0, 0); }
    if (ROPE) {
#pragma unroll
        for (int d0 = 0; d0 < 4; ++d0) { const ATT_LAS char* a = Kr + KSWZ64(r32, (d0 * 16 + hi * 8) * 2);
            const bf16x8 b0 = *(const ATT_LAS bf16x8*)a, b1 = *(const ATT_LAS bf16x8*)(a + 32 * 128);
            p0 = __builtin_amdgcn_mfma_f32_32x32x16_bf16(b0, qr[8 + d0], p0, 0, 0, 0);
            p1 = __builtin_amdgcn_mfma_f32_32x32x16_bf16(b1, qr[8 + d0], p1, 0, 0, 0); } }
}
__device__ __forceinline__ void pv_tile_T(f32x16* o, int vb, bf16x8 pa0, bf16x8 pa1, bf16x8 pa2, bf16x8 pa3) {
#define TRRD(dst, off) asm volatile("ds_read_b64_tr_b16 %0, %1 offset:%2" : "=&v"(dst) : "v"(vb), "i"(off) : "memory")
#define PV_D0(d0) do { s16x4 l0, l1, l2, l3, h0, h1, h2, h3; constexpr int b_ = v_rd_off(d0, 0, 0); \
        TRRD(l0, b_); TRRD(h0, b_ + 2048); TRRD(l1, b_ + 4096); TRRD(h1, b_ + 6144); TRRD(l2, b_ + 8192); TRRD(h2, b_ + 10240); TRRD(l3, b_ + 12288); TRRD(h3, b_ + 14336); \
        asm volatile("s_waitcnt lgkmcnt(0)" ::: "memory"); SBAR(); \
        o[d0] = __builtin_amdgcn_mfma_f32_32x32x16_bf16((bf16x8){l0[0], l0[1], l0[2], l0[3], h0[0], h0[1], h0[2], h0[3]}, pa0, o[d0], 0, 0, 0); \
        o[d0] = __builtin_amdgcn_mfma_f32_32x32x16_bf16((bf16x8){l1[0], l1[1], l1[2], l1[3], h1[0], h1[1], h1[2], h1[3]}, pa1, o[d0], 0, 0, 0); \
        o[d0] = __builtin_amdgcn_mfma_f32_32x32x16_bf16((bf16x8){l2[0], l2[1], l2[2], l2[3], h2[0], h2[1], h2[2], h2[3]}, pa2, o[d0], 0, 0, 0); \
        o[d0] = __builtin_amdgcn_mfma_f32_32x32x16_bf16((bf16x8){l3[0], l3[1], l3[2], l3[3], h3[0], h3[1], h3[2], h3[3]}, pa3, o[d0], 0, 0, 0); } while (0)
    PV_D0(0); PV_D0(1); PV_D0(2); PV_D0(3);
#undef PV_D0
#undef TRRD
}
struct VPre { s16x4 l0, l1, l2, l3, h0, h1, h2, h3; };
__device__ __forceinline__ void v_preload(VPre& v, int vb) {
#define TRRD(dst, off) asm volatile("ds_read_b64_tr_b16 %0, %1 offset:%2" : "=&v"(dst) : "v"(vb), "i"(off) : "memory")
    constexpr int b_ = v_rd_off(0, 0, 0);
    TRRD(v.l0, b_); TRRD(v.h0, b_ + 2048); TRRD(v.l1, b_ + 4096); TRRD(v.h1, b_ + 6144); TRRD(v.l2, b_ + 8192); TRRD(v.h2, b_ + 10240); TRRD(v.l3, b_ + 12288); TRRD(v.h3, b_ + 14336);
#undef TRRD
}
__device__ __forceinline__ void pv_tile_T_pre(f32x16* o, int vb, const VPre& v, bf16x8 pa0, bf16x8 pa1, bf16x8 pa2, bf16x8 pa3) {
#define TRRD(dst, off) asm volatile("ds_read_b64_tr_b16 %0, %1 offset:%2" : "=&v"(dst) : "v"(vb), "i"(off) : "memory")
#define PV_D0(d0) do { s16x4 l0, l1, l2, l3, h0, h1, h2, h3; constexpr int b_ = v_rd_off(d0, 0, 0); \
        TRRD(l0, b_); TRRD(h0, b_ + 2048); TRRD(l1, b_ + 4096); TRRD(h1, b_ + 6144); TRRD(l2, b_ + 8192); TRRD(h2, b_ + 10240); TRRD(l3, b_ + 12288); TRRD(h3, b_ + 14336); \
        asm volatile("s_waitcnt lgkmcnt(0)" ::: "memory"); SBAR(); \
        o[d0] = __builtin_amdgcn_mfma_f32_32x32x16_bf16((bf16x8){l0[0], l0[1], l0[2], l0[3], h0[0], h0[1], h0[2], h0[3]}, pa0, o[d0], 0, 0, 0); \
        o[d0] = __builtin_amdgcn_mfma_f32_32x32x16_bf16((bf16x8){l1[0], l1[1], l1[2], l1[3], h1[0], h1[1], h1[2], h1[3]}, pa1, o[d0], 0, 0, 0); \
        o[d0] = __builtin_amdgcn_mfma_f32_32x32x16_bf16((bf16x8){l2[0], l2[1], l2[2], l2[3], h2[0], h2[1], h2[2], h2[3]}, pa2, o[d0], 0, 0, 0); \
        o[d0] = __builtin_amdgcn_mfma_f32_32x32x16_bf16((bf16x8){l3[0], l3[1], l3[2], l3[3], h3[0], h3[1], h3[2], h3[3]}, pa3, o[d0], 0, 0, 0); } while (0)
    asm volatile("s_waitcnt lgkmcnt(0)" ::: "memory"); SBAR();
    o[0] = __builtin_amdgcn_mfma_f32_32x32x16_bf16((bf16x8){v.l0[0], v.l0[1], v.l0[2], v.l0[3], v.h0[0], v.h0[1], v.h0[2], v.h0[3]}, pa0, o[0], 0, 0, 0);
    o[0] = __builtin_amdgcn_mfma_f32_32x32x16_bf16((bf16x8){v.l1[0], v.l1[1], v.l1[2], v.l1[3], v.h1[0], v.h1[1], v.h1[2], v.h1[3]}, pa1, o[0], 0, 0, 0);
    o[0] = __builtin_amdgcn_mfma_f32_32x32x16_bf16((bf16x8){v.l2[0], v.l2[1], v.l2[2], v.l2[3], v.h2[0], v.h2[1], v.h2[2], v.h2[3]}, pa2, o[0], 0, 0, 0);
    o[0] = __builtin_amdgcn_mfma_f32_32x32x16_bf16((bf16x8){v.l3[0], v.l3[1], v.l3[2], v.l3[3], v.h3[0], v.h3[1], v.h3[2], v.h3[3]}, pa3, o[0], 0, 0, 0);
    PV_D0(1); PV_D0(2); PV_D0(3);
#undef PV_D0
#undef TRRD
}
__device__ __forceinline__ void pack_p(const f32x16& p0, const f32x16& p1, bf16x8& pa0, bf16x8& pa1, bf16x8& pa2, bf16x8& pa3) {
#define PK4(P, B_, OUT) do { unsigned a0 = cvtpk(P[B_+0], P[B_+1]), a1 = cvtpk(P[B_+2], P[B_+3]); \
        unsigned b0 = cvtpk(P[B_+4], P[B_+5]), b1 = cvtpk(P[B_+6], P[B_+7]); \
        auto r0 = __builtin_amdgcn_permlane32_swap(a0, b0, false, false); auto r1 = __builtin_amdgcn_permlane32_swap(a1, b1, false, false); \
        u32x4 w = {r0[0], r1[0], r0[1], r1[1]}; OUT = *reinterpret_cast<bf16x8*>(&w); } while (0)
    PK4(p0, 0, pa0); PK4(p0, 8, pa1); PK4(p1, 0, pa2); PK4(p1, 8, pa3);
#undef PK4
}
__device__ __forceinline__ float swap_max(float v) { auto rr = __builtin_amdgcn_permlane32_swap(__float_as_uint(v), __float_as_uint(v), false, false); return fmaxf(__uint_as_float(rr[0]), __uint_as_float(rr[1])); }
__device__ __forceinline__ float swap_sum(float v) { auto rr = __builtin_amdgcn_permlane32_swap(__float_as_uint(v), __float_as_uint(v), false, false); return __uint_as_float(rr[0]) + __uint_as_float(rr[1]); }

__device__ __forceinline__ void store_pair16(bf16_t* row_pair_base  , u32x2 a, u32x2 b) {
    auto rx = __builtin_amdgcn_permlane32_swap(a.x, b.x, false, false); auto ry = __builtin_amdgcn_permlane32_swap(a.y, b.y, false, false);
    const u32x4 w = {rx[0], ry[0], rx[1], ry[1]}; *(u32x4*)row_pair_base = w; }
struct UnitPtrs {
    const bf16_t* Q; int ldq;
    const bf16_t* K; int ldk;
    const bf16_t* V; int ldv;
    const bf16_t* KR;
    const float* bias;
    const bf16_t* G;
    bf16_t* O; int ldo;
    int P0;
    float c2;
    const bf16_t* ST;
    int T0;
};
template <int MODE>
__device__ __forceinline__ void mixer_unit(const UnitPtrs& U, ATT_LAS char* lds, unsigned* qhead, volatile ATT_LAS unsigned* slot) {
    constexpr bool ROPE = (MODE == 1);
    constexpr int NQ = ROPE ? 12 : 8;
    constexpr int K_OFF = 0, KR_OFF = 32768, V_OFF = (MODE == 1) ? 49152 : 32768, V_SZ = (MODE == 2) ? 32768 : 16384, BIAS_OFF = 65536, SCR_OFF = 98304;
    int tid_ = threadIdx.x; asm volatile("" : "+v"(tid_));
    const int tid = tid_, wid = __builtin_amdgcn_readfirstlane(tid >> 6), lane = tid & 63, r32 = lane & 31, hi = lane >> 5;
    const int rg = (MODE == 2) ? (wid >> 1) : wid;
    const int vhalf = (MODE == 2) ? (wid & 1) : 0;
    const int qlo = U.P0 + 32 * rg;
    const int tbase = (MODE == 2) ? (U.T0 >> 6) : 0;
    const int NT = (U.P0 + ((MODE == 2) ? 128 : 256)) / 64 - tbase;
    const int tlast = (qlo >> 6) - tbase;
    bf16x8 qr[NQ];
    { const bf16_t* qp = U.Q + (size_t)(32 * rg + r32) * U.ldq + hi * 8;
#pragma unroll
      for (int d0 = 0; d0 < NQ; ++d0) qr[d0] = *(const bf16x8*)(qp + d0 * 16); }
    const int sr = tid >> 4, sc = (tid & 15) * 8;
    const int kws = KSWZ(sr, sc * 2), vst0 = v_st(sr, sc), vst1 = v_st(32 + sr, sc);
    const int rr = tid >> 3, rc = (tid & 7) * 8, krs = KSWZ64(rr, rc * 2);
    const int vbase = (int)(unsigned)(uintptr_t)(lds + V_OFF) + v_rd_base(lane) + vhalf * SHM_T;
    bf16x8 st_k0, st_k1, st_v0, st_v1, st_v2, st_v3, st_r;
#define ST_LOAD(kb_) do { const bf16_t* kp_ = U.K + (size_t)((kb_) + sr) * U.ldk + sc; st_k0 = *(const bf16x8*)kp_; st_k1 = *(const bf16x8*)(kp_ + (size_t)32 * U.ldk); \
        const bf16_t* vp_ = U.V + (size_t)((kb_) + sr) * U.ldv + sc; st_v0 = *(const bf16x8*)vp_; st_v1 = *(const bf16x8*)(vp_ + (size_t)32 * U.ldv); \
        if (MODE == 2) { st_v2 = *(const bf16x8*)(vp_ + 128); st_v3 = *(const bf16x8*)(vp_ + (size_t)32 * U.ldv + 128); } \
        if (MODE == 1) { st_r = *(const bf16x8*)(U.KR + (size_t)((kb_) + rr) * 64 + rc); } } while (0)
#define ST_WRITE(bf) do { ATT_LAS char* kd_ = lds + K_OFF + (bf) * SHM_T; *(ATT_LAS bf16x8*)(kd_ + kws) = st_k0; *(ATT_LAS bf16x8*)(kd_ + kws + 32 * 256) = st_k1; \
        ATT_LAS char* vd_ = lds + V_OFF + (bf) * V_SZ; *(ATT_LAS bf16x8*)(vd_ + vst0) = st_v0; *(ATT_LAS bf16x8*)(vd_ + vst1) = st_v1; \
        if (MODE == 2) { *(ATT_LAS bf16x8*)(vd_ + SHM_T + vst0) = st_v2; *(ATT_LAS bf16x8*)(vd_ + SHM_T + vst1) = st_v3; } \
        if (MODE == 1) { *(ATT_LAS bf16x8*)(lds + KR_OFF + (bf) * 8192 + krs) = st_r; } } while (0)
    float m_reg = -1e30f, l_reg = 0.f; f32x16 o[4] = {};
    float colf[(MODE == 2) ? 32 : 1];
    if (MODE == 2) {
#pragma unroll
        for (int r = 0; r < 16; ++r) { const int c = (r & 3) + 8 * (r >> 2); colf[r] = __builtin_amdgcn_exp2f(-U.c2 * (float)c); colf[16 + r] = __builtin_amdgcn_exp2f(-U.c2 * (float)(c + 32)); } }
    const int qpos = qlo + r32;
#define TIDX(t) ((MODE == 0) ? (NT - 1 - (t)) : (t))
    ST_LOAD((tbase + TIDX(0)) * 64);
    if (MODE == 0) { const int nk = U.P0 + 256; ATT_LAS float* bl = (ATT_LAS float*)(lds + BIAS_OFF); float bv[8];
#pragma unroll
        for (int j = 0; j < 8; ++j) { const int i = tid + 512 * j; bv[j] = (i < nk) ? U.bias[i] : 0.f; }
#pragma unroll
        for (int j = 0; j < 8; ++j) { const int i = tid + 512 * j; if (i < nk) bl[i] = -bv[j]; } }
    ST_WRITE(0);
    __syncthreads();
    if (MODE == 2) { if (U.ST) {
        const bf16_t* sp = U.ST + (size_t)(vhalf * 128 + r32) * 128 + hi * 8;
        bf16x8 sa[4][8];
#pragma unroll
        for (int d0 = 0; d0 < 4; ++d0)
#pragma unroll
            for (int ks = 0; ks < 8; ++ks) sa[d0][ks] = *(const bf16x8*)(sp + (size_t)d0 * 32 * 128 + ks * 16);
#pragma unroll
        for (int d0 = 0; d0 < 4; ++d0)
#pragma unroll
            for (int ks = 0; ks < 8; ++ks) o[d0] = __builtin_amdgcn_mfma_f32_32x32x16_bf16(sa[d0][ks], qr[ks], o[d0], 0, 0, 0);
        const float rf = __builtin_amdgcn_exp2f(U.c2 * (float)(qpos - U.T0 + 1));
#pragma unroll
        for (int d0 = 0; d0 < 4; ++d0)
#pragma unroll
            for (int r = 0; r < 16; ++r) o[d0][r] *= rf; } }
#define STEP(t, B) do { const int t_ = TIDX(t); const bool more_ = ((t) + 1 < NT); \
        if (more_) ST_LOAD((tbase + TIDX((t) + 1)) * 64); \
        if (t_ <= tlast) { f32x16 p0, p1; bf16x8 pa0, pa1, pa2, pa3; VPre vpre; \
            qkt<ROPE>(p0, p1, lds + K_OFF + (B) * SHM_T, lds + KR_OFF + (B) * 8192, r32, hi, qr); \
            if (MODE != 2) v_preload(vpre, vbase + (B) * V_SZ); \
            const int dq = qpos - (tbase + t_) * 64 - 4 * hi; \
            if (MODE == 2) { \
                if (t_ < tlast) { const float rowf = __builtin_amdgcn_exp2f(U.c2 * (float)dq);     \
                    _Pragma("unroll") for (int r = 0; r < 16; ++r) { p0[r] *= rowf * colf[r]; p1[r] *= rowf * colf[16 + r]; } \
                } else { \
                    _Pragma("unroll") for (int r = 0; r < 16; ++r) { const int c = (r & 3) + 8 * (r >> 2); \
                        p0[r] *= __builtin_amdgcn_exp2f(U.c2 * fabsf((float)(dq - c))); p1[r] *= __builtin_amdgcn_exp2f(U.c2 * fabsf((float)(dq - c - 32))); } } \
            } else { \
                if (MODE == 0) { const ATT_LAS float* bl = (const ATT_LAS float*)(lds + BIAS_OFF) + t_ * 64 + 4 * hi; \
                    _Pragma("unroll") for (int g = 0; g < 4; ++g) { const f32x4 b0 = *(const ATT_LAS f32x4*)(bl + 8 * g), b1 = *(const ATT_LAS f32x4*)(bl + 32 + 8 * g); \
                        _Pragma("unroll") for (int j = 0; j < 4; ++j) { p0[4 * g + j] = fmaf(p0[4 * g + j], U.c2, b0[j]); p1[4 * g + j] = fmaf(p1[4 * g + j], U.c2, b1[j]); } } \
                    if (t_ == tlast) { const float NEG = -__builtin_inff(); \
                        _Pragma("unroll") for (int r = 0; r < 16; ++r) { const int c = (r & 3) + 8 * (r >> 2); if (dq - c < 0) p0[r] = NEG; if (dq - c - 32 < 0) p1[r] = NEG; } } \
                }                                                         \
                float pmax = p0[0]; \
                _Pragma("unroll") for (int r = 1; r < 16; ++r) pmax = fmaxf(pmax, p0[r]); \
                _Pragma("unroll") for (int r = 0; r < 16; ++r) pmax = fmaxf(pmax, p1[r]); \
                pmax = swap_max(pmax); \
                if (__any(pmax > m_reg + ((MODE == 1) ? 8.0f : 0.0f))) { const float mn = fmaxf(m_reg, pmax), alpha = __builtin_amdgcn_exp2f(m_reg - mn); m_reg = mn; l_reg *= alpha; \
                    _Pragma("unroll") for (int d_ = 0; d_ < 4; ++d_) _Pragma("unroll") for (int r = 0; r < 16; ++r) o[d_][r] *= alpha; } \
                float ps = 0.f; \
                _Pragma("unroll") for (int r = 0; r < 16; ++r) { p0[r] = __builtin_amdgcn_exp2f(p0[r] - m_reg); p1[r] = __builtin_amdgcn_exp2f(p1[r] - m_reg); ps += p0[r] + p1[r]; } \
                ps = swap_sum(ps); l_reg += ps; \
            } \
            pack_p(p0, p1, pa0, pa1, pa2, pa3); \
            if (MODE != 2) pv_tile_T_pre(o, vbase + (B) * V_SZ, vpre, pa0, pa1, pa2, pa3); else pv_tile_T(o, vbase + (B) * V_SZ, pa0, pa1, pa2, pa3); } \
        if (more_) ST_WRITE((B) ^ 1); \
        __syncthreads(); } while (0)
    for (int t = 0; t < NT; t += 2) { STEP(t, 0); STEP(t + 1, 1); }
#undef STEP
#undef TIDX
#undef ST_LOAD
#undef ST_WRITE
    unsigned tk = 0u; if (tid == 0) tk = __hip_atomic_fetch_add(qhead, 1u, __ATOMIC_RELAXED, __HIP_MEMORY_SCOPE_AGENT);
    bf16_t* orow = U.O + (size_t)(32 * rg + r32) * U.ldo + vhalf * 128 + 8 * hi;
    if (MODE == 2) {
        float ss = 0.f;
#pragma unroll
        for (int d0 = 0; d0 < 4; ++d0)
#pragma unroll
            for (int r = 0; r < 16; ++r) ss += o[d0][r] * o[d0][r];
        ss = swap_sum(ss);
        ATT_LAS float* scr = (ATT_LAS float*)(lds + SCR_OFF);
        if (hi == 0) scr[wid * 32 + r32] = ss;
        __syncthreads();
        const float tot = ss + scr[(wid ^ 1) * 32 + r32];
        const float rstd = __builtin_amdgcn_rsqf(tot * (1.0f / 256.0f) + 1e-6f);
        const bf16_t* grow = U.G + (size_t)(32 * rg + r32) * 1024 + vhalf * 128 + 4 * hi;
#pragma unroll
        for (int d0 = 0; d0 < 4; ++d0)
#pragma unroll
            for (int gp = 0; gp < 4; gp += 2) { u32x2 w[2];
#pragma unroll
                for (int e = 0; e < 2; ++e) { const int g = gp + e; const u32x2 gw = *(const u32x2*)(grow + 32 * d0 + 8 * g);
                    const float g0 = __uint_as_float(gw.x << 16), g1 = __uint_as_float(gw.x & 0xffff0000u), g2 = __uint_as_float(gw.y << 16), g3 = __uint_as_float(gw.y & 0xffff0000u);
                    w[e].x = cvtpk(o[d0][4 * g] * rstd * g0, o[d0][4 * g + 1] * rstd * g1); w[e].y = cvtpk(o[d0][4 * g + 2] * rstd * g2, o[d0][4 * g + 3] * rstd * g3); }
                store_pair16(orow + 32 * d0 + 8 * gp, w[0], w[1]); }
        __syncthreads();
    } else {
        const float inv = 1.0f / l_reg;
#pragma unroll
        for (int d0 = 0; d0 < 4; ++d0)
#pragma unroll
            for (int gp = 0; gp < 4; gp += 2) { u32x2 w[2];
#pragma unroll
                for (int e = 0; e < 2; ++e) { const int g = gp + e; w[e].x = cvtpk(o[d0][4 * g] * inv, o[d0][4 * g + 1] * inv); w[e].y = cvtpk(o[d0][4 * g + 2] * inv, o[d0][4 * g + 3] * inv); }
                store_pair16(orow + 32 * d0 + 8 * gp, w[0], w[1]); }
    }
    if (tid == 0) *slot = tk;
}

__device__ __forceinline__ void ret_state_unit(const bf16_t* K, int ldk, const bf16_t* V, int ldv, float c2, float* SL, ATT_LAS char* lds) {
    int tid_ = threadIdx.x; asm volatile("" : "+v"(tid_));
    const int tid = tid_, wid = __builtin_amdgcn_readfirstlane(tid >> 6), lane = tid & 63, r32 = lane & 31, hi = lane >> 5;
    const int sr = tid >> 4, sc = (tid & 15) * 8, vst0 = v_st(sr, sc), vst1 = v_st(32 + sr, sc);
    constexpr int KI = 0, VI = 16384;
    const int kb = (int)(unsigned)(uintptr_t)(lds + KI) + v_rd_base(lane), vb = (int)(unsigned)(uintptr_t)(lds + VI) + v_rd_base(lane) + (wid >> 2) * SHM_T;
    f32x16 acc[4] = {};
    for (int t = 0; t < 4; ++t) {
        const bf16_t* kp = K + (size_t)(t * 64 + sr) * ldk + sc; const bf16_t* vp = V + (size_t)(t * 64 + sr) * ldv + sc;
        const u32x4 k0 = *(const u32x4*)kp, k1 = *(const u32x4*)(kp + (size_t)32 * ldk);
        const bf16x8 v0 = *(const bf16x8*)vp, v1 = *(const bf16x8*)(vp + (size_t)32 * ldv), v2 = *(const bf16x8*)(vp + 128), v3 = *(const bf16x8*)(vp + (size_t)32 * ldv + 128);
        const float w0 = __builtin_amdgcn_exp2f(c2 * (float)(255 - (t * 64 + sr))), w1 = __builtin_amdgcn_exp2f(c2 * (float)(255 - (t * 64 + 32 + sr)));
        u32x4 q0, q1;
#define WSC(w, s) cvtpk(__uint_as_float((w) << 16) * (s), __uint_as_float((w) & 0xffff0000u) * (s))
        q0.x = WSC(k0.x, w0); q0.y = WSC(k0.y, w0); q0.z = WSC(k0.z, w0); q0.w = WSC(k0.w, w0); q1.x = WSC(k1.x, w1); q1.y = WSC(k1.y, w1); q1.z = WSC(k1.z, w1); q1.w = WSC(k1.w, w1);
#undef WSC
        __syncthreads();
        *(ATT_LAS u32x4*)(lds + KI + vst0) = q0; *(ATT_LAS u32x4*)(lds + KI + vst1) = q1;
        *(ATT_LAS bf16x8*)(lds + VI + vst0) = v0; *(ATT_LAS bf16x8*)(lds + VI + vst1) = v1; *(ATT_LAS bf16x8*)(lds + VI + SHM_T + vst0) = v2; *(ATT_LAS bf16x8*)(lds + VI + SHM_T + vst1) = v3;
        __syncthreads();
#define TRR(dst, base, off) asm volatile("ds_read_b64_tr_b16 %0, %1 offset:%2" : "=&v"(dst) : "v"(base), "i"(off) : "memory")
#define KS_STEP(ks) do { s16x4 vl, vh, kl0, kh0, kl1, kh1, kl2, kh2, kl3, kh3; \
        TRR(vl, vbw, (ks) * 4096); TRR(vh, vbw, (ks) * 4096 + 2048); \
        TRR(kl0, kb, 0 * 512 + (ks) * 4096); TRR(kh0, kb, 0 * 512 + (ks) * 4096 + 2048); TRR(kl1, kb, 1 * 512 + (ks) * 4096); TRR(kh1, kb, 1 * 512 + (ks) * 4096 + 2048); \
        TRR(kl2, kb, 2 * 512 + (ks) * 4096); TRR(kh2, kb, 2 * 512 + (ks) * 4096 + 2048); TRR(kl3, kb, 3 * 512 + (ks) * 4096); TRR(kh3, kb, 3 * 512 + (ks) * 4096 + 2048); \
        asm volatile("s_waitcnt lgkmcnt(0)" ::: "memory"); SBAR(); \
        const bf16x8 vf = (bf16x8){vl[0], vl[1], vl[2], vl[3], vh[0], vh[1], vh[2], vh[3]}; \
        acc[0] = __builtin_amdgcn_mfma_f32_32x32x16_bf16(vf, (bf16x8){kl0[0], kl0[1], kl0[2], kl0[3], kh0[0], kh0[1], kh0[2], kh0[3]}, acc[0], 0, 0, 0); \
        acc[1] = __builtin_amdgcn_mfma_f32_32x32x16_bf16(vf, (bf16x8){kl1[0], kl1[1], kl1[2], kl1[3], kh1[0], kh1[1], kh1[2], kh1[3]}, acc[1], 0, 0, 0); \
        acc[2] = __builtin_amdgcn_mfma_f32_32x32x16_bf16(vf, (bf16x8){kl2[0], kl2[1], kl2[2], kl2[3], kh2[0], kh2[1], kh2[2], kh2[3]}, acc[2], 0, 0, 0); \
        acc[3] = __builtin_amdgcn_mfma_f32_32x32x16_bf16(vf, (bf16x8){kl3[0], kl3[1], kl3[2], kl3[3], kh3[0], kh3[1], kh3[2], kh3[3]}, acc[3], 0, 0, 0); } while (0)
        const int vbw = vb + (wid & 3) * 512;
        KS_STEP(0); KS_STEP(1); KS_STEP(2); KS_STEP(3);
#undef KS_STEP
#undef TRR
    }
#pragma unroll
    for (int e0 = 0; e0 < 4; ++e0)
#pragma unroll
        for (int r = 0; r < 16; ++r) SL[(size_t)(32 * wid + (r & 3) + 8 * (r >> 2) + 4 * hi) * 128 + 32 * e0 + r32] = acc[e0][r];
    __syncthreads();
}
}

constexpr int DM = 2048, NBATCH = 8, SEQ = 4096, DEPTH = 4, M = NBATCH * SEQ;
constexpr int IN_W = 12358, NIN = 12544, DFF = 5632, NUG = 2 * DFF, NUQ = 1280, NUKV = 1536;
constexpr float NORM_EPS = 1e-6f;
constexpr int NWAVES = 8;
constexpr int PH = 11, NPHASE = DEPTH * PH + 1;

constexpr size_t MiB = 1u << 20;
constexpr size_t WS_CTL = 0, CTL_ZERO_BYTES = 1 * MiB;
constexpr size_t WS_T128 = 1 * MiB, WS_T64 = 3 * MiB, WS_CL = 4 * MiB, WS_RSQ = 5 * MiB, WS_RSKV = 5 * MiB + 512 * 1024, WS_FF = 6 * MiB;
constexpr size_t WS_W = 8 * MiB;
constexpr size_t WO_IN = 0, WO_UQ = WO_IN + (size_t)NIN * DM * 2, WO_UKV = WO_UQ + (size_t)NUQ * 512 * 2, WO_BF = WO_UKV + (size_t)NUKV * 256 * 2, WO_BM = WO_BF + (size_t)DM * 1024 * 2,
                 WO_BR = WO_BM + (size_t)DM * 1024 * 2, WO_OUT = WO_BR + (size_t)DM * 1024 * 2, WO_UG = WO_OUT + (size_t)DM * DM * 2, WO_DN = WO_UG + (size_t)NUG * DM * 2, WO_END = WO_DN + (size_t)DM * DFF * 2;
static_assert(WO_END == 137 * MiB, "weight region");
constexpr size_t WS_H = 146 * MiB;
constexpr size_t WS_BIG = 274 * MiB;
constexpr size_t WS_GATES = WS_BIG, WS_FQKV = WS_GATES + 384 * MiB, WS_CQ = WS_FQKV + 144 * MiB, WS_CKV = WS_CQ + 32 * MiB, WS_RQ = WS_CKV + 16 * MiB, WS_RK = WS_RQ + 32 * MiB,
                 WS_RV = WS_RK + 32 * MiB, WS_RG = WS_RV + 64 * MiB, WS_KR = WS_RG + 64 * MiB, WS_QM = WS_KR + 4 * MiB, WS_KVM = WS_QM + 72 * MiB, WS_A = WS_KVM + 96 * MiB,
                 WS_BM = WS_A + 64 * MiB, WS_C = WS_BM + 64 * MiB, WS_SLOC = WS_C + 64 * MiB, WS_SST = WS_SLOC + 64 * MiB, WS_MIX_END = WS_SST + 32 * MiB;
constexpr size_t WS_TMP = WS_FQKV;
static_assert(WS_RV - WS_FQKV == 256 * MiB, "tmp overlay");
constexpr size_t WS_U = WS_BIG, WS_GT = WS_U + 352 * MiB, WS_ACT = WS_GT + 352 * MiB, WS_FFN_END = WS_ACT + 352 * MiB;
constexpr size_t WS_UTAIL = WS_U, WS_UHEAD = WS_U + 8 * MiB, WS_GHEAD = WS_U + 16 * MiB;
constexpr size_t WS_END = WS_MIX_END > WS_FFN_END ? WS_MIX_END : WS_FFN_END;
constexpr int CW_BAR = 4096;
constexpr int CW_QUEUE = 16384;

constexpr int RING_OFF = 0, RING_BYTES = 131072;
constexpr int LDSCTL_OFF = RING_BYTES, MISC_OFF = LDSCTL_OFF + 320;
constexpr int LDS_BYTES = 147456;
static_assert(MISC_OFF + 128 <= LDS_BYTES, "LDS map");

#define LAS __attribute__((address_space(3)))
typedef unsigned short bf16;
typedef unsigned v4u __attribute__((ext_vector_type(4)));
typedef float f32x4 __attribute__((ext_vector_type(4)));
#define LDS_WAIT() asm volatile("s_waitcnt lgkmcnt(0)" ::: "memory")
__device__ __forceinline__ unsigned f2bf(float f) { unsigned u = __builtin_bit_cast(unsigned, f); return (u + 0x7fffu + ((u >> 16) & 1u)) >> 16; }
__device__ __forceinline__ unsigned pk2(float lo, float hi) { return f2bf(lo) | (f2bf(hi) << 16); }

#define XB_TMO      128
#define XB_XCNT(j)  (256  + 64 * (j))
#define XB_XSUB(j)  (1280 + 64 * (j))
#define XB_XGEN(j)  (2304 + 64 * (j))
#define XB_TOP      3328
#define XB_TOPGEN   3392
#define XCD_BAR_WORDS 3456
#define XB_SPIN_CAP (1u << 18)
__device__ __forceinline__ unsigned xb_ld(unsigned* p)              { return __hip_atomic_load(p, __ATOMIC_RELAXED, __HIP_MEMORY_SCOPE_AGENT); }
__device__ __forceinline__ unsigned xb_add(unsigned* p, unsigned v) { return __hip_atomic_fetch_add(p, v, __ATOMIC_RELAXED, __HIP_MEMORY_SCOPE_AGENT); }
__device__ __forceinline__ unsigned xb_xcc_id() { return (unsigned)__builtin_amdgcn_s_getreg((3 << 11) | 20) & 0xFu; }
#define XB_SPIN(cond, bar) do { unsigned _sp = 0; while (cond) { __builtin_amdgcn_s_sleep(1); \
    if ((++_sp & 255u) == 0u) { if (xb_ld(&(bar)[XB_TMO])) break; if (_sp > XB_SPIN_CAP) { atomicAdd(&(bar)[XB_TMO], 1u); break; } } } } while (0)
struct XcdBarrier { unsigned* bar; unsigned x; volatile LAS unsigned* st; };
__device__ __forceinline__ XcdBarrier xcd_barrier_post(unsigned* bar, volatile LAS unsigned* st) {
    XcdBarrier b; b.bar = bar; b.x = xb_xcc_id(); b.st = st;
    if (threadIdx.x == 0) (void)xb_add(&bar[XB_XCNT(b.x)], 1u);
    return b;
}
__device__ __forceinline__ void xcd_barrier_complete(unsigned* bar, unsigned x, unsigned& nloc, unsigned& nx) {
    const unsigned G = gridDim.x * gridDim.y * gridDim.z;
    unsigned sum, cnt, mine, sp = 0u;
    for (;;) {
        sum = 0u; cnt = 0u; mine = 0u;
#pragma unroll
        for (unsigned j = 0; j < 16; ++j) { const unsigned c = xb_ld(&bar[XB_XCNT(j)]); sum += c; cnt += (c > 0u) ? 1u : 0u; mine = (j == x) ? c : mine; }
        if (sum == G) break;
        __builtin_amdgcn_s_sleep(1);
        if ((++sp & 255u) == 0u) { if (xb_ld(&bar[XB_TMO])) break; if (sp > XB_SPIN_CAP) { atomicAdd(&bar[XB_TMO], 1u); break; } }
    }
    nloc = mine > 0u ? mine : 1u; nx = cnt > 0u ? cnt : 1u;
}
__device__ __forceinline__ void xcd_barrier(const XcdBarrier& b) {
    asm volatile("s_waitcnt vmcnt(0)" ::: "memory");
    __syncthreads();
    if (threadIdx.x == 0) {
        unsigned bx = b.x; size_t bz_ = 0; asm volatile("" : "+s"(bz_), "+s"(bx)); unsigned* bar = b.bar + bz_;
        __builtin_amdgcn_s_waitcnt(0);
        unsigned nloc = b.st[0], nx = b.st[1];
        if (nloc == 0u) { xcd_barrier_complete(bar, bx, nloc, nx); b.st[0] = nloc; b.st[1] = nx; }
        const unsigned old = xb_add(&bar[XB_XSUB(bx)], 1u);
        const unsigned gen = old / nloc;
        if (old + 1u == (gen + 1u) * nloc) {
            __builtin_amdgcn_fence(__ATOMIC_RELEASE, "agent");
            asm volatile("s_waitcnt vmcnt(0)" ::: "memory");
            const unsigned og = xb_add(&bar[XB_TOP], 1u);
            const unsigned tg = og / nx;
            if (og + 1u == (tg + 1u) * nx) xb_add(&bar[XB_TOPGEN], 1u);
            else XB_SPIN(xb_ld(&bar[XB_TOPGEN]) == tg, bar);
            __builtin_amdgcn_fence(__ATOMIC_ACQUIRE, "agent");
            xb_add(&bar[XB_XGEN(bx)], 1u);
            asm volatile("s_waitcnt vmcnt(0)" ::: "memory");
        } else {
            XB_SPIN(xb_ld(&bar[XB_XGEN(bx)]) == gen, bar);
            __builtin_amdgcn_fence(__ATOMIC_ACQUIRE, "agent");
            asm volatile("s_waitcnt vmcnt(0)" ::: "memory");
        }
    }
    __syncthreads();
}

__device__ __forceinline__ float wave_sum(float v, int lane) {
#pragma unroll
    for (int o = 1; o < 64; o <<= 1) v += __builtin_bit_cast(float, __builtin_amdgcn_ds_bpermute((lane ^ o) << 2, __builtin_bit_cast(int, v)));
    return v;
}
__device__ __forceinline__ double lane_up_d(double v, int lane, int o) {
    const int src = (lane >= o ? lane - o : lane) << 2; const unsigned long long u = __builtin_bit_cast(unsigned long long, v);
    const unsigned lo = (unsigned)__builtin_amdgcn_ds_bpermute(src, (int)(unsigned)u), hi = (unsigned)__builtin_amdgcn_ds_bpermute(src, (int)(unsigned)(u >> 32));
    return __builtin_bit_cast(double, ((unsigned long long)hi << 32) | lo);
}
__device__ __forceinline__ void wconv_item(const float* W, int ldw, int src, int valid, const float* kscale, bf16* dst, int K, int k0, LAS float* scr, int lane) {
    const int j = lane & 31; const bool ok = j < valid;
    float wv[32];
#pragma unroll
    for (int i = 0; i < 32; ++i) { const int kk = 2 * i + (lane >> 5); wv[i] = ok ? W[(size_t)(k0 + kk) * ldw + src + j] : 0.f; }
    if (kscale) {
#pragma unroll
        for (int i = 0; i < 32; ++i) wv[i] *= kscale[k0 + 2 * i + (lane >> 5)]; }
#pragma unroll
    for (int i = 0; i < 32; ++i) scr[(2 * i + (lane >> 5)) * 33 + j] = wv[i];
    LDS_WAIT(); asm volatile("" ::: "memory");
    const int c = lane & 7;
#pragma unroll
    for (int jj = 0; jj < 4; ++jj) { const int n = (lane >> 3) + 8 * jj; const LAS float* s = scr + (8 * c) * 33 + n;
        v4u o; o.x = pk2(s[0 * 33], s[1 * 33]); o.y = pk2(s[2 * 33], s[3 * 33]); o.z = pk2(s[4 * 33], s[5 * 33]); o.w = pk2(s[6 * 33], s[7 * 33]);
        *(v4u*)(dst + (size_t)n * K + k0 + 8 * c) = o; }
    LDS_WAIT(); asm volatile("" ::: "memory");
}
__device__ __forceinline__ void inproj_src(int g, int& src, int& valid) {
    const int n = g * 32; valid = 32;
    if (n < 2304) src = n;
    else if (n < 2816) src = 2310 + (n - 2304);
    else if (n < 3072) src = 2822 + (n - 2816);
    else if (n < 3328) { const int p = n - 3072; if (p == 0) src = 3078; else if (p == 32) { src = 2304; valid = 6; } else if (p == 128) src = 3110; else { src = 0; valid = 0; } }
    else if (n < 4352) { const int base = (n < 3840) ? 3142 : 3654; const int p = (n < 3840) ? n - 3328 : n - 3840; const int t = p >> 8, q = p & 255, bj = q >> 7, x = q & 127, hh = x >> 6, i = x & 63;
        src = base + 128 * (2 * t + hh) + 64 * bj + i; }
    else if (n < 5376) src = 4166 + (n - 4352);
    else if (n < 6400) src = 5190 + (n - 5376);
    else if (n < 10496) { const int q = n - 6400, j = q >> 8, bj = (q >> 7) & 1, x = q & 127; src = 6214 + 2048 * bj + 128 * j + x; }
    else src = 6214 + (n - 6400);
}
__device__ __forceinline__ void uq_src(int g, int& src, int& valid) {
    const int n = g * 32; valid = 32;
    if (n < 768) { const int t = n >> 8, q = n & 255, bj = q >> 7, x = q & 127; src = 192 * (2 * t + bj) + x; }
    else { const int t4 = (n >= 1024) ? 1 : 0; const int q = n - 768 - 256 * t4, bj = q >> 7, x = q & 127, hh = (x >> 5) + 4 * t4; if (hh < 6) src = 192 * hh + 128 + 32 * bj; else { src = 0; valid = 0; } }
}

struct Args {
    const float* in[19]; float* out; unsigned char* ws;
    float invf128[64]; float invf64[32];
    int ph_lo, ph_hi;
};

static_assert(sizeof(Args) == 560, "Args layout");

#define KAS __attribute__((address_space(4)))
#define GAS1 __attribute__((address_space(1)))
__device__ __forceinline__ const KAS char* karg_base() { size_t z = 0; asm volatile("" : "+s"(z)); return (const KAS char*)__builtin_amdgcn_kernarg_segment_ptr() + z; }
__device__ __forceinline__ const float* arg_in(int i) { typedef const GAS1 float* gp; return (const float*)(*(const KAS gp*)(karg_base() + 8 * i)); }
__device__ __forceinline__ float* arg_out() { typedef GAS1 float* gp; return (float*)(*(const KAS gp*)(karg_base() + 152)); }
__device__ __forceinline__ unsigned char* arg_ws() { typedef GAS1 unsigned char* gp; return (unsigned char*)(*(const KAS gp*)(karg_base() + 160)); }
__device__ __forceinline__ float arg_invf128(int i) { return *(const KAS float*)(karg_base() + 168 + 4 * i); }
__device__ __forceinline__ float arg_invf64(int i) { return *(const KAS float*)(karg_base() + 424 + 4 * i); }
struct Ctx { int tid, lane, wave, G, vcu, gw, NGW; LAS unsigned char* lds; unsigned char* ws; };
__device__ __forceinline__ Ctx ctx_local(const Ctx& C0) { Ctx C = C0; int t_ = threadIdx.x; asm volatile("" : "+v"(t_)); C.tid = t_; C.lane = t_ & 63; size_t z_ = 0; asm volatile("" : "+s"(C.wave), "+s"(C.gw), "+s"(C.vcu), "+s"(z_)); C.ws = arg_ws() + z_; return C; }

constexpr int XPITCH = 4096;
__device__ __forceinline__ void cvt8(const v4u w, float (&v)[8]) {
    v[0] = __uint_as_float(w.x << 16); v[1] = __uint_as_float(w.x & 0xffff0000u); v[2] = __uint_as_float(w.y << 16); v[3] = __uint_as_float(w.y & 0xffff0000u);
    v[4] = __uint_as_float(w.z << 16); v[5] = __uint_as_float(w.z & 0xffff0000u); v[6] = __uint_as_float(w.w << 16); v[7] = __uint_as_float(w.w & 0xffff0000u); }
__device__ __forceinline__ void rows_rmsnorm_first(const Ctx& C0, const float* x, const float* gain, bf16* xb, bf16* out) { const Ctx C = ctx_local(C0);
    f32x4 g[8];
#pragma unroll
    for (int j = 0; j < 8; ++j) g[j] = ((const f32x4*)gain + C.lane)[64 * j];
    for (int m = C.gw; m < M; m += 2 * C.NGW) {
        const int m2 = m + C.NGW; const bool has2 = m2 < M;
        const f32x4* xa = (const f32x4*)(x + (size_t)m * DM) + C.lane; const f32x4* xq = (const f32x4*)(x + (size_t)(has2 ? m2 : m) * DM) + C.lane;
        f32x4 va[8], vb[8]; float sa = 0.f, sb = 0.f;
#pragma unroll
        for (int j = 0; j < 8; ++j) va[j] = xa[64 * j];
#pragma unroll
        for (int j = 0; j < 8; ++j) vb[j] = xq[64 * j];
#pragma unroll
        for (int j = 0; j < 8; ++j) { sa += (va[j].x * va[j].x + va[j].y * va[j].y) + (va[j].z * va[j].z + va[j].w * va[j].w); sb += (vb[j].x * vb[j].x + vb[j].y * vb[j].y) + (vb[j].z * vb[j].z + vb[j].w * vb[j].w); }
        const float ra = __builtin_amdgcn_rsqf(wave_sum(sa, C.lane) * (1.0f / DM) + NORM_EPS), rb = __builtin_amdgcn_rsqf(wave_sum(sb, C.lane) * (1.0f / DM) + NORM_EPS);
        unsigned long long* oa = (unsigned long long*)(out + (size_t)m * DM) + C.lane; unsigned long long* ya = (unsigned long long*)(xb + (size_t)m * XPITCH) + C.lane;
#pragma unroll
        for (int j = 0; j < 8; ++j) { oa[64 * j] = (unsigned long long)pk2(va[j].x * ra * g[j].x, va[j].y * ra * g[j].y) | ((unsigned long long)pk2(va[j].z * ra * g[j].z, va[j].w * ra * g[j].w) << 32);
            ya[64 * j] = (unsigned long long)pk2(va[j].x, va[j].y) | ((unsigned long long)pk2(va[j].z, va[j].w) << 32); }
        if (has2) { unsigned long long* ob = (unsigned long long*)(out + (size_t)m2 * DM) + C.lane; unsigned long long* yb = (unsigned long long*)(xb + (size_t)m2 * XPITCH) + C.lane;
#pragma unroll
            for (int j = 0; j < 8; ++j) { ob[64 * j] = (unsigned long long)pk2(vb[j].x * rb * g[j].x, vb[j].y * rb * g[j].y) | ((unsigned long long)pk2(vb[j].z * rb * g[j].z, vb[j].w * rb * g[j].w) << 32);
                yb[64 * j] = (unsigned long long)pk2(vb[j].x, vb[j].y) | ((unsigned long long)pk2(vb[j].z, vb[j].w) << 32); } }
    }
}
__device__ __forceinline__ void rows_rmsnorm_bf16(const Ctx& C0, const bf16* xb, const float* gain, bf16* out) { const Ctx C = ctx_local(C0);
    f32x4 g[4][2];
#pragma unroll
    for (int j = 0; j < 4; ++j) { g[j][0] = *(const f32x4*)(gain + 8 * (C.lane + 64 * j)); g[j][1] = *(const f32x4*)(gain + 8 * (C.lane + 64 * j) + 4); }
    for (int m0 = C.gw; m0 < M; m0 += 4 * C.NGW) {
        v4u w[4][4];
#pragma unroll
        for (int q = 0; q < 4; ++q) { const int m = m0 + q * C.NGW; const v4u* xr = (const v4u*)(xb + (size_t)(m < M ? m : m0) * XPITCH) + C.lane;
#pragma unroll
            for (int j = 0; j < 4; ++j) w[q][j] = xr[64 * j]; }
#pragma unroll
        for (int q = 0; q < 4; ++q) { const int m = m0 + q * C.NGW; float s = 0.f;
#pragma unroll
            for (int j = 0; j < 4; ++j) { float v[8]; cvt8(w[q][j], v);
#pragma unroll
                for (int e = 0; e < 8; ++e) s += v[e] * v[e]; }
            const float r = __builtin_amdgcn_rsqf(wave_sum(s, C.lane) * (1.0f / DM) + NORM_EPS);
            if (m < M) { v4u* orow = (v4u*)(out + (size_t)m * DM) + C.lane;
#pragma unroll
                for (int j = 0; j < 4; ++j) { float v[8]; cvt8(w[q][j], v);
                    v4u o; o.x = pk2(v[0] * r * g[j][0][0], v[1] * r * g[j][0][1]); o.y = pk2(v[2] * r * g[j][0][2], v[3] * r * g[j][0][3]); o.z = pk2(v[4] * r * g[j][1][0], v[5] * r * g[j][1][1]); o.w = pk2(v[6] * r * g[j][1][2], v[7] * r * g[j][1][3]);
                    orow[64 * j] = o; } } }
    }
}
__device__ __forceinline__ void rows_rmsnorm_final(const Ctx& C0, float* outp, const float* gain) { const Ctx C = ctx_local(C0);
    f32x4 g[4][2];
#pragma unroll
    for (int j = 0; j < 4; ++j) { g[j][0] = *(const f32x4*)(gain + 8 * (C.lane + 64 * j)); g[j][1] = *(const f32x4*)(gain + 8 * (C.lane + 64 * j) + 4); }
    for (int m0 = C.gw; m0 < M; m0 += 4 * C.NGW) {
        v4u w[4][4];
#pragma unroll
        for (int q = 0; q < 4; ++q) { const int m = m0 + q * C.NGW; const v4u* xr = (const v4u*)((const bf16*)outp + (size_t)(m < M ? m : m0) * XPITCH) + C.lane;
#pragma unroll
            for (int j = 0; j < 4; ++j) w[q][j] = xr[64 * j]; }
        asm volatile("s_waitcnt vmcnt(0)" ::: "memory");
#pragma unroll
        for (int q = 0; q < 4; ++q) { const int m = m0 + q * C.NGW; float s = 0.f;
#pragma unroll
            for (int j = 0; j < 4; ++j) { float v[8]; cvt8(w[q][j], v);
#pragma unroll
                for (int e = 0; e < 8; ++e) s += v[e] * v[e]; }
            const float r = __builtin_amdgcn_rsqf(wave_sum(s, C.lane) * (1.0f / DM) + NORM_EPS);
            if (m < M) { float* orow = outp + (size_t)m * DM + 8 * C.lane;
#pragma unroll
                for (int j = 0; j < 4; ++j) { float v[8]; cvt8(w[q][j], v);
                    *(f32x4*)(orow + 512 * j) = (f32x4){v[0] * r * g[j][0][0], v[1] * r * g[j][0][1], v[2] * r * g[j][0][2], v[3] * r * g[j][0][3]};
                    *(f32x4*)(orow + 512 * j + 4) = (f32x4){v[4] * r * g[j][1][0], v[5] * r * g[j][1][1], v[6] * r * g[j][1][2], v[7] * r * g[j][1][3]}; } } }
    }
}
__device__ __forceinline__ void sincos_d(float angf, float& co, float& si) {
    const double a = (double)angf; const double k = __builtin_rint(a * 0.15915494309189535); double r = a - k * 6.283185307179586477;
    const double q = __builtin_rint(r * 0.63661977236758134308); const double y = r - q * 1.57079632679489661923; const double y2 = y * y;
    const double sy = y * (1.0 + y2 * (-1.0 / 6 + y2 * (1.0 / 120 + y2 * (-1.0 / 5040 + y2 * (1.0 / 362880 + y2 * (-1.0 / 39916800 + y2 * (1.0 / 6227020800.0)))))));
    const double cy = 1.0 + y2 * (-0.5 + y2 * (1.0 / 24 + y2 * (-1.0 / 720 + y2 * (1.0 / 40320 + y2 * (-1.0 / 3628800 + y2 * (1.0 / 479001600 + y2 * (-1.0 / 87178291200.0)))))));
    const int qi = ((int)q) & 3;
    const double s = (qi == 0) ? sy : (qi == 1) ? cy : (qi == 2) ? -sy : -cy;
    const double c = (qi == 0) ? cy : (qi == 1) ? -sy : (qi == 2) ? -cy : sy;
    co = (float)c; si = (float)s;
}
__device__ __forceinline__ void rope_tables(const Ctx& C0, const Args& A) { const Ctx C = ctx_local(C0);
    float* T128 = (float*)(C.ws + WS_T128); float* T64 = (float*)(C.ws + WS_T64);
    const int gt = (C.vcu * NWAVES + C.wave) * 64 + C.lane, NGT = C.NGW * 64;
    for (int e = gt; e < SEQ * 64; e += NGT) { const int pos = e >> 6, i = e & 63; float c, s; sincos_d((float)pos * arg_invf128(i), c, s); T128[2 * e] = c; T128[2 * e + 1] = s; }
    for (int e = gt; e < SEQ * 32; e += NGT) { const int pos = e >> 5, i = e & 31; float c, s; sincos_d((float)pos * arg_invf64(i), c, s); T64[2 * e] = c; T64[2 * e + 1] = s; }
}
__device__ __forceinline__ void p0_phase(const Ctx& C0, const Args& A, int layer) { const Ctx C = ctx_local(C0);
    LAS float* scr = (LAS float*)(C.lds + RING_OFF + C.wave * 16384);
    const float* w_in = arg_in(2) + (size_t)layer * DM * IN_W;
    const float* w_uq = arg_in(5) + (size_t)layer * 512 * 1152; const float* w_ukv = arg_in(6) + (size_t)layer * 256 * 1536;
    const float* qg = arg_in(3) + (size_t)layer * 512; const float* kvg = arg_in(4) + (size_t)layer * 256;
    const float* w_bf = arg_in(8) + (size_t)layer * 768 * DM; const float* w_bm = arg_in(9) + (size_t)layer * 768 * DM; const float* w_br = arg_in(10) + (size_t)layer * 1024 * DM;
    const float* w_out = arg_in(11) + (size_t)layer * DM * DM;
    const float* w_up = arg_in(13) + (size_t)layer * DM * DFF; const float* w_gate = arg_in(14) + (size_t)layer * DM * DFF; const float* w_dn = arg_in(17) + (size_t)layer * DFF * DM;
    bf16* Wb = (bf16*)(C.ws + WS_W);
    constexpr int I_IN = (NIN / 32) * (DM / 64), I_UQ = (NUQ / 32) * (512 / 64), I_UKV = (NUKV / 32) * (256 / 64), I_BF = (DM / 32) * (768 / 64), I_BR = (DM / 32) * (1024 / 64),
                  I_OUT = (DM / 32) * (DM / 64), I_UG = (NUG / 32) * (DM / 64), I_DN = (DM / 32) * (DFF / 64);
    constexpr int NITEMS = I_IN + I_UQ + I_UKV + 2 * I_BF + I_BR + I_OUT;
    for (int it = C.gw; it < NITEMS; it += C.NGW) {
        int r = it, src, valid;
        if (r < I_IN) { const int g = r / (DM / 64), kb = r % (DM / 64); inproj_src(g, src, valid); wconv_item(w_in, IN_W, src, valid, nullptr, (bf16*)((char*)Wb + WO_IN) + (size_t)g * 32 * DM, DM, kb * 64, scr, C.lane); continue; } r -= I_IN;
        if (r < I_UQ) { const int g = r / 8, kb = r % 8; uq_src(g, src, valid); wconv_item(w_uq, 1152, src, valid, qg, (bf16*)((char*)Wb + WO_UQ) + (size_t)g * 32 * 512, 512, kb * 64, scr, C.lane); continue; } r -= I_UQ;
        if (r < I_UKV) { const int g = r / 4, kb = r % 4; wconv_item(w_ukv, 1536, g * 32, 32, kvg, (bf16*)((char*)Wb + WO_UKV) + (size_t)g * 32 * 256, 256, kb * 64, scr, C.lane); continue; } r -= I_UKV;
        if (r < I_BF) { const int g = r / 12, kb = r % 12; wconv_item(w_bf, DM, g * 32, 32, nullptr, (bf16*)((char*)Wb + WO_BF) + (size_t)g * 32 * 1024, 1024, kb * 64, scr, C.lane); continue; } r -= I_BF;
        if (r < I_BF) { const int g = r / 12, kb = r % 12; wconv_item(w_bm, DM, g * 32, 32, nullptr, (bf16*)((char*)Wb + WO_BM) + (size_t)g * 32 * 1024, 1024, kb * 64, scr, C.lane); continue; } r -= I_BF;
        if (r < I_BR) { const int g = r / 16, kb = r % 16; wconv_item(w_br, DM, g * 32, 32, nullptr, (bf16*)((char*)Wb + WO_BR) + (size_t)g * 32 * 1024, 1024, kb * 64, scr, C.lane); continue; } r -= I_BR;
        if (r < I_OUT) { const int g = r / 32, kb = r % 32; wconv_item(w_out, DM, g * 32, 32, nullptr, (bf16*)((char*)Wb + WO_OUT) + (size_t)g * 32 * DM, DM, kb * 64, scr, C.lane); }
    }
    if (layer == 0) rows_rmsnorm_first(C, arg_in(0), arg_in(1), (bf16*)arg_out(), (bf16*)(C.ws + WS_H));
    else rows_rmsnorm_bf16(C, (const bf16*)arg_out(), arg_in(1) + (size_t)layer * DM, (bf16*)(C.ws + WS_H));
}
__device__ __forceinline__ void wconv_ffn(const Ctx& C0, int layer, int first, int nblk) { const Ctx C = ctx_local(C0);
    LAS float* scr = (LAS float*)(C.lds + RING_OFF + C.wave * 16384);
    const float* w_up = arg_in(13) + (size_t)layer * DM * DFF; const float* w_gate = arg_in(14) + (size_t)layer * DM * DFF; const float* w_dn = arg_in(17) + (size_t)layer * DFF * DM;
    bf16* Wb = (bf16*)(C.ws + WS_W);
    constexpr int I_UG = (NUG / 32) * (DM / 64), I_DN = (DM / 32) * (DFF / 64);
    for (int it = first * NWAVES + C.wave; it < I_UG + I_DN; it += nblk * NWAVES) {
        int r = it;
        if (r < I_UG) { const int g = r / 32, kb = r % 32; const int n = g * 32, t = n >> 8, bj = (n >> 7) & 1, x = n & 127;
            wconv_item(bj ? w_gate : w_up, DFF, 128 * t + x, 32, nullptr, (bf16*)((char*)Wb + WO_UG) + (size_t)g * 32 * DM, DM, kb * 64, scr, C.lane); continue; } r -= I_UG;
        { const int g = r / 88, kb = r % 88; wconv_item(w_dn, DM, g * 32, 32, nullptr, (bf16*)((char*)Wb + WO_DN) + (size_t)g * 32 * DFF, DFF, kb * 64, scr, C.lane); }
    }
}
__device__ __forceinline__ void p2_phase(const Ctx& C0, const Args& A, int layer) { const Ctx C = ctx_local(C0);
    const float* ff = (const float*)(C.ws + WS_FF); float* cL = (float*)(C.ws + WS_CL);
    LAS double* red = (LAS double*)(C.lds + RING_OFF);
    for (int sq = C.vcu; sq < NBATCH * 6; sq += C.G) {
        const int b = sq / 6, h = sq % 6; const float bias = arg_in(7)[layer * 6 + h];
        double v[8]; double run = 0.0;
#pragma unroll
        for (int j = 0; j < 8; ++j) { const float xf = ff[((size_t)b * SEQ + C.tid * 8 + j) * 8 + h] + bias;
            const float ls = fminf(xf, 0.f) - 0.6931471805599453f * __builtin_amdgcn_logf(1.0f + __builtin_amdgcn_exp2f(-1.4426950408889634f * fabsf(xf)));
            run += (double)ls; v[j] = run; }
        double incl = run;
#pragma unroll
        for (int o = 1; o < 64; o <<= 1) { const double t = lane_up_d(incl, C.lane, o); if (C.lane >= o) incl += t; }
        __syncthreads();
        if (C.lane == 63) red[C.wave] = incl;
        __syncthreads();
        double base = incl - run;
        for (int w = 0; w < C.wave; ++w) base += red[w];
        float* dst = cL + (size_t)sq * SEQ + C.tid * 8;
#pragma unroll
        for (int j = 0; j < 8; ++j) dst[j] = (float)((base + v[j]) * 1.4426950408889634);
    }
    const bf16* cq = (const bf16*)(C.ws + WS_CQ); const bf16* ckv = (const bf16*)(C.ws + WS_CKV); float* rq = (float*)(C.ws + WS_RSQ); float* rkv = (float*)(C.ws + WS_RSKV);
    for (int m0 = C.gw; m0 < M; m0 += 4 * C.NGW) {
        v4u a[4], c[4];
#pragma unroll
        for (int q = 0; q < 4; ++q) { const int m = m0 + q * C.NGW; const int mm = m < M ? m : m0; a[q] = *((const v4u*)(cq + (size_t)mm * 512) + C.lane); c[q] = *((const v4u*)(ckv + (size_t)mm * 256) + (C.lane & 31)); }
#pragma unroll
        for (int q = 0; q < 4; ++q) { const int m = m0 + q * C.NGW;
            float s = 0.f, s2 = 0.f; const unsigned w[4] = {a[q].x, a[q].y, a[q].z, a[q].w}, w2[4] = {c[q].x, c[q].y, c[q].z, c[q].w};
#pragma unroll
            for (int j = 0; j < 4; ++j) { const float lo = __uint_as_float(w[j] << 16), hi = __uint_as_float(w[j] & 0xffff0000u); s += lo * lo + hi * hi;
                const float lo2 = __uint_as_float(w2[j] << 16), hi2 = __uint_as_float(w2[j] & 0xffff0000u); if (C.lane < 32) s2 += lo2 * lo2 + hi2 * hi2; }
            s = wave_sum(s, C.lane); s2 = wave_sum(s2, C.lane);
            if (C.lane == 0 && m < M) { rq[m] = __builtin_amdgcn_rsqf(s * (1.0f / 512.0f) + NORM_EPS); rkv[m] = __builtin_amdgcn_rsqf(s2 * (1.0f / 256.0f) + NORM_EPS); } }
    }
    { const bf16* rk = (const bf16*)(C.ws + WS_RK); const bf16* rv = (const bf16*)(C.ws + WS_RV); float* sloc = (float*)(C.ws + WS_SLOC);
      for (int u = C.vcu; u < NBATCH * 4 * 16; u += C.G) { const int k = u & 15, h = (u >> 4) & 3, b = u >> 6; const size_t row0 = (size_t)b * SEQ + 256 * k;
          att::ret_state_unit(rk + row0 * 512 + 128 * h, 512, rv + row0 * 1024 + 256 * h, 1024, __builtin_amdgcn_logf(1.0f - __builtin_amdgcn_exp2f(-5.0f - (float)h)), sloc + (size_t)u * 32768, (LAS char*)(C.lds + RING_OFF)); } }
}
__device__ __forceinline__ void ret_scan(const Ctx& C0) { const Ctx C = ctx_local(C0);
    const float* sloc = (const float*)(C.ws + WS_SLOC); bf16* sst = (bf16*)(C.ws + WS_SST);
    for (int it = C.gw * 64 + C.lane; it < NBATCH * 4 * 8192; it += C.NGW * 64) {
        const int bh = it >> 13, e4 = (it & 8191) * 4, h = bh & 3;
        const float g256 = __builtin_amdgcn_exp2f(256.0f * __builtin_amdgcn_logf(1.0f - __builtin_amdgcn_exp2f(-5.0f - (float)h)));
        float z_ = 0.f; asm volatile("" : "+v"(z_));
        f32x4 s = {z_, z_, z_, z_};
        f32x4 l[16];
#pragma unroll
        for (int k = 0; k < 15; ++k) l[k] = *(const f32x4*)(sloc + ((size_t)bh * 16 + k) * 32768 + e4);
#pragma unroll
        for (int k = 0; k < 16; ++k) { const size_t o = ((size_t)bh * 16 + k) * 32768 + e4;
            *(unsigned long long*)(sst + o) = (unsigned long long)pk2(s[0], s[1]) | ((unsigned long long)pk2(s[2], s[3]) << 32);
            if (k < 15) s = s * g256 + l[k]; }
    }
}
__device__ __forceinline__ void p9_phase(const Ctx& C0, const Args& A, int layer) { const Ctx C = ctx_local(C0);
    const float* utail = (const float*)(C.ws + WS_UTAIL); const float* uhead = (const float*)(C.ws + WS_UHEAD); const float* ghead = (const float*)(C.ws + WS_GHEAD); bf16* act = (bf16*)(C.ws + WS_ACT);
    const float* cw = arg_in(15) + (size_t)layer * 3 * DFF; const float* cb = arg_in(16) + (size_t)layer * DFF;
    constexpr int NCH = DFF / 8, NITEM = (M / 256) * 2 * NCH;
    for (int it = C.gw * 64 + C.lane; it < NITEM; it += C.NGW * 64) {
        const int ch = it % NCH, rr = (it / NCH) & 1, pm = it / (2 * NCH), f0 = ch * 8;
        if ((pm & 15) == 0) continue;
        const float* p2 = rr ? utail + ((size_t)(pm - 1) * 2 + 1) * DFF : utail + ((size_t)(pm - 1) * 2) * DFF;
        const float* p1 = rr ? uhead + ((size_t)pm * 2) * DFF : utail + ((size_t)(pm - 1) * 2 + 1) * DFF;
        const float* p0 = uhead + ((size_t)pm * 2 + rr) * DFF; const float* pg = ghead + ((size_t)pm * 2 + rr) * DFF;
        unsigned o[4];
#pragma unroll
        for (int h = 0; h < 2; ++h) { const f32x4 x2 = *(const f32x4*)(p2 + f0 + 4 * h), x1 = *(const f32x4*)(p1 + f0 + 4 * h), x0 = *(const f32x4*)(p0 + f0 + 4 * h), g = *(const f32x4*)(pg + f0 + 4 * h);
            const f32x4 a = *(const f32x4*)(cw + f0 + 4 * h), b = *(const f32x4*)(cw + DFF + f0 + 4 * h), c = *(const f32x4*)(cw + 2 * DFF + f0 + 4 * h), d = *(const f32x4*)(cb + f0 + 4 * h);
            float r[4];
#pragma unroll
            for (int j = 0; j < 4; ++j) r[j] = pg8::gelu_gate(d[j] + a[j] * x2[j] + b[j] * x1[j] + c[j] * x0[j], g[j]);
            o[2 * h] = pg8::cvt_pk_bf16(r[0], r[1]); o[2 * h + 1] = pg8::cvt_pk_bf16(r[2], r[3]); }
        *(v4u*)(act + (size_t)(pm * 256 + rr) * DFF + f0) = (v4u){o[0], o[1], o[2], o[3]};
    }
}
#ifndef PROBE_SKIP_EPI
#define PROBE_SKIP_EPI 0
#endif
#ifndef KIND_MASK
#define KIND_MASK 7
#endif

__device__ __forceinline__ int queue_next(unsigned* head, volatile LAS unsigned* slot) {
    __syncthreads();
    if (threadIdx.x == 0) *slot = __hip_atomic_fetch_add(head, 1u, __ATOMIC_RELAXED, __HIP_MEMORY_SCOPE_AGENT);
    __syncthreads();
    return (int)*slot;
}
__device__ __forceinline__ int queue_after(volatile LAS unsigned* slot) { __syncthreads(); return (int)*slot; }
__device__ __forceinline__ void p4_phase(const Ctx& C0, const Args& A, int layer, volatile LAS unsigned* slot, int rep) { const Ctx C = ctx_local(C0);
    unsigned* qh = (unsigned*)(C.ws + WS_CTL) + CW_QUEUE + 64 * 3 * layer + 64 * 12 * rep;
    const bool k0 = rep == 0 || (KIND_MASK & 1), k1 = rep == 0 || (KIND_MASK & 2), k2 = rep == 0 || (KIND_MASK & 4);
    LAS char* lds = (LAS char*)(C.lds + RING_OFF);
    const bf16* fqkv = (const bf16*)(C.ws + WS_FQKV); const float* cL = (const float*)(C.ws + WS_CL);
    const bf16* qm = (const bf16*)(C.ws + WS_QM); const bf16* kvm = (const bf16*)(C.ws + WS_KVM); const bf16* kr = (const bf16*)(C.ws + WS_KR);
    const bf16* rq = (const bf16*)(C.ws + WS_RQ); const bf16* rk = (const bf16*)(C.ws + WS_RK); const bf16* rv = (const bf16*)(C.ws + WS_RV); const bf16* rg = (const bf16*)(C.ws + WS_RG);
    bf16* oa = (bf16*)(C.ws + WS_A); bf16* ob = (bf16*)(C.ws + WS_BM); bf16* oc = (bf16*)(C.ws + WS_C);
    if (k2) for (int i = queue_next(qh + 128, slot); i < 1024; i = queue_after(slot)) {
        const int qb = 31 - i / 32, bh = i % 32, b = bh >> 2, h = bh & 3; const size_t row0 = (size_t)b * SEQ + 128 * qb, seq0 = (size_t)b * SEQ;
        att::UnitPtrs U; U.Q = rq + row0 * 512 + 128 * h; U.ldq = 512; U.K = rk + seq0 * 512 + 128 * h; U.ldk = 512; U.V = rv + seq0 * 1024 + 256 * h; U.ldv = 1024; U.KR = nullptr; U.bias = nullptr;
        U.G = rg + row0 * 1024 + 256 * h; U.O = oc + row0 * 1024 + 256 * h; U.ldo = 1024; U.P0 = 128 * qb; U.T0 = 256 * (qb >> 1);
        U.ST = (qb >> 1) ? (const bf16*)(C.ws + WS_SST) + ((size_t)bh * 16 + (qb >> 1)) * 32768 : nullptr; U.c2 = __builtin_amdgcn_logf(1.0f - __builtin_amdgcn_exp2f(-5.0f - (float)h));
        att::mixer_unit<2>(U, lds, qh + 128, slot); }
    if (k1) for (int i = queue_next(qh + 64, slot); i < 768; i = queue_after(slot)) {
        const int qb = 15 - i / 48, bh = i % 48, b = bh / 6, h = bh % 6; const size_t row0 = (size_t)b * SEQ + 256 * qb, seq0 = (size_t)b * SEQ;
        att::UnitPtrs U; U.Q = qm + row0 * 1152 + 192 * h; U.ldq = 1152; U.K = kvm + seq0 * 1536 + 256 * h; U.ldk = 1536; U.V = U.K + 128; U.ldv = 1536; U.KR = kr + seq0 * 64; U.bias = nullptr; U.G = nullptr; U.ST = nullptr; U.T0 = 0;
        U.O = ob + row0 * 1024 + 128 * h; U.ldo = 1024; U.P0 = 256 * qb; U.c2 = 0.07216878364870322f * 1.4426950408889634f;
        att::mixer_unit<1>(U, lds, qh + 64, slot); }
    if (k0) for (int i = queue_next(qh, slot); i < 768; i = queue_after(slot)) {
        const int qb = 15 - i / 48, bh = i % 48, b = bh / 6, h = bh % 6; const size_t row0 = (size_t)b * SEQ + 256 * qb, seq0 = (size_t)b * SEQ;
        att::UnitPtrs U; U.Q = fqkv + row0 * 2304 + 128 * h; U.ldq = 2304; U.K = fqkv + seq0 * 2304 + 768 + 128 * h; U.ldk = 2304; U.V = U.K + 768; U.ldv = 2304; U.KR = nullptr; U.G = nullptr; U.ST = nullptr; U.T0 = 0;
        U.bias = cL + (size_t)bh * SEQ; U.O = oa + row0 * 1024 + 128 * h; U.ldo = 1024; U.P0 = 256 * qb; U.c2 = 0.08838834764831845f * 1.4426950408889634f;
        att::mixer_unit<0>(U, lds, qh, slot); }
}

__global__ void __launch_bounds__(NWAVES * 64, 2) hyb_fwd(Args args) {
    extern __shared__ __attribute__((aligned(16))) unsigned char lds_raw[];
    Ctx C;
    C.lds = (LAS unsigned char*)lds_raw;
    volatile LAS unsigned* MISC = (volatile LAS unsigned*)(C.lds + MISC_OFF);
    C.tid = 0; C.lane = 0; C.wave = __builtin_amdgcn_readfirstlane((int)threadIdx.x >> 6);
    C.G = gridDim.x; { const int bx = blockIdx.x; C.vcu = (C.G % 8 == 0) ? (bx % 8) * (C.G / 8) + bx / 8 : bx; }
    C.gw = C.vcu * NWAVES + C.wave; C.NGW = C.G * NWAVES; C.ws = arg_ws();
    unsigned* ctl = (unsigned*)(C.ws + WS_CTL);
    for (int u = threadIdx.x; u < (LDS_BYTES - LDSCTL_OFF) / 4; u += NWAVES * 64) ((LAS unsigned*)(C.lds + LDSCTL_OFF))[u] = 0u;
    __syncthreads();
#if MK_PER_PHASE
    XcdBarrier bar; bar.bar = ctl + CW_BAR; bar.x = 0; bar.st = nullptr; (void)bar;
#define GRID_BAR() do { } while (0)
#else
    XcdBarrier bar = xcd_barrier_post(ctl + CW_BAR, MISC + 8);
#define GRID_BAR() xcd_barrier(bar)
#endif
    const int lo = args.ph_lo, hi = args.ph_hi;
#define IN(k) (lo <= (k) && (k) < hi)
#ifndef PHASE_MASK
#define PHASE_MASK 0xFFFF
#endif
#define PHM(k) (((PHASE_MASK) >> (k)) & 1)
#ifndef SUB_MASK
#define SUB_MASK 0xFF
#endif
#define SUBM(k) (((SUB_MASK) >> (k)) & 1)
#ifndef REPEAT_MASK
#define REPEAT_MASK 0
#endif
#define REPS(k) (1 + (((REPEAT_MASK) >> (k)) & 1))

#define SEAM(k) do { if (IN(k) && IN((k) + 1)) GRID_BAR(); } while (0)
    PG8_LAS unsigned char* ring = (PG8_LAS unsigned char*)(C.lds + RING_OFF);
    const int bid = (int)blockIdx.x;
    if (PHM(0) && IN(0)) rope_tables(C, args);
    for (int layer = 0; layer < DEPTH; ++layer) {
        const int p = layer * PH;
        _Pragma("unroll") for (int rep = 0; rep < REPS(0); ++rep) if (PHM(0) && IN(p + 0)) { p0_phase(C, args, layer); if (rep + 1 < REPS(0)) GRID_BAR(); else SEAM(p + 0); }
        _Pragma("unroll") for (int rep = 0; rep < REPS(1); ++rep) if (PHM(1) && IN(p + 1)) { size_t wz_ = 0; asm volatile("" : "+s"(wz_)); unsigned char* wsl = arg_ws() + wz_; pg8::bf16_t* Wb = (pg8::bf16_t*)(wsl + WS_W); pg8::bf16_t* Hb = (pg8::bf16_t*)(wsl + WS_H);
            pg8::Gemm g{Hb, (const pg8::bf16_t*)((char*)Wb + WO_IN), M, NIN, DM}; pg8::StaticOrder S; S.init(M, NIN, C.G, bid);
            pg8::EpiInProj E{wsl, WS_FQKV, WS_CQ, WS_CKV, WS_KR, WS_RQ, WS_RK, WS_RV, WS_RG, WS_GATES, WS_FF, WS_T128, WS_T64, (rep + 1 < REPS(1)) ? PROBE_SKIP_EPI : 0};
            pg8::gemm_phase<pg8::EpiInProj, pg8::StaticOrder, true, true>(ring, g, S, E);
            { const int nfull = (M / 256) * (NIN / 256) % C.G; if (rep + 1 == REPS(1)) { if (nfull == 0) wconv_ffn(C, layer, bid, C.G); else if (bid >= nfull) wconv_ffn(C, layer, bid - nfull, C.G - nfull); } }
            if (rep + 1 < REPS(1)) GRID_BAR(); else SEAM(p + 1); }
        _Pragma("unroll") for (int rep = 0; rep < REPS(2); ++rep) if (PHM(2) && IN(p + 2)) { p2_phase(C, args, layer); if (rep + 1 < REPS(2)) GRID_BAR(); else SEAM(p + 2); }
        _Pragma("unroll") for (int rep = 0; rep < REPS(3); ++rep) if (PHM(3) && IN(p + 3)) { size_t wz_ = 0; asm volatile("" : "+s"(wz_)); unsigned char* wsl = arg_ws() + wz_; pg8::bf16_t* Wb = (pg8::bf16_t*)(wsl + WS_W); pg8::bf16_t* Hb = (pg8::bf16_t*)(wsl + WS_H);
            if (SUBM(0)) { pg8::Gemm g{(const pg8::bf16_t*)(wsl + WS_CQ), (const pg8::bf16_t*)((char*)Wb + WO_UQ), M, NUQ, 512}; pg8::StaticOrder S; S.init(M, NUQ, C.G, bid);
              pg8::EpiUq E{(pg8::bf16_t*)(wsl + WS_QM), (const float*)(wsl + WS_RSQ), (const float*)(wsl + WS_T64)};
              pg8::gemm_phase<pg8::EpiUq, pg8::StaticOrder, true, true>(ring, g, S, E); }
            if (SUBM(1)) { pg8::Gemm g{(const pg8::bf16_t*)(wsl + WS_CKV), (const pg8::bf16_t*)((char*)Wb + WO_UKV), M, NUKV, 256}; pg8::StaticOrder S; S.init(M, NUKV, C.G, bid);
              pg8::EpiUkv E{(pg8::bf16_t*)(wsl + WS_KVM), (const float*)(wsl + WS_RSKV)};
              pg8::gemm_phase<pg8::EpiUkv, pg8::StaticOrder, true, true>(ring, g, S, E); }
            ret_scan(C);
            if (rep + 1 < REPS(3)) GRID_BAR(); else SEAM(p + 3); }
        _Pragma("unroll") for (int rep = 0; rep < REPS(4); ++rep) if (PHM(4) && IN(p + 4)) { p4_phase(C, args, layer, MISC + 16, rep); if (rep + 1 < REPS(4)) GRID_BAR(); else SEAM(p + 4); }
        _Pragma("unroll") for (int rep = 0; rep < REPS(5); ++rep) if (PHM(5) && IN(p + 5)) { size_t wz_ = 0; asm volatile("" : "+s"(wz_)); unsigned char* wsl = arg_ws() + wz_; pg8::bf16_t* Wb = (pg8::bf16_t*)(wsl + WS_W); pg8::bf16_t* Hb = (pg8::bf16_t*)(wsl + WS_H);
            { static_assert(WS_BM - WS_A == WS_C - WS_BM && WO_BM - WO_BF == WO_BR - WO_BM, "equally spaced sub-GEMM operands");
              pg8::GemmM g{(const pg8::bf16_t*)(wsl + WS_A), (const pg8::bf16_t*)((char*)Wb + WO_BF), (WS_BM - WS_A) / 2, (WO_BM - WO_BF) / 2, 12, 4, 1024, 1024};
              pg8::StaticOrder3 S; S.init(M, DM, C.G, bid);
              pg8::EpiMergeM E{(const pg8::bf16_t*)(wsl + WS_GATES), Hb};
              pg8::gemm_phase_m<pg8::EpiMergeM, pg8::StaticOrder3, true, true>(ring, g, S, E); }
            if (rep + 1 < REPS(5)) GRID_BAR(); else SEAM(p + 5); }
        _Pragma("unroll") for (int rep = 0; rep < REPS(6); ++rep) if (PHM(6) && IN(p + 6)) { size_t wz_ = 0; asm volatile("" : "+s"(wz_)); unsigned char* wsl = arg_ws() + wz_; pg8::bf16_t* Wb = (pg8::bf16_t*)(wsl + WS_W); pg8::bf16_t* Hb = (pg8::bf16_t*)(wsl + WS_H);
            pg8::Gemm g{Hb, (const pg8::bf16_t*)((char*)Wb + WO_OUT), M, DM, DM}; pg8::StaticOrder S; S.init(M, DM, C.G, bid);
            pg8::EpiResid E{(rep + 1 < REPS(6)) ? (pg8::bf16_t*)(wsl + WS_GATES) : (pg8::bf16_t*)arg_out()}; pg8::gemm_phase<pg8::EpiResid, pg8::StaticOrder, true, true>(ring, g, S, E);
            if (rep + 1 < REPS(6)) GRID_BAR(); else SEAM(p + 6); }
        _Pragma("unroll") for (int rep = 0; rep < REPS(7); ++rep) if (PHM(7) && IN(p + 7)) { rows_rmsnorm_bf16(C, (const bf16*)arg_out(), arg_in(12) + (size_t)layer * DM, (bf16*)(C.ws + WS_H)); if (rep + 1 < REPS(7)) GRID_BAR(); else SEAM(p + 7); }
        _Pragma("unroll") for (int rep = 0; rep < REPS(8); ++rep) if (PHM(8) && IN(p + 8)) { size_t wz_ = 0; asm volatile("" : "+s"(wz_)); unsigned char* wsl = arg_ws() + wz_; pg8::bf16_t* Wb = (pg8::bf16_t*)(wsl + WS_W); pg8::bf16_t* Hb = (pg8::bf16_t*)(wsl + WS_H);
            pg8::Gemm g{Hb, (const pg8::bf16_t*)((char*)Wb + WO_UG), M, NUG, DM}; pg8::StaticOrder S; S.init(M, NUG, C.G, bid);
            pg8::EpiConvAct E{(pg8::bf16_t*)(wsl + WS_ACT), (float*)(wsl + WS_UTAIL), (float*)(wsl + WS_UHEAD), (float*)(wsl + WS_GHEAD), arg_in(15) + (size_t)layer * 3 * DFF, arg_in(16) + (size_t)layer * DFF, (PG8_LAS float*)(C.lds + LDSCTL_OFF + 1024)};
            pg8::gemm_phase<pg8::EpiConvAct, pg8::StaticOrder, true, true>(ring, g, S, E);
            if (rep + 1 < REPS(8)) GRID_BAR(); else SEAM(p + 8); }
        _Pragma("unroll") for (int rep = 0; rep < REPS(9); ++rep) if (PHM(9) && IN(p + 9)) { p9_phase(C, args, layer); if (rep + 1 < REPS(9)) GRID_BAR(); else SEAM(p + 9); }
        _Pragma("unroll") for (int rep = 0; rep < REPS(10); ++rep) if (PHM(10) && IN(p + 10)) { size_t wz_ = 0; asm volatile("" : "+s"(wz_)); unsigned char* wsl = arg_ws() + wz_; pg8::bf16_t* Wb = (pg8::bf16_t*)(wsl + WS_W); pg8::bf16_t* Hb = (pg8::bf16_t*)(wsl + WS_H);
            pg8::Gemm g{(const pg8::bf16_t*)(wsl + WS_ACT), (const pg8::bf16_t*)((char*)Wb + WO_DN), M, DM, DFF}; pg8::StaticOrder S; S.init(M, DM, C.G, bid);
            pg8::EpiResid E{(rep + 1 < REPS(10)) ? (pg8::bf16_t*)(wsl + WS_GATES) : (pg8::bf16_t*)arg_out()}; pg8::gemm_phase<pg8::EpiResid, pg8::StaticOrder, true, true>(ring, g, S, E);
            if (rep + 1 < REPS(10)) GRID_BAR(); else SEAM(p + 10); }
    }
    if (IN(DEPTH * PH)) rows_rmsnorm_final(C, arg_out(), arg_in(18));
#if defined(PROBE_EXTRA_BARRIERS) && !MK_PER_PHASE
    for (int i = 0; i < PROBE_EXTRA_BARRIERS; ++i) GRID_BAR();
#endif
#undef IN
#undef SEAM
#undef GRID_BAR
}

extern "C" void kernel_launch(void* const* d_in, const int* in_sizes, int n_in, void* d_out, int out_size, void* d_ws, size_t ws_size, hipStream_t stream) {
    static int grid = 0;
    if (grid == 0) {
        if (n_in != 19 || out_size != M * DM || ws_size < WS_END) { fprintf(stderr, "kernel_launch: unexpected problem (n_in %d, out %d, ws %zu < %zu); nothing launched\n", n_in, out_size, ws_size, (size_t)WS_END); grid = -1; return; }
        int dev = 0, cus = 0, per_cu = 0;
        if (hipGetDevice(&dev) != hipSuccess || hipDeviceGetAttribute(&cus, hipDeviceAttributeMultiprocessorCount, dev) != hipSuccess) { grid = -1; return; }
        if (hipFuncSetAttribute((const void*)hyb_fwd, hipFuncAttributeMaxDynamicSharedMemorySize, LDS_BYTES) != hipSuccess) { fprintf(stderr, "kernel_launch: hipFuncSetAttribute failed\n"); grid = -1; return; }
        if (hipOccupancyMaxActiveBlocksPerMultiprocessor(&per_cu, (const void*)hyb_fwd, NWAVES * 64, LDS_BYTES) != hipSuccess || per_cu < 1) { fprintf(stderr, "kernel_launch: occupancy query says %d\n", per_cu); }
        (void)hipGetLastError();
        grid = cus;
    }
    if (grid < 0) return;
    (void)in_sizes;
    if (hipMemsetAsync((char*)d_ws + WS_CTL, 0, CTL_ZERO_BYTES, stream) != hipSuccess) return;
    Args a; memset(&a, 0, sizeof(a));
    for (int i = 0; i < 19; ++i) a.in[i] = (const float*)d_in[i];
    a.out = (float*)d_out; a.ws = (unsigned char*)d_ws;
    for (int i = 0; i < 64; ++i) a.invf128[i] = (float)pow(10000.0, -(double)(2 * i) / 128.0);
    for (int i = 0; i < 32; ++i) a.invf64[i] = (float)pow(10000.0, -(double)(2 * i) / 64.0);
#if MK_PER_PHASE
    for (int ph = 0; ph < NPHASE; ++ph) { a.ph_lo = ph; a.ph_hi = ph + 1; hipLaunchKernelGGL(hyb_fwd, dim3(grid), dim3(NWAVES * 64), LDS_BYTES, stream, a); }
#else
    a.ph_lo = 0; a.ph_hi = NPHASE; hipLaunchKernelGGL(hyb_fwd, dim3(grid), dim3(NWAVES * 64), LDS_BYTES, stream, a);
#endif
    const hipError_t le = hipPeekAtLastError();
    if (le != hipSuccess) fprintf(stderr, "kernel_launch: launch failed: %s\n", hipGetErrorName(le));
}
```
